# Optimizing an MI355X kernel written in HIP

```python
import math
import jax, jax.numpy as jnp
from jax import lax
import numpy as np

D_MODEL = 1024
BATCH = 8
SEQ = 2048
DEPTH = 1

CHUNK = 64
Q_BLOCK = 128
D_MIX = D_MODEL
D_ATTN = D_MIX // 2
D_RWKV = D_MIX - D_ATTN
DH_A = 64
DV_A = 2 * DH_A
H_A = D_ATTN // DV_A
ROT_DIM = DH_A // 4
ROPE_THETA = 500000.0
QK_NORM_EPS = 1e-6
SUBLN_EPS = 1e-5
RWKV_HEAD = 64
H_R = D_RWKV // RWKV_HEAD
DECAY_LORA = 64
AAA_LORA = 64
GATE_LORA = 128
LN_X_EPS = 64e-5
RWKV_COLS = 3 * D_RWKV + DECAY_LORA + AAA_LORA + GATE_LORA
D_IN = 3 * D_ATTN + RWKV_COLS
N_GROUPS = 4
EXPERTS_PER_GROUP = 8
N_EXPERTS = N_GROUPS * EXPERTS_PER_GROUP
TOP_K = 2
D_EXPERT = 512
MOE_BLOCK = 128
NORM_EPS = 1e-6

kernel_name = 'hymba_diffattn_rwkv7_hmoe_block'


def rms_norm(x, g, eps):
    xf = x.astype(jnp.float32)
    y = xf * lax.rsqrt(jnp.mean(xf * xf, axis=-1, keepdims=True) + eps)
    return (y * g.astype(jnp.float32)).astype(x.dtype)


def rope_tables(seq):
    inv = ROPE_THETA ** (-jnp.arange(0, ROT_DIM, 2, dtype=jnp.float32) / ROT_DIM)
    ang = jnp.arange(seq, dtype=jnp.float32)[:, None] * inv[None, :]
    return jnp.cos(ang), jnp.sin(ang)


def partial_rope(t, cos, sin):
    half = ROT_DIM // 2
    c = cos[None, :, None, None, :].astype(t.dtype)
    s = sin[None, :, None, None, :].astype(t.dtype)
    x1 = t[..., :half]
    x2 = t[..., half:ROT_DIM]
    return jnp.concatenate([x1 * c - x2 * s, x2 * c + x1 * s, t[..., ROT_DIM:]], axis=-1)


def diff_attention(q, k, v, lam):
    b, s = q.shape[0], q.shape[1]
    nb = s // Q_BLOCK
    scale = DH_A ** -0.5
    qb = q.reshape(b, nb, Q_BLOCK, H_A, 2, DH_A).transpose(1, 0, 2, 3, 4, 5)
    key_chunk = jnp.arange(s) // CHUNK

    def one_block(args):
        q_blk, i = args
        sc = jnp.einsum('bqhcd,bkhcd->bhcqk', q_blk, k).astype(jnp.float32) * scale
        q_chunk = (i * Q_BLOCK + jnp.arange(Q_BLOCK)) // CHUNK
        allowed = key_chunk[None, :] <= q_chunk[:, None]
        sc = jnp.where(allowed, sc, jnp.finfo(jnp.float32).min)
        p = jax.nn.softmax(sc, axis=-1)
        p_diff = p[:, :, 0] - lam * p[:, :, 1]
        return jnp.einsum('bhqk,bkhe->bqhe', p_diff.astype(v.dtype), v)

    o = lax.map(one_block, (qb, jnp.arange(nb)))
    return o.transpose(1, 0, 2, 3, 4).reshape(b, s, H_A, DV_A)


def diff_attn_mixer(u, cos, sin, q_norm_g, k_norm_g, lq1, lk1, lq2, lk2, subln_g, lambda_init):
    f32 = jnp.float32
    b, s, _ = u.shape
    q = u[..., :D_ATTN].reshape(b, s, H_A, 2, DH_A)
    k = u[..., D_ATTN:2 * D_ATTN].reshape(b, s, H_A, 2, DH_A)
    v = u[..., 2 * D_ATTN:].reshape(b, s, H_A, DV_A)
    q = partial_rope(rms_norm(q, q_norm_g, QK_NORM_EPS), cos, sin)
    k = partial_rope(rms_norm(k, k_norm_g, QK_NORM_EPS), cos, sin)
    lam = (jnp.exp(jnp.sum(lq1.astype(f32) * lk1.astype(f32)))
           - jnp.exp(jnp.sum(lq2.astype(f32) * lk2.astype(f32))) + lambda_init)
    o = diff_attention(q, k, v, lam)
    o = rms_norm(o, subln_g, SUBLN_EPS) * (1.0 - lambda_init)
    return o.reshape(b, s, D_ATTN)


def rwkv7_mixer(u, shift_mu, w0, w_lora_up, a0, a_lora_up, g_lora_up, k_k, k_a, r_k, ln_x_g, ln_x_b):
    f32 = jnp.float32
    b, s, _ = u.shape
    u_prev = jnp.concatenate([jnp.zeros_like(u[:, :1]), u[:, :-1]], axis=1)
    u = u + (u_prev - u) * shift_mu
    r = u[..., :D_RWKV]
    k = u[..., D_RWKV:2 * D_RWKV]
    v = u[..., 2 * D_RWKV:3 * D_RWKV]
    o = 3 * D_RWKV
    w_lo = u[..., o:o + DECAY_LORA]
    a_lo = u[..., o + DECAY_LORA:o + DECAY_LORA + AAA_LORA]
    g_lo = u[..., o + DECAY_LORA + AAA_LORA:]
    w = -jax.nn.softplus(-(w0.astype(f32) + (jnp.tanh(w_lo) @ w_lora_up).astype(f32))) - 0.5
    decay = jnp.exp(-jnp.exp(w))
    a = jax.nn.sigmoid(a0.astype(f32) + (a_lo @ a_lora_up).astype(f32))
    g = jax.nn.sigmoid(g_lo) @ g_lora_up
    kk = (k.astype(f32) * k_k.astype(f32)).reshape(b, s, H_R, RWKV_HEAD)
    kk = kk / jnp.maximum(jnp.linalg.norm(kk, axis=-1, keepdims=True), 1e-12)
    k_mod = k.astype(f32) * (1.0 + (a - 1.0) * k_a.astype(f32))
    heads = lambda t: t.astype(f32).reshape(b, s, H_R, RWKV_HEAD)
    r_h, k_h, v_h, w_h, a_h = heads(r), heads(k_mod), heads(v), heads(decay), heads(a)
    b_h = kk * a_h

    def step(state, inp):
        r_t, w_t, k_t, v_t, kk_t, b_t = inp
        sa = jnp.einsum('bhvk,bhk->bhv', state, -kk_t)
        state = (state * w_t[:, :, None, :] + sa[..., None] * b_t[:, :, None, :]
                 + v_t[..., None] * k_t[:, :, None, :])
        return state, jnp.einsum('bhvk,bhk->bhv', state, r_t)

    tm = lambda t: jnp.moveaxis(t, 1, 0)
    state0 = jnp.zeros((b, H_R, RWKV_HEAD, RWKV_HEAD), f32)
    _, y = lax.scan(step, state0, (tm(r_h), tm(w_h), tm(k_h), tm(v_h), tm(kk), tm(b_h)))
    y = jnp.moveaxis(y, 0, 1)
    mu = jnp.mean(y, axis=-1, keepdims=True)
    var = jnp.mean(jnp.square(y - mu), axis=-1, keepdims=True)
    y = ((y - mu) * lax.rsqrt(var + LN_X_EPS)).reshape(b, s, D_RWKV)
    y = y * ln_x_g.astype(f32) + ln_x_b.astype(f32)
    bonus = jnp.sum(r_h * k_h * r_k.astype(f32).reshape(H_R, RWKV_HEAD), axis=-1, keepdims=True) * v_h
    y = (y + bonus.reshape(b, s, D_RWKV)) * g.astype(f32)
    return y.astype(u.dtype)


def hier_moe(h, w_rg, b_rg, w_re, b_re, w_gate, w_up, w_down):
    f32 = jnp.float32
    b, s, d = h.shape
    n = b * s
    t = h.reshape(n, d)
    gprob = jax.nn.softmax((t @ w_rg).astype(f32) + b_rg.astype(f32), axis=-1)
    p_group, gsel = lax.top_k(gprob, 1)
    elog = ((t @ w_re).astype(f32) + b_re.astype(f32)).reshape(n, N_GROUPS, EXPERTS_PER_GROUP)
    elog_sel = elog[jnp.arange(n), gsel[:, 0]]
    top_p, top_i = lax.top_k(jax.nn.softmax(elog_sel, axis=-1), TOP_K)
    gate = p_group * top_p / jnp.sum(top_p, axis=-1, keepdims=True)
    eid = gsel * EXPERTS_PER_GROUP + top_i

    flat_e = eid.reshape(-1)
    order = jnp.argsort(flat_e)
    sorted_e = flat_e[order]
    tok = order // TOP_K
    counts = jnp.bincount(flat_e, length=N_EXPERTS)
    padded = (counts + MOE_BLOCK - 1) // MOE_BLOCK * MOE_BLOCK
    pad_ends = jnp.cumsum(padded)
    pad_starts = pad_ends - padded
    starts = jnp.cumsum(counts) - counts
    dest = pad_starts[sorted_e] + (jnp.arange(n * TOP_K) - starts[sorted_e])
    m_pad = n * TOP_K + N_EXPERTS * MOE_BLOCK
    n_blocks = m_pad // MOE_BLOCK
    xs = jnp.zeros((m_pad, d), t.dtype).at[dest].set(t[tok])
    block_e = jnp.minimum(jnp.searchsorted(pad_ends, jnp.arange(n_blocks) * MOE_BLOCK, side='right'),
                          N_EXPERTS - 1)

    def expert_block(args):
        xb, e = args
        return (jax.nn.silu(xb @ w_gate[e]) * (xb @ w_up[e])) @ w_down[e]

    y_pad = lax.map(expert_block, (xs.reshape(n_blocks, MOE_BLOCK, d), block_e)).reshape(m_pad, d)
    dest_by_slot = jnp.zeros((n * TOP_K,), dest.dtype).at[order].set(dest)
    y_slots = y_pad[dest_by_slot].reshape(n, TOP_K, d)
    y = jnp.einsum('nkd,nk->nd', y_slots, gate.astype(y_slots.dtype))
    return y.reshape(b, s, d)


def setup_inputs(seed: int = 0) -> dict:
    key = jax.random.key(seed)
    ks = iter(jax.random.split(key, 32))
    f32 = jnp.float32
    L = DEPTH
    nrm = lambda shape, sc: jax.random.normal(next(ks), shape, f32) * sc
    uni = lambda shape, lo, hi: jax.random.uniform(next(ks), shape, f32, lo, hi)
    return {
        'x': nrm((BATCH, SEQ, D_MODEL), 1.0),
        'ln1_g': 1.0 + nrm((L, D_MODEL), 0.02),
        'w_in': nrm((L, D_MODEL, D_IN), D_MODEL ** -0.5),
        'q_norm_g': 1.0 + nrm((L, DH_A), 0.02),
        'k_norm_g': 1.0 + nrm((L, DH_A), 0.02),
        'lambda_q1': nrm((L, DH_A), 0.1),
        'lambda_k1': nrm((L, DH_A), 0.1),
        'lambda_q2': nrm((L, DH_A), 0.1),
        'lambda_k2': nrm((L, DH_A), 0.1),
        'subln_g': 1.0 + nrm((L, DV_A), 0.02),
        'shift_mu': uni((L, RWKV_COLS), 0.0, 1.0),
        'w0': uni((L, D_RWKV), -6.5, -1.5),
        'w_lora_up': nrm((L, DECAY_LORA, D_RWKV), 0.1),
        'a0': nrm((L, D_RWKV), 0.1),
        'a_lora_up': nrm((L, AAA_LORA, D_RWKV), AAA_LORA ** -0.5),
        'g_lora_up': nrm((L, GATE_LORA, D_RWKV), GATE_LORA ** -0.5),
        'k_k': 0.85 + nrm((L, D_RWKV), 0.02),
        'k_a': 1.0 + nrm((L, D_RWKV), 0.02),
        'r_k': nrm((L, D_RWKV), 0.1),
        'ln_x_g': 1.0 + nrm((L, D_RWKV), 0.02),
        'ln_x_b': nrm((L, D_RWKV), 0.02),
        'w_out': nrm((L, D_MIX, D_MODEL), D_MIX ** -0.5),
        'ln2_g': 1.0 + nrm((L, D_MODEL), 0.02),
        'w_router_group': nrm((L, D_MODEL, N_GROUPS), D_MODEL ** -0.5),
        'b_router_group': nrm((L, N_GROUPS), 0.01),
        'w_router_expert': nrm((L, D_MODEL, N_EXPERTS), D_MODEL ** -0.5),
        'b_router_expert': nrm((L, N_EXPERTS), 0.01),
        'w_exp_gate': nrm((L, N_EXPERTS, D_MODEL, D_EXPERT), D_MODEL ** -0.5),
        'w_exp_up': nrm((L, N_EXPERTS, D_MODEL, D_EXPERT), D_MODEL ** -0.5),
        'w_exp_down': nrm((L, N_EXPERTS, D_EXPERT, D_MODEL), D_EXPERT ** -0.5),
    }


def reference(x, ln1_g, w_in, q_norm_g, k_norm_g, lambda_q1, lambda_k1, lambda_q2, lambda_k2, subln_g,
              shift_mu, w0, w_lora_up, a0, a_lora_up, g_lora_up, k_k, k_a, r_k, ln_x_g, ln_x_b,
              w_out, ln2_g, w_router_group, b_router_group, w_router_expert, b_router_expert,
              w_exp_gate, w_exp_up, w_exp_down):
    cos, sin = rope_tables(x.shape[1])
    h = x
    for l in range(DEPTH):
        lambda_init = 0.8 - 0.6 * math.exp(-0.3 * l)
        u = rms_norm(h, ln1_g[l], NORM_EPS) @ w_in[l]
        o_a = diff_attn_mixer(u[..., :3 * D_ATTN], cos, sin, q_norm_g[l], k_norm_g[l],
                              lambda_q1[l], lambda_k1[l], lambda_q2[l], lambda_k2[l],
                              subln_g[l], lambda_init)
        o_b = rwkv7_mixer(u[..., 3 * D_ATTN:], shift_mu[l], w0[l], w_lora_up[l], a0[l],
                          a_lora_up[l], g_lora_up[l], k_k[l], k_a[l], r_k[l], ln_x_g[l], ln_x_b[l])
        h = h + jnp.concatenate([o_a, o_b], axis=-1) @ w_out[l]
        h = h + hier_moe(rms_norm(h, ln2_g[l], NORM_EPS), w_router_group[l], b_router_group[l],
                         w_router_expert[l], b_router_expert[l], w_exp_gate[l], w_exp_up[l],
                         w_exp_down[l])
    return h
```

```cpp
#include <hip/hip_runtime.h>
#include <cstdio>
#include <cstdint>
#include <cmath>

namespace {
constexpr int BATCH = 8, SEQ = 2048, DM = 1024, M = BATCH * SEQ;
constexpr int DIN = 3328, DATT = 512, DRW = 512, RC = 1792;
constexpr int NEXP = 32, DEXP = 512;
constexpr int QTOK = 4096;

__device__ __forceinline__ float wave_sum(float v) {
#pragma unroll
    for (int o = 1; o < 64; o <<= 1) v += __shfl_xor(v, o);
    return v;
}

__global__ __launch_bounds__(256) void k_rmsnorm(const float* __restrict__ x, const float* __restrict__ g, float* __restrict__ out, int rows, float eps) {
    const int lane = threadIdx.x & 63, w = threadIdx.x >> 6;
    const int row = blockIdx.x * 4 + w;
    if (row >= rows) return;
    const float4* xr = (const float4*)(x + (size_t)row * DM) + lane;
    float4 v[4]; float s = 0.f;
#pragma unroll
    for (int j = 0; j < 4; ++j) { v[j] = xr[64 * j]; s += v[j].x * v[j].x + v[j].y * v[j].y + v[j].z * v[j].z + v[j].w * v[j].w; }
    const float rstd = 1.0f / sqrtf(wave_sum(s) * (1.0f / DM) + eps);
    float4* o = (float4*)(out + (size_t)row * DM) + lane;
    const float4* gg = (const float4*)g + lane;
#pragma unroll
    for (int j = 0; j < 4; ++j) { const float4 gv = gg[64 * j]; float4 r; r.x = v[j].x * rstd * gv.x; r.y = v[j].y * rstd * gv.y; r.z = v[j].z * rstd * gv.z; r.w = v[j].w * rstd * gv.w; o[64 * j] = r; }
}

__global__ __launch_bounds__(256) void k_gemm(const float* __restrict__ A, int lda, const float* __restrict__ B, int ldb, float* C, int ldc, const float* R, int ldr, int K) {
    __shared__ float As[16][68];
    __shared__ float Bs[16][68];
    const int tid = threadIdx.x, tx = tid & 15, ty = tid >> 4;
    const int m0 = blockIdx.y * 64, n0 = blockIdx.x * 64;
    float acc[4][4];
#pragma unroll
    for (int i = 0; i < 4; ++i)
#pragma unroll
        for (int j = 0; j < 4; ++j) acc[i][j] = 0.f;
    for (int k0 = 0; k0 < K; k0 += 16) {
        const float4 a = *(const float4*)&A[(size_t)(m0 + (tid >> 2)) * lda + k0 + (tid & 3) * 4];
        As[(tid & 3) * 4 + 0][tid >> 2] = a.x; As[(tid & 3) * 4 + 1][tid >> 2] = a.y; As[(tid & 3) * 4 + 2][tid >> 2] = a.z; As[(tid & 3) * 4 + 3][tid >> 2] = a.w;
        const float4 b = *(const float4*)&B[(size_t)(k0 + (tid >> 4)) * ldb + n0 + (tid & 15) * 4];
        *(float4*)&Bs[tid >> 4][(tid & 15) * 4] = b;
        __syncthreads();
#pragma unroll
        for (int kk = 0; kk < 16; ++kk) {
            const float4 av = *(const float4*)&As[kk][ty * 4];
            const float4 bv = *(const float4*)&Bs[kk][tx * 4];
            const float aa[4] = {av.x, av.y, av.z, av.w}, bb[4] = {bv.x, bv.y, bv.z, bv.w};
#pragma unroll
            for (int i = 0; i < 4; ++i)
#pragma unroll
                for (int j = 0; j < 4; ++j) acc[i][j] += aa[i] * bb[j];
        }
        __syncthreads();
    }
#pragma unroll
    for (int i = 0; i < 4; ++i) {
        const int r = m0 + ty * 4 + i;
        float4 o = {acc[i][0], acc[i][1], acc[i][2], acc[i][3]};
        if (R) { const float4 rv = *(const float4*)&R[(size_t)r * ldr + n0 + tx * 4]; o.x += rv.x; o.y += rv.y; o.z += rv.z; o.w += rv.w; }
        *(float4*)&C[(size_t)r * ldc + n0 + tx * 4] = o;
    }
}

__global__ __launch_bounds__(256) void k_attn_prep(float* u, const float* __restrict__ qg, const float* __restrict__ kg, int tok0, int ntok) {
    const int lane = threadIdx.x & 63, w = threadIdx.x >> 6;
    const int t = blockIdx.x * 4 + w;
    if (t >= ntok) return;
    const int pos = (tok0 + t) % SEQ;
    float cs = 1.f, sn = 0.f;
    if (lane < 16) {
        const int j = lane & 7;
        const double inv = pow(500000.0, -(double)j / 8.0);
        const double ang = (double)pos * inv;
        cs = (float)cos(ang); sn = (float)sin(ang);
    }
    float* row = u + (size_t)t * DIN;
    for (int grp = 0; grp < 16; ++grp) {
        const float gv = (grp < 8 ? qg : kg)[lane];
        float v = row[grp * 64 + lane];
        const float ss = wave_sum(v * v);
        v = v * (1.0f / sqrtf(ss * (1.0f / 64.0f) + 1e-6f)) * gv;
        const float partner = __shfl_xor(v, 8);
        float o = v;
        if (lane < 8) o = v * cs - partner * sn;
        else if (lane < 16) o = v * cs + partner * sn;
        row[grp * 64 + lane] = o;
    }
}

__global__ __launch_bounds__(256) void k_attn(const float* __restrict__ u, float* __restrict__ mix, int tok0,
                                               const float* __restrict__ lq1, const float* __restrict__ lk1, const float* __restrict__ lq2, const float* __restrict__ lk2,
                                               const float* __restrict__ subg) {
    __shared__ float Qs[64][132];
    __shared__ float Ks[16][128];
    __shared__ float Vs[16][128];
    __shared__ float lam_s;
    const int tid = threadIdx.x, r = tid >> 2, p = tid & 3;
    const int qt = blockIdx.x, h = blockIdx.y, bl = blockIdx.z;
    const size_t base = (size_t)bl * SEQ;
    if (tid == 0) {
        float s1 = 0.f, s2 = 0.f;
        for (int i = 0; i < 64; ++i) { s1 += lq1[i] * lk1[i]; s2 += lq2[i] * lk2[i]; }
        lam_s = expf(s1) - expf(s2) + 0.2f;
    }
    for (int i = tid; i < 64 * 32; i += 256) {
        const int rr = i >> 5, c4 = i & 31;
        *(float4*)&Qs[rr][c4 * 4] = *(const float4*)&u[(base + qt * 64 + rr) * DIN + h * 128 + c4 * 4];
    }
    __syncthreads();
    const float lam = lam_s;
    float m0 = -1e30f, m1 = -1e30f, l0 = 0.f, l1 = 0.f;
    float a0[32], a1[32];
#pragma unroll
    for (int e = 0; e < 32; ++e) { a0[e] = 0.f; a1[e] = 0.f; }
    const int nkt = (qt + 1) * 4;
    for (int kt = 0; kt < nkt; ++kt) {
        __syncthreads();
        for (int i = tid; i < 16 * 32; i += 256) {
            const int rr = i >> 5, c4 = i & 31;
            const size_t tok = base + kt * 16 + rr;
            *(float4*)&Ks[rr][c4 * 4] = *(const float4*)&u[tok * DIN + 512 + h * 128 + c4 * 4];
            *(float4*)&Vs[rr][c4 * 4] = *(const float4*)&u[tok * DIN + 1024 + h * 128 + c4 * 4];
        }
        __syncthreads();
        float s0[16], s1[16];
#pragma unroll
        for (int j = 0; j < 16; ++j) {
            float x0 = 0.f, x1 = 0.f;
#pragma unroll 8
            for (int d = 0; d < 64; d += 4) {
                const float4 q0 = *(const float4*)&Qs[r][d], q1 = *(const float4*)&Qs[r][64 + d];
                const float4 k0 = *(const float4*)&Ks[j][d], k1 = *(const float4*)&Ks[j][64 + d];
                x0 += q0.x * k0.x + q0.y * k0.y + q0.z * k0.z + q0.w * k0.w;
                x1 += q1.x * k1.x + q1.y * k1.y + q1.z * k1.z + q1.w * k1.w;
            }
            s0[j] = x0 * 0.125f; s1[j] = x1 * 0.125f;
        }
        float t0 = m0, t1 = m1;
#pragma unroll
        for (int j = 0; j < 16; ++j) { t0 = fmaxf(t0, s0[j]); t1 = fmaxf(t1, s1[j]); }
        const float f0 = expf(m0 - t0), f1 = expf(m1 - t1);
        m0 = t0; m1 = t1; l0 *= f0; l1 *= f1;
#pragma unroll
        for (int e = 0; e < 32; ++e) { a0[e] *= f0; a1[e] *= f1; }
#pragma unroll
        for (int j = 0; j < 16; ++j) {
            const float p0 = expf(s0[j] - m0), p1 = expf(s1[j] - m1);
            l0 += p0; l1 += p1;
#pragma unroll
            for (int e = 0; e < 32; e += 4) {
                const float4 vv = *(const float4*)&Vs[j][p * 32 + e];
                a0[e] += p0 * vv.x; a0[e + 1] += p0 * vv.y; a0[e + 2] += p0 * vv.z; a0[e + 3] += p0 * vv.w;
                a1[e] += p1 * vv.x; a1[e + 1] += p1 * vv.y; a1[e + 2] += p1 * vv.z; a1[e + 3] += p1 * vv.w;
            }
        }
    }
    const float i0 = 1.0f / l0, i1 = lam / l1;
    float ss = 0.f;
#pragma unroll
    for (int e = 0; e < 32; ++e) { a0[e] = a0[e] * i0 - a1[e] * i1; ss += a0[e] * a0[e]; }
    ss += __shfl_xor(ss, 1); ss += __shfl_xor(ss, 2);
    const float rs = 0.8f / sqrtf(ss * (1.0f / 128.0f) + 1e-5f);
    float* orow = mix + ((size_t)tok0 + base + qt * 64 + r) * DM + h * 128 + p * 32;
#pragma unroll
    for (int e = 0; e < 32; ++e) orow[e] = a0[e] * rs * subg[p * 32 + e];
}

__global__ __launch_bounds__(512) void k_rwkv_prep(const float* __restrict__ u, int tok0, int ntok,
        const float* __restrict__ mu, const float* __restrict__ w0, const float* __restrict__ wup, const float* __restrict__ a0p, const float* __restrict__ aup,
        const float* __restrict__ gup, const float* __restrict__ kk_w, const float* __restrict__ ka_w,
        float* __restrict__ pr, float* __restrict__ pdec, float* __restrict__ pkm, float* __restrict__ pv, float* __restrict__ pkk, float* __restrict__ pb, float* __restrict__ pg) {
    __shared__ float sh[RC];
    __shared__ float tw[64], al[64], sg[128];
    const int t = blockIdx.x, c = threadIdx.x;
    const int pos = (tok0 + t) % SEQ;
    const float* ur = u + (size_t)t * DIN + 1536;
    const float* up = ur - DIN;
    for (int i = c; i < RC; i += 512) {
        const float cur = ur[i];
        const float prev = pos == 0 ? 0.f : up[i];
        sh[i] = cur + (prev - cur) * mu[i];
    }
    __syncthreads();
    if (c < 64) { tw[c] = tanhf(sh[1536 + c]); al[c] = sh[1600 + c]; }
    if (c >= 64 && c < 192) { sg[c - 64] = 1.0f / (1.0f + expf(-sh[1664 + c - 64])); }
    __syncthreads();
    float wv = w0[c], av = a0p[c], gv = 0.f;
#pragma unroll 4
    for (int j = 0; j < 64; ++j) { wv += tw[j] * wup[j * DRW + c]; av += al[j] * aup[j * DRW + c]; }
#pragma unroll 4
    for (int j = 0; j < 128; ++j) gv += sg[j] * gup[j * DRW + c];
    const float nx = -wv;
    const float sp = fmaxf(nx, 0.f) + log1pf(expf(-fabsf(nx)));
    const float w = -sp - 0.5f;
    const float dec = expf(-expf(w));
    const float a = 1.0f / (1.0f + expf(-av));
    const float rr = sh[c], kx = sh[512 + c], vx = sh[1024 + c];
    const float kkr = kx * kk_w[c];
    const float nrm = sqrtf(wave_sum(kkr * kkr));
    const float kk = kkr / fmaxf(nrm, 1e-12f);
    const float km = kx * (1.0f + (a - 1.0f) * ka_w[c]);
    const size_t o = (size_t)t * DRW + c;
    pr[o] = rr; pdec[o] = dec; pkm[o] = km; pv[o] = vx; pkk[o] = kk; pb[o] = kk * a; pg[o] = gv;
}

__global__ __launch_bounds__(256) void k_rwkv_scan(const float* __restrict__ pr, const float* __restrict__ pdec, const float* __restrict__ pkm, const float* __restrict__ pv,
                                                    const float* __restrict__ pkk, const float* __restrict__ pb, float* __restrict__ py) {
    const int tid = threadIdx.x, v = tid >> 2, part = tid & 3;
    const int h = blockIdx.x, bl = blockIdx.y;
    float st[16];
#pragma unroll
    for (int i = 0; i < 16; ++i) st[i] = 0.f;
    const size_t cb = (size_t)h * 64 + part * 16;
    for (int t = 0; t < SEQ; ++t) {
        const size_t ro = ((size_t)bl * SEQ + t) * DRW;
        float kk[16], dd[16], bb[16], km[16], rr[16];
#pragma unroll
        for (int i = 0; i < 16; i += 4) {
            const float4 a = *(const float4*)&pkk[ro + cb + i]; kk[i] = a.x; kk[i + 1] = a.y; kk[i + 2] = a.z; kk[i + 3] = a.w;
            const float4 b = *(const float4*)&pdec[ro + cb + i]; dd[i] = b.x; dd[i + 1] = b.y; dd[i + 2] = b.z; dd[i + 3] = b.w;
            const float4 c = *(const float4*)&pb[ro + cb + i]; bb[i] = c.x; bb[i + 1] = c.y; bb[i + 2] = c.z; bb[i + 3] = c.w;
            const float4 d = *(const float4*)&pkm[ro + cb + i]; km[i] = d.x; km[i + 1] = d.y; km[i + 2] = d.z; km[i + 3] = d.w;
            const float4 e = *(const float4*)&pr[ro + cb + i]; rr[i] = e.x; rr[i + 1] = e.y; rr[i + 2] = e.z; rr[i + 3] = e.w;
        }
        const float vv = pv[ro + h * 64 + v];
        float sa = 0.f;
#pragma unroll
        for (int i = 0; i < 16; ++i) sa -= st[i] * kk[i];
        sa += __shfl_xor(sa, 1); sa += __shfl_xor(sa, 2);
        float y = 0.f;
#pragma unroll
        for (int i = 0; i < 16; ++i) { st[i] = st[i] * dd[i] + sa * bb[i] + vv * km[i]; y += st[i] * rr[i]; }
        y += __shfl_xor(y, 1); y += __shfl_xor(y, 2);
        if (part == 0) py[ro + h * 64 + v] = y;
    }
}

__global__ __launch_bounds__(256) void k_rwkv_post(const float* __restrict__ py, const float* __restrict__ pr, const float* __restrict__ pkm, const float* __restrict__ pv, const float* __restrict__ pg,
                                                    const float* __restrict__ rk, const float* __restrict__ lng, const float* __restrict__ lnb, float* __restrict__ mix, int tok0, int ntok) {
    const int lane = threadIdx.x & 63, w = threadIdx.x >> 6;
    const int idx = blockIdx.x * 4 + w;
    if (idx >= ntok * 8) return;
    const int t = idx >> 3, h = idx & 7, c = h * 64 + lane;
    const size_t o = (size_t)t * DRW + c;
    const float y = py[o];
    const float mean = wave_sum(y) * (1.0f / 64.0f);
    const float d = y - mean;
    const float var = wave_sum(d * d) * (1.0f / 64.0f);
    const float yn = d * (1.0f / sqrtf(var + 64e-5f)) * lng[c] + lnb[c];
    const float bonus = wave_sum(pr[o] * pkm[o] * rk[c]) * pv[o];
    mix[((size_t)tok0 + t) * DM + 512 + c] = (yn + bonus) * pg[o];
}

__global__ __launch_bounds__(256) void k_router(const float* __restrict__ hbuf, const float* __restrict__ g2, const float* __restrict__ wrg, const float* __restrict__ brg,
                                                 const float* __restrict__ wre, const float* __restrict__ bre, float* __restrict__ T, int* __restrict__ cnt, int* __restrict__ lists,
                                                 int* __restrict__ eid, float* __restrict__ gate) {
    const int lane = threadIdx.x & 63, w = threadIdx.x >> 6;
    const int tok = blockIdx.x * 4 + w;
    const float4* xr = (const float4*)(hbuf + (size_t)tok * DM) + lane;
    float4 v[4]; float s = 0.f;
#pragma unroll
    for (int j = 0; j < 4; ++j) { v[j] = xr[64 * j]; s += v[j].x * v[j].x + v[j].y * v[j].y + v[j].z * v[j].z + v[j].w * v[j].w; }
    const float rstd = 1.0f / sqrtf(wave_sum(s) * (1.0f / DM) + 1e-6f);
    float4* o = (float4*)(T + (size_t)tok * DM) + lane;
    const float4* gg = (const float4*)g2 + lane;
#pragma unroll
    for (int j = 0; j < 4; ++j) { const float4 gv = gg[64 * j]; v[j].x *= rstd * gv.x; v[j].y *= rstd * gv.y; v[j].z *= rstd * gv.z; v[j].w *= rstd * gv.w; o[64 * j] = v[j]; }
    float mylogit = 0.f;
#pragma unroll 2
    for (int q = 0; q < 36; ++q) {
        const float* wp = q < 32 ? (wre + q) : (wrg + (q - 32));
        const int ld = q < 32 ? 32 : 4;
        float a = 0.f;
#pragma unroll
        for (int j = 0; j < 4; ++j) { const int d = 256 * j + 4 * lane; a += v[j].x * wp[(d + 0) * ld] + v[j].y * wp[(d + 1) * ld] + v[j].z * wp[(d + 2) * ld] + v[j].w * wp[(d + 3) * ld]; }
        a = wave_sum(a) + (q < 32 ? bre[q] : brg[q - 32]);
        if (lane == q) mylogit = a;
    }
    const float lg0 = __shfl(mylogit, 32), lg1 = __shfl(mylogit, 33), lg2 = __shfl(mylogit, 34), lg3 = __shfl(mylogit, 35);
    int gs = 0; float gm = lg0;
    if (lg1 > gm) { gm = lg1; gs = 1; }
    if (lg2 > gm) { gm = lg2; gs = 2; }
    if (lg3 > gm) { gm = lg3; gs = 3; }
    const float gsum = expf(lg0 - gm) + expf(lg1 - gm) + expf(lg2 - gm) + expf(lg3 - gm);
    const float pgroup = 1.0f / gsum;
    float es[8];
#pragma unroll
    for (int q = 0; q < 8; ++q) es[q] = __shfl(mylogit, gs * 8 + q);
    int i1 = 0; float v1 = es[0];
#pragma unroll
    for (int q = 1; q < 8; ++q) if (es[q] > v1) { v1 = es[q]; i1 = q; }
    int i2 = -1; float v2 = -3.0e38f;
#pragma unroll
    for (int q = 0; q < 8; ++q) if (q != i1 && es[q] > v2) { v2 = es[q]; i2 = q; }
    const float e2 = expf(v2 - v1);
    const float g1 = pgroup / (1.0f + e2), g2v = pgroup * e2 / (1.0f + e2);
    if (lane == 0) {
        const int ea = gs * 8 + i1, eb = gs * 8 + i2;
        eid[tok * 2] = ea; eid[tok * 2 + 1] = eb; gate[tok * 2] = g1; gate[tok * 2 + 1] = g2v;
        const int pa = atomicAdd(&cnt[ea * 2], 1); lists[(size_t)(ea * 2) * M + pa] = tok;
        const int pb = atomicAdd(&cnt[eb * 2 + 1], 1); lists[(size_t)(eb * 2 + 1) * M + pb] = tok;
    }
}

__global__ __launch_bounds__(256) void k_moe_up(const float* __restrict__ T, const float* __restrict__ Wg, const float* __restrict__ Wu, const int* __restrict__ cnt, const int* __restrict__ lists, float* __restrict__ act) {
    __shared__ float As[16][68];
    __shared__ float Bg[16][68];
    __shared__ float Bu[16][68];
    __shared__ int toks[64];
    const int list = blockIdx.z, e = list >> 1, k = list & 1;
    const int n = cnt[list];
    const int r0 = blockIdx.y * 64;
    if (r0 >= n) return;
    const int tid = threadIdx.x, tx = tid & 15, ty = tid >> 4;
    if (tid < 64) toks[tid] = (r0 + tid < n) ? lists[(size_t)list * M + r0 + tid] : -1;
    __syncthreads();
    const int n0 = blockIdx.x * 64;
    const float* wg = Wg + (size_t)e * DM * DEXP;
    const float* wu = Wu + (size_t)e * DM * DEXP;
    float ag[4][4], au[4][4];
#pragma unroll
    for (int i = 0; i < 4; ++i)
#pragma unroll
        for (int j = 0; j < 4; ++j) { ag[i][j] = 0.f; au[i][j] = 0.f; }
    const int myt = toks[tid >> 2];
    for (int k0 = 0; k0 < DM; k0 += 16) {
        float4 a = {0.f, 0.f, 0.f, 0.f};
        if (myt >= 0) a = *(const float4*)&T[(size_t)myt * DM + k0 + (tid & 3) * 4];
        As[(tid & 3) * 4 + 0][tid >> 2] = a.x; As[(tid & 3) * 4 + 1][tid >> 2] = a.y; As[(tid & 3) * 4 + 2][tid >> 2] = a.z; As[(tid & 3) * 4 + 3][tid >> 2] = a.w;
        *(float4*)&Bg[tid >> 4][(tid & 15) * 4] = *(const float4*)&wg[(size_t)(k0 + (tid >> 4)) * DEXP + n0 + (tid & 15) * 4];
        *(float4*)&Bu[tid >> 4][(tid & 15) * 4] = *(const float4*)&wu[(size_t)(k0 + (tid >> 4)) * DEXP + n0 + (tid & 15) * 4];
        __syncthreads();
#pragma unroll
        for (int kk = 0; kk < 16; ++kk) {
            const float4 av = *(const float4*)&As[kk][ty * 4];
            const float4 gv = *(const float4*)&Bg[kk][tx * 4];
            const float4 uv = *(const float4*)&Bu[kk][tx * 4];
            const float aa[4] = {av.x, av.y, av.z, av.w}, gg[4] = {gv.x, gv.y, gv.z, gv.w}, uu[4] = {uv.x, uv.y, uv.z, uv.w};
#pragma unroll
            for (int i = 0; i < 4; ++i)
#pragma unroll
                for (int j = 0; j < 4; ++j) { ag[i][j] += aa[i] * gg[j]; au[i][j] += aa[i] * uu[j]; }
        }
        __syncthreads();
    }
#pragma unroll
    for (int i = 0; i < 4; ++i) {
        const int tk = toks[ty * 4 + i];
        if (tk < 0) continue;
        float4 o;
        o.x = ag[i][0] / (1.0f + expf(-ag[i][0])) * au[i][0];
        o.y = ag[i][1] / (1.0f + expf(-ag[i][1])) * au[i][1];
        o.z = ag[i][2] / (1.0f + expf(-ag[i][2])) * au[i][2];
        o.w = ag[i][3] / (1.0f + expf(-ag[i][3])) * au[i][3];
        *(float4*)&act[((size_t)tk * 2 + k) * DEXP + n0 + tx * 4] = o;
    }
}

__global__ __launch_bounds__(256) void k_moe_down(const float* __restrict__ act, const float* __restrict__ Wd, const int* __restrict__ cnt, const int* __restrict__ lists, const float* __restrict__ gate, float* out, int k) {
    __shared__ float As[16][68];
    __shared__ float Bs[16][68];
    __shared__ int toks[64];
    const int e = blockIdx.z, list = e * 2 + k;
    const int n = cnt[list];
    const int r0 = blockIdx.y * 64;
    if (r0 >= n) return;
    const int tid = threadIdx.x, tx = tid & 15, ty = tid >> 4;
    if (tid < 64) toks[tid] = (r0 + tid < n) ? lists[(size_t)list * M + r0 + tid] : -1;
    __syncthreads();
    const int n0 = blockIdx.x * 64;
    const float* wd = Wd + (size_t)e * DEXP * DM;
    float acc[4][4];
#pragma unroll
    for (int i = 0; i < 4; ++i)
#pragma unroll
        for (int j = 0; j < 4; ++j) acc[i][j] = 0.f;
    const int myt = toks[tid >> 2];
    for (int k0 = 0; k0 < DEXP; k0 += 16) {
        float4 a = {0.f, 0.f, 0.f, 0.f};
        if (myt >= 0) a = *(const float4*)&act[((size_t)myt * 2 + k) * DEXP + k0 + (tid & 3) * 4];
        As[(tid & 3) * 4 + 0][tid >> 2] = a.x; As[(tid & 3) * 4 + 1][tid >> 2] = a.y; As[(tid & 3) * 4 + 2][tid >> 2] = a.z; As[(tid & 3) * 4 + 3][tid >> 2] = a.w;
        *(float4*)&Bs[tid >> 4][(tid & 15) * 4] = *(const float4*)&wd[(size_t)(k0 + (tid >> 4)) * DM + n0 + (tid & 15) * 4];
        __syncthreads();
#pragma unroll
        for (int kk = 0; kk < 16; ++kk) {
            const float4 av = *(const float4*)&As[kk][ty * 4];
            const float4 bv = *(const float4*)&Bs[kk][tx * 4];
            const float aa[4] = {av.x, av.y, av.z, av.w}, bb[4] = {bv.x, bv.y, bv.z, bv.w};
#pragma unroll
            for (int i = 0; i < 4; ++i)
#pragma unroll
                for (int j = 0; j < 4; ++j) acc[i][j] += aa[i] * bb[j];
        }
        __syncthreads();
    }
#pragma unroll
    for (int i = 0; i < 4; ++i) {
        const int tk = toks[ty * 4 + i];
        if (tk < 0) continue;
        const float gt = gate[tk * 2 + k];
        float4* op = (float4*)&out[(size_t)tk * DM + n0 + tx * 4];
        float4 o = *op;
        o.x += gt * acc[i][0]; o.y += gt * acc[i][1]; o.z += gt * acc[i][2]; o.w += gt * acc[i][3];
        *op = o;
    }
}
}

extern "C" void kernel_launch(void* const* d_in, const int* in_sizes, int n_in, void* d_out, int out_size, void* d_ws, size_t ws_size, hipStream_t stream) {
    const float* x = (const float*)d_in[0];
    const float* ln1_g = (const float*)d_in[1];
    const float* w_in = (const float*)d_in[2];
    const float* qg = (const float*)d_in[3];
    const float* kg = (const float*)d_in[4];
    const float* lq1 = (const float*)d_in[5];
    const float* lk1 = (const float*)d_in[6];
    const float* lq2 = (const float*)d_in[7];
    const float* lk2 = (const float*)d_in[8];
    const float* subg = (const float*)d_in[9];
    const float* mu = (const float*)d_in[10];
    const float* w0 = (const float*)d_in[11];
    const float* wup = (const float*)d_in[12];
    const float* a0 = (const float*)d_in[13];
    const float* aup = (const float*)d_in[14];
    const float* gup = (const float*)d_in[15];
    const float* k_k = (const float*)d_in[16];
    const float* k_a = (const float*)d_in[17];
    const float* r_k = (const float*)d_in[18];
    const float* lng = (const float*)d_in[19];
    const float* lnb = (const float*)d_in[20];
    const float* w_out = (const float*)d_in[21];
    const float* ln2_g = (const float*)d_in[22];
    const float* wrg = (const float*)d_in[23];
    const float* brg = (const float*)d_in[24];
    const float* wre = (const float*)d_in[25];
    const float* bre = (const float*)d_in[26];
    const float* Wg = (const float*)d_in[27];
    const float* Wu = (const float*)d_in[28];
    const float* Wd = (const float*)d_in[29];
    float* out = (float*)d_out;
    char* ws = (char*)d_ws;
    constexpr size_t MB = 1000000;
    float* XN = (float*)(ws);
    float* uq = (float*)(ws + 68 * MB);
    float* prep = (float*)(ws + 124 * MB);
    float* mix = (float*)(ws + 192 * MB);
    char* re = ws + 262 * MB;
    int* cnt = (int*)re;
    int* eid = (int*)(re + 4096);
    float* gate = (float*)(re + 4096 + (size_t)M * 2 * 4);
    int* lists = (int*)(re + 4096 + (size_t)M * 4 * 4);
    float* T = XN;
    float* act = uq;
    const size_t PA = (size_t)QTOK * DRW;
    float *p_r = prep, *p_dec = prep + PA, *p_km = prep + 2 * PA, *p_v = prep + 3 * PA, *p_kk = prep + 4 * PA, *p_b = prep + 5 * PA, *p_g = prep + 6 * PA;
    float* p_y = (float*)(ws + 183 * MB);

    hipMemsetAsync(cnt, 0, 4096, stream);
    k_rmsnorm<<<M / 4, 256, 0, stream>>>(x, ln1_g, XN, M, 1e-6f);
    for (int q = 0; q < M / QTOK; ++q) {
        const int tok0 = q * QTOK;
        k_gemm<<<dim3(DIN / 64, QTOK / 64), 256, 0, stream>>>(XN + (size_t)tok0 * DM, DM, w_in, DIN, uq, DIN, nullptr, 0, DM);
        k_rwkv_prep<<<QTOK, 512, 0, stream>>>(uq, tok0, QTOK, mu, w0, wup, a0, aup, gup, k_k, k_a, p_r, p_dec, p_km, p_v, p_kk, p_b, p_g);
        k_attn_prep<<<QTOK / 4, 256, 0, stream>>>(uq, qg, kg, tok0, QTOK);
        k_attn<<<dim3(SEQ / 64, 4, QTOK / SEQ), 256, 0, stream>>>(uq, mix, tok0, lq1, lk1, lq2, lk2, subg);
        k_rwkv_scan<<<dim3(8, QTOK / SEQ), 256, 0, stream>>>(p_r, p_dec, p_km, p_v, p_kk, p_b, p_y);
        k_rwkv_post<<<QTOK * 8 / 4, 256, 0, stream>>>(p_y, p_r, p_km, p_v, p_g, r_k, lng, lnb, mix, tok0, QTOK);
    }
    k_gemm<<<dim3(DM / 64, M / 64), 256, 0, stream>>>(mix, DM, w_out, DM, out, DM, x, DM, DM);
    k_router<<<M / 4, 256, 0, stream>>>(out, ln2_g, wrg, brg, wre, bre, T, cnt, lists, eid, gate);
    k_moe_up<<<dim3(DEXP / 64, M / 64, 64), 256, 0, stream>>>(T, Wg, Wu, cnt, lists, act);
    k_moe_down<<<dim3(DM / 64, M / 64, 32), 256, 0, stream>>>(act, Wd, cnt, lists, gate, out, 0);
    k_moe_down<<<dim3(DM / 64, M / 64, 32), 256, 0, stream>>>(act, Wd, cnt, lists, gate, out, 1);
}
```

```cpp
#include <hip/hip_runtime.h>
#include <cstdio>
#include <cstdint>
namespace pg8 {
#define PG8_LAS __attribute__((address_space(3)))
typedef unsigned short bf16_t;
typedef short bf16x8 __attribute__((ext_vector_type(8)));
typedef float f32x4 __attribute__((ext_vector_type(4)));
typedef unsigned u32x4 __attribute__((ext_vector_type(4)));
constexpr int BM = 256, BK = 64, HALF = 128, HTB = HALF * BK * 2  , STAGE_BYTES = 8 * HTB, NXCD = 8, WGM = 8;

__host__ __device__ __forceinline__ int lds_byte(int r, int c) { const int st = (r >> 4) * 2 + (c >> 5), rr = r & 15, cc = c & 31, ob = rr * 64 + cc * 2; return st * 1024 + (ob ^ (((ob >> 9) & 1) << 5)); }
__host__ __device__ __forceinline__ void stage_rc(int b, int& R, int& C) { const int st = b / 1024, sb = b % 1024, swz = sb ^ (((sb >> 9) & 1) << 5); R = (st >> 1) * 16 + swz / 64; C = (st & 1) * 32 + (swz % 64) / 2; }
__host__ __device__ __forceinline__ int perm32(int rho) { const int n = rho >> 4, i = rho & 15; return 8 * (i >> 2) + 4 * n + (i & 3); }

struct Unit { int pm, pn; };
struct Gemm { const bf16_t* A; const bf16_t* Bt; int M, N, K; };

struct StaticOrder {
    int nM, nN, nwg, G, c;
    __host__ __device__ void init(int M, int N, int G_, int c_) { nM = M / BM; nN = N / BM; nwg = nM * nN; G = G_; c = c_; }
    __host__ __device__ bool next(int i, Unit& u) const {
        const long L = (long)i * G + c; if (L >= nwg) return false;
        int wgid = (int)L; { const int q = nwg / NXCD, r = nwg % NXCD, xcd = wgid % NXCD, off = wgid / NXCD; wgid = (xcd < r ? xcd * (q + 1) : r * (q + 1) + (xcd - r) * q) + off; }
        const int nig = WGM * nN, gid = wgid / nig, fm = gid * WGM, gsz = (nM - fm) < WGM ? (nM - fm) : WGM;
        u.pm = fm + ((wgid % nig) % gsz); u.pn = (wgid % nig) / gsz; return true;
    }
    __device__ __forceinline__ void a_ready(const Unit&) const {}
    __device__ __forceinline__ void done(const Unit&) const {}
};

__device__ __forceinline__ unsigned cvt_pk_bf16(float lo, float hi) { unsigned r; asm volatile("v_cvt_pk_bf16_f32 %0, %1, %2" : "=v"(r) : "v"(lo), "v"(hi)); return r; }
typedef float f32x2 __attribute__((ext_vector_type(2)));
__device__ __forceinline__ f32x2 gelu_pk(f32x2 v) {
    const f32x2 av = __builtin_elementwise_abs(v), d = av * 0.2316418882f + 1.0f;
    f32x2 t; t.x = __builtin_amdgcn_rcpf(d.x); t.y = __builtin_amdgcn_rcpf(d.y);
    f32x2 q = t * 0.5307027145f + (-0.7265760135f); q = q * t + 0.7107068705f; q = q * t + (-0.142248368f); q = q * t + 0.127414796f; q = q * t;
    const f32x2 s = (v * v) * (-0.72134752044f);
    f32x2 e; e.x = __builtin_amdgcn_exp2f(s.x); e.y = __builtin_amdgcn_exp2f(s.y);
    const f32x2 m = v * (q * e), r = v - m;
    f32x2 o; o.x = v.x < 0.f ? m.x : r.x; o.y = v.y < 0.f ? m.y : r.y; return o;
}

template <int ACT  > struct EpiBf16 {
    static constexpr bool PERM = true, AFTER_DRAIN = false; static_assert(ACT == 0 || ACT == 1, "EpiBf16: ACT is 0 (none) or 1 (gelu_pk)");
    bf16_t* O; int ldc; const float* bias; int split_cols; size_t split_stride; float scale0;
    __device__ __forceinline__ void operator()(const f32x4 (&acc)[2][2][4][2], const Unit& u, int wr, int wc, int fr, int fq) const {
        const int row0 = u.pm * BM + wr * 64 + fr; int colt = u.pn * BM; bf16_t* base = O;
        float sc = 1.f; if (split_cols) { const int t = colt / split_cols; base += (size_t)t * split_stride; colt -= t * split_cols; if (t == 0) sc = scale0; }
        const int col0 = colt + wc * 32 + 8 * fq, bcol0 = u.pn * BM + wc * 32 + 8 * fq;
        f32x4 bv[2][2];
#pragma unroll
        for (int bj = 0; bj < 2; ++bj)
#pragma unroll
            for (int n = 0; n < 2; ++n) bv[bj][n] = bias ? *(const f32x4*)(bias + bcol0 + bj * HALF + 4 * n) : (f32x4){0.f, 0.f, 0.f, 0.f};
#pragma unroll
        for (int ai = 0; ai < 2; ++ai)
#pragma unroll
            for (int m = 0; m < 4; ++m) { bf16_t* rowp = base + (size_t)(row0 + ai * HALF + m * 16) * ldc + col0;
#pragma unroll
                for (int bj = 0; bj < 2; ++bj) { f32x4 v0 = acc[ai][bj][m][0] + bv[bj][0], v1 = acc[ai][bj][m][1] + bv[bj][1];
                    if (ACT == 1) { f32x2 a = gelu_pk((f32x2){v0[0], v0[1]}), b = gelu_pk((f32x2){v0[2], v0[3]}), c = gelu_pk((f32x2){v1[0], v1[1]}), d = gelu_pk((f32x2){v1[2], v1[3]});
                        v0 = (f32x4){a.x, a.y, b.x, b.y}; v1 = (f32x4){c.x, c.y, d.x, d.y}; }
                    v0 = v0 * sc; v1 = v1 * sc; u32x4 w; w.x = cvt_pk_bf16(v0[0], v0[1]); w.y = cvt_pk_bf16(v0[2], v0[3]); w.z = cvt_pk_bf16(v1[0], v1[1]); w.w = cvt_pk_bf16(v1[2], v1[3]);
                    *(u32x4*)(rowp + bj * HALF) = w; } }
    }
};

struct PanelStats {
    unsigned* xbuf;
    unsigned* cnt;
    unsigned* tmo;
    int ntn; float eps;
    unsigned code;
    __device__ __forceinline__ bool run(const f32x4 (&v)[2][2][4][2], const Unit& u, int wr, int wc, int fr, int fq, PG8_LAS unsigned char* lds, int wid, int lane) const {
        typedef float f32x2v __attribute__((ext_vector_type(2)));
        PG8_LAS f32x2v* P = (PG8_LAS f32x2v*)lds;
        PG8_LAS f32x2v* S = (PG8_LAS f32x2v*)(lds + 8192);
        PG8_LAS unsigned* flag = (PG8_LAS unsigned*)(lds + 8192 + 2048);
#pragma unroll
        for (int ai = 0; ai < 2; ++ai)
#pragma unroll
            for (int m = 0; m < 4; ++m) {
                float s = 0.f;
#pragma unroll
                for (int bj = 0; bj < 2; ++bj)
#pragma unroll
                    for (int n = 0; n < 2; ++n) { const f32x4 x = v[ai][bj][m][n]; s += (x[0] + x[1]) + (x[2] + x[3]); }
                s += __shfl_xor(s, 16); s += __shfl_xor(s, 32);
                const float mw = s * (1.0f / 64.0f); float q = 0.f;
#pragma unroll
                for (int bj = 0; bj < 2; ++bj)
#pragma unroll
                    for (int n = 0; n < 2; ++n) { const f32x4 d = v[ai][bj][m][n] - mw; q += (d[0] * d[0] + d[1] * d[1]) + (d[2] * d[2] + d[3] * d[3]); }
                q += __shfl_xor(q, 16); q += __shfl_xor(q, 32);
                if (fq == 0) P[(ai * HALF + wr * 64 + m * 16 + fr) * 4 + wc] = (f32x2v){mw, q};
            }
        asm volatile("s_waitcnt lgkmcnt(0)" ::: "memory"); __builtin_amdgcn_s_barrier(); asm volatile("" ::: "memory");
#if defined(BROKEN_EXCHANGE_NO_WAIT)
#warning BROKEN CONTROL BUILD: the row-statistics exchange does not wait; results are wrong by design
        if (blockIdx.x >= 64) { const long long t0_ = clock64(); while (clock64() - t0_ < 60000) __builtin_amdgcn_s_sleep(8); }
#endif
        const int row = wid * 32 + (lane & 31);
        if (lane < 32) {
            const f32x2v a = P[row * 4 + 0], b = P[row * 4 + 1], c = P[row * 4 + 2], d = P[row * 4 + 3];
            const float mt = (a.x + b.x + c.x + d.x) * 0.25f;
            const float da = a.x - mt, db = b.x - mt, dc = c.x - mt, dd = d.x - mt;
            const float m2 = (a.y + b.y) + (c.y + d.y) + 64.0f * ((da * da + db * db) + (dc * dc + dd * dd));
            unsigned long long* slot = (unsigned long long*)xbuf + ((size_t)(u.pm * BM + row) * 4 + u.pn);
            __hip_atomic_store(slot, ((unsigned long long)__float_as_uint(m2) << 32) | __float_as_uint(mt), __ATOMIC_RELAXED, __HIP_MEMORY_SCOPE_AGENT);
        }
        asm volatile("s_waitcnt vmcnt(0)" ::: "memory");
        if (lane == 0) __hip_atomic_fetch_add(cnt + 64 * u.pm, 1u, __ATOMIC_RELAXED, __HIP_MEMORY_SCOPE_AGENT);
        if (wid == 0) {
            bool dead = false; const unsigned long long t0 = __builtin_amdgcn_s_memrealtime(); const unsigned want = 8u * (unsigned)ntn;
            for (;;) {
#if defined(BROKEN_EXCHANGE_NO_WAIT)
                break;
#endif
                if ((unsigned)__builtin_amdgcn_readfirstlane(__hip_atomic_load(cnt + 64 * u.pm, __ATOMIC_RELAXED, __HIP_MEMORY_SCOPE_AGENT)) >= want) break;
                if (__builtin_amdgcn_s_memrealtime() - t0 > 2000000ull) {
                    if (lane == 0) { unsigned expect = 0u; __hip_atomic_compare_exchange_strong(tmo + 1, &expect, code | (unsigned)(u.pm & 0xff), __ATOMIC_RELAXED, __ATOMIC_RELAXED, __HIP_MEMORY_SCOPE_AGENT);
                                     __hip_atomic_store(tmo, 1u, __ATOMIC_RELAXED, __HIP_MEMORY_SCOPE_AGENT); }
                    dead = true; break; }
                __builtin_amdgcn_s_sleep(2);
            }
            __builtin_amdgcn_fence(__ATOMIC_ACQUIRE, "agent");
            if (lane == 0) flag[0] = dead ? 1u : 0u;
        }
        asm volatile("s_waitcnt vmcnt(0) lgkmcnt(0)" ::: "memory"); __builtin_amdgcn_s_barrier(); asm volatile("" ::: "memory");
        const bool bad = flag[0] != 0u;
        if (lane < 32) {
            const unsigned long long* slot = (const unsigned long long*)xbuf + (size_t)(u.pm * BM + row) * 4; float mt[4], m2[4]; float ms = 0.f;
#pragma unroll
            for (int t = 0; t < 4; ++t) { if (t < ntn) { const unsigned long long w = __hip_atomic_load(slot + t, __ATOMIC_RELAXED, __HIP_MEMORY_SCOPE_AGENT); mt[t] = __uint_as_float((unsigned)w); m2[t] = __uint_as_float((unsigned)(w >> 32)); } else { mt[t] = 0.f; m2[t] = 0.f; } ms += mt[t]; }
            const float mean = ms / (float)ntn; float q = 0.f;
#pragma unroll
            for (int t = 0; t < 4; ++t) if (t < ntn) { const float dm = mt[t] - mean; q += m2[t] + 256.0f * dm * dm; }
            S[row] = (f32x2v){mean, 1.0f / sqrtf(q / (256.0f * (float)ntn) + eps)};
        }
        asm volatile("s_waitcnt lgkmcnt(0)" ::: "memory"); __builtin_amdgcn_s_barrier(); asm volatile("" ::: "memory");
        return bad;
    }
};
struct EpiLnRes {
    static constexpr bool PERM = false, AFTER_DRAIN = true;
    const float* base; float* out; int ldc; const float* bias; PanelStats st; unsigned poison;
    __device__ __forceinline__ void fused(f32x4 (&acc)[2][2][4][2], const Unit& u, int wr, int wc, int fr, int fq, PG8_LAS unsigned char* lds, int wid, int lane) const {
        typedef float f32x2v __attribute__((ext_vector_type(2)));
        const PG8_LAS f32x2v* S = (const PG8_LAS f32x2v*)(lds + 8192);
        const int col0 = u.pn * BM + wc * 32 + 4 * fq;
#pragma unroll
        for (int bj = 0; bj < 2; ++bj)
#pragma unroll
            for (int n = 0; n < 2; ++n) { const f32x4 bv = bias ? *(const f32x4*)(bias + col0 + bj * HALF + n * 16) : (f32x4){0.f, 0.f, 0.f, 0.f};
#pragma unroll
                for (int ai = 0; ai < 2; ++ai)
#pragma unroll
                    for (int m = 0; m < 4; ++m) acc[ai][bj][m][n] += bv; }
        f32x4 pre[4][2][2];
#pragma unroll
        for (int m = 0; m < 4; ++m) { const size_t off = (size_t)(u.pm * BM + wr * 64 + m * 16 + fr) * ldc + col0;
#pragma unroll
            for (int bj = 0; bj < 2; ++bj)
#pragma unroll
                for (int n = 0; n < 2; ++n) pre[m][bj][n] = *(const f32x4*)(base + off + bj * HALF + n * 16); }
        const bool bad = st.run(acc, u, wr, wc, fr, fq, lds, wid, lane) || poison != 0u;
        const float qnan = __builtin_nanf("");
#pragma unroll
        for (int ai = 0; ai < 2; ++ai)
#pragma unroll
            for (int m = 0; m < 4; ++m) { const int r = ai * HALF + wr * 64 + m * 16 + fr; const f32x2v sr = S[r]; const size_t off = (size_t)(u.pm * BM + r) * ldc + col0;
#pragma unroll
                for (int bj = 0; bj < 2; ++bj)
#pragma unroll
                    for (int n = 0; n < 2; ++n) { const f32x4 bs = ai == 0 ? pre[m][bj][n] : *(const f32x4*)(base + off + bj * HALF + n * 16); f32x4 o = bs + (acc[ai][bj][m][n] - sr.x) * sr.y;
                        if (bad) o = (f32x4){qnan, qnan, qnan, qnan}; *(f32x4*)(out + off + bj * HALF + n * 16) = o; }
                if (m & 1) asm volatile("" ::: "memory"); }
    }
};
struct EpiLnResLn {
    static constexpr bool PERM = false, AFTER_DRAIN = true;
    const float* base; float* out; bf16_t* xn; int ldc; const float* bias; PanelStats st1, st2; unsigned poison;
    __device__ __forceinline__ void fused(f32x4 (&acc)[2][2][4][2], const Unit& u, int wr, int wc, int fr, int fq, PG8_LAS unsigned char* lds, int wid, int lane) const {
        typedef float f32x2v __attribute__((ext_vector_type(2))); typedef unsigned u32x2v __attribute__((ext_vector_type(2)));
        const PG8_LAS f32x2v* S = (const PG8_LAS f32x2v*)(lds + 8192);
        const int col0 = u.pn * BM + wc * 32 + 4 * fq;
#pragma unroll
        for (int bj = 0; bj < 2; ++bj)
#pragma unroll
            for (int n = 0; n < 2; ++n) { const f32x4 bv = bias ? *(const f32x4*)(bias + col0 + bj * HALF + n * 16) : (f32x4){0.f, 0.f, 0.f, 0.f};
#pragma unroll
                for (int ai = 0; ai < 2; ++ai)
#pragma unroll
                    for (int m = 0; m < 4; ++m) acc[ai][bj][m][n] += bv; }
        bool bad = st1.run(acc, u, wr, wc, fr, fq, lds, wid, lane) || poison != 0u;
        const float qnan = __builtin_nanf("");
#pragma unroll
        for (int ai = 0; ai < 2; ++ai)
#pragma unroll
            for (int m = 0; m < 4; ++m) { const int r = ai * HALF + wr * 64 + m * 16 + fr; const f32x2v sr = S[r]; const size_t off = (size_t)(u.pm * BM + r) * ldc + col0;
#pragma unroll
                for (int bj = 0; bj < 2; ++bj)
#pragma unroll
                    for (int n = 0; n < 2; ++n) { const f32x4 bs = *(const f32x4*)(base + off + bj * HALF + n * 16); acc[ai][bj][m][n] = bs + (acc[ai][bj][m][n] - sr.x) * sr.y; }
                asm volatile("" : "+v"(acc[ai][0][m][0]), "+v"(acc[ai][0][m][1]), "+v"(acc[ai][1][m][0]), "+v"(acc[ai][1][m][1]));
                if (m & 1) asm volatile("" ::: "memory"); }
        const bool bad1 = bad;
        bad = st2.run(acc, u, wr, wc, fr, fq, lds, wid, lane) || bad;
#pragma unroll
        for (int ai = 0; ai < 2; ++ai)
#pragma unroll
            for (int m = 0; m < 4; ++m) { const int r = ai * HALF + wr * 64 + m * 16 + fr; const f32x2v sr = S[r]; const size_t off = (size_t)(u.pm * BM + r) * ldc + col0;
#pragma unroll
                for (int bj = 0; bj < 2; ++bj)
#pragma unroll
                    for (int n = 0; n < 2; ++n) { const f32x4 x1 = acc[ai][bj][m][n]; *(f32x4*)(out + off + bj * HALF + n * 16) = bad1 ? (f32x4){qnan, qnan, qnan, qnan} : x1;
                        const f32x4 o = (x1 - sr.x) * sr.y; u32x2v w; w.x = cvt_pk_bf16(o[0], o[1]); w.y = cvt_pk_bf16(o[2], o[3]);
                        if (bad) { w.x = 0x7fc07fc0u; w.y = 0x7fc07fc0u; } *(u32x2v*)(xn + off + bj * HALF + n * 16) = w; }
                asm volatile("" ::: "memory"); }
    }
};

template <class Epi, class Sched, bool ALIGN_EPI = false, bool SP2 = false>
__device__ __forceinline__ void gemm_phase(PG8_LAS unsigned char* lds, const Gemm g, const Sched& S, const Epi& E) {
    const int tid = threadIdx.x, wid = __builtin_amdgcn_readfirstlane(tid >> 6), lane = tid & 63, wr = wid >> 2, wc = wid & 3, fr = lane & 15, fq = lane >> 4;
    const int K = g.K, nt = K / BK;
    unsigned voffA[2], voffB[2];
#pragma unroll
    for (int i = 0; i < 2; ++i) { int R, C; stage_rc(tid * 16 + i * 8192, R, C); const int Rb = Epi::PERM ? ((R & ~31) + perm32(R & 31)) : R;
        voffA[i] = (unsigned)(R * K + C) * 2u; voffB[i] = (unsigned)(Rb * K + C) * 2u; }
    const size_t kstep = (size_t)(BK * 2);
    const size_t hstep = (size_t)HALF * K * 2;
    const size_t tstep = 2 * hstep;
    const unsigned ldsw = (unsigned)wid * 1024u;
    const int aoff = lds_byte(wr * 64 + fr, fq * 8), boff = lds_byte(wc * 32 + fr, fq * 8);
#define PG8_SA(b, h) (((b) * 2 + (h)) * HTB)
#define PG8_SB(b, h) ((4 + (b) * 2 + (h)) * HTB)
#define PG8_STAGE(bufoff, gbase, voff) do { _Pragma("unroll") for (int _i = 0; _i < 2; ++_i) \
        __builtin_amdgcn_global_load_lds((const unsigned*)((const char*)(gbase) + (voff)[_i]), (PG8_LAS unsigned*)(lds + (bufoff) + ldsw + _i * 8192), 16, 0, 0); } while (0)
#define PG8_LDA(dst, b, h) do { _Pragma("unroll") for (int m = 0; m < 4; ++m) _Pragma("unroll") for (int k = 0; k < 2; ++k) dst[m][k] = *(const PG8_LAS bf16x8*)(lds + PG8_SA(b, h) + aoff + m * 2048 + k * 1024); } while (0)
#define PG8_LDB(dst, b, h) do { _Pragma("unroll") for (int n = 0; n < 2; ++n) _Pragma("unroll") for (int k = 0; k < 2; ++k) dst[n][k] = *(const PG8_LAS bf16x8*)(lds + PG8_SB(b, h) + boff + n * 2048 + k * 1024); } while (0)
#define PG8_MMA(ai, bj, At, Bt) do { __builtin_amdgcn_s_setprio(1); _Pragma("unroll") for (int m = 0; m < 4; ++m) _Pragma("unroll") for (int n = 0; n < 2; ++n) _Pragma("unroll") for (int k = 0; k < 2; ++k) \
        acc[ai][bj][m][n] = __builtin_amdgcn_mfma_f32_16x16x32_bf16(Bt[n][k], At[m][k], acc[ai][bj][m][n], 0, 0, 0); __builtin_amdgcn_s_setprio(0); } while (0)
#define PG8_WAIT_V(n) asm volatile("s_waitcnt vmcnt(" #n ")" ::: "memory")
#define PG8_WAIT_L(n) asm volatile("s_waitcnt lgkmcnt(" #n ")" ::: "memory")
#define PG8_BAR __builtin_amdgcn_s_barrier()
#define PG8_SCHED __builtin_amdgcn_sched_barrier(0)
    Unit cur, nxt; int ui = 0;
    if (!S.next(0, cur)) return;
    f32x4 acc[2][2][4][2];
#pragma unroll
    for (int a = 0; a < 2; ++a)
#pragma unroll
        for (int b = 0; b < 2; ++b)
#pragma unroll
            for (int m = 0; m < 4; ++m)
#pragma unroll
                for (int n = 0; n < 2; ++n) acc[a][b][m][n] = (f32x4){0.f, 0.f, 0.f, 0.f};
    bf16x8 At[4][2], B0[2][2], B1[2][2];
    const char* cA = (const char*)g.A + (size_t)cur.pm * tstep; const char* cB = (const char*)g.Bt + (size_t)cur.pn * tstep;
    S.a_ready(cur);
    if constexpr (SP2) {
        PG8_STAGE(PG8_SB(0, 0), cB, voffB); PG8_STAGE(PG8_SB(0, 1), cB + hstep, voffB); PG8_STAGE(PG8_SA(0, 0), cA, voffA); PG8_STAGE(PG8_SA(0, 1), cA + hstep, voffA);
        if (wr == 1) PG8_BAR;
        PG8_WAIT_V(2); PG8_BAR;
        PG8_STAGE(PG8_SB(1, 0), cB + kstep, voffB); PG8_STAGE(PG8_SA(1, 0), cA + kstep, voffA); PG8_STAGE(PG8_SB(1, 1), cB + hstep + kstep, voffB);
        PG8_WAIT_V(6); PG8_BAR;
    } else {
        PG8_STAGE(PG8_SB(0, 0), cB, voffB); PG8_STAGE(PG8_SA(0, 0), cA, voffA); PG8_STAGE(PG8_SB(0, 1), cB + hstep, voffB); PG8_STAGE(PG8_SA(0, 1), cA + hstep, voffA);
        if (wr == 1) PG8_BAR;
        PG8_WAIT_V(4); PG8_BAR;
        PG8_STAGE(PG8_SB(1, 0), cB + kstep, voffB); PG8_STAGE(PG8_SA(1, 0), cA + kstep, voffA); PG8_STAGE(PG8_SB(1, 1), cB + hstep + kstep, voffB);
        PG8_WAIT_V(6); PG8_BAR;
    }
    for (;;) {
        const bool has_next = S.next(ui + 1, nxt);
        const char* nA = has_next ? (const char*)g.A + (size_t)nxt.pm * tstep : cA; const char* nB = has_next ? (const char*)g.Bt + (size_t)nxt.pn * tstep : cB;
        for (int t = 0; t < nt; t += 2) {
            const bool last = (t == nt - 2);
            const char* a1 = cA + (size_t)(t + 1) * kstep;
            const char* a2 = last ? nA : cA + (size_t)(t + 2) * kstep; const char* b2 = last ? nB : cB + (size_t)(t + 2) * kstep;
            const char* a3 = a2 + kstep; const char* b3 = b2 + kstep;
            if (last && has_next) S.a_ready(nxt);
            if constexpr (SP2) {
            PG8_LDB(B0, 0, 0); PG8_LDB(B1, 0, 1); PG8_SCHED; PG8_LDA(At, 0, 0); PG8_STAGE(PG8_SA(1, 1), a1 + hstep, voffA);
            PG8_WAIT_V(8); PG8_WAIT_L(0); PG8_BAR; PG8_MMA(0, 0, At, B0); PG8_MMA(0, 1, At, B1); PG8_BAR; PG8_SCHED;
            PG8_LDA(At, 0, 1); PG8_STAGE(PG8_SB(0, 0), b2, voffB); PG8_STAGE(PG8_SB(0, 1), b2 + hstep, voffB); PG8_STAGE(PG8_SA(0, 0), a2, voffA);
            PG8_WAIT_V(8); PG8_WAIT_L(0); PG8_BAR; PG8_MMA(1, 0, At, B0); PG8_MMA(1, 1, At, B1); PG8_BAR; PG8_SCHED;
            PG8_LDB(B0, 1, 0); PG8_LDB(B1, 1, 1); PG8_SCHED; PG8_LDA(At, 1, 0); PG8_STAGE(PG8_SA(0, 1), a2 + hstep, voffA);
            PG8_WAIT_V(8); PG8_WAIT_L(0); PG8_BAR; PG8_MMA(0, 0, At, B0); PG8_MMA(0, 1, At, B1); PG8_BAR; PG8_SCHED;
            PG8_LDA(At, 1, 1); PG8_STAGE(PG8_SB(1, 0), b3, voffB); PG8_STAGE(PG8_SB(1, 1), b3 + hstep, voffB); PG8_STAGE(PG8_SA(1, 0), a3, voffA);
            PG8_WAIT_V(8); PG8_WAIT_L(0); PG8_BAR; PG8_MMA(1, 0, At, B0); PG8_MMA(1, 1, At, B1); PG8_BAR; PG8_SCHED;
            } else {
            PG8_LDB(B0, 0, 0); PG8_SCHED; PG8_LDA(At, 0, 0); PG8_STAGE(PG8_SA(1, 1), a1 + hstep, voffA);
            PG8_WAIT_L(8); PG8_BAR; PG8_WAIT_L(0); PG8_MMA(0, 0, At, B0); PG8_BAR; PG8_SCHED;
            PG8_LDB(B1, 0, 1); PG8_STAGE(PG8_SB(0, 0), b2, voffB);
            PG8_BAR; PG8_WAIT_L(0); PG8_MMA(0, 1, At, B1); PG8_BAR;
            PG8_LDA(At, 0, 1); PG8_STAGE(PG8_SA(0, 0), a2, voffA);
            PG8_BAR; PG8_WAIT_L(0); PG8_MMA(1, 0, At, B0); PG8_BAR; PG8_SCHED;
            PG8_STAGE(PG8_SB(0, 1), b2 + hstep, voffB);
            PG8_WAIT_V(6); PG8_BAR; PG8_MMA(1, 1, At, B1); PG8_BAR;
            PG8_LDB(B0, 1, 0); PG8_SCHED; PG8_LDA(At, 1, 0); PG8_STAGE(PG8_SA(0, 1), a2 + hstep, voffA);
            PG8_WAIT_L(8); PG8_BAR; PG8_WAIT_L(0); PG8_MMA(0, 0, At, B0); PG8_BAR; PG8_SCHED;
            PG8_LDB(B1, 1, 1); PG8_STAGE(PG8_SB(1, 0), b3, voffB);
            PG8_BAR; PG8_WAIT_L(0); PG8_MMA(0, 1, At, B1); PG8_BAR;
            PG8_LDA(At, 1, 1); PG8_STAGE(PG8_SA(1, 0), a3, voffA);
            PG8_BAR; PG8_WAIT_L(0); PG8_MMA(1, 0, At, B0); PG8_BAR; PG8_SCHED;
            PG8_STAGE(PG8_SB(1, 1), b3 + hstep, voffB);
            PG8_WAIT_V(6); PG8_BAR; PG8_MMA(1, 1, At, B1); PG8_BAR;
            }
        }
        if constexpr (ALIGN_EPI) { if (wr == 0) PG8_BAR; }
        if constexpr (!Epi::AFTER_DRAIN) { E(acc, cur, wr, wc, fr, fq); S.done(cur); }
        if (!has_next) break;
#pragma unroll
        for (int a = 0; a < 2; ++a)
#pragma unroll
            for (int b = 0; b < 2; ++b)
#pragma unroll
                for (int m = 0; m < 4; ++m)
#pragma unroll
                    for (int n = 0; n < 2; ++n) acc[a][b][m][n] = (f32x4){0.f, 0.f, 0.f, 0.f};
        cur = nxt; cA = nA; cB = nB; ++ui;
        if constexpr (ALIGN_EPI) { if (wr == 1) PG8_BAR; }
    }
    PG8_WAIT_V(0);
    if constexpr (!ALIGN_EPI) { if (wr == 0) PG8_BAR; }
    PG8_BAR;
    if constexpr (Epi::AFTER_DRAIN) { E.fused(acc, cur, wr, wc, fr, fq, lds, wid, lane); S.done(cur); }
#undef PG8_SA
#undef PG8_SB
#undef PG8_STAGE
#undef PG8_LDA
#undef PG8_LDB
#undef PG8_MMA
#undef PG8_WAIT_V
#undef PG8_WAIT_L
#undef PG8_BAR
#undef PG8_SCHED
}
}

#ifndef PG8_SP2
#define PG8_SP2 true
#endif
#ifndef PG8_ALIGN
#define PG8_ALIGN true
#endif

namespace pg8 {
struct EpiResF32 {
    static constexpr bool PERM = false, AFTER_DRAIN = false;
    const float* base; float* out; int ldc;
    __device__ __forceinline__ void operator()(const f32x4 (&acc)[2][2][4][2], const Unit& u, int wr, int wc, int fr, int fq) const {
        const int col0 = u.pn * BM + wc * 32 + 4 * fq;
#pragma unroll
        for (int ai = 0; ai < 2; ++ai)
#pragma unroll
            for (int m = 0; m < 4; ++m) { const size_t off = (size_t)(u.pm * BM + ai * HALF + wr * 64 + m * 16 + fr) * ldc + col0;
#pragma unroll
                for (int bj = 0; bj < 2; ++bj)
#pragma unroll
                    for (int n = 0; n < 2; ++n) { const f32x4 bs = *(const f32x4*)(base + off + bj * HALF + n * 16); *(f32x4*)(out + off + bj * HALF + n * 16) = bs + acc[ai][bj][m][n]; }
                asm volatile("" ::: "memory"); }
    }
};
struct EpiSwiGLU {
    static constexpr bool PERM = true, AFTER_DRAIN = false;
    bf16_t* O;
    __device__ __forceinline__ void operator()(const f32x4 (&acc)[2][2][4][2], const Unit& u, int wr, int wc, int fr, int fq) const {
        const int row0 = u.pm * BM + wr * 64 + fr; const int col0 = (u.pn & 3) * 128 + wc * 32 + 8 * fq;
#pragma unroll
        for (int ai = 0; ai < 2; ++ai)
#pragma unroll
            for (int m = 0; m < 4; ++m) { bf16_t* rowp = O + (size_t)(row0 + ai * HALF + m * 16) * 512 + col0;
                f32x4 g0 = acc[ai][0][m][0], g1 = acc[ai][0][m][1]; const f32x4 u0 = acc[ai][1][m][0], u1 = acc[ai][1][m][1];
#pragma unroll
                for (int e = 0; e < 4; ++e) { g0[e] = g0[e] * __builtin_amdgcn_rcpf(1.0f + __expf(-g0[e])) * u0[e]; g1[e] = g1[e] * __builtin_amdgcn_rcpf(1.0f + __expf(-g1[e])) * u1[e]; }
                u32x4 w; w.x = cvt_pk_bf16(g0[0], g0[1]); w.y = cvt_pk_bf16(g0[2], g0[3]); w.z = cvt_pk_bf16(g1[0], g1[1]); w.w = cvt_pk_bf16(g1[2], g1[3]);
                *(u32x4*)rowp = w; asm volatile("" ::: "memory"); }
    }
};
struct EpiScatter {
    static constexpr bool PERM = true, AFTER_DRAIN = false;
    bf16_t* Y; const int* rowslot; const float* rowgate;
    __device__ __forceinline__ void operator()(const f32x4 (&acc)[2][2][4][2], const Unit& u, int wr, int wc, int fr, int fq) const {
        const int row0 = u.pm * BM + wr * 64 + fr; const int col0 = (u.pn & 3) * BM + wc * 32 + 8 * fq;
#pragma unroll
        for (int ai = 0; ai < 2; ++ai)
#pragma unroll
            for (int m = 0; m < 4; ++m) { const int r = row0 + ai * HALF + m * 16; const int slot = rowslot[r]; const float gt = rowgate[r];
                if (slot >= 0) { bf16_t* rowp = Y + (size_t)slot * 1024 + col0;
#pragma unroll
                    for (int bj = 0; bj < 2; ++bj) { const f32x4 v0 = acc[ai][bj][m][0] * gt, v1 = acc[ai][bj][m][1] * gt;
                        u32x4 w; w.x = cvt_pk_bf16(v0[0], v0[1]); w.y = cvt_pk_bf16(v0[2], v0[3]); w.z = cvt_pk_bf16(v1[0], v1[1]); w.w = cvt_pk_bf16(v1[2], v1[3]);
                        *(u32x4*)(rowp + bj * HALF) = w; } }
                asm volatile("" ::: "memory"); }
    }
};
struct MoeOrder {
    int ntiles, G, c; const PG8_LAS int* tile_e;
    __device__ __forceinline__ bool next(int i, Unit& u) const {
        const int L = i * G + c; if (L >= ntiles * 4) return false;
        const int ti = L >> 2; const int e = __builtin_amdgcn_readfirstlane(tile_e[ti]);
        u.pm = ti; u.pn = e * 4 + (L & 3); return true;
    }
    __device__ __forceinline__ void a_ready(const Unit&) const {}
    __device__ __forceinline__ void done(const Unit&) const {}
};
struct G1Order : StaticOrder {
    __device__ __forceinline__ bool next(int i, Unit& u) const { if (!StaticOrder::next(i, u)) return false; if (u.pn >= 11) u.pn = 12; return true; }
};
struct P3Order {
    int c;
    __device__ __forceinline__ bool next(int i, Unit& u) const {
        if (c < 64) { if (i > 0) return false; u.pm = c; u.pn = 11; return true; }
        const int L = i * 192 + (c - 64); if (L >= 384) return false; u.pm = L / 6; u.pn = L % 6; return true; }
    __device__ __forceinline__ void a_ready(const Unit&) const {}
    __device__ __forceinline__ void done(const Unit&) const {}
};
}


#include <hip/hip_bf16.h>
#include <cmath>
namespace attn_body {
using bf16=__hip_bfloat16;
using bf16x8=__attribute__((ext_vector_type(8)))short;
using s16x4=__attribute__((ext_vector_type(4)))short;
using f32x16=__attribute__((ext_vector_type(16)))float;
using u32x4=__attribute__((ext_vector_type(4)))unsigned;
constexpr int BATCH=8,NHEAD=16,SEQ=2048,D=64,QP=3328,OP=1024;
constexpr int NW=8,QBLK=32,QB=QBLK*NW,KVBLK=64,NQB=SEQ/QB;
constexpr int ATTN_UNIT_ROWS=QB;
__device__ __forceinline__ int crow(int r,int hi){return (r&3)+8*(r>>2)+4*hi;}
#define SBAR() __builtin_amdgcn_sched_barrier(0)
__device__ __forceinline__ void cmask(f32x16&p0,f32x16&p1,int jb,int qrel,int hi){
  const float NEG=-INFINITY;
  if(jb>(qrel>>6)){
  #pragma unroll
  for(int r=0;r<16;++r){p0[r]=NEG;p1[r]=NEG;}}
}

constexpr int NSLOT=3, SLOTB=8192;
constexpr int LDS_K=0, LDS_V=NSLOT*SLOTB, LDS_WS=2*NSLOT*SLOTB, LDS_OST=LDS_WS+NW*64*4, LDS_BYTES=LDS_OST+NW*4096;
constexpr float C2=0.125f*1.4426950408889634f;
__device__ __forceinline__ void glds16(const void*gsrc,unsigned lds_dst){unsigned keep;
  asm volatile("s_mov_b32 %0, m0\n\ts_mov_b32 m0, %2\n\ts_nop 0\n\tglobal_load_lds_dwordx4 %1, off\n\ts_mov_b32 m0, %0":"=&s"(keep):"v"(gsrc),"s"(lds_dst):"memory");}
__device__ __forceinline__ float max3f(float a,float b,float c){float r;asm("v_max3_f32 %0, %1, %2, %3":"=v"(r):"v"(a),"v"(b),"v"(c));return r;}
__device__ __forceinline__ float max2f(float a,float b){float r;asm("v_max_f32_e32 %0, %1, %2":"=v"(r):"v"(a),"v"(b));return r;}
__device__ __forceinline__ float fadd_s(float a,float b){float r;asm("v_add_f32_e32 %0, %1, %2":"=v"(r):"v"(a),"v"(b));return r;}
__device__ __forceinline__ float fsub_s(float a,float b){float r;asm("v_sub_f32_e32 %0, %1, %2":"=v"(r):"v"(a),"v"(b));return r;}
typedef float f32x2_t __attribute__((ext_vector_type(2))); typedef __bf16 bf16x2_t __attribute__((ext_vector_type(2)));
__device__ __forceinline__ unsigned cvtpk_s(float lo,float hi){f32x2_t v={lo,hi};bf16x2_t b=__builtin_convertvector(v,bf16x2_t);return __builtin_bit_cast(unsigned,b);}
#define WAIT_BAR(N) asm volatile("s_waitcnt vmcnt(" #N ") lgkmcnt(0)\n\ts_barrier":::"memory")

__device__ __forceinline__ void qkt(f32x16&p0,f32x16&p1,const char*Kslot,const bf16x8*qr,const f32x16&negm,int r32,int hi){
  const char*kb=Kslot+hi*1024+r32*16;
  #pragma unroll
  for(int d0=0;d0<4;++d0){
    const bf16x8 b0=*reinterpret_cast<const bf16x8*>(kb+d0*2048);
    const bf16x8 b1=*reinterpret_cast<const bf16x8*>(kb+d0*2048+512);
    if(d0==0){p0=__builtin_amdgcn_mfma_f32_32x32x16_bf16(b0,qr[0],negm,0,0,0);p1=__builtin_amdgcn_mfma_f32_32x32x16_bf16(b1,qr[0],negm,0,0,0);}
    else{p0=__builtin_amdgcn_mfma_f32_32x32x16_bf16(b0,qr[d0],p0,0,0,0);p1=__builtin_amdgcn_mfma_f32_32x32x16_bf16(b1,qr[d0],p1,0,0,0);}}
}
typedef __attribute__((address_space(3))) const char* lds_cptr;
typedef short v4i16_t __attribute__((ext_vector_type(4)));
__device__ __forceinline__ void kload8(bf16x8*kf,lds_cptr kp){
  kf[0]=*(const __attribute__((address_space(3))) bf16x8*)(kp);      kf[1]=*(const __attribute__((address_space(3))) bf16x8*)(kp+512);
  kf[2]=*(const __attribute__((address_space(3))) bf16x8*)(kp+2048); kf[3]=*(const __attribute__((address_space(3))) bf16x8*)(kp+2560);
  kf[4]=*(const __attribute__((address_space(3))) bf16x8*)(kp+4096); kf[5]=*(const __attribute__((address_space(3))) bf16x8*)(kp+4608);
  kf[6]=*(const __attribute__((address_space(3))) bf16x8*)(kp+6144); kf[7]=*(const __attribute__((address_space(3))) bf16x8*)(kp+6656);
}
__device__ __forceinline__ void kload2(bf16x8*kf,lds_cptr kp,int j){ kf[2*j]=*(const __attribute__((address_space(3))) bf16x8*)(kp+j*2048); kf[2*j+1]=*(const __attribute__((address_space(3))) bf16x8*)(kp+j*2048+512); }
__device__ __forceinline__ s16x4 vtr(lds_cptr p){ return __builtin_bit_cast(s16x4,__builtin_amdgcn_ds_read_tr16_b64_v4i16((__attribute__((address_space(3))) v4i16_t*)p)); }
__device__ __forceinline__ float rowmax(const f32x16&p0,const f32x16&p1){
  float a=max3f(p0[0],p0[1],p1[0]),b=max3f(p0[2],p0[3],p1[1]);a=max3f(a,p1[2],p1[3]);
  #pragma unroll
  for(int r=4;r<16;r+=4){a=max3f(a,p0[r],p0[r+1]);b=max3f(b,p0[r+2],p0[r+3]);a=max3f(a,p1[r],p1[r+1]);b=max3f(b,p1[r+2],p1[r+3]);}
  const float m=max2f(a,b);
  auto rr=__builtin_amdgcn_permlane32_swap(__float_as_uint(m),__float_as_uint(m),false,false);
  return max2f(__uint_as_float(rr[0]),__uint_as_float(rr[1]));
}
__device__ __forceinline__ void pv(f32x16*o,int vb,bf16x8 pa0,bf16x8 pa1,bf16x8 pa2,bf16x8 pa3){
  #pragma unroll
  for(int d0=0;d0<2;++d0){s16x4 lo[4],hi[4];
    #pragma unroll
    for(int ks=0;ks<4;++ks){
      asm volatile("ds_read_b64_tr_b16 %0,%1 offset:%c2":"=&v"(lo[ks]):"v"(vb),"i"(d0*4096+ks*1024):"memory");
      asm volatile("ds_read_b64_tr_b16 %0,%1 offset:%c2":"=&v"(hi[ks]):"v"(vb),"i"(d0*4096+ks*1024+512):"memory");}
    asm volatile("s_waitcnt lgkmcnt(0)":::"memory");SBAR();
    #define PK(k) (bf16x8){lo[k][0],lo[k][1],lo[k][2],lo[k][3],hi[k][0],hi[k][1],hi[k][2],hi[k][3]}
    o[d0]=__builtin_amdgcn_mfma_f32_32x32x16_bf16(pa0,PK(0),o[d0],0,0,0);
    o[d0]=__builtin_amdgcn_mfma_f32_32x32x16_bf16(pa1,PK(1),o[d0],0,0,0);
    o[d0]=__builtin_amdgcn_mfma_f32_32x32x16_bf16(pa2,PK(2),o[d0],0,0,0);
    o[d0]=__builtin_amdgcn_mfma_f32_32x32x16_bf16(pa3,PK(3),o[d0],0,0,0);
    #undef PK
  }
}

#ifndef ATTN_STORE16
#define ATTN_STORE16(p,v) (*(u32x4*)(p)=(v))
#endif
template<int THRL> __device__ __forceinline__ void attn_unit(int b,int qb,const bf16*Q,const bf16*__restrict__ K,const bf16*__restrict__ V,bf16*O,char*shm){
  const int tid=threadIdx.x,lane=tid&63,r32=lane&31,hi=lane>>5; const int wid=__builtin_amdgcn_readfirstlane(tid>>6);
  const long rowbase=(long)b*SEQ; const int q0=qb*QB;
  const bf16*Qw=Q+(rowbase+q0+wid*QBLK)*QP;
  const bf16*Kh=K+rowbase*QP,*Vh=V+rowbase*QP;
  const unsigned lds0=(unsigned)(uintptr_t)shm;
  float*wsf=(float*)(shm+LDS_WS)+wid*64;
  const bf16*ksrc=Kh+(long)lane*QP+wid*8;
  const bf16*vsrc=Vh+(long)(16*(wid&3)+(lane>>2))*QP+(wid>>2)*32+(lane&3)*8;
  const unsigned kdst=lds0+LDS_K+wid*1024, vdst=lds0+LDS_V+wid*1024;
  #define DMA_K(t,slot) glds16(ksrc+(long)(t)*KVBLK*QP,(unsigned)__builtin_amdgcn_readfirstlane(kdst+(slot)))
  #define DMA_V(t,slot) glds16(vsrc+(long)(t)*KVBLK*QP,(unsigned)__builtin_amdgcn_readfirstlane(vdst+(slot)))
  const int vb0=(int)(lds0+LDS_V)+((lane>>4)&1)*32+(lane&3)*8+(4*hi+((lane&15)>>2))*64;
  const char*Kbase=shm+LDS_K; bf16x8 kf[8];
  const lds_cptr shm3=(lds_cptr)shm; const lds_cptr kp0=shm3+LDS_K+hi*1024+r32*16; const lds_cptr vp0=shm3+LDS_V+((lane>>4)&1)*32+(lane&3)*8+(4*hi+((lane&15)>>2))*64;
  const int NT=(q0+QB)/KVBLK;
  DMA_K(0,0);DMA_V(0,0);DMA_K(1,SLOTB);
  bf16x8 qr[4];
  #pragma unroll
  for(int d0=0;d0<4;++d0)qr[d0]=*reinterpret_cast<const bf16x8*>(&Qw[(long)r32*QP+d0*16+hi*8]);
  float mhat=0.f,l_reg=0.f;f32x16 o[2];o[0]=f32x16{};o[1]=f32x16{};f32x16 negm=f32x16{};asm volatile("":"+v"(negm));
  const int qrel=wid*QBLK+r32;
  #define CMASK(P0,P1,t) do{int jb_=(t)-(NT-4); if(jb_>=0)cmask(P0,P1,jb_,qrel,hi);}while(0)
  bool resc=false;
  #define START(P0,P1) do{ const float rm=rowmax(P0,P1); resc=false; \
    { const float dl=rm; mhat=fadd_s(mhat,dl); \
      _Pragma("unroll") for(int r=0;r<16;++r){P0[r]=fsub_s(P0[r],dl);P1[r]=fsub_s(P1[r],dl);} \
      _Pragma("unroll") for(int r=0;r<16;++r)negm[r]=-mhat; asm volatile("":"+v"(negm)); } \
    _Pragma("unroll") for(int r=0;r<16;++r)P0[r]=__builtin_amdgcn_exp2f(P0[r]); }while(0)
  #define RESC() do{ if(resc){ asm volatile("s_waitcnt lgkmcnt(0)":::"memory"); \
      _Pragma("unroll") for(int d_=0;d_<2;++d_) _Pragma("unroll") for(int r=0;r<16;++r)o[d_][r]*=wsf[crow(r,hi)]; } }while(0)
  f32x16 pA0,pA1,pB0,pB1;
  int sl_prev=0,sl_cur=0,sl_next=SLOTB;
  #define ROT() do{sl_prev=sl_cur;sl_cur=sl_next;sl_next=(sl_next==(NSLOT-1)*SLOTB)?0:sl_next+SLOTB;}while(0)
  DMA_K(2,2*SLOTB);
  WAIT_BAR(3);
  qkt(pA0,pA1,Kbase,qr,negm,r32,hi);asm volatile("s_nop 15\n\ts_nop 7":"+v"(pA0),"+v"(pA1));CMASK(pA0,pA1,0);
  START(pA0,pA1);
  _Pragma("unroll") for(int r=0;r<16;++r)pA1[r]=__builtin_amdgcn_exp2f(pA1[r]);
  WAIT_BAR(0);
  DMA_K(3,0);DMA_V(1,SLOTB);
  ROT();
  kload8(kf,kp0+sl_cur);
  WAIT_BAR(2);
  s16x4 vlo[8],vhi[8]; u32x4 pw0,pw1,pw2,pw3;
  #define PKW(P,B) cvtpk_s(P[B],P[B+1])
  #define PAF(k) __builtin_bit_cast(bf16x8,pw##k)
  #define VFR(i) (bf16x8){vlo[i][0],vlo[i][1],vlo[i][2],vlo[i][3],vhi[i][0],vhi[i][1],vhi[i][2],vhi[i][3]}
  #define PIN(x) asm volatile("":"+v"(x))
  #define MX3(a,b,c) __builtin_fmaxf(__builtin_fmaxf((a),(b)),(c))
  #define GAPA(MF,A0,A1,A2,A3,W0,W1,PW) do{ MF; sacc+=A0; sacc+=A1; sacc+=A2; sacc+=A3; PIN(sacc); W0; W1; PIN(PW); SBAR(); }while(0)
  #define EX(v) __builtin_amdgcn_exp2f(v)
  #define GAPB(MF,X,B) do{ MF; X[B]=EX(X[B]); X[B+1]=EX(X[B+1]); X[B+2]=EX(X[B+2]); X[B+3]=EX(X[B+3]); PIN(X); SBAR(); }while(0)
  #define VRD(i) do{ vlo[i]=vtr(vp_+(((i)>>2)*4096+((i)&3)*1024)); vhi[i]=vtr(vp_+(((i)>>2)*4096+((i)&3)*1024+512)); }while(0)
  #define KRD(G,j) do{ if(G){ kload2(kf,kp0+sl_next,j); SBAR(); } }while(0)
  #define STEP(C0,C1,P0,P1,t,GK,GV,GL) do{ SBAR(); \
    const lds_cptr vp_=vp0+sl_prev; \
    VRD(0); SBAR(); float sacc=(P0[0]+P0[1]); \
    GAPA(C0=__builtin_amdgcn_mfma_f32_32x32x16_bf16(kf[0],qr[0],negm,0,0,0), P0[2],P0[3],P0[4],P0[5],     pw0[0]=PKW(P0,0), pw0[1]=PKW(P0,2), pw0); \
    VRD(4); SBAR(); GAPA(C1=__builtin_amdgcn_mfma_f32_32x32x16_bf16(kf[1],qr[0],negm,0,0,0), P0[6],P0[7],P0[8],P0[9],     pw0[2]=PKW(P0,4), pw0[3]=PKW(P0,6), pw0); \
    VRD(1); SBAR(); GAPA(C0=__builtin_amdgcn_mfma_f32_32x32x16_bf16(kf[2],qr[1],C0,0,0,0),   P0[10],P0[11],P0[12],P0[13], pw1[0]=PKW(P0,8), pw1[1]=PKW(P0,10), pw1); \
    VRD(5); SBAR(); GAPA(C1=__builtin_amdgcn_mfma_f32_32x32x16_bf16(kf[3],qr[1],C1,0,0,0),   P0[14],P0[15],P1[0],P1[1],   pw1[2]=PKW(P0,12),pw1[3]=PKW(P0,14), pw1); \
    VRD(2); SBAR(); GAPA(C0=__builtin_amdgcn_mfma_f32_32x32x16_bf16(kf[4],qr[2],C0,0,0,0),   P1[2],P1[3],P1[4],P1[5],     pw2[0]=PKW(P1,0), pw2[1]=PKW(P1,2), pw2); \
    VRD(6); SBAR(); GAPA(C1=__builtin_amdgcn_mfma_f32_32x32x16_bf16(kf[5],qr[2],C1,0,0,0),   P1[6],P1[7],P1[8],P1[9],     pw2[2]=PKW(P1,4), pw2[3]=PKW(P1,6), pw2); \
    VRD(3); SBAR(); GAPA(C0=__builtin_amdgcn_mfma_f32_32x32x16_bf16(kf[6],qr[3],C0,0,0,0),   P1[10],P1[11],P1[12],P1[13], pw3[0]=PKW(P1,8), pw3[1]=PKW(P1,10), pw3); \
    VRD(7); SBAR(); GAPA(C1=__builtin_amdgcn_mfma_f32_32x32x16_bf16(kf[7],qr[3],C1,0,0,0),   P1[14],P1[15],0.f,0.f,       pw3[2]=PKW(P1,12),pw3[3]=PKW(P1,14), pw3); \
    l_reg+=sacc; \
    if(GK){DMA_K((t)+3,sl_cur);} if(GV){DMA_V((t)+1,sl_next);} \
    CMASK(C0,C1,t); \
    { float a=MX3(C0[0],C0[1],C1[0]),b=MX3(C0[2],C0[3],C1[1]); a=MX3(a,C1[2],C1[3]); \
      _Pragma("unroll") for(int r=4;r<16;r+=4){a=MX3(a,C0[r],C0[r+1]);b=MX3(b,C0[r+2],C0[r+3]);a=MX3(a,C1[r],C1[r+1]);b=MX3(b,C1[r+2],C1[r+3]);} \
      float rm=__builtin_fmaxf(a,b); { auto rr=__builtin_amdgcn_permlane32_swap(__float_as_uint(rm),__float_as_uint(rm),false,false); rm=__builtin_fmaxf(__uint_as_float(rr[0]),__uint_as_float(rr[1])); } \
      resc=false; \
      if(__builtin_expect(__any(rm>(float)THRL),0)){ const float dl=__builtin_fmaxf(rm,0.f); mhat+=dl; \
        _Pragma("unroll") for(int r=0;r<16;++r){C0[r]-=dl;C1[r]-=dl;} \
        _Pragma("unroll") for(int r=0;r<16;++r)negm[r]=-mhat; asm volatile("":"+v"(negm)); \
        const float f=__builtin_amdgcn_exp2f(-dl); l_reg*=f; if(hi==0)wsf[r32]=f; resc=true; } } \
    SBAR(); \
    GAPB(o[0]=__builtin_amdgcn_mfma_f32_32x32x16_bf16(PAF(0),VFR(0),o[0],0,0,0), C0,0); \
    GAPB(o[1]=__builtin_amdgcn_mfma_f32_32x32x16_bf16(PAF(0),VFR(4),o[1],0,0,0), C0,4); \
    KRD(GL,0); GAPB(o[0]=__builtin_amdgcn_mfma_f32_32x32x16_bf16(PAF(1),VFR(1),o[0],0,0,0), C0,8); \
    KRD(GL,1); GAPB(o[1]=__builtin_amdgcn_mfma_f32_32x32x16_bf16(PAF(1),VFR(5),o[1],0,0,0), C0,12); \
    KRD(GL,2); GAPB(o[0]=__builtin_amdgcn_mfma_f32_32x32x16_bf16(PAF(2),VFR(2),o[0],0,0,0), C1,0); \
    KRD(GL,3); GAPB(o[1]=__builtin_amdgcn_mfma_f32_32x32x16_bf16(PAF(2),VFR(6),o[1],0,0,0), C1,4); \
    GAPB(o[0]=__builtin_amdgcn_mfma_f32_32x32x16_bf16(PAF(3),VFR(3),o[0],0,0,0), C1,8); \
    GAPB(o[1]=__builtin_amdgcn_mfma_f32_32x32x16_bf16(PAF(3),VFR(7),o[1],0,0,0), C1,12); \
    }while(0)
  int t=1;
  #undef CMASK
  #define CMASK(P0,P1,t) do{}while(0)
  for(;t+5<NT;t+=2){
    STEP(pB0,pB1,pA0,pA1,t,true,true,true);     WAIT_BAR(2); RESC(); ROT();
    STEP(pA0,pA1,pB0,pB1,t+1,true,true,true);   WAIT_BAR(2); RESC(); ROT();
  }
  #undef CMASK
  #define CMASK(P0,P1,t) do{int jb_=(t)-(NT-4); if(jb_>=0)cmask(P0,P1,jb_,qrel,hi);}while(0)
  #define ENDW(tt) do{ if((tt)+3<NT){WAIT_BAR(2);} else if((tt)+2<NT){WAIT_BAR(1);} else {WAIT_BAR(0);} }while(0)
  for(;t+1<NT;t+=2){
    STEP(pB0,pB1,pA0,pA1,t,(t+3<NT),(t+1<NT),(t+1<NT));       ENDW(t);   RESC(); ROT();
    STEP(pA0,pA1,pB0,pB1,t+1,(t+4<NT),(t+2<NT),(t+2<NT));     ENDW(t+1); RESC(); ROT();
  }
  STEP(pB0,pB1,pA0,pA1,NT-1,false,false,false); RESC();
  { float sacc=pB0[0]+pB0[1]; _Pragma("unroll") for(int r=2;r<16;++r)sacc+=pB0[r]; _Pragma("unroll") for(int r=0;r<16;++r)sacc+=pB1[r]; l_reg+=sacc;
    pw0=(u32x4){PKW(pB0,0),PKW(pB0,2),PKW(pB0,4),PKW(pB0,6)};pw1=(u32x4){PKW(pB0,8),PKW(pB0,10),PKW(pB0,12),PKW(pB0,14)};pw2=(u32x4){PKW(pB1,0),PKW(pB1,2),PKW(pB1,4),PKW(pB1,6)};pw3=(u32x4){PKW(pB1,8),PKW(pB1,10),PKW(pB1,12),PKW(pB1,14)};
    SBAR(); pv(o,vb0+sl_cur,PAF(0),PAF(1),PAF(2),PAF(3)); }
  #undef PKW
  #undef PAF
  #undef VFR
  #undef PIN
  #undef MX3
  #undef GAPA
  #undef GAPB
  #undef EX
  #undef VRD
  #undef KRD
  #undef STEP
  #undef ENDW
  {auto rr=__builtin_amdgcn_permlane32_swap(__float_as_uint(l_reg),__float_as_uint(l_reg),false,false);l_reg=__uint_as_float(rr[0])+__uint_as_float(rr[1]);}
  if(hi==0)wsf[32+r32]=l_reg;asm volatile("s_waitcnt lgkmcnt(0)":::"memory");
  float rli[16];
  #pragma unroll
  for(int r=0;r<16;++r)rli[r]=__builtin_amdgcn_rcpf(wsf[32+crow(r,hi)]);
  bf16*Ow=O+(rowbase+q0+wid*QBLK)*OP;
  { bf16*stg=(bf16*)(shm+LDS_OST)+wid*2048;
    #pragma unroll
    for(int r=0;r<16;++r){const int orow=crow(r,hi);
      #pragma unroll
      for(int d0=0;d0<2;++d0)stg[orow*64+d0*32+r32]=__float2bfloat16(o[d0][r]*rli[r]);}
    asm volatile("s_waitcnt lgkmcnt(0)":::"memory");
    #pragma unroll
    for(int i=0;i<4;++i){const int row=i*8+(lane>>3),ch=lane&7; const u32x4 v=*(const u32x4*)(stg+row*64+ch*8); ATTN_STORE16(Ow+(long)row*OP+ch*8,v);} }
  asm volatile("s_waitcnt lgkmcnt(0)\n\ts_barrier":::"memory");
  #undef DMA_K
  #undef DMA_V
  #undef CMASK
  #undef START
  #undef RESC
  #undef ROT
}
constexpr int ATTN_LDS_BYTES=LDS_BYTES;
struct AttnTensors { const bf16* U; bf16* O; };
__device__ __forceinline__ void attn_phase_static(char*lds,const AttnTensors&T,int vcu){
  if(vcu>=256)return; const int s=vcu&1,pr=vcu>>1; const int b=pr>>4,ph=pr&15; const int h=ph>>2,c=(ph>>1)&1,vh=ph&1;
  for(int i=0;i<4;++i){ const int qb=(i==0)?(7-s):(i==1)?s:(i==2)?(4+s):(3-s);
    attn_unit<8>(b,qb,T.U+h*128+c*64,T.U+512+h*128+c*64,T.U+1024+h*128+vh*64,T.O+ph*64,lds); }
}
template<int THRL=8> __device__ __forceinline__ void attn_phase_dyn(char*lds,const AttnTensors&T,unsigned*ctr,volatile __attribute__((address_space(3))) unsigned*bcast,int q0){
  for(int dq=0;dq<8;++dq){ const int q=(q0+dq)&7;
    for(;;){
      if(threadIdx.x==0) bcast[0]=__hip_atomic_fetch_add(ctr+64*q,1u,__ATOMIC_RELAXED,__HIP_MEMORY_SCOPE_AGENT);
      __syncthreads(); const unsigned j=bcast[0]; __syncthreads();
      if(j>=128u)break;
      const int pr=q*16+(int)(j>>3),qb=7-(int)(j&7); const int b=pr>>4,ph=pr&15; const int h=ph>>2,c=(ph>>1)&1,vh=ph&1;
      attn_unit<THRL>(b,qb,T.U+h*128+c*64,T.U+512+h*128+c*64,T.U+1024+h*128+vh*64,T.O+ph*64,lds);
    }
  }
}
#undef SBAR
#undef WAIT_BAR
}

namespace scan_body {
#define SLDS __attribute__((address_space(3)))
typedef float sf4 __attribute__((ext_vector_type(4)));
typedef float sf2 __attribute__((ext_vector_type(2)));
typedef unsigned su2 __attribute__((ext_vector_type(2)));
constexpr int TB = 16;
constexpr int OFF_NKK = 0, OFF_DEC = TB * 64, OFF_BB = 2 * TB * 64, OFF_KM = 3 * TB * 64, OFF_RR = 4 * TB * 64, OFF_VV = 5 * TB * 64, IN_FLOATS = 5 * TB * 64 + TB * 32, YP_FLOATS = TB * 512;
constexpr int OFF_YP = 2 * IN_FLOATS;
constexpr int SCAN_LDS_BYTES = (2 * IN_FLOATS + 2 * YP_FLOATS) * 4;
__device__ __forceinline__ float bf_lo(unsigned w) { return __uint_as_float(w << 16); }
__device__ __forceinline__ float bf_hi(unsigned w) { return __uint_as_float(w & 0xffff0000u); }
__device__ __forceinline__ unsigned pk_bf(float lo, float hi) { unsigned a = __builtin_bit_cast(unsigned, lo), b = __builtin_bit_cast(unsigned, hi);
    a = (a + 0x7fffu + ((a >> 16) & 1u)) >> 16; b = (b + 0x7fffu + ((b >> 16) & 1u)) & 0xffff0000u; return a | b; }
template <int CTRL> __device__ __forceinline__ float dpp_add(float x) {
    return x + __builtin_bit_cast(float, __builtin_amdgcn_mov_dpp(__builtin_bit_cast(int, x), CTRL, 0xF, 0xF, true));
}
__device__ __forceinline__ float reduce16(float x) {
    x = dpp_add<0xB1>(x);
    x = dpp_add<0x4E>(x);
    x = dpp_add<0x124>(x);
    x = dpp_add<0x128>(x);
    return x;
}
struct ScanArgs { const unsigned short* U; const unsigned short* E; unsigned short* Y; unsigned short* BT; const float* mu; const float* k_k; const float* k_a; const float* r_k; const float* w0; const float* a0; };
struct PrepRegs { su2 rc, kc, vc, rp, kp, vp, ew, ea; };

__device__ __forceinline__ void prep_load(PrepRegs& R, const ScanArgs& A, int b, int h, int blk, int tid) {
    const int i = tid >> 4, c = h * 64 + (tid & 15) * 4, t = blk * TB + i;
    const size_t tok = (size_t)b * 2048 + t;
    const unsigned short* ur = A.U + tok * 3328 + 1536 + c;
    R.rc = *(const su2*)ur; R.kc = *(const su2*)(ur + 512); R.vc = *(const su2*)(ur + 1024);
    const unsigned short* up = (t > 0) ? ur - 3328 : ur;
    R.rp = *(const su2*)up; R.kp = *(const su2*)(up + 512); R.vp = *(const su2*)(up + 1024);
    R.ew = *(const su2*)(A.E + tok * 1536 + c); R.ea = *(const su2*)(A.E + tok * 1536 + 512 + c);
}
__device__ __forceinline__ void prep_compute(SLDS float* buf, const PrepRegs& R, const ScanArgs& A, int b, int h, int hf, int blk, int tid,
                                             const sf4& mu_r, const sf4& mu_k, const sf4& mu_v, const sf4& kkw, const sf4& kaw, const sf4& rkw, const sf4& w0c, const sf4& a0c) {
    const int i = tid >> 4, sl = tid & 15, t = blk * TB + i;
    const float pz = (t > 0) ? 1.0f : 0.0f;
    sf4 rc = {bf_lo(R.rc.x), bf_hi(R.rc.x), bf_lo(R.rc.y), bf_hi(R.rc.y)}, kc = {bf_lo(R.kc.x), bf_hi(R.kc.x), bf_lo(R.kc.y), bf_hi(R.kc.y)}, vc = {bf_lo(R.vc.x), bf_hi(R.vc.x), bf_lo(R.vc.y), bf_hi(R.vc.y)};
    sf4 rp = {bf_lo(R.rp.x), bf_hi(R.rp.x), bf_lo(R.rp.y), bf_hi(R.rp.y)}, kp = {bf_lo(R.kp.x), bf_hi(R.kp.x), bf_lo(R.kp.y), bf_hi(R.kp.y)}, vp = {bf_lo(R.vp.x), bf_hi(R.vp.x), bf_lo(R.vp.y), bf_hi(R.vp.y)};
    rp = rp * pz; kp = kp * pz; vp = vp * pz;
    const sf4 r = rc + (rp - rc) * mu_r, k = kc + (kp - kc) * mu_k, v = vc + (vp - vc) * mu_v;
    const sf4 zw = w0c + (sf4){bf_lo(R.ew.x), bf_hi(R.ew.x), bf_lo(R.ew.y), bf_hi(R.ew.y)}, za = a0c + (sf4){bf_lo(R.ea.x), bf_hi(R.ea.x), bf_lo(R.ea.y), bf_hi(R.ea.y)};
    sf4 dec, a;
#pragma unroll
    for (int e = 0; e < 4; ++e) { const float nx = -zw[e]; const float sp = fmaxf(nx, 0.f) + __logf(1.0f + __expf(-fabsf(nx)));
        dec[e] = __expf(-__expf(-sp - 0.5f));
        a[e] = __builtin_amdgcn_rcpf(1.0f + __expf(-za[e])); }
    const sf4 kkr = k * kkw;
    const float n2 = reduce16((kkr.x * kkr.x + kkr.y * kkr.y) + (kkr.z * kkr.z + kkr.w * kkr.w));
    const sf4 kk = kkr * (1.0f / fmaxf(sqrtf(n2), 1e-12f));
    const sf4 km = k * (1.0f + (a - 1.0f) * kaw);
    const sf4 rkm = r * km * rkw;
    const float bon = reduce16((rkm.x + rkm.y) + (rkm.z + rkm.w));
    *(SLDS sf4*)&buf[OFF_NKK + i * 64 + sl * 4] = -kk;
    *(SLDS sf4*)&buf[OFF_DEC + i * 64 + sl * 4] = dec;
    *(SLDS sf4*)&buf[OFF_BB + i * 64 + sl * 4] = kk * a;
    *(SLDS sf4*)&buf[OFF_KM + i * 64 + sl * 4] = km;
    *(SLDS sf4*)&buf[OFF_RR + i * 64 + sl * 4] = r;
    if ((sl >> 3) == hf) {
        SLDS float* vv = &buf[OFF_VV + i * 32 + ((sl & 7) >> 1) * 8 + (sl & 1)];
        vv[0] = v.x; vv[2] = v.y; vv[4] = v.z; vv[6] = v.w;
        const sf4 bt = v * bon; su2 o; o.x = pk_bf(bt.x, bt.y); o.y = pk_bf(bt.z, bt.w);
        *(su2*)(A.BT + ((size_t)b * 2048 + t) * 512 + h * 64 + sl * 4) = o;
    }
}
struct StepOps { sf4 nk, dc, bb, km, rr; sf2 v; };
__device__ __forceinline__ void step_load(StepOps& o, const SLDS float* L, int i, int kq, int vo) {
    o.nk = *(const SLDS sf4*)&L[OFF_NKK + i * 64 + kq]; o.dc = *(const SLDS sf4*)&L[OFF_DEC + i * 64 + kq]; o.bb = *(const SLDS sf4*)&L[OFF_BB + i * 64 + kq];
    o.km = *(const SLDS sf4*)&L[OFF_KM + i * 64 + kq]; o.rr = *(const SLDS sf4*)&L[OFF_RR + i * 64 + kq]; o.v = *(const SLDS sf2*)&L[OFF_VV + i * 32 + vo];
}
__device__ __forceinline__ void step_compute(const StepOps& o, sf2& a01, sf2& a23, sf2& b01, sf2& b23, SLDS sf2* yp) {
    const sf2 pa = a01 * o.nk.xy + a23 * o.nk.zw, pb = b01 * o.nk.xy + b23 * o.nk.zw;
    const sf2 va = {o.v.x, o.v.x}, vb = {o.v.y, o.v.y};
    const float sa = reduce16(pa.x + pa.y), sb = reduce16(pb.x + pb.y);
    const sf2 sa2 = {sa, sa}, sb2 = {sb, sb};
    a01 = a01 * o.dc.xy + (sa2 * o.bb.xy + va * o.km.xy);
    a23 = a23 * o.dc.zw + (sa2 * o.bb.zw + va * o.km.zw);
    b01 = b01 * o.dc.xy + (sb2 * o.bb.xy + vb * o.km.xy);
    b23 = b23 * o.dc.zw + (sb2 * o.bb.zw + vb * o.km.zw);
    const sf2 qa = a01 * o.rr.xy + a23 * o.rr.zw, qb = b01 * o.rr.xy + b23 * o.rr.zw;
    *yp = (sf2){qa.x + qa.y, qb.x + qb.y};
}
__device__ __forceinline__ void flush_block(const SLDS float* YPb, const ScanArgs& A, int b, int h, int hf, int blk, int ptid) {
    const int i = ptid >> 4, w = (ptid >> 2) & 3, g = ptid & 3;
    const SLDS sf4* pp = (const SLDS sf4*)&YPb[i * 512 + (w * 64 + g * 16) * 2];
    sf4 acc = pp[0];
#pragma unroll
    for (int q = 1; q < 8; ++q) acc = acc + pp[q];
    unsigned short* yr = A.Y + ((size_t)b * 2048 + blk * TB + i) * 512 + h * 64 + hf * 32 + w * 8 + g;
    const unsigned pk = pk_bf(acc.x + acc.z, acc.y + acc.w);
    yr[0] = (unsigned short)(pk & 0xffffu); yr[4] = (unsigned short)(pk >> 16);
}
__device__ __forceinline__ void scan_unit(SLDS float* L, const ScanArgs& A, int b, int h, int hf) {
    const int tid = threadIdx.x, lane = tid & 63; const int wid = __builtin_amdgcn_readfirstlane(tid >> 6);
    constexpr int NBLK = 2048 / TB;
    if (wid >= 4) {
        const int ptid = tid - 256;
        const int c0 = h * 64 + (ptid & 15) * 4;
        const sf4 mu_r = *(const sf4*)(A.mu + c0), mu_k = *(const sf4*)(A.mu + 512 + c0), mu_v = *(const sf4*)(A.mu + 1024 + c0);
        const sf4 kkw = *(const sf4*)(A.k_k + c0), kaw = *(const sf4*)(A.k_a + c0), rkw = *(const sf4*)(A.r_k + c0), w0c = *(const sf4*)(A.w0 + c0), a0c = *(const sf4*)(A.a0 + c0);
        PrepRegs R;
        prep_load(R, A, b, h, 0, ptid);
        prep_compute(L, R, A, b, h, hf, 0, ptid, mu_r, mu_k, mu_v, kkw, kaw, rkw, w0c, a0c);
        prep_load(R, A, b, h, 1, ptid);
        __syncthreads();
        for (int blk = 0; blk < NBLK; ++blk) {
            if (blk + 1 < NBLK) prep_compute(L + ((blk + 1) & 1) * IN_FLOATS, R, A, b, h, hf, blk + 1, ptid, mu_r, mu_k, mu_v, kkw, kaw, rkw, w0c, a0c);
            if (blk + 2 < NBLK) prep_load(R, A, b, h, blk + 2, ptid);
            if (blk >= 1) flush_block(L + OFF_YP + ((blk - 1) & 1) * YP_FLOATS, A, b, h, hf, blk - 1, ptid);
            __syncthreads();
        }
        flush_block(L + OFF_YP + ((NBLK - 1) & 1) * YP_FLOATS, A, b, h, hf, NBLK - 1, ptid);
    } else {
        sf2 a01 = {0.f, 0.f}, a23 = {0.f, 0.f}, b01 = {0.f, 0.f}, b23 = {0.f, 0.f};
        const int kq = (lane & 15) * 4, vo = wid * 8 + (lane >> 4) * 2;
        __syncthreads();
        for (int blk = 0; blk < NBLK; ++blk) {
            const SLDS float* IN = L + (blk & 1) * IN_FLOATS;
            SLDS sf2* ypl = (SLDS sf2*)(L + OFF_YP + (blk & 1) * YP_FLOATS) + tid;
            StepOps oa, ob, na, nb;
            step_load(oa, IN, 0, kq, vo); step_load(ob, IN, 1, kq, vo);
#pragma unroll
            for (int i = 0; i < TB; i += 2) {
                if (i + 2 < TB) { step_load(na, IN, i + 2, kq, vo); step_load(nb, IN, i + 3, kq, vo); }
                __builtin_amdgcn_sched_barrier(0);
                step_compute(oa, a01, a23, b01, b23, ypl + i * 256);
                step_compute(ob, a01, a23, b01, b23, ypl + (i + 1) * 256);
                __builtin_amdgcn_sched_barrier(0);
                oa = na; ob = nb;
            }
            __syncthreads();
        }
    }
    __syncthreads();
}
}

#ifndef RW_STAGE
#define RW_STAGE 0
#endif
#ifndef PROBE_K
#define PROBE_K (-1)
#endif
namespace rwkv_body {
#define RWSTAMP(k) do { if (PROBE_K >= 0 && blockIdx.x == 0 && threadIdx.x == 0 && c == 0) tsp[k] = __builtin_amdgcn_s_memrealtime(); } while (0)
#define RL __attribute__((address_space(3)))
#define RWBAR() do { asm volatile("s_waitcnt lgkmcnt(0)" ::: "memory"); __builtin_amdgcn_s_barrier(); asm volatile("" ::: "memory"); } while (0)
typedef short h8 __attribute__((ext_vector_type(8)));
typedef float f4 __attribute__((ext_vector_type(4)));
typedef unsigned u2 __attribute__((ext_vector_type(2)));
typedef unsigned u4 __attribute__((ext_vector_type(4)));
constexpr int ST = 72, SB = ST * 2, MBY = 64 * SB;
constexpr int O_AH = 0, O_BH = MBY, O_KH = 2 * MBY, O_RH = 3 * MBY, O_KHT = 4 * MBY, O_BHT = 5 * MBY, O_VMT = 6 * MBY, O_YT = 7 * MBY  ,
              O_MP0 = 9 * MBY, O_MPT0 = 10 * MBY, O_MP1 = 11 * MBY, O_MPT1 = 12 * MBY, O_OT = 13 * MBY, O_PC = O_OT + 2048, O_KC = O_PC + 256  , RWKV_LDS_BYTES = O_KC + 2048;
constexpr int O_CL = O_MP0;
constexpr int O_VM = O_MP1;
__device__ __forceinline__ float bflo(unsigned w) { return __uint_as_float(w << 16); }
__device__ __forceinline__ float bfhi(unsigned w) { return __uint_as_float(w & 0xffff0000u); }
typedef float f2t_ __attribute__((ext_vector_type(2))); typedef __bf16 b2t_ __attribute__((ext_vector_type(2)));
__device__ __forceinline__ unsigned pkbf(float lo, float hi) { const f2t_ v = {lo, hi}; const b2t_ b = __builtin_convertvector(v, b2t_); return __builtin_bit_cast(unsigned, b); }
template <int CTRL> __device__ __forceinline__ float dppadd(float x) { return x + __builtin_bit_cast(float, __builtin_amdgcn_mov_dpp(__builtin_bit_cast(int, x), CTRL, 0xF, 0xF, true)); }
__device__ __forceinline__ float reduce8(float x) { x = dppadd<0xB1>(x); x = dppadd<0x4E>(x); x = dppadd<0x141>(x); return x; }
__device__ __forceinline__ h8 ldfrag(const RL char* base, int row0, int ks, int lane) { return *(const RL h8*)(base + (row0 + (lane & 15)) * SB + ks * 64 + (lane >> 4) * 16); }
__device__ __forceinline__ void mma2(f4& acc, const RL char* A, int am0, const RL char* B, int bn0, int lane) {
    acc = __builtin_amdgcn_mfma_f32_16x16x32_bf16(ldfrag(A, am0, 0, lane), ldfrag(B, bn0, 0, lane), acc, 0, 0, 0);
    acc = __builtin_amdgcn_mfma_f32_16x16x32_bf16(ldfrag(A, am0, 1, lane), ldfrag(B, bn0, 1, lane), acc, 0, 0, 0);
}
__device__ __forceinline__ void mma2p(f4& acc0, f4& acc1, const RL char* A, int am0, const RL char* B, int bn0, int lane) {
    const h8 a0 = ldfrag(A, am0, 0, lane), a1 = ldfrag(A, am0, 1, lane);
    acc0 = __builtin_amdgcn_mfma_f32_16x16x32_bf16(a0, ldfrag(B, bn0, 0, lane), acc0, 0, 0, 0); acc1 = __builtin_amdgcn_mfma_f32_16x16x32_bf16(a0, ldfrag(B, bn0 + 16, 0, lane), acc1, 0, 0, 0);
    acc0 = __builtin_amdgcn_mfma_f32_16x16x32_bf16(a1, ldfrag(B, bn0, 1, lane), acc0, 0, 0, 0); acc1 = __builtin_amdgcn_mfma_f32_16x16x32_bf16(a1, ldfrag(B, bn0 + 16, 1, lane), acc1, 0, 0, 0);
}
__device__ __forceinline__ void storeT(RL char* dst, int m0, int n0, const f4& acc, int lane) {
    u2 w; w.x = pkbf(acc[0], acc[1]); w.y = pkbf(acc[2], acc[3]);
    *(RL u2*)(dst + (n0 + (lane & 15)) * SB + (m0 + 4 * (lane >> 4)) * 2) = w;
}
struct Args { unsigned long long* tsp_; const unsigned short* U; const unsigned short* E; unsigned short* Y; unsigned short* BT; unsigned char* GH; unsigned char* Q1; unsigned char* Q2;
              const float* mu; const float* k_k; const float* k_a; const float* r_k; const float* w0; const float* a0; };
__device__ __forceinline__ unsigned char* qptr(const Args& A, int cid) { return cid < 1024 ? A.Q1 + (size_t)cid * 8192 : A.Q2 + (size_t)(cid - 1024) * 8192; }

struct ChunkLoads { u4 rc, kc, vc, rp, kp, vp, ew, ea; };
__device__ __forceinline__ void chunk_consts_to_lds(RL char* L, const Args& A, int h) {
    const int tid = threadIdx.x; RL float* kc = (RL float*)(L + O_KC);
    if (tid < 64) { const int c = h * 64 + tid; kc[tid] = A.mu[c]; kc[64 + tid] = A.mu[512 + c]; kc[128 + tid] = A.mu[1024 + c]; kc[192 + tid] = A.k_k[c]; kc[256 + tid] = A.k_a[c]; kc[320 + tid] = A.r_k[c]; kc[384 + tid] = A.w0[c]; kc[448 + tid] = A.a0[c]; }
}
__device__ __forceinline__ void chunk_load(ChunkLoads& R, const Args& A, int b, int h, int c) {
    const int tid = threadIdx.x, ti = tid >> 3, ch0 = 8 * (tid & 7), t = c * 64 + ti;
    const size_t tok = (size_t)b * 2048 + t;
    const unsigned short* ur = A.U + tok * 3328 + 1536 + h * 64 + ch0;
    R.rc = *(const u4*)ur; R.kc = *(const u4*)(ur + 512); R.vc = *(const u4*)(ur + 1024);
    const unsigned short* up = (t > 0) ? ur - 3328 : ur;
    R.rp = *(const u4*)up; R.kp = *(const u4*)(up + 512); R.vp = *(const u4*)(up + 1024);
    R.ew = *(const u4*)(A.E + tok * 1536 + h * 64 + ch0); R.ea = *(const u4*)(A.E + tok * 1536 + 512 + h * 64 + ch0);
}
#define CVT_LOAD(P_, N_) const f4 cv0 = *(const f4*)(P_), cv1 = *(const f4*)((P_) + (size_t)(N_)), cv2 = *(const f4*)((P_) + (size_t)2 * (N_)), cv3 = *(const f4*)((P_) + (size_t)3 * (N_)), \
                               cv4 = *(const f4*)((P_) + (size_t)4 * (N_)), cv5 = *(const f4*)((P_) + (size_t)5 * (N_)), cv6 = *(const f4*)((P_) + (size_t)6 * (N_)), cv7 = *(const f4*)((P_) + (size_t)7 * (N_))
#define CVT_STORE(Q_, K_) do { _Pragma("unroll") for (int e_ = 0; e_ < 4; ++e_) *(u4*)((Q_) + (size_t)e_ * (K_)) = (u4){pkbf(cv0[e_], cv1[e_]), pkbf(cv2[e_], cv3[e_]), pkbf(cv4[e_], cv5[e_]), pkbf(cv6[e_], cv7[e_])}; } while (0)
__device__ __forceinline__ void rwkv_chunk_task(RL char* L, const Args& A, const ChunkLoads& LD, ChunkLoads& NEXT, bool has_next, int b, int h, int c, int cnext, const float* jWg, const float* jWu, unsigned short* jWGU, int jitem) {
    const int tid = threadIdx.x, lane = tid & 63; const int wid = __builtin_amdgcn_readfirstlane(tid >> 6);
    const int cid = (b * 8 + h) * 32 + c; unsigned long long* tsp = A.tsp_;
    RWSTAMP(17);
    const int ti = tid >> 3, ch0 = 8 * (tid & 7), t = c * 64 + ti;
    const size_t tok = (size_t)b * 2048 + t;
    float r8[8], km8[8], b8[8], nk8[8], v8[8], lw8[8];
    {
        const u4 rc = LD.rc, kc = LD.kc, vc = LD.vc, rp = LD.rp, kp = LD.kp, vp = LD.vp, ew = LD.ew, ea = LD.ea;
        const float pz = (t > 0) ? 1.0f : 0.0f;
        const RL float* kcst = (const RL float*)(L + O_KC) + ch0;
        float cmr[8], cmk[8], cmv[8], ckk[8], cka[8], crk[8], cw0[8], ca0[8];
#define LDC8(dst, off) do { const f4 t0_ = *(const RL f4*)(kcst + (off)), t1_ = *(const RL f4*)(kcst + (off) + 4); dst[0] = t0_[0]; dst[1] = t0_[1]; dst[2] = t0_[2]; dst[3] = t0_[3]; dst[4] = t1_[0]; dst[5] = t1_[1]; dst[6] = t1_[2]; dst[7] = t1_[3]; } while (0)
        LDC8(cmr, 0); LDC8(cmk, 64); LDC8(cmv, 128); LDC8(ckk, 192); LDC8(cka, 256); LDC8(crk, 320); LDC8(cw0, 384); LDC8(ca0, 448);
#undef LDC8
        float kkr[8], ag[8]; float n2 = 0.f, bon = 0.f;
#pragma unroll
        for (int e = 0; e < 8; ++e) {
            const unsigned wr = rc[e >> 1], wk = kc[e >> 1], wv = vc[e >> 1], pr = rp[e >> 1], pk = kp[e >> 1], pv = vp[e >> 1], we = ew[e >> 1], wa = ea[e >> 1];
            const float rcur = (e & 1) ? bfhi(wr) : bflo(wr), kcur = (e & 1) ? bfhi(wk) : bflo(wk), vcur = (e & 1) ? bfhi(wv) : bflo(wv);
            const float rprv = ((e & 1) ? bfhi(pr) : bflo(pr)) * pz, kprv = ((e & 1) ? bfhi(pk) : bflo(pk)) * pz, vprv = ((e & 1) ? bfhi(pv) : bflo(pv)) * pz;
            const float rr = rcur + (rprv - rcur) * cmr[e], kk_ = kcur + (kprv - kcur) * cmk[e], vv = vcur + (vprv - vcur) * cmv[e];
            const float zw = cw0[e] + ((e & 1) ? bfhi(we) : bflo(we)), za = ca0[e] + ((e & 1) ? bfhi(wa) : bflo(wa));
            const float nx = -zw; const float sp = fmaxf(nx, 0.f) + __logf(1.0f + __expf(-fabsf(nx)));
            lw8[e] = -__expf(-sp - 0.5f);
            ag[e] = __builtin_amdgcn_rcpf(1.0f + __expf(-za));
            kkr[e] = kk_ * ckk[e]; n2 += kkr[e] * kkr[e];
            km8[e] = kk_ * (1.0f + (ag[e] - 1.0f) * cka[e]);
            r8[e] = rr; v8[e] = vv; bon += rr * km8[e] * crk[e];
        }
        n2 = reduce8(n2); bon = reduce8(bon);
        const float inv = 1.0f / fmaxf(sqrtf(n2), 1e-12f);
#pragma unroll
        for (int e = 0; e < 8; ++e) { const float kk = kkr[e] * inv; nk8[e] = -kk; b8[e] = kk * ag[e]; }
        u4 bo; bo.x = pkbf(bon * v8[0], bon * v8[1]); bo.y = pkbf(bon * v8[2], bon * v8[3]); bo.z = pkbf(bon * v8[4], bon * v8[5]); bo.w = pkbf(bon * v8[6], bon * v8[7]);
        *(u4*)(A.BT + tok * 512 + h * 64 + ch0) = bo;
        RL float* cl = (RL float*)(L + O_CL) + ti * 64 + ch0;
        *(RL f4*)cl = (f4){lw8[0], lw8[1], lw8[2], lw8[3]}; *(RL f4*)(cl + 4) = (f4){lw8[4], lw8[5], lw8[6], lw8[7]};
    }
    if (has_next) chunk_load(NEXT, A, b, h, cnext);
    const int citem = jitem >= 0 ? jitem : 0;
    const int ce_ = citem >> 9, cmat = (citem >> 8) & 1, cit = citem & 255; const int ck0 = 64 * (cit >> 4), cn0 = 32 * (cit & 15);
    const float* cvp = (cmat ? jWu : jWg) + (size_t)ce_ * 1024 * 512 + (size_t)(ck0 + 8 * (lane >> 3)) * 512 + cn0 + 4 * (lane & 7);
    CVT_LOAD(cvp, 512);
    RWBAR();
    {
        RL float* cl = (RL float*)(L + O_CL); RL float* ot = (RL float*)(L + O_OT);
        const int ch = tid & 63, oc = tid >> 6;
        float run = 0.f, loc[8];
#pragma unroll
        for (int j = 0; j < 8; ++j) { run += cl[(8 * oc + j) * 64 + ch]; loc[j] = run; }
        ot[oc * 64 + ch] = run;
        RWBAR();
        float off = 0.f;
#pragma unroll
        for (int o = 0; o < 7; ++o) off += (o < oc) ? ot[o * 64 + ch] : 0.f;
#pragma unroll
        for (int j = 0; j < 8; ++j) cl[(8 * oc + j) * 64 + ch] = loc[j] + off;
        if (oc == 7) ((RL float*)(L + O_PC))[ch] = __expf(loc[7] + off);
    }
    RWBAR();
    {
        const RL float* cl = (const RL float*)(L + O_CL) + ti * 64 + ch0;
        const f4 c0 = *(const RL f4*)cl, c1 = *(const RL f4*)(cl + 4);
        const float cl8[8] = {c0[0], c0[1], c0[2], c0[3], c1[0], c1[1], c1[2], c1[3]};
        float ah[8], bh[8], kh[8], rh[8];
#pragma unroll
        for (int e = 0; e < 8; ++e) { const float P = __expf(cl8[e]), Pp = __expf(cl8[e] - lw8[e]), iP = __expf(-cl8[e]);
            ah[e] = nk8[e] * Pp; bh[e] = b8[e] * iP; kh[e] = km8[e] * iP; rh[e] = r8[e] * P; }
        const int off = ti * SB + ch0 * 2;
        *(RL u4*)(L + O_AH + off) = (u4){pkbf(ah[0], ah[1]), pkbf(ah[2], ah[3]), pkbf(ah[4], ah[5]), pkbf(ah[6], ah[7])};
        *(RL u4*)(L + O_BH + off) = (u4){pkbf(bh[0], bh[1]), pkbf(bh[2], bh[3]), pkbf(bh[4], bh[5]), pkbf(bh[6], bh[7])};
        *(RL u4*)(L + O_KH + off) = (u4){pkbf(kh[0], kh[1]), pkbf(kh[2], kh[3]), pkbf(kh[4], kh[5]), pkbf(kh[6], kh[7])};
        *(RL u4*)(L + O_RH + off) = (u4){pkbf(rh[0], rh[1]), pkbf(rh[2], rh[3]), pkbf(rh[4], rh[5]), pkbf(rh[6], rh[7])};
        *(RL u4*)(L + O_VM + off) = (u4){pkbf(v8[0], v8[1]), pkbf(v8[2], v8[3]), pkbf(v8[4], v8[5]), pkbf(v8[6], v8[7])};
    }
    RWBAR();
    {
        const int k = tid & 63, og = tid >> 6;
        const int srcs[4] = {O_KH, O_BH, O_VM, O_AH}, dsts[4] = {O_KHT, O_BHT, O_VMT, O_YT};
#pragma unroll
        for (int q = 0; q < 4; ++q) {
            unsigned short e[8];
#pragma unroll
            for (int j = 0; j < 8; ++j) e[j] = *(const RL unsigned short*)(L + srcs[q] + (8 * og + j) * SB + k * 2);
            *(RL u4*)(L + dsts[q] + k * SB + og * 16) = (u4){(unsigned)e[0] | ((unsigned)e[1] << 16), (unsigned)e[2] | ((unsigned)e[3] << 16), (unsigned)e[4] | ((unsigned)e[5] << 16), (unsigned)e[6] | ((unsigned)e[7] << 16)};
        }
    }
    RWBAR(); RWSTAMP(18);
    const int mb = wid & 3, nb0 = 2 * (wid >> 2);
    const int lm = 4 * (lane >> 4), ln = lane & 15;
    {
        const int m_ = 16 * mb + lm, na = 16 * nb0 + ln, nb_ = na + 16;
        f4 c1a = {0.f, 0.f, 0.f, 0.f}, c1b = c1a, c2a = c1a, c2b = c1a, c3a = c1a, c3b = c1a;
        mma2p(c1a, c1b, L + O_BH, 16 * mb, L + O_AH, 16 * nb0, lane);
        mma2p(c2a, c2b, L + O_AH, 16 * mb, L + O_BH, 16 * nb0, lane);
        mma2p(c3a, c3b, L + O_KH, 16 * mb, L + O_AH, 16 * nb0, lane);
#pragma unroll
        for (int q = 0; q < 4; ++q) { if (!(na > m_ + q)) { c1a[q] = 0.f; c3a[q] = 0.f; } if (!(m_ + q > na)) c2a[q] = 0.f;
                                      if (!(nb_ > m_ + q)) { c1b[q] = 0.f; c3b[q] = 0.f; } if (!(m_ + q > nb_)) c2b[q] = 0.f; }
        storeT(L + O_MP0, 16 * mb, 16 * nb0, c1a, lane); storeT(L + O_MPT0, 16 * mb, 16 * nb0, c2a, lane); storeT(L + O_MP1, 16 * mb, 16 * nb0, c3a, lane);
        storeT(L + O_MP0, 16 * mb, 16 * nb0 + 16, c1b, lane); storeT(L + O_MPT0, 16 * mb, 16 * nb0 + 16, c2b, lane); storeT(L + O_MP1, 16 * mb, 16 * nb0 + 16, c3b, lane);
    }
    RWBAR();
    {   f4 cxa = {0.f, 0.f, 0.f, 0.f}, cxb = cxa; mma2p(cxa, cxb, L + O_MP1, 16 * mb, L + O_VMT, 16 * nb0, lane);
        storeT(L + O_YT + 64 * SB, 16 * mb, 16 * nb0, cxa, lane); storeT(L + O_YT + 64 * SB, 16 * mb, 16 * nb0 + 16, cxb, lane); }
    RWBAR();
    {
        f4 acc[4];
        const RL char* yrow = L + O_YT + (16 * wid + ln) * SB;
#pragma unroll
        for (int ib = 0; ib < 4; ++ib) { const u2 w = *(const RL u2*)(yrow + (16 * ib + lm) * 2); acc[ib] = (f4){bflo(w.x), bfhi(w.x), bflo(w.y), bfhi(w.y)}; }
#pragma unroll
        for (int lev = 0; lev < 6; ++lev) {
            const RL char* Mp = L + ((lev & 1) ? O_MP1 : O_MP0); const RL char* MpT = L + ((lev & 1) ? O_MPT1 : O_MPT0);
            RL char* Mn = L + ((lev & 1) ? O_MP0 : O_MP1); RL char* MnT = L + ((lev & 1) ? O_MPT0 : O_MPT1);
            const h8 y0 = ldfrag(L + O_YT, 16 * wid, 0, lane), y1 = ldfrag(L + O_YT, 16 * wid, 1, lane);
#pragma unroll
            for (int ib = 0; ib < 4; ++ib) {
                acc[ib] = __builtin_amdgcn_mfma_f32_16x16x32_bf16(ldfrag(Mp, 16 * ib, 0, lane), y0, acc[ib], 0, 0, 0);
                acc[ib] = __builtin_amdgcn_mfma_f32_16x16x32_bf16(ldfrag(Mp, 16 * ib, 1, lane), y1, acc[ib], 0, 0, 0);
            }
            if (lev < 5) {
                f4 s1a = {0.f, 0.f, 0.f, 0.f}, s1b = s1a, s2a = s1a, s2b = s1a;
                mma2p(s1a, s1b, MpT, 16 * mb, Mp, 16 * nb0, lane);
                mma2p(s2a, s2b, Mp, 16 * mb, MpT, 16 * nb0, lane);
                storeT(Mn, 16 * mb, 16 * nb0, s1a, lane); storeT(MnT, 16 * mb, 16 * nb0, s2a, lane); storeT(Mn, 16 * mb, 16 * nb0 + 16, s1b, lane); storeT(MnT, 16 * mb, 16 * nb0 + 16, s2b, lane);
            }
#pragma unroll
            for (int ib = 0; ib < 4; ++ib) storeT(L + O_YT, 16 * ib, 16 * wid, acc[ib], lane);
            RWBAR();
        }
    }
    RWSTAMP(19);
    {
        const int m_ = 16 * mb + lm, na = 16 * nb0 + ln, nb_ = na + 16;
        f4 c3a = {0.f, 0.f, 0.f, 0.f}, c3b = c3a, c4a = c3a, c4b = c3a;
        mma2p(c3a, c3b, L + O_KH, 16 * mb, L + O_RH, 16 * nb0, lane); mma2p(c4a, c4b, L + O_BH, 16 * mb, L + O_RH, 16 * nb0, lane);
#pragma unroll
        for (int q = 0; q < 4; ++q) { if (!(m_ + q <= na)) { c3a[q] = 0.f; c4a[q] = 0.f; } if (!(m_ + q <= nb_)) { c3b[q] = 0.f; c4b[q] = 0.f; } }
        storeT(L + O_MP0, 16 * mb, 16 * nb0, c3a, lane); storeT(L + O_MPT0, 16 * mb, 16 * nb0, c4a, lane); storeT(L + O_MP0, 16 * mb, 16 * nb0 + 16, c3b, lane); storeT(L + O_MPT0, 16 * mb, 16 * nb0 + 16, c4b, lane);
    }
    if (jitem >= 0) { unsigned short* cvq = jWGU + (size_t)(ce_ * 1024 + (cn0 >> 7) * 256 + (cn0 & 127) + cmat * 128 + 4 * (lane & 7)) * 1024 + ck0 + 8 * (lane >> 3); CVT_STORE(cvq, 1024); }
    RWBAR();
    RWSTAMP(20);
    {
        unsigned char* gh = A.GH + (size_t)cid * 16384; unsigned char* qq = qptr(A, cid);
        const RL float* pc = (const RL float*)(L + O_PC);
        const RL char* AtT = L + O_YT; const RL char* WT = L + O_YT + 64 * SB;
#pragma unroll
        for (int tt = 0; tt < 2; ++tt) {
            const int nb = nb0 + tt; const int m_ = 16 * mb + lm, n_ = 16 * nb + ln;
            const float pcn = pc[n_];
            f4 g = {0.f, 0.f, 0.f, 0.f}; mma2(g, AtT, 16 * mb, L + O_BHT, 16 * nb, lane);
#pragma unroll
            for (int q = 0; q < 4; ++q) g[q] = (g[q] + ((m_ + q == n_) ? 1.0f : 0.0f)) * pcn;
            *(u2*)(gh + (size_t)n_ * 128 + (size_t)m_ * 2) = (u2){pkbf(g[0], g[1]), pkbf(g[2], g[3])};
            f4 hh = {0.f, 0.f, 0.f, 0.f}; mma2(hh, L + O_VMT, 16 * mb, L + O_KHT, 16 * nb, lane); mma2(hh, WT, 16 * mb, L + O_BHT, 16 * nb, lane);
            *(u2*)(gh + 8192 + ((size_t)(wid * 2 + tt) * 64 + lane) * 8) = (u2){pkbf(hh[0] * pcn, hh[1] * pcn), pkbf(hh[2] * pcn, hh[3] * pcn)};
            f4 qv; { const u2 w = *(const RL u2*)(L + O_RH + n_ * SB + m_ * 2); qv = (f4){bflo(w.x), bfhi(w.x), bflo(w.y), bfhi(w.y)}; }
            mma2(qv, AtT, 16 * mb, L + O_MPT0, 16 * nb, lane);
            *(u2*)(qq + (size_t)n_ * 128 + (size_t)m_ * 2) = (u2){pkbf(qv[0], qv[1]), pkbf(qv[2], qv[3])};
            f4 y0 = {0.f, 0.f, 0.f, 0.f};
            if (RW_STAGE == 0 || RW_STAGE == 1) mma2(y0, L + O_VMT, 16 * mb, L + O_MP0, 16 * nb, lane);
            if (RW_STAGE == 0 || RW_STAGE == 2) mma2(y0, WT, 16 * mb, L + O_MPT0, 16 * nb, lane);
            if (RW_STAGE == 7) mma2(y0, L + O_VMT, 16 * mb, L + O_VMT, 16 * nb, lane);
            if (RW_STAGE == 8) mma2(y0, L + O_VMT, 16 * mb, L + O_RH, 16 * nb, lane);
            if (RW_STAGE == 3) { const u2 w = *(const RL u2*)(L + O_MP0 + n_ * SB + m_ * 2); y0 = (f4){bflo(w.x), bfhi(w.x), bflo(w.y), bfhi(w.y)}; }
            if (RW_STAGE == 4) { const u2 w = *(const RL u2*)(WT + n_ * SB + m_ * 2); y0 = (f4){bflo(w.x), bfhi(w.x), bflo(w.y), bfhi(w.y)}; }
            if (RW_STAGE == 5) { const u2 w = *(const RL u2*)(L + O_VMT + n_ * SB + m_ * 2); y0 = (f4){bflo(w.x), bfhi(w.x), bflo(w.y), bfhi(w.y)}; }
            if (RW_STAGE == 6) { const u2 w = *(const RL u2*)(L + O_RH + n_ * SB + m_ * 2); y0 = (f4){bflo(w.x), bfhi(w.x), bflo(w.y), bfhi(w.y)}; }
            *(u2*)(A.Y + ((size_t)b * 2048 + c * 64 + n_) * 512 + h * 64 + m_) = (u2){pkbf(y0[0], y0[1]), pkbf(y0[2], y0[3])};
        }
    }
    RWBAR();
}

__device__ __forceinline__ void rwkv_seq_head(RL char* L, const Args& A, int b, int h, int mb) {
    const int tid = threadIdx.x, lane = tid & 63; const int wid = __builtin_amdgcn_readfirstlane(tid >> 6);
    const int lm = 4 * (lane >> 4), ln = lane & 15; const bool isS = wid < 4; const int nb = wid & 3;
    RL char* Sb = L;
    for (int i = tid; i < 16 * SB / 4; i += 512) ((RL unsigned*)Sb)[i] = 0u;
    RWBAR();
    const int cid0 = (b * 8 + h) * 32;
    const int hdump = ((4 * (nb >> 1) + mb) * 2 + (nb & 1)) * 64 + lane;
    struct Ops { h8 f0, f1; u2 x; };
#define RB_LOAD(O_, c_) do { const unsigned char* gh_ = A.GH + (size_t)(cid0 + (c_)) * 16384; \
        const unsigned char* src_ = (isS ? gh_ : qptr(A, cid0 + (c_))) + (size_t)(16 * nb + ln) * 128 + (lane >> 4) * 16; \
        O_.f0 = *(const h8*)src_; O_.f1 = *(const h8*)(src_ + 64); \
        O_.x = isS ? *(const u2*)(gh_ + 8192 + (size_t)hdump * 8) : *(const u2*)(A.Y + ((size_t)b * 2048 + (c_) * 64 + 16 * nb + ln) * 512 + h * 64 + 16 * mb + lm); } while (0)
#define RB_STEP(O_, c_) do { \
        const h8 a0 = ldfrag(Sb, 0, 0, lane), a1 = ldfrag(Sb, 0, 1, lane); \
        f4 r = {bflo(O_.x.x), bfhi(O_.x.x), bflo(O_.x.y), bfhi(O_.x.y)}; \
        r = __builtin_amdgcn_mfma_f32_16x16x32_bf16(a0, O_.f0, r, 0, 0, 0); r = __builtin_amdgcn_mfma_f32_16x16x32_bf16(a1, O_.f1, r, 0, 0, 0); \
        if (!isS) *(u2*)(A.Y + ((size_t)b * 2048 + (c_) * 64 + 16 * nb + ln) * 512 + h * 64 + 16 * mb + lm) = (u2){pkbf(r[0], r[1]), pkbf(r[2], r[3])}; \
        if ((c_) + 2 < 32) RB_LOAD(O_, (c_) + 2);                       \
        RWBAR();                                                      \
        if (isS) { RL unsigned short* sp = (RL unsigned short*)(Sb + lm * SB) + 16 * nb + ln; \
            _Pragma("unroll") for (int q = 0; q < 4; ++q) sp[q * ST] = (unsigned short)(pkbf(r[q], 0.f) & 0xffffu); } \
        RWBAR(); } while (0)
    Ops OA_, OB_;
    RB_LOAD(OA_, 0); RB_LOAD(OB_, 1);
    for (int c = 0; c < 32; c += 2) { RB_STEP(OA_, c); RB_STEP(OB_, c + 1); }
#undef RB_LOAD
#undef RB_STEP
}
}


#define GAS __attribute__((address_space(1)))
#define LAS __attribute__((address_space(3)))
typedef unsigned short bf16;
typedef unsigned v4u __attribute__((ext_vector_type(4)));
typedef float f32x4 __attribute__((ext_vector_type(4)));
typedef short bf16x8 __attribute__((ext_vector_type(8)));
typedef GAS unsigned gu32;
typedef GAS unsigned long long gu64;
#define RLX_AGENT __ATOMIC_RELAXED, __HIP_MEMORY_SCOPE_AGENT
#define LDS_WAIT() asm volatile("s_waitcnt lgkmcnt(0)" ::: "memory")
#define VM_WAIT() asm volatile("s_waitcnt vmcnt(0)" ::: "memory")
__device__ __forceinline__ unsigned long long rt() { return __builtin_amdgcn_s_memrealtime(); }
__device__ __forceinline__ unsigned f2bf(float f) { unsigned u = __builtin_bit_cast(unsigned, f); return (u + 0x7fffu + ((u >> 16) & 1u)) >> 16; }
__device__ __forceinline__ unsigned pk2(float lo, float hi) { return f2bf(lo) | (f2bf(hi) << 16); }

#define XB_TMO      128
#define XB_XCNT(j)  (256  + 64 * (j))
#define XB_XSUB(j)  (1280 + 64 * (j))
#define XB_XGEN(j)  (2304 + 64 * (j))
#define XB_TOP      3328
#define XB_TOPGEN   3392
#define XCD_BAR_WORDS 3456
#define XB_SPIN_CAP (1u << 18)

__device__ __forceinline__ unsigned xb_ld(unsigned* p)              { return __hip_atomic_load(p, __ATOMIC_RELAXED, __HIP_MEMORY_SCOPE_AGENT); }
__device__ __forceinline__ unsigned xb_add(unsigned* p, unsigned v) { return __hip_atomic_fetch_add(p, v, __ATOMIC_RELAXED, __HIP_MEMORY_SCOPE_AGENT); }
__device__ __forceinline__ unsigned xb_xcc_id() { return (unsigned)__builtin_amdgcn_s_getreg((3 << 11) | 20) & 0xFu; }
#define XB_SPIN(cond, bar) do { unsigned _sp = 0; while (cond) { __builtin_amdgcn_s_sleep(1); \
    if ((++_sp & 255u) == 0u) { if (xb_ld(&(bar)[XB_TMO])) break; if (_sp > XB_SPIN_CAP) { atomicAdd(&(bar)[XB_TMO], 1u); break; } } } } while (0)

struct XcdBarrier {
    unsigned* bar; unsigned x;
    volatile LAS unsigned* st;
};

__device__ __forceinline__ XcdBarrier xcd_barrier_post(unsigned* bar, volatile LAS unsigned* st) {
    XcdBarrier b; b.bar = bar; b.x = xb_xcc_id(); b.st = st;
    if (threadIdx.x == 0) (void)xb_add(&bar[XB_XCNT(b.x)], 1u);
    return b;
}
__device__ __forceinline__ void xcd_barrier_complete(unsigned* bar, unsigned x, unsigned& nloc, unsigned& nx) {
    const unsigned G = gridDim.x * gridDim.y * gridDim.z;
    unsigned sum, cnt, mine, sp = 0u;
    for (;;) {
        sum = 0u; cnt = 0u; mine = 0u;
#pragma unroll
        for (unsigned j = 0; j < 16; ++j) { const unsigned c = xb_ld(&bar[XB_XCNT(j)]); sum += c; cnt += (c > 0u) ? 1u : 0u; mine = (j == x) ? c : mine; }
        if (sum == G) break;
        __builtin_amdgcn_s_sleep(1);
        if ((++sp & 255u) == 0u) { if (xb_ld(&bar[XB_TMO])) break; if (sp > XB_SPIN_CAP) { atomicAdd(&bar[XB_TMO], 1u); break; } }
    }
    nloc = mine > 0u ? mine : 1u; nx = cnt > 0u ? cnt : 1u;
}

__device__ __forceinline__ void xcd_barrier(const XcdBarrier& b) {
    asm volatile("s_waitcnt vmcnt(0)" ::: "memory");
    __syncthreads();
    if (threadIdx.x == 0) {
        unsigned* bar = b.bar;
        __builtin_amdgcn_s_waitcnt(0);
        unsigned nloc = b.st[0], nx = b.st[1];
        if (nloc == 0u) { xcd_barrier_complete(bar, b.x, nloc, nx); b.st[0] = nloc; b.st[1] = nx; }
        const unsigned old = xb_add(&bar[XB_XSUB(b.x)], 1u);
        const unsigned gen = old / nloc;
        if (old + 1u == (gen + 1u) * nloc) {
            __builtin_amdgcn_fence(__ATOMIC_RELEASE, "agent");
            asm volatile("s_waitcnt vmcnt(0)" ::: "memory");
            const unsigned og = xb_add(&bar[XB_TOP], 1u);
            const unsigned tg = og / nx;
            if (og + 1u == (tg + 1u) * nx) xb_add(&bar[XB_TOPGEN], 1u);
            else XB_SPIN(xb_ld(&bar[XB_TOPGEN]) == tg, bar);
            __builtin_amdgcn_fence(__ATOMIC_ACQUIRE, "agent");
            xb_add(&bar[XB_XGEN(b.x)], 1u);
            asm volatile("s_waitcnt vmcnt(0)" ::: "memory");
        } else {
            XB_SPIN(xb_ld(&bar[XB_XGEN(b.x)]) == gen, bar);
            __builtin_amdgcn_fence(__ATOMIC_ACQUIRE, "agent");
            asm volatile("s_waitcnt vmcnt(0)" ::: "memory");
        }
    }
    __syncthreads();
}


constexpr int BATCH = 8, SEQ = 2048, DM = 1024, M = BATCH * SEQ;
constexpr int DIN = 3328, DRW = 512, RC = 1792;
constexpr int NEXP = 32, DEXP = 512;
constexpr int NWAVES = 8;
constexpr int RING_OFF = 0, RING_BYTES = 131072;
constexpr int LDSCTL_OFF = RING_BYTES, MISC_OFF = LDSCTL_OFF + 320;
constexpr int LDS_BYTES = 147456;
constexpr size_t MBy = 1000000;
constexpr size_t WS_CTL = 0, CTL_ZERO_BYTES = 1 << 20;
constexpr int CW_TMO = 0, CW_CODE = 1, CW_BAR = 4096;

struct Frame {
    LAS unsigned char* lds;
    volatile LAS unsigned* MISC;
    gu32* ctl;
    int tid, lane, wave;
    int vcu, G;
};

__device__ __forceinline__ float wave_sum(float v) {
#pragma unroll
    for (int o = 1; o < 64; o <<= 1) v += __shfl_xor(v, o);
    return v;
}
__device__ __forceinline__ void p0_transpose_item(const float* W, int K, int N, bf16* WT, int row_off, LAS float* scr, int item, int lane) {
    const int nblk = N / 32, kb = item / nblk, nb = item % nblk, k0 = 64 * kb, n0 = 32 * nb;
#pragma unroll 8
    for (int i = 0; i < 32; ++i) { const int kk = 2 * i + (lane >> 5); scr[kk * 33 + (lane & 31)] = W[(size_t)(k0 + kk) * N + n0 + (lane & 31)]; }
    LDS_WAIT(); asm volatile("" ::: "memory");
    const int c = lane & 7;
#pragma unroll
    for (int j = 0; j < 4; ++j) { const int n = (lane >> 3) + 8 * j; const LAS float* s = scr + (8 * c) * 33 + n;
        v4u o; o.x = pk2(s[0 * 33], s[1 * 33]); o.y = pk2(s[2 * 33], s[3 * 33]); o.z = pk2(s[4 * 33], s[5 * 33]); o.w = pk2(s[6 * 33], s[7 * 33]);
        *(GAS v4u*)(WT + (size_t)(row_off + n0 + n) * K + k0 + 8 * c) = o; }
    LDS_WAIT(); asm volatile("" ::: "memory");
}
__device__ __forceinline__ void rms_row_to_bf16(int lane, const float* xrow, const float* g, bf16* orow, float eps) {
    const GAS f32x4* xr = (const GAS f32x4*)xrow + lane;
    const GAS f32x4* gr = (const GAS f32x4*)g + lane;
    f32x4 v[4]; float s = 0.f;
#pragma unroll
    for (int j = 0; j < 4; ++j) { v[j] = xr[64 * j]; s += (v[j].x * v[j].x + v[j].y * v[j].y) + (v[j].z * v[j].z + v[j].w * v[j].w); }
    const float rstd = 1.f / sqrtf(wave_sum(s) * (1.f / DM) + eps);
    GAS unsigned long long* o8 = (GAS unsigned long long*)orow + lane;
#pragma unroll
    for (int j = 0; j < 4; ++j) { const f32x4 gv = gr[64 * j];
        o8[64 * j] = (unsigned long long)pk2(v[j].x * rstd * gv.x, v[j].y * rstd * gv.y) | ((unsigned long long)pk2(v[j].z * rstd * gv.z, v[j].w * rstd * gv.w) << 32); }
}

__device__ __forceinline__ void rms_rows_pipelined(int lane, const float* x, const float* g, bf16* out, int first, int stride, float eps) {
    const GAS f32x4* gr = (const GAS f32x4*)g + lane;
    const f32x4 g0 = gr[0], g1 = gr[64], g2 = gr[128], g3 = gr[192];
    f32x4 c0, c1, c2, c3;
    if (first < M) { const GAS f32x4* xr = (const GAS f32x4*)(x + (size_t)first * DM) + lane; c0 = xr[0]; c1 = xr[64]; c2 = xr[128]; c3 = xr[192]; }
    for (int m = first; m < M; m += stride) {
        f32x4 n0 = c0, n1 = c1, n2 = c2, n3 = c3;
        if (m + stride < M) { const GAS f32x4* xr = (const GAS f32x4*)(x + (size_t)(m + stride) * DM) + lane; n0 = xr[0]; n1 = xr[64]; n2 = xr[128]; n3 = xr[192]; }
        const float ssq = ((c0.x * c0.x + c0.y * c0.y) + (c0.z * c0.z + c0.w * c0.w)) + ((c1.x * c1.x + c1.y * c1.y) + (c1.z * c1.z + c1.w * c1.w))
                        + ((c2.x * c2.x + c2.y * c2.y) + (c2.z * c2.z + c2.w * c2.w)) + ((c3.x * c3.x + c3.y * c3.y) + (c3.z * c3.z + c3.w * c3.w));
        const float rstd = 1.f / sqrtf(wave_sum(ssq) * (1.f / DM) + eps);
        GAS unsigned long long* o8 = (GAS unsigned long long*)(out + (size_t)m * DM) + lane;
        o8[0]   = (unsigned long long)pk2(c0.x * rstd * g0.x, c0.y * rstd * g0.y) | ((unsigned long long)pk2(c0.z * rstd * g0.z, c0.w * rstd * g0.w) << 32);
        o8[64]  = (unsigned long long)pk2(c1.x * rstd * g1.x, c1.y * rstd * g1.y) | ((unsigned long long)pk2(c1.z * rstd * g1.z, c1.w * rstd * g1.w) << 32);
        o8[128] = (unsigned long long)pk2(c2.x * rstd * g2.x, c2.y * rstd * g2.y) | ((unsigned long long)pk2(c2.z * rstd * g2.z, c2.w * rstd * g2.w) << 32);
        o8[192] = (unsigned long long)pk2(c3.x * rstd * g3.x, c3.y * rstd * g3.y) | ((unsigned long long)pk2(c3.z * rstd * g3.z, c3.w * rstd * g3.w) << 32);
        c0 = n0; c1 = n1; c2 = n2; c3 = n3;
    }
}
struct Args { const float* in[30]; float* out; unsigned char* ws; int ph_lo, ph_hi; };
constexpr size_t WS_U = 2 * MBy;
constexpr size_t DO_XN = 0, DO_WIN = 34 * MBy;
constexpr size_t DO_O = 0;
constexpr size_t DO_Y = 33554432, DO_BT = 50331648;
constexpr size_t WS_E = 112 * MBy;
constexpr size_t WS_LA = 163 * MBy;
constexpr size_t WS_WL = 172 * MBy;
constexpr size_t WS_WOUT = 163 * MBy;
constexpr size_t WS_MIX = 2 * MBy;
constexpr size_t WS_T = WS_MIX;
constexpr size_t WS_WGU = 173 * MBy;
constexpr size_t WS_WD = 241 * MBy;
constexpr size_t WS_ACT = 120 * MBy;
constexpr size_t WS_XS = 36 * MBy;
constexpr size_t WS_YB = 36 * MBy;
constexpr size_t WS_ROWSLOT = 275 * MBy;
constexpr size_t WS_ROWGATE = WS_ROWSLOT + 40960 * 4;
constexpr size_t WS_SLOT_E = WS_ROWGATE + 40960 * 4;
constexpr size_t WS_SLOT_P = WS_SLOT_E + 32768 * 4;
constexpr size_t WS_SLOT_G = WS_SLOT_P + 32768 * 4;
constexpr size_t WS_WRP = 65536;
constexpr size_t WS_END = WS_SLOT_G + 32768 * 4;
constexpr size_t WS_GH = 241 * MBy;
constexpr size_t WS_Q1 = (size_t)162500000;
constexpr size_t WS_Q2 = (size_t)274600000;
constexpr size_t WS_TOTAL = 274600000 + 8388608;
static_assert(WS_END <= WS_TOTAL && WS_GH + 33554432 <= WS_Q2 && WS_Q1 + 8388608 <= 172 * MBy, "ws map");
constexpr int CW_DBG = 10240;
constexpr int CW_AQ = 8192;
constexpr int CW_CNT = 2048;
constexpr int TILE_E_OFF = LDSCTL_OFF + 1024;
constexpr size_t WS_ROPE = 512 * 1024;
constexpr float QSCALE = 0.125f * 1.4426950408889634f;

__device__ __forceinline__ unsigned long long ldarg(int byte_off) {
    const __attribute__((address_space(4))) unsigned char* kp = (const __attribute__((address_space(4))) unsigned char*)__builtin_amdgcn_kernarg_segment_ptr();
    return *(const volatile __attribute__((address_space(4))) unsigned long long*)(kp + byte_off);
}
#define ARG_IN(i) ((const float*)(const GAS float*)ldarg(8 * (i)))
#define ARG_OUT ((unsigned char*)(GAS unsigned char*)ldarg(240))
#define ARG_WS ((unsigned char*)(GAS unsigned char*)ldarg(248))
static_assert(sizeof(Args) == 264, "Args layout vs ldarg offsets");
__global__ void __launch_bounds__(NWAVES * 64, 2) skel_fwd(Args args) {
    extern __shared__ __attribute__((aligned(16))) unsigned char lds[];
    Frame F;
    F.lds = (LAS unsigned char*)lds;
    F.MISC = (volatile LAS unsigned*)(F.lds + MISC_OFF);
    F.tid = threadIdx.x; F.lane = F.tid & 63; F.wave = __builtin_amdgcn_readfirstlane(F.tid >> 6);
    F.G = gridDim.x; { const int bx = blockIdx.x; F.vcu = (F.G % 8 == 0) ? (bx % 8) * (F.G / 8) + bx / 8 : bx; }
    F.ctl = (gu32*)(ARG_WS + WS_CTL);
    for (int u = F.tid; u < (LDS_BYTES - LDSCTL_OFF) / 4; u += NWAVES * 64) ((LAS unsigned*)(F.lds + LDSCTL_OFF))[u] = 0u;
    __syncthreads();
    XcdBarrier bar = xcd_barrier_post((unsigned*)(F.ctl + CW_BAR), F.MISC + 8);
    const int lo = args.ph_lo, hi = args.ph_hi;
#ifndef PROBE_K
#define PROBE_K (-1)
#endif
#ifndef RWKV_DBG
#define RWKV_DBG 0
#endif
#ifndef RW_STAGE
#define RW_STAGE 0
#endif
    constexpr int CW_TS = 9216;
#define STAMP(k) do { if (PROBE_K >= 0 && blockIdx.x == 0 && F.tid == 0) ((GAS unsigned long long*)(F.ctl + CW_TS))[k] = rt(); } while (0)
    STAMP(0);
#define P_U ((bf16*)(ARG_WS + WS_U))
#define IN(k) (lo <= (k) && (k) < hi)
#define BOTH(k) (IN(k) && IN((k) + 1))
    if (IN(0)) {
        unsigned char* ws = ARG_WS; unsigned char* dout = ARG_OUT;
        const float* x = ARG_IN(0); const float* ln1_g = ARG_IN(1); const float* w_in = ARG_IN(2);
        bf16* XN = (bf16*)(dout + DO_XN); bf16* Wt_in = (bf16*)(dout + DO_WIN); float2* rope = (float2*)(ws + WS_ROPE);
        bf16* WL = (bf16*)(ws + WS_WL);
        LAS float* scr = (LAS float*)(F.lds + RING_OFF + F.wave * 16384);
        const int gw = F.vcu * NWAVES + F.wave, NGW = F.G * NWAVES;
        constexpr int I_IN = (DM / 64) * (DIN / 32);
        for (int it = gw; it < I_IN; it += NGW) p0_transpose_item(w_in, DM, DIN, Wt_in, 0, scr, it, F.lane);
        rms_rows_pipelined(F.lane, x, ln1_g, XN, gw, NGW, 1e-6f);
        {   const float* wup = ARG_IN(12); const float* aup = ARG_IN(14); const float* gup = ARG_IN(15);
            for (int idx = gw * 64 + F.lane; idx < 1536 * 256; idx += NGW * 64) {
                const int n = idx >> 8, j = idx & 255; float v = 0.f;
                if (n < 512) { if (j < 64) v = wup[j * 512 + n]; }
                else if (n < 1024) { if (j >= 64 && j < 128) v = aup[(j - 64) * 512 + (n - 512)]; }
                else { if (j >= 128) v = gup[(j - 128) * 512 + (n - 1024)]; }
                WL[idx] = (bf16)f2bf(v);
            }
        }
        {   const float* g2 = ARG_IN(22); const float* wrg = ARG_IN(23); const float* wre = ARG_IN(25); float* WRP = (float*)(ws + WS_WRP);
            for (int idx = gw * 64 + F.lane; idx < 64 * 3 * 64 * 4; idx += NGW * 64) {
                const int i = idx & 3, l = (idx >> 2) & 63, nt = (idx >> 8) % 3, sgrp = idx / 768;
                const int k = 16 * sgrp + 4 * (l >> 4) + i, n = nt * 16 + (l & 15);
                float v = 0.f; if (n < 32) v = wre[k * 32 + n]; else if (n < 36) v = wrg[k * 4 + (n - 32)];
                WRP[idx] = v * g2[k];
            }
        }
        for (int idx = gw * 64 + F.lane; idx < SEQ * 8; idx += NGW * 64) {
            const int pos = idx >> 3, j = idx & 7;
            const double invrev = j == 0 ? 0.15915494309189535 : j == 1 ? 0.03086376340470123 : j == 2 ? 0.005985185712713705 : j == 3 ? 0.001160663641240061 :
                                  j == 4 ? 0.00022507907903927653 : j == 5 ? 4.364795279280289e-05 : j == 6 ? 8.464330808241401e-06 : 1.6414262627950345e-06;
            const double tr = (double)pos * invrev; const float fr = (float)(tr - floor(tr));
            rope[idx] = make_float2(__builtin_amdgcn_cosf(fr), __builtin_amdgcn_sinf(fr));
        }
        if (BOTH(0)) xcd_barrier(bar); STAMP(1);
    }
    if (IN(1)) {
        unsigned char* dout = ARG_OUT; bf16* XN = (bf16*)(dout + DO_XN); bf16* Wt_in = (bf16*)(dout + DO_WIN); bf16* U = P_U;
        pg8::Gemm g{XN, Wt_in, M, DIN, DM}; pg8::G1Order S; S.init(M, DIN - 256, F.G, (int)blockIdx.x);
        pg8::EpiBf16<0> E{U, DIN, nullptr, 0, 0, 1.f};
        pg8::gemm_phase<pg8::EpiBf16<0>, pg8::G1Order, PG8_ALIGN, PG8_SP2>(F.lds + RING_OFF, g, S, E);
        if (BOTH(1)) xcd_barrier(bar); STAMP(2);
    }
    if (IN(2)) {
        unsigned char* ws = ARG_WS; bf16* U = P_U; const float* qg = ARG_IN(3); const float* kg = ARG_IN(4); const float* mu = ARG_IN(10);
        const float2* rope = (const float2*)(ws + WS_ROPE); bf16* LA = (bf16*)(ws + WS_LA);
        const int gw = F.vcu * NWAVES + F.wave, NGW = F.G * NWAVES;
        const int lane = F.lane;
        for (int t = gw; t < M; t += NGW) {
            const int pos = t & (SEQ - 1);
            GAS v4u* rowp = (GAS v4u*)(U + (size_t)t * DIN + lane * 16);
            const v4u wa = rowp[0], wb = rowp[1];
            float v[16];
            v[0] = __uint_as_float(wa.x << 16); v[1] = __uint_as_float(wa.x & 0xffff0000u); v[2] = __uint_as_float(wa.y << 16); v[3] = __uint_as_float(wa.y & 0xffff0000u);
            v[4] = __uint_as_float(wa.z << 16); v[5] = __uint_as_float(wa.z & 0xffff0000u); v[6] = __uint_as_float(wa.w << 16); v[7] = __uint_as_float(wa.w & 0xffff0000u);
            v[8] = __uint_as_float(wb.x << 16); v[9] = __uint_as_float(wb.x & 0xffff0000u); v[10] = __uint_as_float(wb.y << 16); v[11] = __uint_as_float(wb.y & 0xffff0000u);
            v[12] = __uint_as_float(wb.z << 16); v[13] = __uint_as_float(wb.z & 0xffff0000u); v[14] = __uint_as_float(wb.w << 16); v[15] = __uint_as_float(wb.w & 0xffff0000u);
            float ss = 0.f;
#pragma unroll
            for (int i = 0; i < 16; ++i) ss += v[i] * v[i];
            ss += __shfl_xor(ss, 1); ss += __shfl_xor(ss, 2);
            const float rstd = 1.0f / sqrtf(ss * (1.0f / 64.0f) + 1e-6f);
            const float* gp = (lane < 32 ? qg : kg) + (lane & 3) * 16;
#pragma unroll
            for (int i = 0; i < 16; ++i) v[i] *= rstd * gp[i];
            if ((lane & 3) == 0) {
#pragma unroll
                for (int j = 0; j < 8; ++j) { const float2 cs = rope[pos * 8 + j]; const float x1 = v[j], x2 = v[j + 8]; v[j] = x1 * cs.x - x2 * cs.y; v[j + 8] = x2 * cs.x + x1 * cs.y; }
            }
            if (lane < 32) {
#pragma unroll
                for (int i = 0; i < 16; ++i) v[i] *= QSCALE;
            }
            v4u oa, ob;
            oa.x = pk2(v[0], v[1]); oa.y = pk2(v[2], v[3]); oa.z = pk2(v[4], v[5]); oa.w = pk2(v[6], v[7]);
            ob.x = pk2(v[8], v[9]); ob.y = pk2(v[10], v[11]); ob.z = pk2(v[12], v[13]); ob.w = pk2(v[14], v[15]);
            rowp[0] = oa; rowp[1] = ob;
            {   typedef unsigned u32x2v __attribute__((ext_vector_type(2)));
                const GAS u32x2v* lp = (const GAS u32x2v*)(U + (size_t)t * DIN + 3072 + lane * 4);
                const u32x2v cw = lp[0]; u32x2v pw = cw; if (pos > 0) pw = *(const GAS u32x2v*)(U + (size_t)(t - 1) * DIN + 3072 + lane * 4);
                const f32x4 m4 = *(const GAS f32x4*)(mu + 1536 + lane * 4);
                float c4[4] = {__uint_as_float(cw.x << 16), __uint_as_float(cw.x & 0xffff0000u), __uint_as_float(cw.y << 16), __uint_as_float(cw.y & 0xffff0000u)};
                float p4[4] = {__uint_as_float(pw.x << 16), __uint_as_float(pw.x & 0xffff0000u), __uint_as_float(pw.y << 16), __uint_as_float(pw.y & 0xffff0000u)};
                if (pos == 0) { p4[0] = 0.f; p4[1] = 0.f; p4[2] = 0.f; p4[3] = 0.f; }
                float o4[4];
#pragma unroll
                for (int i = 0; i < 4; ++i) { const float xs = c4[i] + (p4[i] - c4[i]) * m4[i];
                    float r = xs;
                    if (lane < 16) { const float e2 = __expf(-2.0f * fabsf(xs)); const float th = (1.0f - e2) / (1.0f + e2); r = xs < 0.f ? -th : th; }
                    else if (lane >= 32) r = 1.0f / (1.0f + __expf(-xs));
                    o4[i] = r; }
                u32x2v ow; ow.x = pk2(o4[0], o4[1]); ow.y = pk2(o4[2], o4[3]);
                *(GAS u32x2v*)(LA + (size_t)t * 256 + lane * 4) = ow;
            }
        }
        if (BOTH(2)) xcd_barrier(bar); STAMP(3);
    }
    if (IN(3)) {
        unsigned char* ws = ARG_WS; bf16* LA = (bf16*)(ws + WS_LA); bf16* WL = (bf16*)(ws + WS_WL); bf16* EB = (bf16*)(ws + WS_E);
        {
            unsigned char* dout = ARG_OUT; const bool big = F.vcu < 64;
            pg8::Gemm g{big ? (const bf16*)(dout + DO_XN) : (const bf16*)LA, big ? (const bf16*)(dout + DO_WIN) : (const bf16*)WL, M, big ? DIN : 1536, big ? DM : 256}; pg8::P3Order S{F.vcu};
            pg8::EpiBf16<0> E{big ? P_U : EB, big ? DIN : 1536, nullptr, 0, 0, 1.f};
            pg8::gemm_phase<pg8::EpiBf16<0>, pg8::P3Order, PG8_ALIGN, PG8_SP2>(F.lds + RING_OFF, g, S, E);
        }
        if (BOTH(3)) xcd_barrier(bar); STAMP(4);
    }
    if (IN(4)) {
        static_assert(attn_body::ATTN_LDS_BYTES <= RING_BYTES && rwkv_body::RWKV_LDS_BYTES <= RING_BYTES, "phase body LDS vs frame");
        {
            unsigned char* ws = ARG_WS; unsigned char* dout = ARG_OUT;
            const rwkv_body::Args RA{(unsigned long long*)(F.ctl + 9216), P_U, (bf16*)(ws + WS_E), RWKV_DBG ? (bf16*)(ws + WS_WGU) : (bf16*)(dout + DO_Y), RWKV_DBG ? (bf16*)(ws + WS_WGU + 16777216) : (bf16*)(dout + DO_BT), ws + WS_GH, ws + WS_Q1, ws + WS_Q2, ARG_IN(10), ARG_IN(16), ARG_IN(17), ARG_IN(18), ARG_IN(11), ARG_IN(13)};
            if (F.vcu < 256) {
                const int hd = F.vcu >> 2;
                rwkv_body::chunk_consts_to_lds((LAS char*)(F.lds + RING_OFF), RA, hd & 7); __syncthreads();
                rwkv_body::ChunkLoads LA_, LB_; const int c0 = (F.vcu & 3) * 8;
                rwkv_body::chunk_load(LA_, RA, hd >> 3, hd & 7, c0);
#pragma unroll 1
                for (int j = 0; j < 8; j += 2) {
                    const int gwv = F.vcu * NWAVES + F.wave; const float* jWg = ARG_IN(27); const float* jWu = ARG_IN(28); bf16* jWGU = (bf16*)(ws + WS_WGU);
                    rwkv_body::rwkv_chunk_task((LAS char*)(F.lds + RING_OFF), RA, LA_, LB_, true, hd >> 3, hd & 7, c0 + j, c0 + j + 1, jWg, jWu, jWGU, RWKV_DBG ? -1 : j * 2048 + gwv);
                    rwkv_body::rwkv_chunk_task((LAS char*)(F.lds + RING_OFF), RA, LB_, LA_, j + 2 < 8, hd >> 3, hd & 7, c0 + j + 1, c0 + j + 2, jWg, jWu, jWGU, RWKV_DBG ? -1 : (j + 1) * 2048 + gwv);
                }
            }
            xcd_barrier(bar); STAMP(13);
            if (RWKV_DBG != 3 && F.vcu < 256) { const int hd = F.vcu >> 2; rwkv_body::rwkv_seq_head((LAS char*)(F.lds + RING_OFF), RA, hd >> 3, hd & 7, F.vcu & 3); }
            STAMP(16);
        }
        if (RWKV_DBG && (F.vcu & 1) == 0 && F.vcu < 256) {
            unsigned char* ws = ARG_WS; unsigned char* dout = ARG_OUT; const int un = F.vcu >> 1;
            const scan_body::ScanArgs SA{P_U, (bf16*)(ws + WS_E), (bf16*)(dout + DO_Y), (bf16*)(dout + DO_BT), ARG_IN(10), ARG_IN(16), ARG_IN(17), ARG_IN(18), ARG_IN(11), ARG_IN(13)};
            scan_body::scan_unit((LAS float*)(F.lds + RING_OFF), SA, un >> 4, (un >> 1) & 7, un & 1);
        }
        {
        bf16* U = P_U; bf16* OA = (bf16*)(ARG_OUT + DO_O);
        const attn_body::AttnTensors AT{(const attn_body::bf16*)U, (attn_body::bf16*)OA};
        if (RWKV_DBG) attn_body::attn_phase_dyn<8>((char*)lds + RING_OFF, AT, (unsigned*)(F.ctl + CW_AQ), F.MISC, (int)(bar.x & 7u));
        else attn_body::attn_phase_static((char*)lds + RING_OFF, AT, F.vcu);
        }
        if (0) {
            unsigned char* ws = ARG_WS; const int lane = F.lane;
            const int gw = ((F.vcu >> 2) * 3 + (F.vcu & 3) - 1) * NWAVES + F.wave, NGW = (F.G >> 2) * 3 * NWAVES;
            LAS float* scr = (LAS float*)(F.lds + RING_OFF + F.wave * 16384);
            const float* Wg = ARG_IN(27); const float* Wu = ARG_IN(28);
            bf16* WGU = (bf16*)(ws + WS_WGU);
            for (int it = gw; it < 16384; it += NGW) { const int e = it >> 9, mat = (it >> 8) & 1, item = it & 255; const int n0 = 32 * (item & 15);
                p0_transpose_item((mat ? Wu : Wg) + (size_t)e * DM * DEXP, DM, DEXP, WGU, e * 1024 + (n0 >> 7) * 256 + (n0 & 127) - n0 + mat * 128, scr, item, lane); }
        }
        if (BOTH(4)) xcd_barrier(bar); STAMP(5);
    }
    if (IN(5)) {
        unsigned char* ws = ARG_WS; unsigned char* dout = ARG_OUT;
        const bf16* OA = (const bf16*)(dout + DO_O); const bf16* YB = (const bf16*)(dout + DO_Y); const bf16* BT = (const bf16*)(dout + DO_BT);
        const bf16* EB = (const bf16*)(ws + WS_E); bf16* MIX = (bf16*)(ws + WS_MIX);
        const int gw = F.vcu * NWAVES + F.wave, NGW = F.G * NWAVES; const int lane = F.lane;
        const float lam = __expf(wave_sum(ARG_IN(5)[lane] * ARG_IN(6)[lane])) - __expf(wave_sum(ARG_IN(7)[lane] * ARG_IN(8)[lane])) + 0.2f;
        const float* subg = ARG_IN(9); const float* lng = ARG_IN(19); const float* lnb = ARG_IN(20);
        const f32x4 sgA = *(const GAS f32x4*)(subg + 8 * (lane & 15)), sgB = *(const GAS f32x4*)(subg + 8 * (lane & 15) + 4);
        const f32x4 lgA = *(const GAS f32x4*)(lng + 8 * lane), lgB = *(const GAS f32x4*)(lng + 8 * lane + 4), lbA = *(const GAS f32x4*)(lnb + 8 * lane), lbB = *(const GAS f32x4*)(lnb + 8 * lane + 4);
#define UNPK8(W_, F_) do { F_[0] = __uint_as_float(W_[0] << 16); F_[1] = __uint_as_float(W_[0] & 0xffff0000u); F_[2] = __uint_as_float(W_[1] << 16); F_[3] = __uint_as_float(W_[1] & 0xffff0000u); \
                           F_[4] = __uint_as_float(W_[2] << 16); F_[5] = __uint_as_float(W_[2] & 0xffff0000u); F_[6] = __uint_as_float(W_[3] << 16); F_[7] = __uint_as_float(W_[3] & 0xffff0000u); } while (0)
        float dbg_d = 0.f, dbg_r = 0.f;
        for (int t = gw; t < M; t += NGW) {
            const int h = lane >> 4, e0 = 8 * (lane & 15);
            const v4u w0 = *(const GAS v4u*)(OA + (size_t)t * 1024 + h * 256 + e0), w1 = *(const GAS v4u*)(OA + (size_t)t * 1024 + h * 256 + 128 + e0);
            const v4u wy = *(const GAS v4u*)(YB + (size_t)t * 512 + 8 * lane), wb = *(const GAS v4u*)(BT + (size_t)t * 512 + 8 * lane), wg = *(const GAS v4u*)(EB + (size_t)t * 1536 + 1024 + 8 * lane);
            float o0[8], o1[8], o[8];
            UNPK8(w0, o0); UNPK8(w1, o1);
            float ss = 0.f;
#pragma unroll
            for (int i = 0; i < 8; ++i) { o[i] = o0[i] - lam * o1[i]; ss += o[i] * o[i]; }
            ss = scan_body::reduce16(ss);
            const float rs = 0.8f / sqrtf(ss * (1.0f / 128.0f) + 1e-5f);
            v4u mo; mo.x = pk2(o[0] * rs * sgA.x, o[1] * rs * sgA.y); mo.y = pk2(o[2] * rs * sgA.z, o[3] * rs * sgA.w); mo.z = pk2(o[4] * rs * sgB.x, o[5] * rs * sgB.y); mo.w = pk2(o[6] * rs * sgB.z, o[7] * rs * sgB.w);
            *(GAS v4u*)(MIX + (size_t)t * DM + h * 128 + e0) = mo;
            float y[8], bt[8], gt[8];
            UNPK8(wy, y); UNPK8(wb, bt); UNPK8(wg, gt);
            float sm = ((y[0] + y[1]) + (y[2] + y[3])) + ((y[4] + y[5]) + (y[6] + y[7]));
            sm = scan_body::dpp_add<0xB1>(sm); sm = scan_body::dpp_add<0x4E>(sm); sm = scan_body::dpp_add<0x141>(sm);
            const float mean = sm * (1.0f / 64.0f);
            float sq = 0.f;
#pragma unroll
            for (int i = 0; i < 8; ++i) { y[i] -= mean; sq += y[i] * y[i]; }
            sq = scan_body::dpp_add<0xB1>(sq); sq = scan_body::dpp_add<0x4E>(sq); sq = scan_body::dpp_add<0x141>(sq);
            const float rv = 1.0f / sqrtf(sq * (1.0f / 64.0f) + 64e-5f);
            const float lg8[8] = {lgA.x, lgA.y, lgA.z, lgA.w, lgB.x, lgB.y, lgB.z, lgB.w}, lb8[8] = {lbA.x, lbA.y, lbA.z, lbA.w, lbB.x, lbB.y, lbB.z, lbB.w};
            float r8[8];
#pragma unroll
            for (int i = 0; i < 8; ++i) r8[i] = (y[i] * rv * lg8[i] + lb8[i] + bt[i]) * gt[i];
            v4u ro; ro.x = pk2(r8[0], r8[1]); ro.y = pk2(r8[2], r8[3]); ro.z = pk2(r8[4], r8[5]); ro.w = pk2(r8[6], r8[7]);
            *(GAS v4u*)(MIX + (size_t)t * DM + 512 + 8 * lane) = ro;
            if (RWKV_DBG) {
                const bf16* S2 = (const bf16*)(ws + WS_WGU) + (RWKV_DBG == 2 ? 8388608 : 0); const bool dsel = (RWKV_DBG < 3) || ((t & 2047) < 64);
                const v4u w2 = *(const GAS v4u*)(S2 + (size_t)t * 512 + 8 * lane); const v4u w1_ = (RWKV_DBG == 2) ? wb : wy;
                float a2[8], a1[8]; UNPK8(w2, a2); UNPK8(w1_, a1);
                float dd = 0.f, rr = 0.f;
#pragma unroll
                for (int i = 0; i < 8; ++i) { const float df = a2[i] - a1[i]; dd += (df == df && fabsf(df) < 1e30f) ? df * df : 1e30f; rr += a1[i] * a1[i]; }
                if (dsel) { dbg_d += dd; dbg_r += rr; }
            }
        }
        if (RWKV_DBG) { dbg_d = wave_sum(dbg_d); dbg_r = wave_sum(dbg_r);
            if (lane == 0) { atomicAdd((float*)(F.ctl + CW_DBG), dbg_d); atomicAdd((float*)(F.ctl + CW_DBG + 1), dbg_r); } }
#undef UNPK8
        {
            LAS float* scr = (LAS float*)(F.lds + RING_OFF + F.wave * 16384);
            const float* Wd = ARG_IN(29); bf16* WDT = (bf16*)(ws + WS_WD);
            for (int it = gw; it < 8192; it += NGW) { const int e = it >> 8, item = it & 255; p0_transpose_item(Wd + (size_t)e * DEXP * DM, DEXP, DM, WDT, e * 1024, scr, item, lane); }
            if (RWKV_DBG) { const float* Wg = ARG_IN(27); const float* Wu = ARG_IN(28); bf16* WGU = (bf16*)(ws + WS_WGU);
                __syncthreads();
                for (int it = gw; it < 16384; it += NGW) { const int e = it >> 9, mat = (it >> 8) & 1, item = it & 255; const int n0 = 32 * (item & 15);
                    p0_transpose_item((mat ? Wu : Wg) + (size_t)e * DM * DEXP, DM, DEXP, WGU, e * 1024 + (n0 >> 7) * 256 + (n0 & 127) - n0 + mat * 128, scr, item, lane); } }
            const float* w_out = ARG_IN(21); bf16* Wt_out = (bf16*)(ws + WS_WOUT);
            for (int it = gw; it < (DM / 64) * (DM / 32); it += NGW) p0_transpose_item(w_out, DM, DM, Wt_out, 0, scr, it, lane);
        }
        if (BOTH(5)) xcd_barrier(bar); STAMP(6);
    }
    if (IN(6)) {
        unsigned char* ws = ARG_WS;
        pg8::Gemm g{(const bf16*)(ws + WS_MIX), (const bf16*)(ws + WS_WOUT), M, DM, DM}; pg8::StaticOrder S; S.init(M, DM, F.G, (int)blockIdx.x);
        pg8::EpiResF32 E{ARG_IN(0), (float*)ARG_OUT, DM};
        pg8::gemm_phase<pg8::EpiResF32, pg8::StaticOrder, false, PG8_SP2>(F.lds + RING_OFF, g, S, E);
        if (BOTH(6)) xcd_barrier(bar); STAMP(7);
    }
    if (IN(7)) {
        unsigned char* ws = ARG_WS; const float* hbuf = (const float*)ARG_OUT; const int lane = F.lane;
        const int gw = F.vcu * NWAVES + F.wave, NGW = F.G * NWAVES;
        {   const float* g2 = ARG_IN(22); bf16* T = (bf16*)(ws + WS_T);
            rms_rows_pipelined(lane, hbuf, g2, T, gw, NGW, 1e-6f); }
        STAMP(14);
        {   const float* brg = ARG_IN(24); const float* bre = ARG_IN(26); const GAS f32x4* WRP0 = (const GAS f32x4*)(ws + WS_WRP);
            int* slot_e = (int*)(ws + WS_SLOT_E); int* slot_p = (int*)(ws + WS_SLOT_P); float* slot_g = (float*)(ws + WS_SLOT_G);
            unsigned* cnt = (unsigned*)(F.ctl + CW_CNT);
            const int r = lane & 15, kq = lane >> 4;
            const int khalf = F.wave >> 2;
            for (int task = (F.wave & 3) * F.G + F.vcu; task < M / 16; task += 4 * F.G) {
                const int tok0 = task * 16;
                const GAS f32x4* arow = (const GAS f32x4*)(hbuf + (size_t)(tok0 + r) * DM) + kq + khalf * 128;
                const GAS f32x4* WRP = WRP0 + khalf * (32 * 3 * 64);
                f32x4 acc0 = {0.f, 0.f, 0.f, 0.f}, acc1 = acc0, acc2 = acc0; float ssq = 0.f;
                f32x4 ca0, ca1, ca2, ca3, cb0, cb1, cb2, cb3, cb4, cb5, cb6, cb7, cb8, cb9, cb10, cb11;
                f32x4 na0, na1, na2, na3, nb0, nb1, nb2, nb3, nb4, nb5, nb6, nb7, nb8, nb9, nb10, nb11;
#define RT_LD1(A_, B0_, B1_, B2_, sg_) do { A_ = arow[4 * (sg_)]; B0_ = WRP[((sg_) * 3 + 0) * 64 + lane]; B1_ = WRP[((sg_) * 3 + 1) * 64 + lane]; B2_ = WRP[((sg_) * 3 + 2) * 64 + lane]; } while (0)
#define RT_MM1(A_, B0_, B1_, B2_) do { ssq += (A_.x * A_.x + A_.y * A_.y) + (A_.z * A_.z + A_.w * A_.w); \
        acc0 = __builtin_amdgcn_mfma_f32_16x16x4f32(A_.x, B0_.x, acc0, 0, 0, 0); acc1 = __builtin_amdgcn_mfma_f32_16x16x4f32(A_.x, B1_.x, acc1, 0, 0, 0); acc2 = __builtin_amdgcn_mfma_f32_16x16x4f32(A_.x, B2_.x, acc2, 0, 0, 0); \
        acc0 = __builtin_amdgcn_mfma_f32_16x16x4f32(A_.y, B0_.y, acc0, 0, 0, 0); acc1 = __builtin_amdgcn_mfma_f32_16x16x4f32(A_.y, B1_.y, acc1, 0, 0, 0); acc2 = __builtin_amdgcn_mfma_f32_16x16x4f32(A_.y, B2_.y, acc2, 0, 0, 0); \
        acc0 = __builtin_amdgcn_mfma_f32_16x16x4f32(A_.z, B0_.z, acc0, 0, 0, 0); acc1 = __builtin_amdgcn_mfma_f32_16x16x4f32(A_.z, B1_.z, acc1, 0, 0, 0); acc2 = __builtin_amdgcn_mfma_f32_16x16x4f32(A_.z, B2_.z, acc2, 0, 0, 0); \
        acc0 = __builtin_amdgcn_mfma_f32_16x16x4f32(A_.w, B0_.w, acc0, 0, 0, 0); acc1 = __builtin_amdgcn_mfma_f32_16x16x4f32(A_.w, B1_.w, acc1, 0, 0, 0); acc2 = __builtin_amdgcn_mfma_f32_16x16x4f32(A_.w, B2_.w, acc2, 0, 0, 0); } while (0)
                RT_LD1(ca0, cb0, cb1, cb2, 0); RT_LD1(ca1, cb3, cb4, cb5, 1); RT_LD1(ca2, cb6, cb7, cb8, 2); RT_LD1(ca3, cb9, cb10, cb11, 3);
                for (int g = 0; g < 8; ++g) {
                    const int gn = (g + 1 < 8) ? g + 1 : g;
                    RT_LD1(na0, nb0, nb1, nb2, gn * 4); RT_LD1(na1, nb3, nb4, nb5, gn * 4 + 1); RT_LD1(na2, nb6, nb7, nb8, gn * 4 + 2); RT_LD1(na3, nb9, nb10, nb11, gn * 4 + 3);
                    __builtin_amdgcn_sched_barrier(0);
                    RT_MM1(ca0, cb0, cb1, cb2); RT_MM1(ca1, cb3, cb4, cb5); RT_MM1(ca2, cb6, cb7, cb8); RT_MM1(ca3, cb9, cb10, cb11);
                    __builtin_amdgcn_sched_barrier(0);
                    ca0 = na0; ca1 = na1; ca2 = na2; ca3 = na3; cb0 = nb0; cb1 = nb1; cb2 = nb2; cb3 = nb3; cb4 = nb4; cb5 = nb5; cb6 = nb6; cb7 = nb7; cb8 = nb8; cb9 = nb9; cb10 = nb10; cb11 = nb11;
                }
#undef RT_LD1
#undef RT_MM1
                ssq += __shfl_xor(ssq, 16); ssq += __shfl_xor(ssq, 32);
                LAS float* LGT = (LAS float*)(F.lds + RING_OFF + (F.wave & 3) * 8192);
                LAS float* LGh = LGT + khalf * 768;
#pragma unroll
                for (int q = 0; q < 4; ++q) { const int row = 4 * kq + q; LGh[row * 48 + r] = acc0[q]; LGh[row * 48 + 16 + r] = acc1[q]; LGh[row * 48 + 32 + r] = acc2[q]; }
                if (lane < 16) LGT[1536 + khalf * 16 + lane] = ssq;
                LAS unsigned* hist = (LAS unsigned*)(F.lds + RING_OFF + 32768); LAS unsigned* hbase = hist + 32;
                if (F.tid < 32) hist[F.tid] = 0u;
                __syncthreads();
                int ea = 0, eb = 0; unsigned la = 0u, lb = 0u; float ga = 0.f, gb = 0.f;
                if (khalf == 0 && lane < 16) {
                    const LAS float* lg = LGT + lane * 48; const LAS float* lh = LGT + 768 + lane * 48;
                    const float rs = 1.f / sqrtf((LGT[1536 + lane] + LGT[1552 + lane]) * (1.f / DM) + 1e-6f);
                    const float lg0 = (lg[32] + lh[32]) * rs + brg[0], lg1 = (lg[33] + lh[33]) * rs + brg[1], lg2 = (lg[34] + lh[34]) * rs + brg[2], lg3 = (lg[35] + lh[35]) * rs + brg[3];
                    int gs = 0; float gm = lg0;
                    if (lg1 > gm) { gm = lg1; gs = 1; }
                    if (lg2 > gm) { gm = lg2; gs = 2; }
                    if (lg3 > gm) { gm = lg3; gs = 3; }
                    const float pgroup = 1.0f / (expf(lg0 - gm) + expf(lg1 - gm) + expf(lg2 - gm) + expf(lg3 - gm));
                    int i1 = 0, i2 = -1; float v1 = -3.0e38f, v2 = -3.0e38f;
                    for (int q = 0; q < 8; ++q) { const float x = (lg[gs * 8 + q] + lh[gs * 8 + q]) * rs + bre[gs * 8 + q];
                        if (x > v1) { v2 = v1; i2 = i1; v1 = x; i1 = q; } else if (x > v2) { v2 = x; i2 = q; } }
                    if (i2 < 0 || i2 == i1) i2 = (i1 + 1) & 7;
                    const float e2 = expf(v2 - v1);
                    ea = gs * 8 + i1; eb = gs * 8 + i2; ga = pgroup / (1.0f + e2); gb = pgroup * e2 / (1.0f + e2);
                    la = __hip_atomic_fetch_add(hist + ea, 1u, __ATOMIC_RELAXED, __HIP_MEMORY_SCOPE_WORKGROUP);
                    lb = __hip_atomic_fetch_add(hist + eb, 1u, __ATOMIC_RELAXED, __HIP_MEMORY_SCOPE_WORKGROUP);
                }
                __syncthreads();
                if (F.tid < 32) { const unsigned n = hist[F.tid]; hbase[F.tid] = n ? __hip_atomic_fetch_add(cnt + 64 * F.tid, n, __ATOMIC_RELAXED, __HIP_MEMORY_SCOPE_AGENT) : 0u; }
                __syncthreads();
                if (khalf == 0 && lane < 16) {
                    const int tok = tok0 + lane;
                    slot_e[tok * 2] = ea; slot_p[tok * 2] = (int)(hbase[ea] + la); slot_g[tok * 2] = ga;
                    slot_e[tok * 2 + 1] = eb; slot_p[tok * 2 + 1] = (int)(hbase[eb] + lb); slot_g[tok * 2 + 1] = gb;
                }
                __syncthreads();
            }
        }
        STAMP(15);
        if (BOTH(7)) xcd_barrier(bar); STAMP(8);
    }
    if (IN(8)) {
        unsigned char* ws = ARG_WS; const int lane = F.lane;
        const bf16* T = (const bf16*)(ws + WS_T); bf16* XS = (bf16*)(ws + WS_XS);
        const int* slot_e = (const int*)(ws + WS_SLOT_E); const int* slot_p = (const int*)(ws + WS_SLOT_P); const float* slot_g = (const float*)(ws + WS_SLOT_G);
        int* rowslot = (int*)(ws + WS_ROWSLOT); float* rowgate = (float*)(ws + WS_ROWGATE);
        const int gw = F.vcu * NWAVES + F.wave, NGW = F.G * NWAVES;
        const int mycnt = lane < 32 ? (int)__hip_atomic_load((unsigned*)(F.ctl + CW_CNT) + 64 * lane, __ATOMIC_RELAXED, __HIP_MEMORY_SCOPE_AGENT) : 0;
        const int mypad = (mycnt + 255) & ~255;
        int incl = mypad;
#pragma unroll
        for (int o = 1; o < 32; o <<= 1) { const int t = __shfl_up(incl, o); if (lane >= o) incl += t; }
        const int myoff = incl - mypad;
        for (int sl = gw; sl < 2 * M; sl += NGW) {
            const int e = slot_e[sl], p = slot_p[sl]; const int dest = __shfl(myoff, e) + p;
            const GAS v4u* src = (const GAS v4u*)(T + (size_t)(sl >> 1) * DM) + lane * 2; GAS v4u* dst = (GAS v4u*)(XS + (size_t)dest * DM) + lane * 2;
            const v4u a = src[0], b = src[1]; dst[0] = a; dst[1] = b;
            if (lane == 0) { rowslot[dest] = sl; rowgate[dest] = slot_g[sl]; }
        }
        for (int idx = gw; idx < 32 * 256; idx += NGW) {
            const int e = idx >> 8, j = idx & 255; const int c = __shfl(mycnt, e), pd = __shfl(mypad, e), of = __shfl(myoff, e);
            if (c + j < pd) { const int dest = of + c + j; GAS v4u* dst = (GAS v4u*)(XS + (size_t)dest * DM) + lane * 2; const v4u z = {0u, 0u, 0u, 0u}; dst[0] = z; dst[1] = z;
                if (lane == 0) { rowslot[dest] = -1; rowgate[dest] = 0.f; } }
        }
        if (BOTH(8)) xcd_barrier(bar); STAMP(9);
    }
    if (IN(9) || IN(10)) {
        LAS int* tile_e = (LAS int*)(F.lds + TILE_E_OFF);
        int ntiles;
        {   const int lane = F.lane;
            const int mycnt = lane < 32 ? (int)__hip_atomic_load((unsigned*)(F.ctl + CW_CNT) + 64 * lane, __ATOMIC_RELAXED, __HIP_MEMORY_SCOPE_AGENT) : 0;
            const int myt = (mycnt + 255) >> 8;
            int incl = myt;
#pragma unroll
            for (int o = 1; o < 32; o <<= 1) { const int t = __shfl_up(incl, o); if (lane >= o) incl += t; }
            ntiles = __shfl(incl, 31);
            if (F.wave == 0 && lane < 32) { for (int j = 0; j < myt; ++j) tile_e[incl - myt + j] = lane; }
            __syncthreads();
        }
        unsigned char* ws = ARG_WS;
        if (IN(9)) {
            pg8::Gemm g{(const bf16*)(ws + WS_XS), (const bf16*)(ws + WS_WGU), 0, 0, DM}; pg8::MoeOrder S{ntiles, F.G, F.vcu, tile_e};
            pg8::EpiSwiGLU E{(bf16*)(ws + WS_ACT)};
            pg8::gemm_phase<pg8::EpiSwiGLU, pg8::MoeOrder, PG8_ALIGN, PG8_SP2>(F.lds + RING_OFF, g, S, E);
            if (BOTH(9)) xcd_barrier(bar); STAMP(10);
        }
        if (IN(10)) {
            pg8::Gemm g{(const bf16*)(ws + WS_ACT), (const bf16*)(ws + WS_WD), 0, 0, DEXP}; pg8::MoeOrder S{ntiles, F.G, F.vcu, tile_e};
            pg8::EpiScatter E{(bf16*)(ws + WS_YB), (const int*)(ws + WS_ROWSLOT), (const float*)(ws + WS_ROWGATE)};
            pg8::gemm_phase<pg8::EpiScatter, pg8::MoeOrder, PG8_ALIGN, PG8_SP2>(F.lds + RING_OFF, g, S, E);
            if (BOTH(10)) xcd_barrier(bar); STAMP(11);
        }
    }
    if (IN(11)) {
        unsigned char* ws = ARG_WS; float* outp = (float*)ARG_OUT; const bf16* YB = (const bf16*)(ws + WS_YB); const int lane = F.lane;
        const int gw = F.vcu * NWAVES + F.wave, NGW = F.G * NWAVES;
        float dscale = 1.0f;
        if (RWKV_DBG) { const float dd = __hip_atomic_load((float*)(F.ctl + CW_DBG), __ATOMIC_RELAXED, __HIP_MEMORY_SCOPE_AGENT), rr = __hip_atomic_load((float*)(F.ctl + CW_DBG + 1), __ATOMIC_RELAXED, __HIP_MEMORY_SCOPE_AGENT);
            dscale = 1.0f + sqrtf(fminf(dd / fmaxf(rr, 1e-30f), 1e6f)); }
        {
            f32x4 ch[4]; unsigned long long ca[4], cb[4];
#define P11_LOAD(H_, A_, B_, tok_) do { const GAS f32x4* or_ = (const GAS f32x4*)(outp + (size_t)(tok_) * DM); \
                const GAS unsigned long long* y0_ = (const GAS unsigned long long*)(YB + (size_t)(2 * (tok_)) * DM), *y1_ = (const GAS unsigned long long*)(YB + (size_t)(2 * (tok_) + 1) * DM); \
                _Pragma("unroll") for (int j_ = 0; j_ < 4; ++j_) { H_[j_] = or_[64 * j_ + lane]; A_[j_] = y0_[64 * j_ + lane]; B_[j_] = y1_[64 * j_ + lane]; } } while (0)
            if (gw < M) P11_LOAD(ch, ca, cb, gw);
            for (int tok = gw; tok < M; tok += NGW) {
                f32x4 nh[4]; unsigned long long na[4], nb[4];
#pragma unroll
                for (int j = 0; j < 4; ++j) { nh[j] = ch[j]; na[j] = ca[j]; nb[j] = cb[j]; }
                if (tok + NGW < M) P11_LOAD(nh, na, nb, tok + NGW);
                GAS f32x4* orow = (GAS f32x4*)(outp + (size_t)tok * DM);
#pragma unroll
                for (int j = 0; j < 4; ++j) { const int q = 64 * j + lane; f32x4 h = ch[j]; const unsigned long long a = ca[j], b = cb[j];
                    h.x += __uint_as_float((unsigned)a << 16) + __uint_as_float((unsigned)b << 16);
                    h.y += __uint_as_float((unsigned)a & 0xffff0000u) + __uint_as_float((unsigned)b & 0xffff0000u);
                    h.z += __uint_as_float((unsigned)(a >> 32) << 16) + __uint_as_float((unsigned)(b >> 32) << 16);
                    h.w += __uint_as_float((unsigned)(a >> 32) & 0xffff0000u) + __uint_as_float((unsigned)(b >> 32) & 0xffff0000u);
                    if (RWKV_DBG) h = h * dscale;
                    orow[q] = h; }
#pragma unroll
                for (int j = 0; j < 4; ++j) { ch[j] = nh[j]; ca[j] = na[j]; cb[j] = nb[j]; }
            }
#undef P11_LOAD
        }
    }
    STAMP(12);
#ifndef PROBE_MULT
#define PROBE_MULT 4
#endif
    if (PROBE_K >= 0 && blockIdx.x == 0 && F.tid == 0) {
        const GAS unsigned long long* ts = (const GAS unsigned long long*)(F.ctl + CW_TS);
#ifndef PROBE_A
#define PROBE_A PROBE_K
#define PROBE_B (PROBE_K + 1)
#endif
        const unsigned long long d = (ts[PROBE_B] - ts[PROBE_A]) * PROBE_MULT, t0 = rt();
        while (rt() - t0 < d) __builtin_amdgcn_s_sleep(8);
    }
#undef IN
#undef BOTH
}

extern "C" void kernel_launch(void* const* d_in, const int* in_sizes, int n_in, void* d_out, int out_size, void* d_ws, size_t ws_size, hipStream_t stream) {
    static int grid = 0;
    if (grid == 0) {
        int dev = 0, cus = 0;
        if (hipGetDevice(&dev) != hipSuccess || hipDeviceGetAttribute(&cus, hipDeviceAttributeMultiprocessorCount, dev) != hipSuccess) { grid = -1; return; }
        if (hipFuncSetAttribute((const void*)skel_fwd, hipFuncAttributeMaxDynamicSharedMemorySize, LDS_BYTES) != hipSuccess) { grid = -1; return; }
        grid = cus;
        if (n_in != 30 || ws_size < WS_TOTAL || out_size != M * DM) { fprintf(stderr, "kernel_launch: unexpected problem (n_in %d, ws %zu, out %d)\n", n_in, ws_size, out_size); grid = -1; return; }
        if (grid != 256) fprintf(stderr, "kernel_launch: %d CUs; the phase programs assume 256\n", grid);
    }
    if (grid < 0) return;
    (void)hipMemsetAsync((char*)d_ws + WS_CTL, 0, CTL_ZERO_BYTES, stream);
    Args a{};
    for (int i = 0; i < 30; ++i) a.in[i] = (const float*)d_in[i];
    a.out = (float*)d_out; a.ws = (unsigned char*)d_ws; a.ph_lo = 0; a.ph_hi = 12;
    hipLaunchKernelGGL(skel_fwd, dim3(grid), dim3(NWAVES * 64), LDS_BYTES, stream, a);
}
```

```cpp
#include <hip/hip_runtime.h>
#include <cstdio>
#include <cstdint>
namespace pg8 {
#define PG8_LAS __attribute__((address_space(3)))
typedef unsigned short bf16_t;
typedef short bf16x8 __attribute__((ext_vector_type(8)));
typedef float f32x4 __attribute__((ext_vector_type(4)));
typedef unsigned u32x4 __attribute__((ext_vector_type(4)));
constexpr int BM = 256, BK = 64, HALF = 128, HTB = HALF * BK * 2  , STAGE_BYTES = 8 * HTB, NXCD = 8, WGM = 8;

__host__ __device__ __forceinline__ int lds_byte(int r, int c) { const int st = (r >> 4) * 2 + (c >> 5), rr = r & 15, cc = c & 31, ob = rr * 64 + cc * 2; return st * 1024 + (ob ^ (((ob >> 9) & 1) << 5)); }
__host__ __device__ __forceinline__ void stage_rc(int b, int& R, int& C) { const int st = b / 1024, sb = b % 1024, swz = sb ^ (((sb >> 9) & 1) << 5); R = (st >> 1) * 16 + swz / 64; C = (st & 1) * 32 + (swz % 64) / 2; }
__host__ __device__ __forceinline__ int perm32(int rho) { const int n = rho >> 4, i = rho & 15; return 8 * (i >> 2) + 4 * n + (i & 3); }

struct Unit { int pm, pn; };
struct Gemm { const bf16_t* A; const bf16_t* Bt; int M, N, K; };

struct StaticOrder {
    int nM, nN, nwg, G, c;
    __host__ __device__ void init(int M, int N, int G_, int c_) { nM = M / BM; nN = N / BM; nwg = nM * nN; G = G_; c = c_; }
    __host__ __device__ bool next(int i, Unit& u) const {
        const long L = (long)i * G + c; if (L >= nwg) return false;
        int wgid = (int)L; { const int q = nwg / NXCD, r = nwg % NXCD, xcd = wgid % NXCD, off = wgid / NXCD; wgid = (xcd < r ? xcd * (q + 1) : r * (q + 1) + (xcd - r) * q) + off; }
        const int nig = WGM * nN, gid = wgid / nig, fm = gid * WGM, gsz = (nM - fm) < WGM ? (nM - fm) : WGM;
        u.pm = fm + ((wgid % nig) % gsz); u.pn = (wgid % nig) / gsz; return true;
    }
    __device__ __forceinline__ void a_ready(const Unit&) const {}
    __device__ __forceinline__ void done(const Unit&) const {}
};

__device__ __forceinline__ unsigned cvt_pk_bf16(float lo, float hi) { unsigned r; asm volatile("v_cvt_pk_bf16_f32 %0, %1, %2" : "=v"(r) : "v"(lo), "v"(hi)); return r; }
typedef float f32x2 __attribute__((ext_vector_type(2)));
__device__ __forceinline__ f32x2 gelu_pk(f32x2 v) {
    const f32x2 av = __builtin_elementwise_abs(v), d = av * 0.2316418882f + 1.0f;
    f32x2 t; t.x = __builtin_amdgcn_rcpf(d.x); t.y = __builtin_amdgcn_rcpf(d.y);
    f32x2 q = t * 0.5307027145f + (-0.7265760135f); q = q * t + 0.7107068705f; q = q * t + (-0.142248368f); q = q * t + 0.127414796f; q = q * t;
    const f32x2 s = (v * v) * (-0.72134752044f);
    f32x2 e; e.x = __builtin_amdgcn_exp2f(s.x); e.y = __builtin_amdgcn_exp2f(s.y);
    const f32x2 m = v * (q * e), r = v - m;
    f32x2 o; o.x = v.x < 0.f ? m.x : r.x; o.y = v.y < 0.f ? m.y : r.y; return o;
}

template <int ACT  > struct EpiBf16 {
    static constexpr bool PERM = true, AFTER_DRAIN = false; static_assert(ACT == 0 || ACT == 1, "EpiBf16: ACT is 0 (none) or 1 (gelu_pk)");
    bf16_t* O; int ldc; const float* bias; int split_cols; size_t split_stride; float scale0;
    __device__ __forceinline__ void operator()(const f32x4 (&acc)[2][2][4][2], const Unit& u, int wr, int wc, int fr, int fq) const {
        const int row0 = u.pm * BM + wr * 64 + fr; int colt = u.pn * BM; bf16_t* base = O;
        float sc = 1.f; if (split_cols) { const int t = colt / split_cols; base += (size_t)t * split_stride; colt -= t * split_cols; if (t == 0) sc = scale0; }
        const int col0 = colt + wc * 32 + 8 * fq, bcol0 = u.pn * BM + wc * 32 + 8 * fq;
        f32x4 bv[2][2];
#pragma unroll
        for (int bj = 0; bj < 2; ++bj)
#pragma unroll
            for (int n = 0; n < 2; ++n) bv[bj][n] = bias ? *(const f32x4*)(bias + bcol0 + bj * HALF + 4 * n) : (f32x4){0.f, 0.f, 0.f, 0.f};
#pragma unroll
        for (int ai = 0; ai < 2; ++ai)
#pragma unroll
            for (int m = 0; m < 4; ++m) { bf16_t* rowp = base + (size_t)(row0 + ai * HALF + m * 16) * ldc + col0;
#pragma unroll
                for (int bj = 0; bj < 2; ++bj) { f32x4 v0 = acc[ai][bj][m][0] + bv[bj][0], v1 = acc[ai][bj][m][1] + bv[bj][1];
                    if (ACT == 1) { f32x2 a = gelu_pk((f32x2){v0[0], v0[1]}), b = gelu_pk((f32x2){v0[2], v0[3]}), c = gelu_pk((f32x2){v1[0], v1[1]}), d = gelu_pk((f32x2){v1[2], v1[3]});
                        v0 = (f32x4){a.x, a.y, b.x, b.y}; v1 = (f32x4){c.x, c.y, d.x, d.y}; }
                    v0 = v0 * sc; v1 = v1 * sc; u32x4 w; w.x = cvt_pk_bf16(v0[0], v0[1]); w.y = cvt_pk_bf16(v0[2], v0[3]); w.z = cvt_pk_bf16(v1[0], v1[1]); w.w = cvt_pk_bf16(v1[2], v1[3]);
                    *(u32x4*)(rowp + bj * HALF) = w; } }
    }
};

struct PanelStats {
    unsigned* xbuf;
    unsigned* cnt;
    unsigned* tmo;
    int ntn; float eps;
    unsigned code;
    __device__ __forceinline__ bool run(const f32x4 (&v)[2][2][4][2], const Unit& u, int wr, int wc, int fr, int fq, PG8_LAS unsigned char* lds, int wid, int lane) const {
        typedef float f32x2v __attribute__((ext_vector_type(2)));
        PG8_LAS f32x2v* P = (PG8_LAS f32x2v*)lds;
        PG8_LAS f32x2v* S = (PG8_LAS f32x2v*)(lds + 8192);
        PG8_LAS unsigned* flag = (PG8_LAS unsigned*)(lds + 8192 + 2048);
#pragma unroll
        for (int ai = 0; ai < 2; ++ai)
#pragma unroll
            for (int m = 0; m < 4; ++m) {
                float s = 0.f;
#pragma unroll
                for (int bj = 0; bj < 2; ++bj)
#pragma unroll
                    for (int n = 0; n < 2; ++n) { const f32x4 x = v[ai][bj][m][n]; s += (x[0] + x[1]) + (x[2] + x[3]); }
                s += __shfl_xor(s, 16); s += __shfl_xor(s, 32);
                const float mw = s * (1.0f / 64.0f); float q = 0.f;
#pragma unroll
                for (int bj = 0; bj < 2; ++bj)
#pragma unroll
                    for (int n = 0; n < 2; ++n) { const f32x4 d = v[ai][bj][m][n] - mw; q += (d[0] * d[0] + d[1] * d[1]) + (d[2] * d[2] + d[3] * d[3]); }
                q += __shfl_xor(q, 16); q += __shfl_xor(q, 32);
                if (fq == 0) P[(ai * HALF + wr * 64 + m * 16 + fr) * 4 + wc] = (f32x2v){mw, q};
            }
        asm volatile("s_waitcnt lgkmcnt(0)" ::: "memory"); __builtin_amdgcn_s_barrier(); asm volatile("" ::: "memory");
#if defined(BROKEN_EXCHANGE_NO_WAIT)
#warning BROKEN CONTROL BUILD: the row-statistics exchange does not wait; results are wrong by design
        if (blockIdx.x >= 64) { const long long t0_ = clock64(); while (clock64() - t0_ < 60000) __builtin_amdgcn_s_sleep(8); }
#endif
        const int row = wid * 32 + (lane & 31);
        if (lane < 32) {
            const f32x2v a = P[row * 4 + 0], b = P[row * 4 + 1], c = P[row * 4 + 2], d = P[row * 4 + 3];
            const float mt = (a.x + b.x + c.x + d.x) * 0.25f;
            const float da = a.x - mt, db = b.x - mt, dc = c.x - mt, dd = d.x - mt;
            const float m2 = (a.y + b.y) + (c.y + d.y) + 64.0f * ((da * da + db * db) + (dc * dc + dd * dd));
            unsigned long long* slot = (unsigned long long*)xbuf + ((size_t)(u.pm * BM + row) * 4 + u.pn);
            __hip_atomic_store(slot, ((unsigned long long)__float_as_uint(m2) << 32) | __float_as_uint(mt), __ATOMIC_RELAXED, __HIP_MEMORY_SCOPE_AGENT);
        }
        asm volatile("s_waitcnt vmcnt(0)" ::: "memory");
        if (lane == 0) __hip_atomic_fetch_add(cnt + 64 * u.pm, 1u, __ATOMIC_RELAXED, __HIP_MEMORY_SCOPE_AGENT);
        if (wid == 0) {
            bool dead = false; const unsigned long long t0 = __builtin_amdgcn_s_memrealtime(); const unsigned want = 8u * (unsigned)ntn;
            for (;;) {
#if defined(BROKEN_EXCHANGE_NO_WAIT)
                break;
#endif
                if ((unsigned)__builtin_amdgcn_readfirstlane(__hip_atomic_load(cnt + 64 * u.pm, __ATOMIC_RELAXED, __HIP_MEMORY_SCOPE_AGENT)) >= want) break;
                if (__builtin_amdgcn_s_memrealtime() - t0 > 2000000ull) {
                    if (lane == 0) { unsigned expect = 0u; __hip_atomic_compare_exchange_strong(tmo + 1, &expect, code | (unsigned)(u.pm & 0xff), __ATOMIC_RELAXED, __ATOMIC_RELAXED, __HIP_MEMORY_SCOPE_AGENT);
                                     __hip_atomic_store(tmo, 1u, __ATOMIC_RELAXED, __HIP_MEMORY_SCOPE_AGENT); }
                    dead = true; break; }
                __builtin_amdgcn_s_sleep(2);
            }
            __builtin_amdgcn_fence(__ATOMIC_ACQUIRE, "agent");
            if (lane == 0) flag[0] = dead ? 1u : 0u;
        }
        asm volatile("s_waitcnt vmcnt(0) lgkmcnt(0)" ::: "memory"); __builtin_amdgcn_s_barrier(); asm volatile("" ::: "memory");
        const bool bad = flag[0] != 0u;
        if (lane < 32) {
            const unsigned long long* slot = (const unsigned long long*)xbuf + (size_t)(u.pm * BM + row) * 4; float mt[4], m2[4]; float ms = 0.f;
#pragma unroll
            for (int t = 0; t < 4; ++t) { if (t < ntn) { const unsigned long long w = __hip_atomic_load(slot + t, __ATOMIC_RELAXED, __HIP_MEMORY_SCOPE_AGENT); mt[t] = __uint_as_float((unsigned)w); m2[t] = __uint_as_float((unsigned)(w >> 32)); } else { mt[t] = 0.f; m2[t] = 0.f; } ms += mt[t]; }
            const float mean = ms / (float)ntn; float q = 0.f;
#pragma unroll
            for (int t = 0; t < 4; ++t) if (t < ntn) { const float dm = mt[t] - mean; q += m2[t] + 256.0f * dm * dm; }
            S[row] = (f32x2v){mean, 1.0f / sqrtf(q / (256.0f * (float)ntn) + eps)};
        }
        asm volatile("s_waitcnt lgkmcnt(0)" ::: "memory"); __builtin_amdgcn_s_barrier(); asm volatile("" ::: "memory");
        return bad;
    }
};
struct EpiLnRes {
    static constexpr bool PERM = false, AFTER_DRAIN = true;
    const float* base; float* out; int ldc; const float* bias; PanelStats st; unsigned poison;
    __device__ __forceinline__ void fused(f32x4 (&acc)[2][2][4][2], const Unit& u, int wr, int wc, int fr, int fq, PG8_LAS unsigned char* lds, int wid, int lane) const {
        typedef float f32x2v __attribute__((ext_vector_type(2)));
        const PG8_LAS f32x2v* S = (const PG8_LAS f32x2v*)(lds + 8192);
        const int col0 = u.pn * BM + wc * 32 + 4 * fq;
#pragma unroll
        for (int bj = 0; bj < 2; ++bj)
#pragma unroll
            for (int n = 0; n < 2; ++n) { const f32x4 bv = bias ? *(const f32x4*)(bias + col0 + bj * HALF + n * 16) : (f32x4){0.f, 0.f, 0.f, 0.f};
#pragma unroll
                for (int ai = 0; ai < 2; ++ai)
#pragma unroll
                    for (int m = 0; m < 4; ++m) acc[ai][bj][m][n] += bv; }
        f32x4 pre[4][2][2];
#pragma unroll
        for (int m = 0; m < 4; ++m) { const size_t off = (size_t)(u.pm * BM + wr * 64 + m * 16 + fr) * ldc + col0;
#pragma unroll
            for (int bj = 0; bj < 2; ++bj)
#pragma unroll
                for (int n = 0; n < 2; ++n) pre[m][bj][n] = *(const f32x4*)(base + off + bj * HALF + n * 16); }
        const bool bad = st.run(acc, u, wr, wc, fr, fq, lds, wid, lane) || poison != 0u;
        const float qnan = __builtin_nanf("");
#pragma unroll
        for (int ai = 0; ai < 2; ++ai)
#pragma unroll
            for (int m = 0; m < 4; ++m) { const int r = ai * HALF + wr * 64 + m * 16 + fr; const f32x2v sr = S[r]; const size_t off = (size_t)(u.pm * BM + r) * ldc + col0;
#pragma unroll
                for (int bj = 0; bj < 2; ++bj)
#pragma unroll
                    for (int n = 0; n < 2; ++n) { const f32x4 bs = ai == 0 ? pre[m][bj][n] : *(const f32x4*)(base + off + bj * HALF + n * 16); f32x4 o = bs + (acc[ai][bj][m][n] - sr.x) * sr.y;
                        if (bad) o = (f32x4){qnan, qnan, qnan, qnan}; *(f32x4*)(out + off + bj * HALF + n * 16) = o; }
                if (m & 1) asm volatile("" ::: "memory"); }
    }
};
struct EpiLnResLn {
    static constexpr bool PERM = false, AFTER_DRAIN = true;
    const float* base; float* out; bf16_t* xn; int ldc; const float* bias; PanelStats st1, st2; unsigned poison;
    __device__ __forceinline__ void fused(f32x4 (&acc)[2][2][4][2], const Unit& u, int wr, int wc, int fr, int fq, PG8_LAS unsigned char* lds, int wid, int lane) const {
        typedef float f32x2v __attribute__((ext_vector_type(2))); typedef unsigned u32x2v __attribute__((ext_vector_type(2)));
        const PG8_LAS f32x2v* S = (const PG8_LAS f32x2v*)(lds + 8192);
        const int col0 = u.pn * BM + wc * 32 + 4 * fq;
#pragma unroll
        for (int bj = 0; bj < 2; ++bj)
#pragma unroll
            for (int n = 0; n < 2; ++n) { const f32x4 bv = bias ? *(const f32x4*)(bias + col0 + bj * HALF + n * 16) : (f32x4){0.f, 0.f, 0.f, 0.f};
#pragma unroll
                for (int ai = 0; ai < 2; ++ai)
#pragma unroll
                    for (int m = 0; m < 4; ++m) acc[ai][bj][m][n] += bv; }
        bool bad = st1.run(acc, u, wr, wc, fr, fq, lds, wid, lane) || poison != 0u;
        const float qnan = __builtin_nanf("");
#pragma unroll
        for (int ai = 0; ai < 2; ++ai)
#pragma unroll
            for (int m = 0; m < 4; ++m) { const int r = ai * HALF + wr * 64 + m * 16 + fr; const f32x2v sr = S[r]; const size_t off = (size_t)(u.pm * BM + r) * ldc + col0;
#pragma unroll
                for (int bj = 0; bj < 2; ++bj)
#pragma unroll
                    for (int n = 0; n < 2; ++n) { const f32x4 bs = *(const f32x4*)(base + off + bj * HALF + n * 16); acc[ai][bj][m][n] = bs + (acc[ai][bj][m][n] - sr.x) * sr.y; }
                asm volatile("" : "+v"(acc[ai][0][m][0]), "+v"(acc[ai][0][m][1]), "+v"(acc[ai][1][m][0]), "+v"(acc[ai][1][m][1]));
                if (m & 1) asm volatile("" ::: "memory"); }
        const bool bad1 = bad;
        bad = st2.run(acc, u, wr, wc, fr, fq, lds, wid, lane) || bad;
#pragma unroll
        for (int ai = 0; ai < 2; ++ai)
#pragma unroll
            for (int m = 0; m < 4; ++m) { const int r = ai * HALF + wr * 64 + m * 16 + fr; const f32x2v sr = S[r]; const size_t off = (size_t)(u.pm * BM + r) * ldc + col0;
#pragma unroll
                for (int bj = 0; bj < 2; ++bj)
#pragma unroll
                    for (int n = 0; n < 2; ++n) { const f32x4 x1 = acc[ai][bj][m][n]; *(f32x4*)(out + off + bj * HALF + n * 16) = bad1 ? (f32x4){qnan, qnan, qnan, qnan} : x1;
                        const f32x4 o = (x1 - sr.x) * sr.y; u32x2v w; w.x = cvt_pk_bf16(o[0], o[1]); w.y = cvt_pk_bf16(o[2], o[3]);
                        if (bad) { w.x = 0x7fc07fc0u; w.y = 0x7fc07fc0u; } *(u32x2v*)(xn + off + bj * HALF + n * 16) = w; }
                asm volatile("" ::: "memory"); }
    }
};

template <class Epi, class Sched, bool ALIGN_EPI = false, bool SP2 = false>
__device__ __forceinline__ void gemm_phase(PG8_LAS unsigned char* lds, const Gemm g, const Sched& S, const Epi& E) {
    const int tid = threadIdx.x, wid = __builtin_amdgcn_readfirstlane(tid >> 6), lane = tid & 63, wr = wid >> 2, wc = wid & 3, fr = lane & 15, fq = lane >> 4;
    const int K = g.K, nt = K / BK;
    unsigned voffA[2], voffB[2];
#pragma unroll
    for (int i = 0; i < 2; ++i) { int R, C; stage_rc(tid * 16 + i * 8192, R, C); const int Rb = Epi::PERM ? ((R & ~31) + perm32(R & 31)) : R;
        voffA[i] = (unsigned)(R * K + C) * 2u; voffB[i] = (unsigned)(Rb * K + C) * 2u; }
    const size_t kstep = (size_t)(BK * 2);
    const size_t hstep = (size_t)HALF * K * 2;
    const size_t tstep = 2 * hstep;
    const unsigned ldsw = (unsigned)wid * 1024u;
    const int aoff = lds_byte(wr * 64 + fr, fq * 8), boff = lds_byte(wc * 32 + fr, fq * 8);
#define PG8_SA(b, h) (((b) * 2 + (h)) * HTB)
#define PG8_SB(b, h) ((4 + (b) * 2 + (h)) * HTB)
#define PG8_STAGE(bufoff, gbase, voff) do { _Pragma("unroll") for (int _i = 0; _i < 2; ++_i) \
        __builtin_amdgcn_global_load_lds((const unsigned*)((const char*)(gbase) + (voff)[_i]), (PG8_LAS unsigned*)(lds + (bufoff) + ldsw + _i * 8192), 16, 0, 0); } while (0)
#define PG8_LDA(dst, b, h) do { _Pragma("unroll") for (int m = 0; m < 4; ++m) _Pragma("unroll") for (int k = 0; k < 2; ++k) dst[m][k] = *(const PG8_LAS bf16x8*)(lds + PG8_SA(b, h) + aoff + m * 2048 + k * 1024); } while (0)
#define PG8_LDB(dst, b, h) do { _Pragma("unroll") for (int n = 0; n < 2; ++n) _Pragma("unroll") for (int k = 0; k < 2; ++k) dst[n][k] = *(const PG8_LAS bf16x8*)(lds + PG8_SB(b, h) + boff + n * 2048 + k * 1024); } while (0)
#define PG8_MMA(ai, bj, At, Bt) do { __builtin_amdgcn_s_setprio(1); _Pragma("unroll") for (int m = 0; m < 4; ++m) _Pragma("unroll") for (int n = 0; n < 2; ++n) _Pragma("unroll") for (int k = 0; k < 2; ++k) \
        acc[ai][bj][m][n] = __builtin_amdgcn_mfma_f32_16x16x32_bf16(Bt[n][k], At[m][k], acc[ai][bj][m][n], 0, 0, 0); __builtin_amdgcn_s_setprio(0); } while (0)
#define PG8_WAIT_V(n) asm volatile("s_waitcnt vmcnt(" #n ")" ::: "memory")
#define PG8_WAIT_L(n) asm volatile("s_waitcnt lgkmcnt(" #n ")" ::: "memory")
#define PG8_BAR __builtin_amdgcn_s_barrier()
#define PG8_SCHED __builtin_amdgcn_sched_barrier(0)
    Unit cur, nxt; int ui = 0;
    if (!S.next(0, cur)) return;
    f32x4 acc[2][2][4][2];
#pragma unroll
    for (int a = 0; a < 2; ++a)
#pragma unroll
        for (int b = 0; b < 2; ++b)
#pragma unroll
            for (int m = 0; m < 4; ++m)
#pragma unroll
                for (int n = 0; n < 2; ++n) acc[a][b][m][n] = (f32x4){0.f, 0.f, 0.f, 0.f};
    bf16x8 At[4][2], B0[2][2], B1[2][2];
    const char* cA = (const char*)g.A + (size_t)cur.pm * tstep; const char* cB = (const char*)g.Bt + (size_t)cur.pn * tstep;
    S.a_ready(cur);
    if constexpr (SP2) {
        PG8_STAGE(PG8_SB(0, 0), cB, voffB); PG8_STAGE(PG8_SB(0, 1), cB + hstep, voffB); PG8_STAGE(PG8_SA(0, 0), cA, voffA); PG8_STAGE(PG8_SA(0, 1), cA + hstep, voffA);
        if (wr == 1) PG8_BAR;
        PG8_WAIT_V(2); PG8_BAR;
        PG8_STAGE(PG8_SB(1, 0), cB + kstep, voffB); PG8_STAGE(PG8_SA(1, 0), cA + kstep, voffA); PG8_STAGE(PG8_SB(1, 1), cB + hstep + kstep, voffB);
        PG8_WAIT_V(6); PG8_BAR;
    } else {
        PG8_STAGE(PG8_SB(0, 0), cB, voffB); PG8_STAGE(PG8_SA(0, 0), cA, voffA); PG8_STAGE(PG8_SB(0, 1), cB + hstep, voffB); PG8_STAGE(PG8_SA(0, 1), cA + hstep, voffA);
        if (wr == 1) PG8_BAR;
        PG8_WAIT_V(4); PG8_BAR;
        PG8_STAGE(PG8_SB(1, 0), cB + kstep, voffB); PG8_STAGE(PG8_SA(1, 0), cA + kstep, voffA); PG8_STAGE(PG8_SB(1, 1), cB + hstep + kstep, voffB);
        PG8_WAIT_V(6); PG8_BAR;
    }
    for (;;) {
        const bool has_next = S.next(ui + 1, nxt);
        const char* nA = has_next ? (const char*)g.A + (size_t)nxt.pm * tstep : cA; const char* nB = has_next ? (const char*)g.Bt + (size_t)nxt.pn * tstep : cB;
        for (int t = 0; t < nt; t += 2) {
            const bool last = (t == nt - 2);
            const char* a1 = cA + (size_t)(t + 1) * kstep;
            const char* a2 = last ? nA : cA + (size_t)(t + 2) * kstep; const char* b2 = last ? nB : cB + (size_t)(t + 2) * kstep;
            const char* a3 = a2 + kstep; const char* b3 = b2 + kstep;
            if (last && has_next) S.a_ready(nxt);
            if constexpr (SP2) {
            PG8_LDB(B0, 0, 0); PG8_LDB(B1, 0, 1); PG8_SCHED; PG8_LDA(At, 0, 0); PG8_STAGE(PG8_SA(1, 1), a1 + hstep, voffA);
            PG8_WAIT_V(8); PG8_WAIT_L(0); PG8_BAR; PG8_MMA(0, 0, At, B0); PG8_MMA(0, 1, At, B1); PG8_BAR; PG8_SCHED;
            PG8_LDA(At, 0, 1); PG8_STAGE(PG8_SB(0, 0), b2, voffB); PG8_STAGE(PG8_SB(0, 1), b2 + hstep, voffB); PG8_STAGE(PG8_SA(0, 0), a2, voffA);
            PG8_WAIT_V(8); PG8_WAIT_L(0); PG8_BAR; PG8_MMA(1, 0, At, B0); PG8_MMA(1, 1, At, B1); PG8_BAR; PG8_SCHED;
            PG8_LDB(B0, 1, 0); PG8_LDB(B1, 1, 1); PG8_SCHED; PG8_LDA(At, 1, 0); PG8_STAGE(PG8_SA(0, 1), a2 + hstep, voffA);
            PG8_WAIT_V(8); PG8_WAIT_L(0); PG8_BAR; PG8_MMA(0, 0, At, B0); PG8_MMA(0, 1, At, B1); PG8_BAR; PG8_SCHED;
            PG8_LDA(At, 1, 1); PG8_STAGE(PG8_SB(1, 0), b3, voffB); PG8_STAGE(PG8_SB(1, 1), b3 + hstep, voffB); PG8_STAGE(PG8_SA(1, 0), a3, voffA);
            PG8_WAIT_V(8); PG8_WAIT_L(0); PG8_BAR; PG8_MMA(1, 0, At, B0); PG8_MMA(1, 1, At, B1); PG8_BAR; PG8_SCHED;
            } else {
            PG8_LDB(B0, 0, 0); PG8_SCHED; PG8_LDA(At, 0, 0); PG8_STAGE(PG8_SA(1, 1), a1 + hstep, voffA);
            PG8_WAIT_L(8); PG8_BAR; PG8_WAIT_L(0); PG8_MMA(0, 0, At, B0); PG8_BAR; PG8_SCHED;
            PG8_LDB(B1, 0, 1); PG8_STAGE(PG8_SB(0, 0), b2, voffB);
            PG8_BAR; PG8_WAIT_L(0); PG8_MMA(0, 1, At, B1); PG8_BAR;
            PG8_LDA(At, 0, 1); PG8_STAGE(PG8_SA(0, 0), a2, voffA);
            PG8_BAR; PG8_WAIT_L(0); PG8_MMA(1, 0, At, B0); PG8_BAR; PG8_SCHED;
            PG8_STAGE(PG8_SB(0, 1), b2 + hstep, voffB);
            PG8_WAIT_V(6); PG8_BAR; PG8_MMA(1, 1, At, B1); PG8_BAR;
            PG8_LDB(B0, 1, 0); PG8_SCHED; PG8_LDA(At, 1, 0); PG8_STAGE(PG8_SA(0, 1), a2 + hstep, voffA);
            PG8_WAIT_L(8); PG8_BAR; PG8_WAIT_L(0); PG8_MMA(0, 0, At, B0); PG8_BAR; PG8_SCHED;
            PG8_LDB(B1, 1, 1); PG8_STAGE(PG8_SB(1, 0), b3, voffB);
            PG8_BAR; PG8_WAIT_L(0); PG8_MMA(0, 1, At, B1); PG8_BAR;
            PG8_LDA(At, 1, 1); PG8_STAGE(PG8_SA(1, 0), a3, voffA);
            PG8_BAR; PG8_WAIT_L(0); PG8_MMA(1, 0, At, B0); PG8_BAR; PG8_SCHED;
            PG8_STAGE(PG8_SB(1, 1), b3 + hstep, voffB);
            PG8_WAIT_V(6); PG8_BAR; PG8_MMA(1, 1, At, B1); PG8_BAR;
            }
        }
        if constexpr (ALIGN_EPI) { if (wr == 0) PG8_BAR; }
        if constexpr (!Epi::AFTER_DRAIN) { E(acc, cur, wr, wc, fr, fq); S.done(cur); }
        if (!has_next) break;
#pragma unroll
        for (int a = 0; a < 2; ++a)
#pragma unroll
            for (int b = 0; b < 2; ++b)
#pragma unroll
                for (int m = 0; m < 4; ++m)
#pragma unroll
                    for (int n = 0; n < 2; ++n) acc[a][b][m][n] = (f32x4){0.f, 0.f, 0.f, 0.f};
        cur = nxt; cA = nA; cB = nB; ++ui;
        if constexpr (ALIGN_EPI) { if (wr == 1) PG8_BAR; }
    }
    PG8_WAIT_V(0);
    if constexpr (!ALIGN_EPI) { if (wr == 0) PG8_BAR; }
    PG8_BAR;
    if constexpr (Epi::AFTER_DRAIN) { E.fused(acc, cur, wr, wc, fr, fq, lds, wid, lane); S.done(cur); }
#undef PG8_SA
#undef PG8_SB
#undef PG8_STAGE
#undef PG8_LDA
#undef PG8_LDB
#undef PG8_MMA
#undef PG8_WAIT_V
#undef PG8_WAIT_L
#undef PG8_BAR
#undef PG8_SCHED
}
}

#ifndef PG8_SP2
#define PG8_SP2 true
#endif
#ifndef PG8_ALIGN
#define PG8_ALIGN true
#endif

namespace pg8 {
struct EpiResF32 {
    static constexpr bool PERM = false, AFTER_DRAIN = false;
    const float* base; float* out; int ldc;
    __device__ __forceinline__ void operator()(const f32x4 (&acc)[2][2][4][2], const Unit& u, int wr, int wc, int fr, int fq) const {
        const int col0 = u.pn * BM + wc * 32 + 4 * fq;
#pragma unroll
        for (int ai = 0; ai < 2; ++ai)
#pragma unroll
            for (int m = 0; m < 4; ++m) { const size_t off = (size_t)(u.pm * BM + ai * HALF + wr * 64 + m * 16 + fr) * ldc + col0;
#pragma unroll
                for (int bj = 0; bj < 2; ++bj)
#pragma unroll
                    for (int n = 0; n < 2; ++n) { const f32x4 bs = *(const f32x4*)(base + off + bj * HALF + n * 16); *(f32x4*)(out + off + bj * HALF + n * 16) = bs + acc[ai][bj][m][n]; }
                asm volatile("" ::: "memory"); }
    }
};
struct EpiSwiGLU {
    static constexpr bool PERM = true, AFTER_DRAIN = false;
    bf16_t* O;
    __device__ __forceinline__ void operator()(const f32x4 (&acc)[2][2][4][2], const Unit& u, int wr, int wc, int fr, int fq) const {
        const int row0 = u.pm * BM + wr * 64 + fr; const int col0 = (u.pn & 3) * 128 + wc * 32 + 8 * fq;
#pragma unroll
        for (int ai = 0; ai < 2; ++ai)
#pragma unroll
            for (int m = 0; m < 4; ++m) { bf16_t* rowp = O + (size_t)(row0 + ai * HALF + m * 16) * 512 + col0;
                f32x4 g0 = acc[ai][0][m][0], g1 = acc[ai][0][m][1]; const f32x4 u0 = acc[ai][1][m][0], u1 = acc[ai][1][m][1];
#pragma unroll
                for (int e = 0; e < 4; ++e) { g0[e] = g0[e] * __builtin_amdgcn_rcpf(1.0f + __expf(-g0[e])) * u0[e]; g1[e] = g1[e] * __builtin_amdgcn_rcpf(1.0f + __expf(-g1[e])) * u1[e]; }
                u32x4 w; w.x = cvt_pk_bf16(g0[0], g0[1]); w.y = cvt_pk_bf16(g0[2], g0[3]); w.z = cvt_pk_bf16(g1[0], g1[1]); w.w = cvt_pk_bf16(g1[2], g1[3]);
                *(u32x4*)rowp = w; asm volatile("" ::: "memory"); }
    }
};
struct EpiScatter {
    static constexpr bool PERM = true, AFTER_DRAIN = false;
    bf16_t* Y; const int* rowslot; const float* rowgate;
    __device__ __forceinline__ void operator()(const f32x4 (&acc)[2][2][4][2], const Unit& u, int wr, int wc, int fr, int fq) const {
        const int row0 = u.pm * BM + wr * 64 + fr; const int col0 = (u.pn & 3) * BM + wc * 32 + 8 * fq;
#pragma unroll
        for (int ai = 0; ai < 2; ++ai)
#pragma unroll
            for (int m = 0; m < 4; ++m) { const int r = row0 + ai * HALF + m * 16; const int slot = rowslot[r]; const float gt = rowgate[r];
                if (slot >= 0) { bf16_t* rowp = Y + (size_t)slot * 1024 + col0;
#pragma unroll
                    for (int bj = 0; bj < 2; ++bj) { const f32x4 v0 = acc[ai][bj][m][0] * gt, v1 = acc[ai][bj][m][1] * gt;
                        u32x4 w; w.x = cvt_pk_bf16(v0[0], v0[1]); w.y = cvt_pk_bf16(v0[2], v0[3]); w.z = cvt_pk_bf16(v1[0], v1[1]); w.w = cvt_pk_bf16(v1[2], v1[3]);
                        *(u32x4*)(rowp + bj * HALF) = w; } }
                asm volatile("" ::: "memory"); }
    }
};
struct MoeOrder {
    int ntiles, G, c; const PG8_LAS int* tile_e;
    __device__ __forceinline__ bool next(int i, Unit& u) const {
        const int L = i * G + c; if (L >= ntiles * 4) return false;
        const int ti = L >> 2; const int e = __builtin_amdgcn_readfirstlane(tile_e[ti]);
        u.pm = ti; u.pn = e * 4 + (L & 3); return true;
    }
    __device__ __forceinline__ void a_ready(const Unit&) const {}
    __device__ __forceinline__ void done(const Unit&) const {}
};
struct G1Order : StaticOrder {
    __device__ __forceinline__ bool next(int i, Unit& u) const { if (!StaticOrder::next(i, u)) return false; if (u.pn >= 11) u.pn = 12; return true; }
};
struct P3Order {
    int c;
    __device__ __forceinline__ bool next(int i, Unit& u) const {
        if (c < 64) { if (i > 0) return false; u.pm = c; u.pn = 11; return true; }
        const int L = i * 192 + (c - 64); if (L >= 384) return false; u.pm = L / 6; u.pn = L % 6; return true; }
    __device__ __forceinline__ void a_ready(const Unit&) const {}
    __device__ __forceinline__ void done(const Unit&) const {}
};
}


#include <hip/hip_bf16.h>
#include <cmath>
namespace attn_body {
using bf16=__hip_bfloat16;
using bf16x8=__attribute__((ext_vector_type(8)))short;
using s16x4=__attribute__((ext_vector_type(4)))short;
using f32x16=__attribute__((ext_vector_type(16)))float;
using u32x4=__attribute__((ext_vector_type(4)))unsigned;
constexpr int BATCH=8,NHEAD=16,SEQ=2048,D=64,QP=3328,OP=1024;
constexpr int NW=8,QBLK=32,QB=QBLK*NW,KVBLK=64,NQB=SEQ/QB;
constexpr int ATTN_UNIT_ROWS=QB;
__device__ __forceinline__ int crow(int r,int hi){return (r&3)+8*(r>>2)+4*hi;}
#define SBAR() __builtin_amdgcn_sched_barrier(0)
__device__ __forceinline__ void cmask(f32x16&p0,f32x16&p1,int jb,int qrel,int hi){
  const float NEG=-INFINITY;
  if(jb>(qrel>>6)){
  #pragma unroll
  for(int r=0;r<16;++r){p0[r]=NEG;p1[r]=NEG;}}
}

constexpr int NSLOT=3, SLOTB=8192;
constexpr int LDS_K=0, LDS_V=NSLOT*SLOTB, LDS_WS=2*NSLOT*SLOTB, LDS_OST=LDS_WS+NW*64*4, LDS_BYTES=LDS_OST+NW*4096;
constexpr float C2=0.125f*1.4426950408889634f;
__device__ __forceinline__ void glds16(const void*gsrc,unsigned lds_dst){unsigned keep;
  asm volatile("s_mov_b32 %0, m0\n\ts_mov_b32 m0, %2\n\ts_nop 0\n\tglobal_load_lds_dwordx4 %1, off\n\ts_mov_b32 m0, %0":"=&s"(keep):"v"(gsrc),"s"(lds_dst):"memory");}
__device__ __forceinline__ float max3f(float a,float b,float c){float r;asm("v_max3_f32 %0, %1, %2, %3":"=v"(r):"v"(a),"v"(b),"v"(c));return r;}
__device__ __forceinline__ float max2f(float a,float b){float r;asm("v_max_f32_e32 %0, %1, %2":"=v"(r):"v"(a),"v"(b));return r;}
__device__ __forceinline__ float fadd_s(float a,float b){float r;asm("v_add_f32_e32 %0, %1, %2":"=v"(r):"v"(a),"v"(b));return r;}
__device__ __forceinline__ float fsub_s(float a,float b){float r;asm("v_sub_f32_e32 %0, %1, %2":"=v"(r):"v"(a),"v"(b));return r;}
typedef float f32x2_t __attribute__((ext_vector_type(2))); typedef __bf16 bf16x2_t __attribute__((ext_vector_type(2)));
__device__ __forceinline__ unsigned cvtpk_s(float lo,float hi){f32x2_t v={lo,hi};bf16x2_t b=__builtin_convertvector(v,bf16x2_t);return __builtin_bit_cast(unsigned,b);}
#define WAIT_BAR(N) asm volatile("s_waitcnt vmcnt(" #N ") lgkmcnt(0)\n\ts_barrier":::"memory")

__device__ __forceinline__ void qkt(f32x16&p0,f32x16&p1,const char*Kslot,const bf16x8*qr,const f32x16&negm,int r32,int hi){
  const char*kb=Kslot+hi*1024+r32*16;
  #pragma unroll
  for(int d0=0;d0<4;++d0){
    const bf16x8 b0=*reinterpret_cast<const bf16x8*>(kb+d0*2048);
    const bf16x8 b1=*reinterpret_cast<const bf16x8*>(kb+d0*2048+512);
    if(d0==0){p0=__builtin_amdgcn_mfma_f32_32x32x16_bf16(b0,qr[0],negm,0,0,0);p1=__builtin_amdgcn_mfma_f32_32x32x16_bf16(b1,qr[0],negm,0,0,0);}
    else{p0=__builtin_amdgcn_mfma_f32_32x32x16_bf16(b0,qr[d0],p0,0,0,0);p1=__builtin_amdgcn_mfma_f32_32x32x16_bf16(b1,qr[d0],p1,0,0,0);}}
}
typedef __attribute__((address_space(3))) const char* lds_cptr;
typedef short v4i16_t __attribute__((ext_vector_type(4)));
__device__ __forceinline__ void kload8(bf16x8*kf,lds_cptr kp){
  kf[0]=*(const __attribute__((address_space(3))) bf16x8*)(kp);      kf[1]=*(const __attribute__((address_space(3))) bf16x8*)(kp+512);
  kf[2]=*(const __attribute__((address_space(3))) bf16x8*)(kp+2048); kf[3]=*(const __attribute__((address_space(3))) bf16x8*)(kp+2560);
  kf[4]=*(const __attribute__((address_space(3))) bf16x8*)(kp+4096); kf[5]=*(const __attribute__((address_space(3))) bf16x8*)(kp+4608);
  kf[6]=*(const __attribute__((address_space(3))) bf16x8*)(kp+6144); kf[7]=*(const __attribute__((address_space(3))) bf16x8*)(kp+6656);
}
__device__ __forceinline__ void kload2(bf16x8*kf,lds_cptr kp,int j){ kf[2*j]=*(const __attribute__((address_space(3))) bf16x8*)(kp+j*2048); kf[2*j+1]=*(const __attribute__((address_space(3))) bf16x8*)(kp+j*2048+512); }
__device__ __forceinline__ s16x4 vtr(lds_cptr p){ return __builtin_bit_cast(s16x4,__builtin_amdgcn_ds_read_tr16_b64_v4i16((__attribute__((address_space(3))) v4i16_t*)p)); }
__device__ __forceinline__ float rowmax(const f32x16&p0,const f32x16&p1){
  float a=max3f(p0[0],p0[1],p1[0]),b=max3f(p0[2],p0[3],p1[1]);a=max3f(a,p1[2],p1[3]);
  #pragma unroll
  for(int r=4;r<16;r+=4){a=max3f(a,p0[r],p0[r+1]);b=max3f(b,p0[r+2],p0[r+3]);a=max3f(a,p1[r],p1[r+1]);b=max3f(b,p1[r+2],p1[r+3]);}
  const float m=max2f(a,b);
  auto rr=__builtin_amdgcn_permlane32_swap(__float_as_uint(m),__float_as_uint(m),false,false);
  return max2f(__uint_as_float(rr[0]),__uint_as_float(rr[1]));
}
__device__ __forceinline__ void pv(f32x16*o,int vb,bf16x8 pa0,bf16x8 pa1,bf16x8 pa2,bf16x8 pa3){
  #pragma unroll
  for(int d0=0;d0<2;++d0){s16x4 lo[4],hi[4];
    #pragma unroll
    for(int ks=0;ks<4;++ks){
      asm volatile("ds_read_b64_tr_b16 %0,%1 offset:%c2":"=&v"(lo[ks]):"v"(vb),"i"(d0*4096+ks*1024):"memory");
      asm volatile("ds_read_b64_tr_b16 %0,%1 offset:%c2":"=&v"(hi[ks]):"v"(vb),"i"(d0*4096+ks*1024+512):"memory");}
    asm volatile("s_waitcnt lgkmcnt(0)":::"memory");SBAR();
    #define PK(k) (bf16x8){lo[k][0],lo[k][1],lo[k][2],lo[k][3],hi[k][0],hi[k][1],hi[k][2],hi[k][3]}
    o[d0]=__builtin_amdgcn_mfma_f32_32x32x16_bf16(pa0,PK(0),o[d0],0,0,0);
    o[d0]=__builtin_amdgcn_mfma_f32_32x32x16_bf16(pa1,PK(1),o[d0],0,0,0);
    o[d0]=__builtin_amdgcn_mfma_f32_32x32x16_bf16(pa2,PK(2),o[d0],0,0,0);
    o[d0]=__builtin_amdgcn_mfma_f32_32x32x16_bf16(pa3,PK(3),o[d0],0,0,0);
    #undef PK
  }
}

#ifndef ATTN_STORE16
#define ATTN_STORE16(p,v) (*(u32x4*)(p)=(v))
#endif
template<int THRL> __device__ __forceinline__ void attn_unit(int b,int qb,const bf16*Q,const bf16*__restrict__ K,const bf16*__restrict__ V,bf16*O,char*shm){
  const int tid=threadIdx.x,lane=tid&63,r32=lane&31,hi=lane>>5; const int wid=__builtin_amdgcn_readfirstlane(tid>>6);
  const long rowbase=(long)b*SEQ; const int q0=qb*QB;
  const bf16*Qw=Q+(rowbase+q0+wid*QBLK)*QP;
  const bf16*Kh=K+rowbase*QP,*Vh=V+rowbase*QP;
  const unsigned lds0=(unsigned)(uintptr_t)shm;
  float*wsf=(float*)(shm+LDS_WS)+wid*64;
  const bf16*ksrc=Kh+(long)lane*QP+wid*8;
  const bf16*vsrc=Vh+(long)(16*(wid&3)+(lane>>2))*QP+(wid>>2)*32+(lane&3)*8;
  const unsigned kdst=lds0+LDS_K+wid*1024, vdst=lds0+LDS_V+wid*1024;
  #define DMA_K(t,slot) glds16(ksrc+(long)(t)*KVBLK*QP,(unsigned)__builtin_amdgcn_readfirstlane(kdst+(slot)))
  #define DMA_V(t,slot) glds16(vsrc+(long)(t)*KVBLK*QP,(unsigned)__builtin_amdgcn_readfirstlane(vdst+(slot)))
  const int vb0=(int)(lds0+LDS_V)+((lane>>4)&1)*32+(lane&3)*8+(4*hi+((lane&15)>>2))*64;
  const char*Kbase=shm+LDS_K; bf16x8 kf[8];
  const lds_cptr shm3=(lds_cptr)shm; const lds_cptr kp0=shm3+LDS_K+hi*1024+r32*16; const lds_cptr vp0=shm3+LDS_V+((lane>>4)&1)*32+(lane&3)*8+(4*hi+((lane&15)>>2))*64;
  const int NT=(q0+QB)/KVBLK;
  DMA_K(0,0);DMA_V(0,0);DMA_K(1,SLOTB);
  bf16x8 qr[4];
  #pragma unroll
  for(int d0=0;d0<4;++d0)qr[d0]=*reinterpret_cast<const bf16x8*>(&Qw[(long)r32*QP+d0*16+hi*8]);
  float mhat=0.f,l_reg=0.f;f32x16 o[2];o[0]=f32x16{};o[1]=f32x16{};f32x16 negm=f32x16{};asm volatile("":"+v"(negm));
  const int qrel=wid*QBLK+r32;
  #define CMASK(P0,P1,t) do{int jb_=(t)-(NT-4); if(jb_>=0)cmask(P0,P1,jb_,qrel,hi);}while(0)
  bool resc=false;
  #define START(P0,P1) do{ const float rm=rowmax(P0,P1); resc=false; \
    { const float dl=rm; mhat=fadd_s(mhat,dl); \
      _Pragma("unroll") for(int r=0;r<16;++r){P0[r]=fsub_s(P0[r],dl);P1[r]=fsub_s(P1[r],dl);} \
      _Pragma("unroll") for(int r=0;r<16;++r)negm[r]=-mhat; asm volatile("":"+v"(negm)); } \
    _Pragma("unroll") for(int r=0;r<16;++r)P0[r]=__builtin_amdgcn_exp2f(P0[r]); }while(0)
  #define RESC() do{ if(resc){ asm volatile("s_waitcnt lgkmcnt(0)":::"memory"); \
      _Pragma("unroll") for(int d_=0;d_<2;++d_) _Pragma("unroll") for(int r=0;r<16;++r)o[d_][r]*=wsf[crow(r,hi)]; } }while(0)
  f32x16 pA0,pA1,pB0,pB1;
  int sl_prev=0,sl_cur=0,sl_next=SLOTB;
  #define ROT() do{sl_prev=sl_cur;sl_cur=sl_next;sl_next=(sl_next==(NSLOT-1)*SLOTB)?0:sl_next+SLOTB;}while(0)
  DMA_K(2,2*SLOTB);
  WAIT_BAR(3);
  qkt(pA0,pA1,Kbase,qr,negm,r32,hi);asm volatile("s_nop 15\n\ts_nop 7":"+v"(pA0),"+v"(pA1));CMASK(pA0,pA1,0);
  START(pA0,pA1);
  _Pragma("unroll") for(int r=0;r<16;++r)pA1[r]=__builtin_amdgcn_exp2f(pA1[r]);
  WAIT_BAR(0);
  DMA_K(3,0);DMA_V(1,SLOTB);
  ROT();
  kload8(kf,kp0+sl_cur);
  WAIT_BAR(2);
  s16x4 vlo[8],vhi[8]; u32x4 pw0,pw1,pw2,pw3;
  #define PKW(P,B) cvtpk_s(P[B],P[B+1])
  #define PAF(k) __builtin_bit_cast(bf16x8,pw##k)
  #define VFR(i) (bf16x8){vlo[i][0],vlo[i][1],vlo[i][2],vlo[i][3],vhi[i][0],vhi[i][1],vhi[i][2],vhi[i][3]}
  #define PIN(x) asm volatile("":"+v"(x))
  #define MX3(a,b,c) __builtin_fmaxf(__builtin_fmaxf((a),(b)),(c))
  #define GAPA(MF,A0,A1,A2,A3,W0,W1,PW) do{ MF; sacc+=A0; sacc+=A1; sacc+=A2; sacc+=A3; PIN(sacc); W0; W1; PIN(PW); SBAR(); }while(0)
  #define EX(v) __builtin_amdgcn_exp2f(v)
  #define GAPB(MF,X,B) do{ MF; X[B]=EX(X[B]); X[B+1]=EX(X[B+1]); X[B+2]=EX(X[B+2]); X[B+3]=EX(X[B+3]); PIN(X); SBAR(); }while(0)
  #define VRD(i) do{ vlo[i]=vtr(vp_+(((i)>>2)*4096+((i)&3)*1024)); vhi[i]=vtr(vp_+(((i)>>2)*4096+((i)&3)*1024+512)); }while(0)
  #define KRD(G,j) do{ if(G){ kload2(kf,kp0+sl_next,j); SBAR(); } }while(0)
  #define STEP(C0,C1,P0,P1,t,GK,GV,GL) do{ SBAR(); \
    const lds_cptr vp_=vp0+sl_prev; \
    VRD(0); SBAR(); float sacc=(P0[0]+P0[1]); \
    GAPA(C0=__builtin_amdgcn_mfma_f32_32x32x16_bf16(kf[0],qr[0],negm,0,0,0), P0[2],P0[3],P0[4],P0[5],     pw0[0]=PKW(P0,0), pw0[1]=PKW(P0,2), pw0); \
    VRD(4); SBAR(); GAPA(C1=__builtin_amdgcn_mfma_f32_32x32x16_bf16(kf[1],qr[0],negm,0,0,0), P0[6],P0[7],P0[8],P0[9],     pw0[2]=PKW(P0,4), pw0[3]=PKW(P0,6), pw0); \
    VRD(1); SBAR(); GAPA(C0=__builtin_amdgcn_mfma_f32_32x32x16_bf16(kf[2],qr[1],C0,0,0,0),   P0[10],P0[11],P0[12],P0[13], pw1[0]=PKW(P0,8), pw1[1]=PKW(P0,10), pw1); \
    VRD(5); SBAR(); GAPA(C1=__builtin_amdgcn_mfma_f32_32x32x16_bf16(kf[3],qr[1],C1,0,0,0),   P0[14],P0[15],P1[0],P1[1],   pw1[2]=PKW(P0,12),pw1[3]=PKW(P0,14), pw1); \
    VRD(2); SBAR(); GAPA(C0=__builtin_amdgcn_mfma_f32_32x32x16_bf16(kf[4],qr[2],C0,0,0,0),   P1[2],P1[3],P1[4],P1[5],     pw2[0]=PKW(P1,0), pw2[1]=PKW(P1,2), pw2); \
    VRD(6); SBAR(); GAPA(C1=__builtin_amdgcn_mfma_f32_32x32x16_bf16(kf[5],qr[2],C1,0,0,0),   P1[6],P1[7],P1[8],P1[9],     pw2[2]=PKW(P1,4), pw2[3]=PKW(P1,6), pw2); \
    VRD(3); SBAR(); GAPA(C0=__builtin_amdgcn_mfma_f32_32x32x16_bf16(kf[6],qr[3],C0,0,0,0),   P1[10],P1[11],P1[12],P1[13], pw3[0]=PKW(P1,8), pw3[1]=PKW(P1,10), pw3); \
    VRD(7); SBAR(); GAPA(C1=__builtin_amdgcn_mfma_f32_32x32x16_bf16(kf[7],qr[3],C1,0,0,0),   P1[14],P1[15],0.f,0.f,       pw3[2]=PKW(P1,12),pw3[3]=PKW(P1,14), pw3); \
    l_reg+=sacc; \
    if(GK){DMA_K((t)+3,sl_cur);} if(GV){DMA_V((t)+1,sl_next);} \
    CMASK(C0,C1,t); \
    { float a=MX3(C0[0],C0[1],C1[0]),b=MX3(C0[2],C0[3],C1[1]); a=MX3(a,C1[2],C1[3]); \
      _Pragma("unroll") for(int r=4;r<16;r+=4){a=MX3(a,C0[r],C0[r+1]);b=MX3(b,C0[r+2],C0[r+3]);a=MX3(a,C1[r],C1[r+1]);b=MX3(b,C1[r+2],C1[r+3]);} \
      float rm=__builtin_fmaxf(a,b); { auto rr=__builtin_amdgcn_permlane32_swap(__float_as_uint(rm),__float_as_uint(rm),false,false); rm=__builtin_fmaxf(__uint_as_float(rr[0]),__uint_as_float(rr[1])); } \
      resc=false; \
      if(__builtin_expect(__any(rm>(float)THRL),0)){ const float dl=__builtin_fmaxf(rm,0.f); mhat+=dl; \
        _Pragma("unroll") for(int r=0;r<16;++r){C0[r]-=dl;C1[r]-=dl;} \
        _Pragma("unroll") for(int r=0;r<16;++r)negm[r]=-mhat; asm volatile("":"+v"(negm)); \
        const float f=__builtin_amdgcn_exp2f(-dl); l_reg*=f; if(hi==0)wsf[r32]=f; resc=true; } } \
    SBAR(); \
    GAPB(o[0]=__builtin_amdgcn_mfma_f32_32x32x16_bf16(PAF(0),VFR(0),o[0],0,0,0), C0,0); \
    GAPB(o[1]=__builtin_amdgcn_mfma_f32_32x32x16_bf16(PAF(0),VFR(4),o[1],0,0,0), C0,4); \
    KRD(GL,0); GAPB(o[0]=__builtin_amdgcn_mfma_f32_32x32x16_bf16(PAF(1),VFR(1),o[0],0,0,0), C0,8); \
    KRD(GL,1); GAPB(o[1]=__builtin_amdgcn_mfma_f32_32x32x16_bf16(PAF(1),VFR(5),o[1],0,0,0), C0,12); \
    KRD(GL,2); GAPB(o[0]=__builtin_amdgcn_mfma_f32_32x32x16_bf16(PAF(2),VFR(2),o[0],0,0,0), C1,0); \
    KRD(GL,3); GAPB(o[1]=__builtin_amdgcn_mfma_f32_32x32x16_bf16(PAF(2),VFR(6),o[1],0,0,0), C1,4); \
    GAPB(o[0]=__builtin_amdgcn_mfma_f32_32x32x16_bf16(PAF(3),VFR(3),o[0],0,0,0), C1,8); \
    GAPB(o[1]=__builtin_amdgcn_mfma_f32_32x32x16_bf16(PAF(3),VFR(7),o[1],0,0,0), C1,12); \
    }while(0)
  int t=1;
  #undef CMASK
  #define CMASK(P0,P1,t) do{}while(0)
  for(;t+5<NT;t+=2){
    STEP(pB0,pB1,pA0,pA1,t,true,true,true);     WAIT_BAR(2); RESC(); ROT();
    STEP(pA0,pA1,pB0,pB1,t+1,true,true,true);   WAIT_BAR(2); RESC(); ROT();
  }
  #undef CMASK
  #define CMASK(P0,P1,t) do{int jb_=(t)-(NT-4); if(jb_>=0)cmask(P0,P1,jb_,qrel,hi);}while(0)
  #define ENDW(tt) do{ if((tt)+3<NT){WAIT_BAR(2);} else if((tt)+2<NT){WAIT_BAR(1);} else {WAIT_BAR(0);} }while(0)
  for(;t+1<NT;t+=2){
    STEP(pB0,pB1,pA0,pA1,t,(t+3<NT),(t+1<NT),(t+1<NT));       ENDW(t);   RESC(); ROT();
    STEP(pA0,pA1,pB0,pB1,t+1,(t+4<NT),(t+2<NT),(t+2<NT));     ENDW(t+1); RESC(); ROT();
  }
  STEP(pB0,pB1,pA0,pA1,NT-1,false,false,false); RESC();
  { float sacc=pB0[0]+pB0[1]; _Pragma("unroll") for(int r=2;r<16;++r)sacc+=pB0[r]; _Pragma("unroll") for(int r=0;r<16;++r)sacc+=pB1[r]; l_reg+=sacc;
    pw0=(u32x4){PKW(pB0,0),PKW(pB0,2),PKW(pB0,4),PKW(pB0,6)};pw1=(u32x4){PKW(pB0,8),PKW(pB0,10),PKW(pB0,12),PKW(pB0,14)};pw2=(u32x4){PKW(pB1,0),PKW(pB1,2),PKW(pB1,4),PKW(pB1,6)};pw3=(u32x4){PKW(pB1,8),PKW(pB1,10),PKW(pB1,12),PKW(pB1,14)};
    SBAR(); pv(o,vb0+sl_cur,PAF(0),PAF(1),PAF(2),PAF(3)); }
  #undef PKW
  #undef PAF
  #undef VFR
  #undef PIN
  #undef MX3
  #undef GAPA
  #undef GAPB
  #undef EX
  #undef VRD
  #undef KRD
  #undef STEP
  #undef ENDW
  {auto rr=__builtin_amdgcn_permlane32_swap(__float_as_uint(l_reg),__float_as_uint(l_reg),false,false);l_reg=__uint_as_float(rr[0])+__uint_as_float(rr[1]);}
  if(hi==0)wsf[32+r32]=l_reg;asm volatile("s_waitcnt lgkmcnt(0)":::"memory");
  float rli[16];
  #pragma unroll
  for(int r=0;r<16;++r)rli[r]=__builtin_amdgcn_rcpf(wsf[32+crow(r,hi)]);
  bf16*Ow=O+(rowbase+q0+wid*QBLK)*OP;
  { bf16*stg=(bf16*)(shm+LDS_OST)+wid*2048;
    #pragma unroll
    for(int r=0;r<16;++r){const int orow=crow(r,hi);
      #pragma unroll
      for(int d0=0;d0<2;++d0)stg[orow*64+d0*32+r32]=__float2bfloat16(o[d0][r]*rli[r]);}
    asm volatile("s_waitcnt lgkmcnt(0)":::"memory");
    #pragma unroll
    for(int i=0;i<4;++i){const int row=i*8+(lane>>3),ch=lane&7; const u32x4 v=*(const u32x4*)(stg+row*64+ch*8); ATTN_STORE16(Ow+(long)row*OP+ch*8,v);} }
  asm volatile("s_waitcnt lgkmcnt(0)\n\ts_barrier":::"memory");
  #undef DMA_K
  #undef DMA_V
  #undef CMASK
  #undef START
  #undef RESC
  #undef ROT
}
constexpr int ATTN_LDS_BYTES=LDS_BYTES;
struct AttnTensors { const bf16* U; bf16* O; };
__device__ __forceinline__ void attn_phase_static(char*lds,const AttnTensors&T,int vcu){
  if(vcu>=256)return; const int s=vcu&1,pr=vcu>>1; const int b=pr>>4,ph=pr&15; const int h=ph>>2,c=(ph>>1)&1,vh=ph&1;
  for(int i=0;i<4;++i){ const int qb=(i==0)?(7-s):(i==1)?s:(i==2)?(4+s):(3-s);
    attn_unit<8>(b,qb,T.U+h*128+c*64,T.U+512+h*128+c*64,T.U+1024+h*128+vh*64,T.O+ph*64,lds); }
}
template<int THRL=8> __device__ __forceinline__ void attn_phase_dyn(char*lds,const AttnTensors&T,unsigned*ctr,volatile __attribute__((address_space(3))) unsigned*bcast,int q0){
  for(int dq=0;dq<8;++dq){ const int q=(q0+dq)&7;
    for(;;){
      if(threadIdx.x==0) bcast[0]=__hip_atomic_fetch_add(ctr+64*q,1u,__ATOMIC_RELAXED,__HIP_MEMORY_SCOPE_AGENT);
      __syncthreads(); const unsigned j=bcast[0]; __syncthreads();
      if(j>=128u)break;
      const int pr=q*16+(int)(j>>3),qb=7-(int)(j&7); const int b=pr>>4,ph=pr&15; const int h=ph>>2,c=(ph>>1)&1,vh=ph&1;
      attn_unit<THRL>(b,qb,T.U+h*128+c*64,T.U+512+h*128+c*64,T.U+1024+h*128+vh*64,T.O+ph*64,lds);
    }
  }
}
#undef SBAR
#undef WAIT_BAR
}

namespace scan_body {
#define SLDS __attribute__((address_space(3)))
typedef float sf4 __attribute__((ext_vector_type(4)));
typedef float sf2 __attribute__((ext_vector_type(2)));
typedef unsigned su2 __attribute__((ext_vector_type(2)));
constexpr int TB = 16;
constexpr int OFF_NKK = 0, OFF_DEC = TB * 64, OFF_BB = 2 * TB * 64, OFF_KM = 3 * TB * 64, OFF_RR = 4 * TB * 64, OFF_VV = 5 * TB * 64, IN_FLOATS = 5 * TB * 64 + TB * 32, YP_FLOATS = TB * 512;
constexpr int OFF_YP = 2 * IN_FLOATS;
constexpr int SCAN_LDS_BYTES = (2 * IN_FLOATS + 2 * YP_FLOATS) * 4;
__device__ __forceinline__ float bf_lo(unsigned w) { return __uint_as_float(w << 16); }
__device__ __forceinline__ float bf_hi(unsigned w) { return __uint_as_float(w & 0xffff0000u); }
__device__ __forceinline__ unsigned pk_bf(float lo, float hi) { unsigned a = __builtin_bit_cast(unsigned, lo), b = __builtin_bit_cast(unsigned, hi);
    a = (a + 0x7fffu + ((a >> 16) & 1u)) >> 16; b = (b + 0x7fffu + ((b >> 16) & 1u)) & 0xffff0000u; return a | b; }
template <int CTRL> __device__ __forceinline__ float dpp_add(float x) {
    return x + __builtin_bit_cast(float, __builtin_amdgcn_mov_dpp(__builtin_bit_cast(int, x), CTRL, 0xF, 0xF, true));
}
__device__ __forceinline__ float reduce16(float x) {
    x = dpp_add<0xB1>(x);
    x = dpp_add<0x4E>(x);
    x = dpp_add<0x124>(x);
    x = dpp_add<0x128>(x);
    return x;
}
struct ScanArgs { const unsigned short* U; const unsigned short* E; unsigned short* Y; unsigned short* BT; const float* mu; const float* k_k; const float* k_a; const float* r_k; const float* w0; const float* a0; };
struct PrepRegs { su2 rc, kc, vc, rp, kp, vp, ew, ea; };

__device__ __forceinline__ void prep_load(PrepRegs& R, const ScanArgs& A, int b, int h, int blk, int tid) {
    const int i = tid >> 4, c = h * 64 + (tid & 15) * 4, t = blk * TB + i;
    const size_t tok = (size_t)b * 2048 + t;
    const unsigned short* ur = A.U + tok * 3328 + 1536 + c;
    R.rc = *(const su2*)ur; R.kc = *(const su2*)(ur + 512); R.vc = *(const su2*)(ur + 1024);
    const unsigned short* up = (t > 0) ? ur - 3328 : ur;
    R.rp = *(const su2*)up; R.kp = *(const su2*)(up + 512); R.vp = *(const su2*)(up + 1024);
    R.ew = *(const su2*)(A.E + tok * 1536 + c); R.ea = *(const su2*)(A.E + tok * 1536 + 512 + c);
}
__device__ __forceinline__ void prep_compute(SLDS float* buf, const PrepRegs& R, const ScanArgs& A, int b, int h, int hf, int blk, int tid,
                                             const sf4& mu_r, const sf4& mu_k, const sf4& mu_v, const sf4& kkw, const sf4& kaw, const sf4& rkw, const sf4& w0c, const sf4& a0c) {
    const int i = tid >> 4, sl = tid & 15, t = blk * TB + i;
    const float pz = (t > 0) ? 1.0f : 0.0f;
    sf4 rc = {bf_lo(R.rc.x), bf_hi(R.rc.x), bf_lo(R.rc.y), bf_hi(R.rc.y)}, kc = {bf_lo(R.kc.x), bf_hi(R.kc.x), bf_lo(R.kc.y), bf_hi(R.kc.y)}, vc = {bf_lo(R.vc.x), bf_hi(R.vc.x), bf_lo(R.vc.y), bf_hi(R.vc.y)};
    sf4 rp = {bf_lo(R.rp.x), bf_hi(R.rp.x), bf_lo(R.rp.y), bf_hi(R.rp.y)}, kp = {bf_lo(R.kp.x), bf_hi(R.kp.x), bf_lo(R.kp.y), bf_hi(R.kp.y)}, vp = {bf_lo(R.vp.x), bf_hi(R.vp.x), bf_lo(R.vp.y), bf_hi(R.vp.y)};
    rp = rp * pz; kp = kp * pz; vp = vp * pz;
    const sf4 r = rc + (rp - rc) * mu_r, k = kc + (kp - kc) * mu_k, v = vc + (vp - vc) * mu_v;
    const sf4 zw = w0c + (sf4){bf_lo(R.ew.x), bf_hi(R.ew.x), bf_lo(R.ew.y), bf_hi(R.ew.y)}, za = a0c + (sf4){bf_lo(R.ea.x), bf_hi(R.ea.x), bf_lo(R.ea.y), bf_hi(R.ea.y)};
    sf4 dec, a;
#pragma unroll
    for (int e = 0; e < 4; ++e) { const float nx = -zw[e]; const float sp = fmaxf(nx, 0.f) + __logf(1.0f + __expf(-fabsf(nx)));
        dec[e] = __expf(-__expf(-sp - 0.5f));
        a[e] = __builtin_amdgcn_rcpf(1.0f + __expf(-za[e])); }
    const sf4 kkr = k * kkw;
    const float n2 = reduce16((kkr.x * kkr.x + kkr.y * kkr.y) + (kkr.z * kkr.z + kkr.w * kkr.w));
    const sf4 kk = kkr * (1.0f / fmaxf(sqrtf(n2), 1e-12f));
    const sf4 km = k * (1.0f + (a - 1.0f) * kaw);
    const sf4 rkm = r * km * rkw;
    const float bon = reduce16((rkm.x + rkm.y) + (rkm.z + rkm.w));
    *(SLDS sf4*)&buf[OFF_NKK + i * 64 + sl * 4] = -kk;
    *(SLDS sf4*)&buf[OFF_DEC + i * 64 + sl * 4] = dec;
    *(SLDS sf4*)&buf[OFF_BB + i * 64 + sl * 4] = kk * a;
    *(SLDS sf4*)&buf[OFF_KM + i * 64 + sl * 4] = km;
    *(SLDS sf4*)&buf[OFF_RR + i * 64 + sl * 4] = r;
    if ((sl >> 3) == hf) {
        SLDS float* vv = &buf[OFF_VV + i * 32 + ((sl & 7) >> 1) * 8 + (sl & 1)];
        vv[0] = v.x; vv[2] = v.y; vv[4] = v.z; vv[6] = v.w;
        const sf4 bt = v * bon; su2 o; o.x = pk_bf(bt.x, bt.y); o.y = pk_bf(bt.z, bt.w);
        *(su2*)(A.BT + ((size_t)b * 2048 + t) * 512 + h * 64 + sl * 4) = o;
    }
}
struct StepOps { sf4 nk, dc, bb, km, rr; sf2 v; };
__device__ __forceinline__ void step_load(StepOps& o, const SLDS float* L, int i, int kq, int vo) {
    o.nk = *(const SLDS sf4*)&L[OFF_NKK + i * 64 + kq]; o.dc = *(const SLDS sf4*)&L[OFF_DEC + i * 64 + kq]; o.bb = *(const SLDS sf4*)&L[OFF_BB + i * 64 + kq];
    o.km = *(const SLDS sf4*)&L[OFF_KM + i * 64 + kq]; o.rr = *(const SLDS sf4*)&L[OFF_RR + i * 64 + kq]; o.v = *(const SLDS sf2*)&L[OFF_VV + i * 32 + vo];
}
__device__ __forceinline__ void step_compute(const StepOps& o, sf2& a01, sf2& a23, sf2& b01, sf2& b23, SLDS sf2* yp) {
    const sf2 pa = a01 * o.nk.xy + a23 * o.nk.zw, pb = b01 * o.nk.xy + b23 * o.nk.zw;
    const sf2 va = {o.v.x, o.v.x}, vb = {o.v.y, o.v.y};
    const float sa = reduce16(pa.x + pa.y), sb = reduce16(pb.x + pb.y);
    const sf2 sa2 = {sa, sa}, sb2 = {sb, sb};
    a01 = a01 * o.dc.xy + (sa2 * o.bb.xy + va * o.km.xy);
    a23 = a23 * o.dc.zw + (sa2 * o.bb.zw + va * o.km.zw);
    b01 = b01 * o.dc.xy + (sb2 * o.bb.xy + vb * o.km.xy);
    b23 = b23 * o.dc.zw + (sb2 * o.bb.zw + vb * o.km.zw);
    const sf2 qa = a01 * o.rr.xy + a23 * o.rr.zw, qb = b01 * o.rr.xy + b23 * o.rr.zw;
    *yp = (sf2){qa.x + qa.y, qb.x + qb.y};
}
__device__ __forceinline__ void flush_block(const SLDS float* YPb, const ScanArgs& A, int b, int h, int hf, int blk, int ptid) {
    const int i = ptid >> 4, w = (ptid >> 2) & 3, g = ptid & 3;
    const SLDS sf4* pp = (const SLDS sf4*)&YPb[i * 512 + (w * 64 + g * 16) * 2];
    sf4 acc = pp[0];
#pragma unroll
    for (int q = 1; q < 8; ++q) acc = acc + pp[q];
    unsigned short* yr = A.Y + ((size_t)b * 2048 + blk * TB + i) * 512 + h * 64 + hf * 32 + w * 8 + g;
    const unsigned pk = pk_bf(acc.x + acc.z, acc.y + acc.w);
    yr[0] = (unsigned short)(pk & 0xffffu); yr[4] = (unsigned short)(pk >> 16);
}
__device__ __forceinline__ void scan_unit(SLDS float* L, const ScanArgs& A, int b, int h, int hf) {
    const int tid = threadIdx.x, lane = tid & 63; const int wid = __builtin_amdgcn_readfirstlane(tid >> 6);
    constexpr int NBLK = 2048 / TB;
    if (wid >= 4) {
        const int ptid = tid - 256;
        const int c0 = h * 64 + (ptid & 15) * 4;
        const sf4 mu_r = *(const sf4*)(A.mu + c0), mu_k = *(const sf4*)(A.mu + 512 + c0), mu_v = *(const sf4*)(A.mu + 1024 + c0);
        const sf4 kkw = *(const sf4*)(A.k_k + c0), kaw = *(const sf4*)(A.k_a + c0), rkw = *(const sf4*)(A.r_k + c0), w0c = *(const sf4*)(A.w0 + c0), a0c = *(const sf4*)(A.a0 + c0);
        PrepRegs R;
        prep_load(R, A, b, h, 0, ptid);
        prep_compute(L, R, A, b, h, hf, 0, ptid, mu_r, mu_k, mu_v, kkw, kaw, rkw, w0c, a0c);
        prep_load(R, A, b, h, 1, ptid);
        __syncthreads();
        for (int blk = 0; blk < NBLK; ++blk) {
            if (blk + 1 < NBLK) prep_compute(L + ((blk + 1) & 1) * IN_FLOATS, R, A, b, h, hf, blk + 1, ptid, mu_r, mu_k, mu_v, kkw, kaw, rkw, w0c, a0c);
            if (blk + 2 < NBLK) prep_load(R, A, b, h, blk + 2, ptid);
            if (blk >= 1) flush_block(L + OFF_YP + ((blk - 1) & 1) * YP_FLOATS, A, b, h, hf, blk - 1, ptid);
            __syncthreads();
        }
        flush_block(L + OFF_YP + ((NBLK - 1) & 1) * YP_FLOATS, A, b, h, hf, NBLK - 1, ptid);
    } else {
        sf2 a01 = {0.f, 0.f}, a23 = {0.f, 0.f}, b01 = {0.f, 0.f}, b23 = {0.f, 0.f};
        const int kq = (lane & 15) * 4, vo = wid * 8 + (lane >> 4) * 2;
        __syncthreads();
        for (int blk = 0; blk < NBLK; ++blk) {
            const SLDS float* IN = L + (blk & 1) * IN_FLOATS;
            SLDS sf2* ypl = (SLDS sf2*)(L + OFF_YP + (blk & 1) * YP_FLOATS) + tid;
            StepOps oa, ob, na, nb;
            step_load(oa, IN, 0, kq, vo); step_load(ob, IN, 1, kq, vo);
#pragma unroll
            for (int i = 0; i < TB; i += 2) {
                if (i + 2 < TB) { step_load(na, IN, i + 2, kq, vo); step_load(nb, IN, i + 3, kq, vo); }
                __builtin_amdgcn_sched_barrier(0);
                step_compute(oa, a01, a23, b01, b23, ypl + i * 256);
                step_compute(ob, a01, a23, b01, b23, ypl + (i + 1) * 256);
                __builtin_amdgcn_sched_barrier(0);
                oa = na; ob = nb;
            }
            __syncthreads();
        }
    }
    __syncthreads();
}
}

#ifndef RW_STAGE
#define RW_STAGE 0
#endif
#ifndef PROBE_K
#define PROBE_K (-1)
#endif
namespace rwkv_body {
#define RWSTAMP(k) do { if (PROBE_K >= 0 && blockIdx.x == 0 && threadIdx.x == 0 && c == 0) tsp[k] = __builtin_amdgcn_s_memrealtime(); } while (0)
#define RL __attribute__((address_space(3)))
#define RWBAR() do { asm volatile("s_waitcnt lgkmcnt(0)" ::: "memory"); __builtin_amdgcn_s_barrier(); asm volatile("" ::: "memory"); } while (0)
typedef short h8 __attribute__((ext_vector_type(8)));
typedef float f4 __attribute__((ext_vector_type(4)));
typedef unsigned u2 __attribute__((ext_vector_type(2)));
typedef unsigned u4 __attribute__((ext_vector_type(4)));
constexpr int ST = 72, SB = ST * 2, MBY = 64 * SB;
constexpr int O_AH = 0, O_BH = MBY, O_KH = 2 * MBY, O_RH = 3 * MBY, O_KHT = 4 * MBY, O_BHT = 5 * MBY, O_VMT = 6 * MBY, O_YT = 7 * MBY  ,
              O_MP0 = 9 * MBY, O_MPT0 = 10 * MBY, O_MP1 = 11 * MBY, O_MPT1 = 12 * MBY, O_OT = 13 * MBY, O_PC = O_OT + 2048, O_KC = O_PC + 256  , RWKV_LDS_BYTES = O_KC + 2048;
constexpr int O_CL = O_MP0;
constexpr int O_VM = O_MP1;
__device__ __forceinline__ float bflo(unsigned w) { return __uint_as_float(w << 16); }
__device__ __forceinline__ float bfhi(unsigned w) { return __uint_as_float(w & 0xffff0000u); }
typedef float f2t_ __attribute__((ext_vector_type(2))); typedef __bf16 b2t_ __attribute__((ext_vector_type(2)));
__device__ __forceinline__ unsigned pkbf(float lo, float hi) { const f2t_ v = {lo, hi}; const b2t_ b = __builtin_convertvector(v, b2t_); return __builtin_bit_cast(unsigned, b); }
template <int CTRL> __device__ __forceinline__ float dppadd(float x) { return x + __builtin_bit_cast(float, __builtin_amdgcn_mov_dpp(__builtin_bit_cast(int, x), CTRL, 0xF, 0xF, true)); }
__device__ __forceinline__ float reduce8(float x) { x = dppadd<0xB1>(x); x = dppadd<0x4E>(x); x = dppadd<0x141>(x); return x; }
__device__ __forceinline__ h8 ldfrag(const RL char* base, int row0, int ks, int lane) { return *(const RL h8*)(base + (row0 + (lane & 15)) * SB + ks * 64 + (lane >> 4) * 16); }
__device__ __forceinline__ void mma2(f4& acc, const RL char* A, int am0, const RL char* B, int bn0, int lane) {
    acc = __builtin_amdgcn_mfma_f32_16x16x32_bf16(ldfrag(A, am0, 0, lane), ldfrag(B, bn0, 0, lane), acc, 0, 0, 0);
    acc = __builtin_amdgcn_mfma_f32_16x16x32_bf16(ldfrag(A, am0, 1, lane), ldfrag(B, bn0, 1, lane), acc, 0, 0, 0);
}
__device__ __forceinline__ void mma2p(f4& acc0, f4& acc1, const RL char* A, int am0, const RL char* B, int bn0, int lane) {
    const h8 a0 = ldfrag(A, am0, 0, lane), a1 = ldfrag(A, am0, 1, lane);
    acc0 = __builtin_amdgcn_mfma_f32_16x16x32_bf16(a0, ldfrag(B, bn0, 0, lane), acc0, 0, 0, 0); acc1 = __builtin_amdgcn_mfma_f32_16x16x32_bf16(a0, ldfrag(B, bn0 + 16, 0, lane), acc1, 0, 0, 0);
    acc0 = __builtin_amdgcn_mfma_f32_16x16x32_bf16(a1, ldfrag(B, bn0, 1, lane), acc0, 0, 0, 0); acc1 = __builtin_amdgcn_mfma_f32_16x16x32_bf16(a1, ldfrag(B, bn0 + 16, 1, lane), acc1, 0, 0, 0);
}
__device__ __forceinline__ void storeT(RL char* dst, int m0, int n0, const f4& acc, int lane) {
    u2 w; w.x = pkbf(acc[0], acc[1]); w.y = pkbf(acc[2], acc[3]);
    *(RL u2*)(dst + (n0 + (lane & 15)) * SB + (m0 + 4 * (lane >> 4)) * 2) = w;
}
struct Args { unsigned long long* tsp_; const unsigned short* U; const unsigned short* E; unsigned short* Y; unsigned short* BT; unsigned char* GH; unsigned char* Q1; unsigned char* Q2;
              const float* mu; const float* k_k; const float* k_a; const float* r_k; const float* w0; const float* a0; };
__device__ __forceinline__ unsigned char* qptr(const Args& A, int cid) { return cid < 1024 ? A.Q1 + (size_t)cid * 8192 : A.Q2 + (size_t)(cid - 1024) * 8192; }

struct ChunkLoads { u4 rc, kc, vc, rp, kp, vp, ew, ea; };
__device__ __forceinline__ void chunk_consts_to_lds(RL char* L, const Args& A, int h) {
    const int tid = threadIdx.x; RL float* kc = (RL float*)(L + O_KC);
    if (tid < 64) { const int c = h * 64 + tid; kc[tid] = A.mu[c]; kc[64 + tid] = A.mu[512 + c]; kc[128 + tid] = A.mu[1024 + c]; kc[192 + tid] = A.k_k[c]; kc[256 + tid] = A.k_a[c]; kc[320 + tid] = A.r_k[c]; kc[384 + tid] = A.w0[c]; kc[448 + tid] = A.a0[c]; }
}
__device__ __forceinline__ void chunk_load(ChunkLoads& R, const Args& A, int b, int h, int c) {
    const int tid = threadIdx.x, ti = tid >> 3, ch0 = 8 * (tid & 7), t = c * 64 + ti;
    const size_t tok = (size_t)b * 2048 + t;
    const unsigned short* ur = A.U + tok * 3328 + 1536 + h * 64 + ch0;
    R.rc = *(const u4*)ur; R.kc = *(const u4*)(ur + 512); R.vc = *(const u4*)(ur + 1024);
    const unsigned short* up = (t > 0) ? ur - 3328 : ur;
    R.rp = *(const u4*)up; R.kp = *(const u4*)(up + 512); R.vp = *(const u4*)(up + 1024);
    R.ew = *(const u4*)(A.E + tok * 1536 + h * 64 + ch0); R.ea = *(const u4*)(A.E + tok * 1536 + 512 + h * 64 + ch0);
}
#define CVT_LOAD(P_, N_) const f4 cv0 = *(const f4*)(P_), cv1 = *(const f4*)((P_) + (size_t)(N_)), cv2 = *(const f4*)((P_) + (size_t)2 * (N_)), cv3 = *(const f4*)((P_) + (size_t)3 * (N_)), \
                               cv4 = *(const f4*)((P_) + (size_t)4 * (N_)), cv5 = *(const f4*)((P_) + (size_t)5 * (N_)), cv6 = *(const f4*)((P_) + (size_t)6 * (N_)), cv7 = *(const f4*)((P_) + (size_t)7 * (N_))
#define CVT_STORE(Q_, K_) do { _Pragma("unroll") for (int e_ = 0; e_ < 4; ++e_) *(u4*)((Q_) + (size_t)e_ * (K_)) = (u4){pkbf(cv0[e_], cv1[e_]), pkbf(cv2[e_], cv3[e_]), pkbf(cv4[e_], cv5[e_]), pkbf(cv6[e_], cv7[e_])}; } while (0)
__device__ __forceinline__ void rwkv_chunk_task(RL char* L, const Args& A, const ChunkLoads& LD, ChunkLoads& NEXT, bool has_next, int b, int h, int c, int cnext, const float* jWg, const float* jWu, unsigned short* jWGU, int jitem) {
    const int tid = threadIdx.x, lane = tid & 63; const int wid = __builtin_amdgcn_readfirstlane(tid >> 6);
    const int cid = (b * 8 + h) * 32 + c; unsigned long long* tsp = A.tsp_;
    RWSTAMP(17);
    const int ti = tid >> 3, ch0 = 8 * (tid & 7), t = c * 64 + ti;
    const size_t tok = (size_t)b * 2048 + t;
    float r8[8], km8[8], b8[8], nk8[8], v8[8], lw8[8];
    {
        const u4 rc = LD.rc, kc = LD.kc, vc = LD.vc, rp = LD.rp, kp = LD.kp, vp = LD.vp, ew = LD.ew, ea = LD.ea;
        const float pz = (t > 0) ? 1.0f : 0.0f;
        const RL float* kcst = (const RL float*)(L + O_KC) + ch0;
        float cmr[8], cmk[8], cmv[8], ckk[8], cka[8], crk[8], cw0[8], ca0[8];
#define LDC8(dst, off) do { const f4 t0_ = *(const RL f4*)(kcst + (off)), t1_ = *(const RL f4*)(kcst + (off) + 4); dst[0] = t0_[0]; dst[1] = t0_[1]; dst[2] = t0_[2]; dst[3] = t0_[3]; dst[4] = t1_[0]; dst[5] = t1_[1]; dst[6] = t1_[2]; dst[7] = t1_[3]; } while (0)
        LDC8(cmr, 0); LDC8(cmk, 64); LDC8(cmv, 128); LDC8(ckk, 192); LDC8(cka, 256); LDC8(crk, 320); LDC8(cw0, 384); LDC8(ca0, 448);
#undef LDC8
        float kkr[8], ag[8]; float n2 = 0.f, bon = 0.f;
#pragma unroll
        for (int e = 0; e < 8; ++e) {
            const unsigned wr = rc[e >> 1], wk = kc[e >> 1], wv = vc[e >> 1], pr = rp[e >> 1], pk = kp[e >> 1], pv = vp[e >> 1], we = ew[e >> 1], wa = ea[e >> 1];
            const float rcur = (e & 1) ? bfhi(wr) : bflo(wr), kcur = (e & 1) ? bfhi(wk) : bflo(wk), vcur = (e & 1) ? bfhi(wv) : bflo(wv);
            const float rprv = ((e & 1) ? bfhi(pr) : bflo(pr)) * pz, kprv = ((e & 1) ? bfhi(pk) : bflo(pk)) * pz, vprv = ((e & 1) ? bfhi(pv) : bflo(pv)) * pz;
            const float rr = rcur + (rprv - rcur) * cmr[e], kk_ = kcur + (kprv - kcur) * cmk[e], vv = vcur + (vprv - vcur) * cmv[e];
            const float zw = cw0[e] + ((e & 1) ? bfhi(we) : bflo(we)), za = ca0[e] + ((e & 1) ? bfhi(wa) : bflo(wa));
            const float nx = -zw; const float sp = fmaxf(nx, 0.f) + __logf(1.0f + __expf(-fabsf(nx)));
            lw8[e] = -__expf(-sp - 0.5f);
            ag[e] = __builtin_amdgcn_rcpf(1.0f + __expf(-za));
            kkr[e] = kk_ * ckk[e]; n2 += kkr[e] * kkr[e];
            km8[e] = kk_ * (1.0f + (ag[e] - 1.0f) * cka[e]);
            r8[e] = rr; v8[e] = vv; bon += rr * km8[e] * crk[e];
        }
        n2 = reduce8(n2); bon = reduce8(bon);
        const float inv = 1.0f / fmaxf(sqrtf(n2), 1e-12f);
#pragma unroll
        for (int e = 0; e < 8; ++e) { const float kk = kkr[e] * inv; nk8[e] = -kk; b8[e] = kk * ag[e]; }
        u4 bo; bo.x = pkbf(bon * v8[0], bon * v8[1]); bo.y = pkbf(bon * v8[2], bon * v8[3]); bo.z = pkbf(bon * v8[4], bon * v8[5]); bo.w = pkbf(bon * v8[6], bon * v8[7]);
        *(u4*)(A.BT + tok * 512 + h * 64 + ch0) = bo;
        RL float* cl = (RL float*)(L + O_CL) + ti * 64 + ch0;
        *(RL f4*)cl = (f4){lw8[0], lw8[1], lw8[2], lw8[3]}; *(RL f4*)(cl + 4) = (f4){lw8[4], lw8[5], lw8[6], lw8[7]};
    }
    if (has_next) chunk_load(NEXT, A, b, h, cnext);
    const int citem = jitem >= 0 ? jitem : 0;
    const int ce_ = citem >> 9, cmat = (citem >> 8) & 1, cit = citem & 255; const int ck0 = 64 * (cit >> 4), cn0 = 32 * (cit & 15);
    const float* cvp = (cmat ? jWu : jWg) + (size_t)ce_ * 1024 * 512 + (size_t)(ck0 + 8 * (lane >> 3)) * 512 + cn0 + 4 * (lane & 7);
    CVT_LOAD(cvp, 512);
    RWBAR();
    {
        RL float* cl = (RL float*)(L + O_CL); RL float* ot = (RL float*)(L + O_OT);
        const int ch = tid & 63, oc = tid >> 6;
        float run = 0.f;
#pragma unroll
        for (int j = 0; j < 8; ++j) { run += cl[(8 * oc + j) * 64 + ch]; cl[(8 * oc + j) * 64 + ch] = run; }
        ot[oc * 64 + ch] = run;
    }
    RWBAR();
    {
        const RL float* cl = (const RL float*)(L + O_CL) + ti * 64 + ch0; const RL float* ot = (const RL float*)(L + O_OT) + ch0;
        f4 c0 = *(const RL f4*)cl, c1 = *(const RL f4*)(cl + 4);
#pragma unroll 1
        for (int o = 0; o < wid; ++o) { c0 = c0 + *(const RL f4*)(ot + o * 64); c1 = c1 + *(const RL f4*)(ot + o * 64 + 4); }
        if (ti == 63) { RL float* pc = (RL float*)(L + O_PC) + ch0; *(RL f4*)pc = (f4){__expf(c0[0]), __expf(c0[1]), __expf(c0[2]), __expf(c0[3])}; *(RL f4*)(pc + 4) = (f4){__expf(c1[0]), __expf(c1[1]), __expf(c1[2]), __expf(c1[3])}; }
        const float cl8[8] = {c0[0], c0[1], c0[2], c0[3], c1[0], c1[1], c1[2], c1[3]};
        float ah[8], bh[8], kh[8], rh[8];
#pragma unroll
        for (int e = 0; e < 8; ++e) { const float P = __expf(cl8[e]), Pp = __expf(cl8[e] - lw8[e]), iP = __expf(-cl8[e]);
            ah[e] = nk8[e] * Pp; bh[e] = b8[e] * iP; kh[e] = km8[e] * iP; rh[e] = r8[e] * P; }
        const int off = ti * SB + ch0 * 2;
        *(RL u4*)(L + O_AH + off) = (u4){pkbf(ah[0], ah[1]), pkbf(ah[2], ah[3]), pkbf(ah[4], ah[5]), pkbf(ah[6], ah[7])};
        *(RL u4*)(L + O_BH + off) = (u4){pkbf(bh[0], bh[1]), pkbf(bh[2], bh[3]), pkbf(bh[4], bh[5]), pkbf(bh[6], bh[7])};
        *(RL u4*)(L + O_KH + off) = (u4){pkbf(kh[0], kh[1]), pkbf(kh[2], kh[3]), pkbf(kh[4], kh[5]), pkbf(kh[6], kh[7])};
        *(RL u4*)(L + O_RH + off) = (u4){pkbf(rh[0], rh[1]), pkbf(rh[2], rh[3]), pkbf(rh[4], rh[5]), pkbf(rh[6], rh[7])};
        *(RL u4*)(L + O_VM + off) = (u4){pkbf(v8[0], v8[1]), pkbf(v8[2], v8[3]), pkbf(v8[4], v8[5]), pkbf(v8[6], v8[7])};
    }
    RWBAR();
    {
        const int k = tid & 63, og = tid >> 6;
        const int srcs[4] = {O_KH, O_BH, O_VM, O_AH}, dsts[4] = {O_KHT, O_BHT, O_VMT, O_YT};
#pragma unroll
        for (int q = 0; q < 4; ++q) {
            unsigned short e[8];
#pragma unroll
            for (int j = 0; j < 8; ++j) e[j] = *(const RL unsigned short*)(L + srcs[q] + (8 * og + j) * SB + k * 2);
            *(RL u4*)(L + dsts[q] + k * SB + og * 16) = (u4){(unsigned)e[0] | ((unsigned)e[1] << 16), (unsigned)e[2] | ((unsigned)e[3] << 16), (unsigned)e[4] | ((unsigned)e[5] << 16), (unsigned)e[6] | ((unsigned)e[7] << 16)};
        }
    }
    RWBAR(); RWSTAMP(18);
    const int mb = wid & 3, nb0 = 2 * (wid >> 2);
    const int lm = 4 * (lane >> 4), ln = lane & 15;
    {
        const int m_ = 16 * mb + lm, na = 16 * nb0 + ln, nb_ = na + 16;
        f4 c1a = {0.f, 0.f, 0.f, 0.f}, c1b = c1a, c2a = c1a, c2b = c1a, c3a = c1a, c3b = c1a;
        mma2p(c1a, c1b, L + O_BH, 16 * mb, L + O_AH, 16 * nb0, lane);
        mma2p(c2a, c2b, L + O_AH, 16 * mb, L + O_BH, 16 * nb0, lane);
        mma2p(c3a, c3b, L + O_KH, 16 * mb, L + O_AH, 16 * nb0, lane);
#pragma unroll
        for (int q = 0; q < 4; ++q) { if (!(na > m_ + q)) { c1a[q] = 0.f; c3a[q] = 0.f; } if (!(m_ + q > na)) c2a[q] = 0.f;
                                      if (!(nb_ > m_ + q)) { c1b[q] = 0.f; c3b[q] = 0.f; } if (!(m_ + q > nb_)) c2b[q] = 0.f; }
        storeT(L + O_MP0, 16 * mb, 16 * nb0, c1a, lane); storeT(L + O_MPT0, 16 * mb, 16 * nb0, c2a, lane); storeT(L + O_MP1, 16 * mb, 16 * nb0, c3a, lane);
        storeT(L + O_MP0, 16 * mb, 16 * nb0 + 16, c1b, lane); storeT(L + O_MPT0, 16 * mb, 16 * nb0 + 16, c2b, lane); storeT(L + O_MP1, 16 * mb, 16 * nb0 + 16, c3b, lane);
    }
    RWBAR();
    {   f4 cxa = {0.f, 0.f, 0.f, 0.f}, cxb = cxa; mma2p(cxa, cxb, L + O_MP1, 16 * mb, L + O_VMT, 16 * nb0, lane);
        storeT(L + O_YT + 64 * SB, 16 * mb, 16 * nb0, cxa, lane); storeT(L + O_YT + 64 * SB, 16 * mb, 16 * nb0 + 16, cxb, lane); }
    RWBAR();
    {
        f4 acc[2][4];
        if (wid < 4) {
#pragma unroll
            for (int cbk = 0; cbk < 2; ++cbk) { const RL char* yrow = L + O_YT + (32 * wid + 16 * cbk + ln) * SB;
#pragma unroll
                for (int ib = 0; ib < 4; ++ib) { const u2 w = *(const RL u2*)(yrow + (16 * ib + lm) * 2); acc[cbk][ib] = (f4){bflo(w.x), bfhi(w.x), bflo(w.y), bfhi(w.y)}; } }
        }
#pragma unroll
        for (int lev = 0; lev < 6; ++lev) {
            const RL char* Mp = L + ((lev & 1) ? O_MP1 : O_MP0); const RL char* MpT = L + ((lev & 1) ? O_MPT1 : O_MPT0);
            RL char* Mn = L + ((lev & 1) ? O_MP0 : O_MP1); RL char* MnT = L + ((lev & 1) ? O_MPT0 : O_MPT1);
            if (wid < 4) {
                const h8 ya0 = ldfrag(L + O_YT, 32 * wid, 0, lane), ya1 = ldfrag(L + O_YT, 32 * wid, 1, lane), yb0 = ldfrag(L + O_YT, 32 * wid + 16, 0, lane), yb1 = ldfrag(L + O_YT, 32 * wid + 16, 1, lane);
#pragma unroll
                for (int ib = 0; ib < 4; ++ib) {
                    const h8 m0 = ldfrag(Mp, 16 * ib, 0, lane), m1 = ldfrag(Mp, 16 * ib, 1, lane);
                    acc[0][ib] = __builtin_amdgcn_mfma_f32_16x16x32_bf16(m0, ya0, acc[0][ib], 0, 0, 0); acc[1][ib] = __builtin_amdgcn_mfma_f32_16x16x32_bf16(m0, yb0, acc[1][ib], 0, 0, 0);
                    acc[0][ib] = __builtin_amdgcn_mfma_f32_16x16x32_bf16(m1, ya1, acc[0][ib], 0, 0, 0); acc[1][ib] = __builtin_amdgcn_mfma_f32_16x16x32_bf16(m1, yb1, acc[1][ib], 0, 0, 0);
                }
#pragma unroll
                for (int cbk = 0; cbk < 2; ++cbk)
#pragma unroll
                    for (int ib = 0; ib < 4; ++ib) storeT(L + O_YT, 16 * ib, 32 * wid + 16 * cbk, acc[cbk][ib], lane);
            } else if (lev < 5) {
                const int sm = wid - 4;
                const h8 t0 = ldfrag(MpT, 16 * sm, 0, lane), t1 = ldfrag(MpT, 16 * sm, 1, lane), p0 = ldfrag(Mp, 16 * sm, 0, lane), p1 = ldfrag(Mp, 16 * sm, 1, lane);
#pragma unroll
                for (int nb = 0; nb < 4; ++nb) {
                    const h8 bp0 = ldfrag(Mp, 16 * nb, 0, lane), bp1 = ldfrag(Mp, 16 * nb, 1, lane), bt0 = ldfrag(MpT, 16 * nb, 0, lane), bt1 = ldfrag(MpT, 16 * nb, 1, lane);
                    f4 s1 = {0.f, 0.f, 0.f, 0.f}, s2 = s1;
                    s1 = __builtin_amdgcn_mfma_f32_16x16x32_bf16(t0, bp0, s1, 0, 0, 0); s2 = __builtin_amdgcn_mfma_f32_16x16x32_bf16(p0, bt0, s2, 0, 0, 0);
                    s1 = __builtin_amdgcn_mfma_f32_16x16x32_bf16(t1, bp1, s1, 0, 0, 0); s2 = __builtin_amdgcn_mfma_f32_16x16x32_bf16(p1, bt1, s2, 0, 0, 0);
                    storeT(Mn, 16 * sm, 16 * nb, s1, lane);
                    storeT(MnT, 16 * sm, 16 * nb, s2, lane);
                }
            }
            RWBAR();
        }
    }
    RWSTAMP(19);
    {
        const int m_ = 16 * mb + lm, na = 16 * nb0 + ln, nb_ = na + 16;
        f4 c3a = {0.f, 0.f, 0.f, 0.f}, c3b = c3a, c4a = c3a, c4b = c3a;
        mma2p(c3a, c3b, L + O_KH, 16 * mb, L + O_RH, 16 * nb0, lane); mma2p(c4a, c4b, L + O_BH, 16 * mb, L + O_RH, 16 * nb0, lane);
#pragma unroll
        for (int q = 0; q < 4; ++q) { if (!(m_ + q <= na)) { c3a[q] = 0.f; c4a[q] = 0.f; } if (!(m_ + q <= nb_)) { c3b[q] = 0.f; c4b[q] = 0.f; } }
        storeT(L + O_MP0, 16 * mb, 16 * nb0, c3a, lane); storeT(L + O_MPT0, 16 * mb, 16 * nb0, c4a, lane); storeT(L + O_MP0, 16 * mb, 16 * nb0 + 16, c3b, lane); storeT(L + O_MPT0, 16 * mb, 16 * nb0 + 16, c4b, lane);
    }
    if (jitem >= 0) { unsigned short* cvq = jWGU + (size_t)(ce_ * 1024 + (cn0 >> 7) * 256 + (cn0 & 127) + cmat * 128 + 4 * (lane & 7)) * 1024 + ck0 + 8 * (lane >> 3); CVT_STORE(cvq, 1024); }
    RWBAR();
    RWSTAMP(20);
    {
        unsigned char* gh = A.GH + (size_t)cid * 16384; unsigned char* qq = qptr(A, cid);
        const RL float* pc = (const RL float*)(L + O_PC);
        const RL char* AtT = L + O_YT; const RL char* WT = L + O_YT + 64 * SB;
#pragma unroll
        for (int tt = 0; tt < 2; ++tt) {
            const int nb = nb0 + tt; const int m_ = 16 * mb + lm, n_ = 16 * nb + ln;
            const float pcn = pc[n_];
            f4 g = {0.f, 0.f, 0.f, 0.f}; mma2(g, AtT, 16 * mb, L + O_BHT, 16 * nb, lane);
#pragma unroll
            for (int q = 0; q < 4; ++q) g[q] = (g[q] + ((m_ + q == n_) ? 1.0f : 0.0f)) * pcn;
            *(u2*)(gh + (size_t)n_ * 128 + (size_t)m_ * 2) = (u2){pkbf(g[0], g[1]), pkbf(g[2], g[3])};
            f4 hh = {0.f, 0.f, 0.f, 0.f}; mma2(hh, L + O_VMT, 16 * mb, L + O_KHT, 16 * nb, lane); mma2(hh, WT, 16 * mb, L + O_BHT, 16 * nb, lane);
            *(u2*)(gh + 8192 + ((size_t)(wid * 2 + tt) * 64 + lane) * 8) = (u2){pkbf(hh[0] * pcn, hh[1] * pcn), pkbf(hh[2] * pcn, hh[3] * pcn)};
            f4 qv; { const u2 w = *(const RL u2*)(L + O_RH + n_ * SB + m_ * 2); qv = (f4){bflo(w.x), bfhi(w.x), bflo(w.y), bfhi(w.y)}; }
            mma2(qv, AtT, 16 * mb, L + O_MPT0, 16 * nb, lane);
            *(u2*)(qq + (size_t)n_ * 128 + (size_t)m_ * 2) = (u2){pkbf(qv[0], qv[1]), pkbf(qv[2], qv[3])};
            f4 y0 = {0.f, 0.f, 0.f, 0.f};
            if (RW_STAGE == 0 || RW_STAGE == 1) mma2(y0, L + O_VMT, 16 * mb, L + O_MP0, 16 * nb, lane);
            if (RW_STAGE == 0 || RW_STAGE == 2) mma2(y0, WT, 16 * mb, L + O_MPT0, 16 * nb, lane);
            if (RW_STAGE == 7) mma2(y0, L + O_VMT, 16 * mb, L + O_VMT, 16 * nb, lane);
            if (RW_STAGE == 8) mma2(y0, L + O_VMT, 16 * mb, L + O_RH, 16 * nb, lane);
            if (RW_STAGE == 3) { const u2 w = *(const RL u2*)(L + O_MP0 + n_ * SB + m_ * 2); y0 = (f4){bflo(w.x), bfhi(w.x), bflo(w.y), bfhi(w.y)}; }
            if (RW_STAGE == 4) { const u2 w = *(const RL u2*)(WT + n_ * SB + m_ * 2); y0 = (f4){bflo(w.x), bfhi(w.x), bflo(w.y), bfhi(w.y)}; }
            if (RW_STAGE == 5) { const u2 w = *(const RL u2*)(L + O_VMT + n_ * SB + m_ * 2); y0 = (f4){bflo(w.x), bfhi(w.x), bflo(w.y), bfhi(w.y)}; }
            if (RW_STAGE == 6) { const u2 w = *(const RL u2*)(L + O_RH + n_ * SB + m_ * 2); y0 = (f4){bflo(w.x), bfhi(w.x), bflo(w.y), bfhi(w.y)}; }
            *(u2*)(A.Y + ((size_t)b * 2048 + c * 64 + n_) * 512 + h * 64 + m_) = (u2){pkbf(y0[0], y0[1]), pkbf(y0[2], y0[3])};
        }
    }
    RWBAR();
}

__device__ __forceinline__ void rwkv_seq_head(RL char* L, const Args& A, int b, int h, int mb) {
    const int tid = threadIdx.x, lane = tid & 63; const int wid = __builtin_amdgcn_readfirstlane(tid >> 6);
    const int lm = 4 * (lane >> 4), ln = lane & 15; const bool isS = wid < 4; const int nb = wid & 3;
    RL char* Sb = L;
    for (int i = tid; i < 16 * SB / 4; i += 512) ((RL unsigned*)Sb)[i] = 0u;
    RWBAR();
    const int cid0 = (b * 8 + h) * 32;
    const int hdump = ((4 * (nb >> 1) + mb) * 2 + (nb & 1)) * 64 + lane;
    struct Ops { h8 f0, f1; u2 x; };
#define RB_LOAD(O_, c_) do { const unsigned char* gh_ = A.GH + (size_t)(cid0 + (c_)) * 16384; \
        const unsigned char* src_ = (isS ? gh_ : qptr(A, cid0 + (c_))) + (size_t)(16 * nb + ln) * 128 + (lane >> 4) * 16; \
        O_.f0 = *(const h8*)src_; O_.f1 = *(const h8*)(src_ + 64); \
        O_.x = isS ? *(const u2*)(gh_ + 8192 + (size_t)hdump * 8) : *(const u2*)(A.Y + ((size_t)b * 2048 + (c_) * 64 + 16 * nb + ln) * 512 + h * 64 + 16 * mb + lm); } while (0)
#define RB_STEP(O_, c_) do { \
        const h8 a0 = ldfrag(Sb, 0, 0, lane), a1 = ldfrag(Sb, 0, 1, lane); \
        f4 r = {bflo(O_.x.x), bfhi(O_.x.x), bflo(O_.x.y), bfhi(O_.x.y)}; \
        r = __builtin_amdgcn_mfma_f32_16x16x32_bf16(a0, O_.f0, r, 0, 0, 0); r = __builtin_amdgcn_mfma_f32_16x16x32_bf16(a1, O_.f1, r, 0, 0, 0); \
        if (!isS) *(u2*)(A.Y + ((size_t)b * 2048 + (c_) * 64 + 16 * nb + ln) * 512 + h * 64 + 16 * mb + lm) = (u2){pkbf(r[0], r[1]), pkbf(r[2], r[3])}; \
        if ((c_) + 2 < 32) RB_LOAD(O_, (c_) + 2);                       \
        RWBAR();                                                      \
        if (isS) { RL unsigned short* sp = (RL unsigned short*)(Sb + lm * SB) + 16 * nb + ln; \
            _Pragma("unroll") for (int q = 0; q < 4; ++q) sp[q * ST] = (unsigned short)(pkbf(r[q], 0.f) & 0xffffu); } \
        RWBAR(); } while (0)
    Ops OA_, OB_;
    RB_LOAD(OA_, 0); RB_LOAD(OB_, 1);
    for (int c = 0; c < 32; c += 2) { RB_STEP(OA_, c); RB_STEP(OB_, c + 1); }
#undef RB_LOAD
#undef RB_STEP
}
}


#define GAS __attribute__((address_space(1)))
#define LAS __attribute__((address_space(3)))
typedef unsigned short bf16;
typedef unsigned v4u __attribute__((ext_vector_type(4)));
typedef float f32x4 __attribute__((ext_vector_type(4)));
typedef short bf16x8 __attribute__((ext_vector_type(8)));
typedef GAS unsigned gu32;
typedef GAS unsigned long long gu64;
#define RLX_AGENT __ATOMIC_RELAXED, __HIP_MEMORY_SCOPE_AGENT
#define LDS_WAIT() asm volatile("s_waitcnt lgkmcnt(0)" ::: "memory")
#define VM_WAIT() asm volatile("s_waitcnt vmcnt(0)" ::: "memory")
__device__ __forceinline__ unsigned long long rt() { return __builtin_amdgcn_s_memrealtime(); }
__device__ __forceinline__ unsigned f2bf(float f) { unsigned u = __builtin_bit_cast(unsigned, f); return (u + 0x7fffu + ((u >> 16) & 1u)) >> 16; }
__device__ __forceinline__ unsigned pk2(float lo, float hi) { return f2bf(lo) | (f2bf(hi) << 16); }

#define XB_TMO      128
#define XB_XCNT(j)  (256  + 64 * (j))
#define XB_XSUB(j)  (1280 + 64 * (j))
#define XB_XGEN(j)  (2304 + 64 * (j))
#define XB_TOP      3328
#define XB_TOPGEN   3392
#define XCD_BAR_WORDS 3456
#define XB_SPIN_CAP (1u << 18)

__device__ __forceinline__ unsigned xb_ld(unsigned* p)              { return __hip_atomic_load(p, __ATOMIC_RELAXED, __HIP_MEMORY_SCOPE_AGENT); }
__device__ __forceinline__ unsigned xb_add(unsigned* p, unsigned v) { return __hip_atomic_fetch_add(p, v, __ATOMIC_RELAXED, __HIP_MEMORY_SCOPE_AGENT); }
__device__ __forceinline__ unsigned xb_xcc_id() { return (unsigned)__builtin_amdgcn_s_getreg((3 << 11) | 20) & 0xFu; }
#define XB_SPIN(cond, bar) do { unsigned _sp = 0; while (cond) { __builtin_amdgcn_s_sleep(1); \
    if ((++_sp & 255u) == 0u) { if (xb_ld(&(bar)[XB_TMO])) break; if (_sp > XB_SPIN_CAP) { atomicAdd(&(bar)[XB_TMO], 1u); break; } } } } while (0)

struct XcdBarrier {
    unsigned* bar; unsigned x;
    volatile LAS unsigned* st;
};

__device__ __forceinline__ XcdBarrier xcd_barrier_post(unsigned* bar, volatile LAS unsigned* st) {
    XcdBarrier b; b.bar = bar; b.x = xb_xcc_id(); b.st = st;
    if (threadIdx.x == 0) (void)xb_add(&bar[XB_XCNT(b.x)], 1u);
    return b;
}
__device__ __forceinline__ void xcd_barrier_complete(unsigned* bar, unsigned x, unsigned& nloc, unsigned& nx) {
    const unsigned G = gridDim.x * gridDim.y * gridDim.z;
    unsigned sum, cnt, mine, sp = 0u;
    for (;;) {
        sum = 0u; cnt = 0u; mine = 0u;
#pragma unroll
        for (unsigned j = 0; j < 16; ++j) { const unsigned c = xb_ld(&bar[XB_XCNT(j)]); sum += c; cnt += (c > 0u) ? 1u : 0u; mine = (j == x) ? c : mine; }
        if (sum == G) break;
        __builtin_amdgcn_s_sleep(1);
        if ((++sp & 255u) == 0u) { if (xb_ld(&bar[XB_TMO])) break; if (sp > XB_SPIN_CAP) { atomicAdd(&bar[XB_TMO], 1u); break; } }
    }
    nloc = mine > 0u ? mine : 1u; nx = cnt > 0u ? cnt : 1u;
}

__device__ __forceinline__ void xcd_barrier(const XcdBarrier& b) {
    asm volatile("s_waitcnt vmcnt(0)" ::: "memory");
    __syncthreads();
    if (threadIdx.x == 0) {
        unsigned* bar = b.bar;
        __builtin_amdgcn_s_waitcnt(0);
        unsigned nloc = b.st[0], nx = b.st[1];
        if (nloc == 0u) { xcd_barrier_complete(bar, b.x, nloc, nx); b.st[0] = nloc; b.st[1] = nx; }
        const unsigned old = xb_add(&bar[XB_XSUB(b.x)], 1u);
        const unsigned gen = old / nloc;
        if (old + 1u == (gen + 1u) * nloc) {
            __builtin_amdgcn_fence(__ATOMIC_RELEASE, "agent");
            asm volatile("s_waitcnt vmcnt(0)" ::: "memory");
            const unsigned og = xb_add(&bar[XB_TOP], 1u);
            const unsigned tg = og / nx;
            if (og + 1u == (tg + 1u) * nx) xb_add(&bar[XB_TOPGEN], 1u);
            else XB_SPIN(xb_ld(&bar[XB_TOPGEN]) == tg, bar);
            __builtin_amdgcn_fence(__ATOMIC_ACQUIRE, "agent");
            xb_add(&bar[XB_XGEN(b.x)], 1u);
            asm volatile("s_waitcnt vmcnt(0)" ::: "memory");
        } else {
            XB_SPIN(xb_ld(&bar[XB_XGEN(b.x)]) == gen, bar);
            __builtin_amdgcn_fence(__ATOMIC_ACQUIRE, "agent");
            asm volatile("s_waitcnt vmcnt(0)" ::: "memory");
        }
    }
    __syncthreads();
}


constexpr int BATCH = 8, SEQ = 2048, DM = 1024, M = BATCH * SEQ;
constexpr int DIN = 3328, DRW = 512, RC = 1792;
constexpr int NEXP = 32, DEXP = 512;
constexpr int NWAVES = 8;
constexpr int RING_OFF = 0, RING_BYTES = 131072;
constexpr int LDSCTL_OFF = RING_BYTES, MISC_OFF = LDSCTL_OFF + 320;
constexpr int LDS_BYTES = 147456;
constexpr size_t MBy = 1000000;
constexpr size_t WS_CTL = 0, CTL_ZERO_BYTES = 1 << 20;
constexpr int CW_TMO = 0, CW_CODE = 1, CW_BAR = 4096;

struct Frame {
    LAS unsigned char* lds;
    volatile LAS unsigned* MISC;
    gu32* ctl;
    int tid, lane, wave;
    int vcu, G;
};

__device__ __forceinline__ float wave_sum(float v) {
#pragma unroll
    for (int o = 1; o < 64; o <<= 1) v += __shfl_xor(v, o);
    return v;
}
__device__ __forceinline__ void p0_transpose_item(const float* W, int K, int N, bf16* WT, int row_off, LAS float* scr, int item, int lane) {
    const int nblk = N / 32, kb = item / nblk, nb = item % nblk, k0 = 64 * kb, n0 = 32 * nb;
#pragma unroll 8
    for (int i = 0; i < 32; ++i) { const int kk = 2 * i + (lane >> 5); scr[kk * 33 + (lane & 31)] = W[(size_t)(k0 + kk) * N + n0 + (lane & 31)]; }
    LDS_WAIT(); asm volatile("" ::: "memory");
    const int c = lane & 7;
#pragma unroll
    for (int j = 0; j < 4; ++j) { const int n = (lane >> 3) + 8 * j; const LAS float* s = scr + (8 * c) * 33 + n;
        v4u o; o.x = pk2(s[0 * 33], s[1 * 33]); o.y = pk2(s[2 * 33], s[3 * 33]); o.z = pk2(s[4 * 33], s[5 * 33]); o.w = pk2(s[6 * 33], s[7 * 33]);
        *(GAS v4u*)(WT + (size_t)(row_off + n0 + n) * K + k0 + 8 * c) = o; }
    LDS_WAIT(); asm volatile("" ::: "memory");
}
__device__ __forceinline__ void rms_row_to_bf16(int lane, const float* xrow, const float* g, bf16* orow, float eps) {
    const GAS f32x4* xr = (const GAS f32x4*)xrow + lane;
    const GAS f32x4* gr = (const GAS f32x4*)g + lane;
    f32x4 v[4]; float s = 0.f;
#pragma unroll
    for (int j = 0; j < 4; ++j) { v[j] = xr[64 * j]; s += (v[j].x * v[j].x + v[j].y * v[j].y) + (v[j].z * v[j].z + v[j].w * v[j].w); }
    const float rstd = 1.f / sqrtf(wave_sum(s) * (1.f / DM) + eps);
    GAS unsigned long long* o8 = (GAS unsigned long long*)orow + lane;
#pragma unroll
    for (int j = 0; j < 4; ++j) { const f32x4 gv = gr[64 * j];
        o8[64 * j] = (unsigned long long)pk2(v[j].x * rstd * gv.x, v[j].y * rstd * gv.y) | ((unsigned long long)pk2(v[j].z * rstd * gv.z, v[j].w * rstd * gv.w) << 32); }
}

__device__ __forceinline__ void rms_rows_pipelined(int lane, const float* x, const float* g, bf16* out, int first, int stride, float eps) {
    const GAS f32x4* gr = (const GAS f32x4*)g + lane;
    const f32x4 g0 = gr[0], g1 = gr[64], g2 = gr[128], g3 = gr[192];
    f32x4 c0, c1, c2, c3;
    if (first < M) { const GAS f32x4* xr = (const GAS f32x4*)(x + (size_t)first * DM) + lane; c0 = xr[0]; c1 = xr[64]; c2 = xr[128]; c3 = xr[192]; }
    for (int m = first; m < M; m += stride) {
        f32x4 n0 = c0, n1 = c1, n2 = c2, n3 = c3;
        if (m + stride < M) { const GAS f32x4* xr = (const GAS f32x4*)(x + (size_t)(m + stride) * DM) + lane; n0 = xr[0]; n1 = xr[64]; n2 = xr[128]; n3 = xr[192]; }
        const float ssq = ((c0.x * c0.x + c0.y * c0.y) + (c0.z * c0.z + c0.w * c0.w)) + ((c1.x * c1.x + c1.y * c1.y) + (c1.z * c1.z + c1.w * c1.w))
                        + ((c2.x * c2.x + c2.y * c2.y) + (c2.z * c2.z + c2.w * c2.w)) + ((c3.x * c3.x + c3.y * c3.y) + (c3.z * c3.z + c3.w * c3.w));
        const float rstd = 1.f / sqrtf(wave_sum(ssq) * (1.f / DM) + eps);
        GAS unsigned long long* o8 = (GAS unsigned long long*)(out + (size_t)m * DM) + lane;
        o8[0]   = (unsigned long long)pk2(c0.x * rstd * g0.x, c0.y * rstd * g0.y) | ((unsigned long long)pk2(c0.z * rstd * g0.z, c0.w * rstd * g0.w) << 32);
        o8[64]  = (unsigned long long)pk2(c1.x * rstd * g1.x, c1.y * rstd * g1.y) | ((unsigned long long)pk2(c1.z * rstd * g1.z, c1.w * rstd * g1.w) << 32);
        o8[128] = (unsigned long long)pk2(c2.x * rstd * g2.x, c2.y * rstd * g2.y) | ((unsigned long long)pk2(c2.z * rstd * g2.z, c2.w * rstd * g2.w) << 32);
        o8[192] = (unsigned long long)pk2(c3.x * rstd * g3.x, c3.y * rstd * g3.y) | ((unsigned long long)pk2(c3.z * rstd * g3.z, c3.w * rstd * g3.w) << 32);
        c0 = n0; c1 = n1; c2 = n2; c3 = n3;
    }
}
struct Args { const float* in[30]; float* out; unsigned char* ws; int ph_lo, ph_hi; };
constexpr size_t WS_U = 2 * MBy;
constexpr size_t DO_XN = 0, DO_WIN = 34 * MBy;
constexpr size_t DO_O = 0;
constexpr size_t DO_Y = 33554432, DO_BT = 50331648;
constexpr size_t WS_E = 112 * MBy;
constexpr size_t WS_LA = 163 * MBy;
constexpr size_t WS_WL = 172 * MBy;
constexpr size_t WS_WOUT = 163 * MBy;
constexpr size_t WS_MIX = 2 * MBy;
constexpr size_t WS_T = WS_MIX;
constexpr size_t WS_WGU = 173 * MBy;
constexpr size_t WS_WD = 241 * MBy;
constexpr size_t WS_ACT = 120 * MBy;
constexpr size_t WS_XS = 36 * MBy;
constexpr size_t WS_YB = 36 * MBy;
constexpr size_t WS_ROWSLOT = 275 * MBy;
constexpr size_t WS_ROWGATE = WS_ROWSLOT + 40960 * 4;
constexpr size_t WS_SLOT_E = WS_ROWGATE + 40960 * 4;
constexpr size_t WS_SLOT_P = WS_SLOT_E + 32768 * 4;
constexpr size_t WS_SLOT_G = WS_SLOT_P + 32768 * 4;
constexpr size_t WS_WRP = 65536;
constexpr size_t WS_END = WS_SLOT_G + 32768 * 4;
constexpr size_t WS_GH = 241 * MBy;
constexpr size_t WS_Q1 = (size_t)162500000;
constexpr size_t WS_Q2 = (size_t)274600000;
constexpr size_t WS_TOTAL = 274600000 + 8388608;
static_assert(WS_END <= WS_TOTAL && WS_GH + 33554432 <= WS_Q2 && WS_Q1 + 8388608 <= 172 * MBy, "ws map");
constexpr int CW_DBG = 10240;
constexpr int CW_AQ = 8192;
constexpr int CW_CNT = 2048;
constexpr int TILE_E_OFF = LDSCTL_OFF + 1024;
constexpr size_t WS_ROPE = 512 * 1024;
constexpr float QSCALE = 0.125f * 1.4426950408889634f;

__device__ __forceinline__ unsigned long long ldarg(int byte_off) {
    const __attribute__((address_space(4))) unsigned char* kp = (const __attribute__((address_space(4))) unsigned char*)__builtin_amdgcn_kernarg_segment_ptr();
    return *(const volatile __attribute__((address_space(4))) unsigned long long*)(kp + byte_off);
}
#define ARG_IN(i) ((const float*)(const GAS float*)ldarg(8 * (i)))
#define ARG_OUT ((unsigned char*)(GAS unsigned char*)ldarg(240))
#define ARG_WS ((unsigned char*)(GAS unsigned char*)ldarg(248))
static_assert(sizeof(Args) == 264, "Args layout vs ldarg offsets");
__global__ void __launch_bounds__(NWAVES * 64, 2) skel_fwd(Args args) {
    extern __shared__ __attribute__((aligned(16))) unsigned char lds[];
    Frame F;
    F.lds = (LAS unsigned char*)lds;
    F.MISC = (volatile LAS unsigned*)(F.lds + MISC_OFF);
    F.tid = threadIdx.x; F.lane = F.tid & 63; F.wave = __builtin_amdgcn_readfirstlane(F.tid >> 6);
    F.G = gridDim.x; { const int bx = blockIdx.x; F.vcu = (F.G % 8 == 0) ? (bx % 8) * (F.G / 8) + bx / 8 : bx; }
    F.ctl = (gu32*)(ARG_WS + WS_CTL);
    for (int u = F.tid; u < (LDS_BYTES - LDSCTL_OFF) / 4; u += NWAVES * 64) ((LAS unsigned*)(F.lds + LDSCTL_OFF))[u] = 0u;
    __syncthreads();
    XcdBarrier bar = xcd_barrier_post((unsigned*)(F.ctl + CW_BAR), F.MISC + 8);
    const int lo = args.ph_lo, hi = args.ph_hi;
#ifndef PROBE_K
#define PROBE_K (-1)
#endif
#ifndef RWKV_DBG
#define RWKV_DBG 0
#endif
#ifndef RW_STAGE
#define RW_STAGE 0
#endif
    constexpr int CW_TS = 9216;
#define STAMP(k) do { if (PROBE_K >= 0 && blockIdx.x == 0 && F.tid == 0) ((GAS unsigned long long*)(F.ctl + CW_TS))[k] = rt(); } while (0)
    STAMP(0);
#define P_U ((bf16*)(ARG_WS + WS_U))
#define IN(k) (lo <= (k) && (k) < hi)
#define BOTH(k) (IN(k) && IN((k) + 1))
    if (IN(0)) {
        unsigned char* ws = ARG_WS; unsigned char* dout = ARG_OUT;
        const float* x = ARG_IN(0); const float* ln1_g = ARG_IN(1); const float* w_in = ARG_IN(2);
        bf16* XN = (bf16*)(dout + DO_XN); bf16* Wt_in = (bf16*)(dout + DO_WIN); float2* rope = (float2*)(ws + WS_ROPE);
        bf16* WL = (bf16*)(ws + WS_WL);
        LAS float* scr = (LAS float*)(F.lds + RING_OFF + F.wave * 16384);
        const int gw = F.vcu * NWAVES + F.wave, NGW = F.G * NWAVES;
        constexpr int I_IN = (DM / 64) * (DIN / 32);
        for (int it = gw; it < I_IN; it += NGW) p0_transpose_item(w_in, DM, DIN, Wt_in, 0, scr, it, F.lane);
        rms_rows_pipelined(F.lane, x, ln1_g, XN, gw, NGW, 1e-6f);
        {   const float* wup = ARG_IN(12); const float* aup = ARG_IN(14); const float* gup = ARG_IN(15);
            for (int idx = gw * 64 + F.lane; idx < 1536 * 256; idx += NGW * 64) {
                const int n = idx >> 8, j = idx & 255; float v = 0.f;
                if (n < 512) { if (j < 64) v = wup[j * 512 + n]; }
                else if (n < 1024) { if (j >= 64 && j < 128) v = aup[(j - 64) * 512 + (n - 512)]; }
                else { if (j >= 128) v = gup[(j - 128) * 512 + (n - 1024)]; }
                WL[idx] = (bf16)f2bf(v);
            }
        }
        {   const float* g2 = ARG_IN(22); const float* wrg = ARG_IN(23); const float* wre = ARG_IN(25); float* WRP = (float*)(ws + WS_WRP);
            for (int idx = gw * 64 + F.lane; idx < 64 * 3 * 64 * 4; idx += NGW * 64) {
                const int i = idx & 3, l = (idx >> 2) & 63, nt = (idx >> 8) % 3, sgrp = idx / 768;
                const int k = 16 * sgrp + 4 * (l >> 4) + i, n = nt * 16 + (l & 15);
                float v = 0.f; if (n < 32) v = wre[k * 32 + n]; else if (n < 36) v = wrg[k * 4 + (n - 32)];
                WRP[idx] = v * g2[k];
            }
        }
        for (int idx = gw * 64 + F.lane; idx < SEQ * 8; idx += NGW * 64) {
            const int pos = idx >> 3, j = idx & 7;
            const double invrev = j == 0 ? 0.15915494309189535 : j == 1 ? 0.03086376340470123 : j == 2 ? 0.005985185712713705 : j == 3 ? 0.001160663641240061 :
                                  j == 4 ? 0.00022507907903927653 : j == 5 ? 4.364795279280289e-05 : j == 6 ? 8.464330808241401e-06 : 1.6414262627950345e-06;
            const double tr = (double)pos * invrev; const float fr = (float)(tr - floor(tr));
            rope[idx] = make_float2(__builtin_amdgcn_cosf(fr), __builtin_amdgcn_sinf(fr));
        }
        if (BOTH(0)) xcd_barrier(bar); STAMP(1);
    }
    if (IN(1)) {
        unsigned char* dout = ARG_OUT; bf16* XN = (bf16*)(dout + DO_XN); bf16* Wt_in = (bf16*)(dout + DO_WIN); bf16* U = P_U;
        pg8::Gemm g{XN, Wt_in, M, DIN, DM}; pg8::G1Order S; S.init(M, DIN - 256, F.G, (int)blockIdx.x);
        pg8::EpiBf16<0> E{U, DIN, nullptr, 0, 0, 1.f};
        pg8::gemm_phase<pg8::EpiBf16<0>, pg8::G1Order, PG8_ALIGN, PG8_SP2>(F.lds + RING_OFF, g, S, E);
        if (BOTH(1)) xcd_barrier(bar); STAMP(2);
    }
    if (IN(2)) {
        unsigned char* ws = ARG_WS; bf16* U = P_U; const float* qg = ARG_IN(3); const float* kg = ARG_IN(4); const float* mu = ARG_IN(10);
        const float2* rope = (const float2*)(ws + WS_ROPE); bf16* LA = (bf16*)(ws + WS_LA);
        const int gw = F.vcu * NWAVES + F.wave, NGW = F.G * NWAVES;
        const int lane = F.lane;
        for (int t = gw; t < M; t += NGW) {
            const int pos = t & (SEQ - 1);
            GAS v4u* rowp = (GAS v4u*)(U + (size_t)t * DIN + lane * 16);
            const v4u wa = rowp[0], wb = rowp[1];
            float v[16];
            v[0] = __uint_as_float(wa.x << 16); v[1] = __uint_as_float(wa.x & 0xffff0000u); v[2] = __uint_as_float(wa.y << 16); v[3] = __uint_as_float(wa.y & 0xffff0000u);
            v[4] = __uint_as_float(wa.z << 16); v[5] = __uint_as_float(wa.z & 0xffff0000u); v[6] = __uint_as_float(wa.w << 16); v[7] = __uint_as_float(wa.w & 0xffff0000u);
            v[8] = __uint_as_float(wb.x << 16); v[9] = __uint_as_float(wb.x & 0xffff0000u); v[10] = __uint_as_float(wb.y << 16); v[11] = __uint_as_float(wb.y & 0xffff0000u);
            v[12] = __uint_as_float(wb.z << 16); v[13] = __uint_as_float(wb.z & 0xffff0000u); v[14] = __uint_as_float(wb.w << 16); v[15] = __uint_as_float(wb.w & 0xffff0000u);
            float ss = 0.f;
#pragma unroll
            for (int i = 0; i < 16; ++i) ss += v[i] * v[i];
            ss += __shfl_xor(ss, 1); ss += __shfl_xor(ss, 2);
            const float rstd = 1.0f / sqrtf(ss * (1.0f / 64.0f) + 1e-6f);
            const float* gp = (lane < 32 ? qg : kg) + (lane & 3) * 16;
#pragma unroll
            for (int i = 0; i < 16; ++i) v[i] *= rstd * gp[i];
            if ((lane & 3) == 0) {
#pragma unroll
                for (int j = 0; j < 8; ++j) { const float2 cs = rope[pos * 8 + j]; const float x1 = v[j], x2 = v[j + 8]; v[j] = x1 * cs.x - x2 * cs.y; v[j + 8] = x2 * cs.x + x1 * cs.y; }
            }
            if (lane < 32) {
#pragma unroll
                for (int i = 0; i < 16; ++i) v[i] *= QSCALE;
            }
            v4u oa, ob;
            oa.x = pk2(v[0], v[1]); oa.y = pk2(v[2], v[3]); oa.z = pk2(v[4], v[5]); oa.w = pk2(v[6], v[7]);
            ob.x = pk2(v[8], v[9]); ob.y = pk2(v[10], v[11]); ob.z = pk2(v[12], v[13]); ob.w = pk2(v[14], v[15]);
            rowp[0] = oa; rowp[1] = ob;
            {   typedef unsigned u32x2v __attribute__((ext_vector_type(2)));
                const GAS u32x2v* lp = (const GAS u32x2v*)(U + (size_t)t * DIN + 3072 + lane * 4);
                const u32x2v cw = lp[0]; u32x2v pw = cw; if (pos > 0) pw = *(const GAS u32x2v*)(U + (size_t)(t - 1) * DIN + 3072 + lane * 4);
                const f32x4 m4 = *(const GAS f32x4*)(mu + 1536 + lane * 4);
                float c4[4] = {__uint_as_float(cw.x << 16), __uint_as_float(cw.x & 0xffff0000u), __uint_as_float(cw.y << 16), __uint_as_float(cw.y & 0xffff0000u)};
                float p4[4] = {__uint_as_float(pw.x << 16), __uint_as_float(pw.x & 0xffff0000u), __uint_as_float(pw.y << 16), __uint_as_float(pw.y & 0xffff0000u)};
                if (pos == 0) { p4[0] = 0.f; p4[1] = 0.f; p4[2] = 0.f; p4[3] = 0.f; }
                float o4[4];
#pragma unroll
                for (int i = 0; i < 4; ++i) { const float xs = c4[i] + (p4[i] - c4[i]) * m4[i];
                    float r = xs;
                    if (lane < 16) { const float e2 = __expf(-2.0f * fabsf(xs)); const float th = (1.0f - e2) / (1.0f + e2); r = xs < 0.f ? -th : th; }
                    else if (lane >= 32) r = 1.0f / (1.0f + __expf(-xs));
                    o4[i] = r; }
                u32x2v ow; ow.x = pk2(o4[0], o4[1]); ow.y = pk2(o4[2], o4[3]);
                *(GAS u32x2v*)(LA + (size_t)t * 256 + lane * 4) = ow;
            }
        }
        if (BOTH(2)) xcd_barrier(bar); STAMP(3);
    }
    if (IN(3)) {
        unsigned char* ws = ARG_WS; bf16* LA = (bf16*)(ws + WS_LA); bf16* WL = (bf16*)(ws + WS_WL); bf16* EB = (bf16*)(ws + WS_E);
        {
            unsigned char* dout = ARG_OUT; const bool big = F.vcu < 64;
            pg8::Gemm g{big ? (const bf16*)(dout + DO_XN) : (const bf16*)LA, big ? (const bf16*)(dout + DO_WIN) : (const bf16*)WL, M, big ? DIN : 1536, big ? DM : 256}; pg8::P3Order S{F.vcu};
            pg8::EpiBf16<0> E{big ? P_U : EB, big ? DIN : 1536, nullptr, 0, 0, 1.f};
            pg8::gemm_phase<pg8::EpiBf16<0>, pg8::P3Order, PG8_ALIGN, PG8_SP2>(F.lds + RING_OFF, g, S, E);
        }
        if (BOTH(3)) xcd_barrier(bar); STAMP(4);
    }
    if (IN(4)) {
        static_assert(attn_body::ATTN_LDS_BYTES <= RING_BYTES && rwkv_body::RWKV_LDS_BYTES <= RING_BYTES, "phase body LDS vs frame");
        {
            unsigned char* ws = ARG_WS; unsigned char* dout = ARG_OUT;
            const rwkv_body::Args RA{(unsigned long long*)(F.ctl + 9216), P_U, (bf16*)(ws + WS_E), RWKV_DBG ? (bf16*)(ws + WS_WGU) : (bf16*)(dout + DO_Y), RWKV_DBG ? (bf16*)(ws + WS_WGU + 16777216) : (bf16*)(dout + DO_BT), ws + WS_GH, ws + WS_Q1, ws + WS_Q2, ARG_IN(10), ARG_IN(16), ARG_IN(17), ARG_IN(18), ARG_IN(11), ARG_IN(13)};
            if (F.vcu < 256) {
                const int hd = F.vcu >> 2;
                rwkv_body::chunk_consts_to_lds((LAS char*)(F.lds + RING_OFF), RA, hd & 7); __syncthreads();
                rwkv_body::ChunkLoads LA_, LB_; const int c0 = (F.vcu & 3) * 8;
                rwkv_body::chunk_load(LA_, RA, hd >> 3, hd & 7, c0);
#pragma unroll 1
                for (int j = 0; j < 8; j += 2) {
                    const int gwv = F.vcu * NWAVES + F.wave; const float* jWg = ARG_IN(27); const float* jWu = ARG_IN(28); bf16* jWGU = (bf16*)(ws + WS_WGU);
                    rwkv_body::rwkv_chunk_task((LAS char*)(F.lds + RING_OFF), RA, LA_, LB_, true, hd >> 3, hd & 7, c0 + j, c0 + j + 1, jWg, jWu, jWGU, RWKV_DBG ? -1 : j * 2048 + gwv);
                    rwkv_body::rwkv_chunk_task((LAS char*)(F.lds + RING_OFF), RA, LB_, LA_, j + 2 < 8, hd >> 3, hd & 7, c0 + j + 1, c0 + j + 2, jWg, jWu, jWGU, RWKV_DBG ? -1 : (j + 1) * 2048 + gwv);
                }
            }
            xcd_barrier(bar); STAMP(13);
            if (RWKV_DBG != 3 && F.vcu < 256) { const int hd = F.vcu >> 2; rwkv_body::rwkv_seq_head((LAS char*)(F.lds + RING_OFF), RA, hd >> 3, hd & 7, F.vcu & 3); }
            STAMP(16);
        }
        if (RWKV_DBG && (F.vcu & 1) == 0 && F.vcu < 256) {
            unsigned char* ws = ARG_WS; unsigned char* dout = ARG_OUT; const int un = F.vcu >> 1;
            const scan_body::ScanArgs SA{P_U, (bf16*)(ws + WS_E), (bf16*)(dout + DO_Y), (bf16*)(dout + DO_BT), ARG_IN(10), ARG_IN(16), ARG_IN(17), ARG_IN(18), ARG_IN(11), ARG_IN(13)};
            scan_body::scan_unit((LAS float*)(F.lds + RING_OFF), SA, un >> 4, (un >> 1) & 7, un & 1);
        }
        {
        bf16* U = P_U; bf16* OA = (bf16*)(ARG_OUT + DO_O);
        const attn_body::AttnTensors AT{(const attn_body::bf16*)U, (attn_body::bf16*)OA};
        if (RWKV_DBG) attn_body::attn_phase_dyn<8>((char*)lds + RING_OFF, AT, (unsigned*)(F.ctl + CW_AQ), F.MISC, (int)(bar.x & 7u));
        else attn_body::attn_phase_static((char*)lds + RING_OFF, AT, F.vcu);
        }
        if (0) {
            unsigned char* ws = ARG_WS; const int lane = F.lane;
            const int gw = ((F.vcu >> 2) * 3 + (F.vcu & 3) - 1) * NWAVES + F.wave, NGW = (F.G >> 2) * 3 * NWAVES;
            LAS float* scr = (LAS float*)(F.lds + RING_OFF + F.wave * 16384);
            const float* Wg = ARG_IN(27); const float* Wu = ARG_IN(28);
            bf16* WGU = (bf16*)(ws + WS_WGU);
            for (int it = gw; it < 16384; it += NGW) { const int e = it >> 9, mat = (it >> 8) & 1, item = it & 255; const int n0 = 32 * (item & 15);
                p0_transpose_item((mat ? Wu : Wg) + (size_t)e * DM * DEXP, DM, DEXP, WGU, e * 1024 + (n0 >> 7) * 256 + (n0 & 127) - n0 + mat * 128, scr, item, lane); }
        }
        if (BOTH(4)) xcd_barrier(bar); STAMP(5);
    }
    if (IN(5)) {
        unsigned char* ws = ARG_WS; unsigned char* dout = ARG_OUT;
        const bf16* OA = (const bf16*)(dout + DO_O); const bf16* YB = (const bf16*)(dout + DO_Y); const bf16* BT = (const bf16*)(dout + DO_BT);
        const bf16* EB = (const bf16*)(ws + WS_E); bf16* MIX = (bf16*)(ws + WS_MIX);
        const int gw = F.vcu * NWAVES + F.wave, NGW = F.G * NWAVES; const int lane = F.lane;
        const float lam = __expf(wave_sum(ARG_IN(5)[lane] * ARG_IN(6)[lane])) - __expf(wave_sum(ARG_IN(7)[lane] * ARG_IN(8)[lane])) + 0.2f;
        const float* subg = ARG_IN(9); const float* lng = ARG_IN(19); const float* lnb = ARG_IN(20);
        const f32x4 sgA = *(const GAS f32x4*)(subg + 8 * (lane & 15)), sgB = *(const GAS f32x4*)(subg + 8 * (lane & 15) + 4);
        const f32x4 lgA = *(const GAS f32x4*)(lng + 8 * lane), lgB = *(const GAS f32x4*)(lng + 8 * lane + 4), lbA = *(const GAS f32x4*)(lnb + 8 * lane), lbB = *(const GAS f32x4*)(lnb + 8 * lane + 4);
#define UNPK8(W_, F_) do { F_[0] = __uint_as_float(W_[0] << 16); F_[1] = __uint_as_float(W_[0] & 0xffff0000u); F_[2] = __uint_as_float(W_[1] << 16); F_[3] = __uint_as_float(W_[1] & 0xffff0000u); \
                           F_[4] = __uint_as_float(W_[2] << 16); F_[5] = __uint_as_float(W_[2] & 0xffff0000u); F_[6] = __uint_as_float(W_[3] << 16); F_[7] = __uint_as_float(W_[3] & 0xffff0000u); } while (0)
        float dbg_d = 0.f, dbg_r = 0.f;
        for (int t = gw; t < M; t += NGW) {
            const int h = lane >> 4, e0 = 8 * (lane & 15);
            const v4u w0 = *(const GAS v4u*)(OA + (size_t)t * 1024 + h * 256 + e0), w1 = *(const GAS v4u*)(OA + (size_t)t * 1024 + h * 256 + 128 + e0);
            const v4u wy = *(const GAS v4u*)(YB + (size_t)t * 512 + 8 * lane), wb = *(const GAS v4u*)(BT + (size_t)t * 512 + 8 * lane), wg = *(const GAS v4u*)(EB + (size_t)t * 1536 + 1024 + 8 * lane);
            float o0[8], o1[8], o[8];
            UNPK8(w0, o0); UNPK8(w1, o1);
            float ss = 0.f;
#pragma unroll
            for (int i = 0; i < 8; ++i) { o[i] = o0[i] - lam * o1[i]; ss += o[i] * o[i]; }
            ss = scan_body::reduce16(ss);
            const float rs = 0.8f / sqrtf(ss * (1.0f / 128.0f) + 1e-5f);
            v4u mo; mo.x = pk2(o[0] * rs * sgA.x, o[1] * rs * sgA.y); mo.y = pk2(o[2] * rs * sgA.z, o[3] * rs * sgA.w); mo.z = pk2(o[4] * rs * sgB.x, o[5] * rs * sgB.y); mo.w = pk2(o[6] * rs * sgB.z, o[7] * rs * sgB.w);
            *(GAS v4u*)(MIX + (size_t)t * DM + h * 128 + e0) = mo;
            float y[8], bt[8], gt[8];
            UNPK8(wy, y); UNPK8(wb, bt); UNPK8(wg, gt);
            float sm = ((y[0] + y[1]) + (y[2] + y[3])) + ((y[4] + y[5]) + (y[6] + y[7]));
            sm = scan_body::dpp_add<0xB1>(sm); sm = scan_body::dpp_add<0x4E>(sm); sm = scan_body::dpp_add<0x141>(sm);
            const float mean = sm * (1.0f / 64.0f);
            float sq = 0.f;
#pragma unroll
            for (int i = 0; i < 8; ++i) { y[i] -= mean; sq += y[i] * y[i]; }
            sq = scan_body::dpp_add<0xB1>(sq); sq = scan_body::dpp_add<0x4E>(sq); sq = scan_body::dpp_add<0x141>(sq);
            const float rv = 1.0f / sqrtf(sq * (1.0f / 64.0f) + 64e-5f);
            const float lg8[8] = {lgA.x, lgA.y, lgA.z, lgA.w, lgB.x, lgB.y, lgB.z, lgB.w}, lb8[8] = {lbA.x, lbA.y, lbA.z, lbA.w, lbB.x, lbB.y, lbB.z, lbB.w};
            float r8[8];
#pragma unroll
            for (int i = 0; i < 8; ++i) r8[i] = (y[i] * rv * lg8[i] + lb8[i] + bt[i]) * gt[i];
            v4u ro; ro.x = pk2(r8[0], r8[1]); ro.y = pk2(r8[2], r8[3]); ro.z = pk2(r8[4], r8[5]); ro.w = pk2(r8[6], r8[7]);
            *(GAS v4u*)(MIX + (size_t)t * DM + 512 + 8 * lane) = ro;
            if (RWKV_DBG) {
                const bf16* S2 = (const bf16*)(ws + WS_WGU) + (RWKV_DBG == 2 ? 8388608 : 0); const bool dsel = (RWKV_DBG < 3) || ((t & 2047) < 64);
                const v4u w2 = *(const GAS v4u*)(S2 + (size_t)t * 512 + 8 * lane); const v4u w1_ = (RWKV_DBG == 2) ? wb : wy;
                float a2[8], a1[8]; UNPK8(w2, a2); UNPK8(w1_, a1);
                float dd = 0.f, rr = 0.f;
#pragma unroll
                for (int i = 0; i < 8; ++i) { const float df = a2[i] - a1[i]; dd += (df == df && fabsf(df) < 1e30f) ? df * df : 1e30f; rr += a1[i] * a1[i]; }
                if (dsel) { dbg_d += dd; dbg_r += rr; }
            }
        }
        if (RWKV_DBG) { dbg_d = wave_sum(dbg_d); dbg_r = wave_sum(dbg_r);
            if (lane == 0) { atomicAdd((float*)(F.ctl + CW_DBG), dbg_d); atomicAdd((float*)(F.ctl + CW_DBG + 1), dbg_r); } }
#undef UNPK8
        {
            LAS float* scr = (LAS float*)(F.lds + RING_OFF + F.wave * 16384);
            const float* Wd = ARG_IN(29); bf16* WDT = (bf16*)(ws + WS_WD);
            for (int it = gw; it < 8192; it += NGW) { const int e = it >> 8, item = it & 255; p0_transpose_item(Wd + (size_t)e * DEXP * DM, DEXP, DM, WDT, e * 1024, scr, item, lane); }
            if (RWKV_DBG) { const float* Wg = ARG_IN(27); const float* Wu = ARG_IN(28); bf16* WGU = (bf16*)(ws + WS_WGU);
                __syncthreads();
                for (int it = gw; it < 16384; it += NGW) { const int e = it >> 9, mat = (it >> 8) & 1, item = it & 255; const int n0 = 32 * (item & 15);
                    p0_transpose_item((mat ? Wu : Wg) + (size_t)e * DM * DEXP, DM, DEXP, WGU, e * 1024 + (n0 >> 7) * 256 + (n0 & 127) - n0 + mat * 128, scr, item, lane); } }
            const float* w_out = ARG_IN(21); bf16* Wt_out = (bf16*)(ws + WS_WOUT);
            for (int it = gw; it < (DM / 64) * (DM / 32); it += NGW) p0_transpose_item(w_out, DM, DM, Wt_out, 0, scr, it, lane);
        }
        if (BOTH(5)) xcd_barrier(bar); STAMP(6);
    }
    if (IN(6)) {
        unsigned char* ws = ARG_WS;
        pg8::Gemm g{(const bf16*)(ws + WS_MIX), (const bf16*)(ws + WS_WOUT), M, DM, DM}; pg8::StaticOrder S; S.init(M, DM, F.G, (int)blockIdx.x);
        pg8::EpiResF32 E{ARG_IN(0), (float*)ARG_OUT, DM};
        pg8::gemm_phase<pg8::EpiResF32, pg8::StaticOrder, false, PG8_SP2>(F.lds + RING_OFF, g, S, E);
        if (BOTH(6)) xcd_barrier(bar); STAMP(7);
    }
    if (IN(7)) {
        unsigned char* ws = ARG_WS; const float* hbuf = (const float*)ARG_OUT; const int lane = F.lane;
        const int gw = F.vcu * NWAVES + F.wave, NGW = F.G * NWAVES;
        {   const float* g2 = ARG_IN(22); bf16* T = (bf16*)(ws + WS_T);
            rms_rows_pipelined(lane, hbuf, g2, T, gw, NGW, 1e-6f); }
        STAMP(14);
        {   const float* brg = ARG_IN(24); const float* bre = ARG_IN(26); const GAS f32x4* WRP0 = (const GAS f32x4*)(ws + WS_WRP);
            int* slot_e = (int*)(ws + WS_SLOT_E); int* slot_p = (int*)(ws + WS_SLOT_P); float* slot_g = (float*)(ws + WS_SLOT_G);
            unsigned* cnt = (unsigned*)(F.ctl + CW_CNT);
            const int r = lane & 15, kq = lane >> 4;
            const int khalf = F.wave >> 2;
            for (int task = (F.wave & 3) * F.G + F.vcu; task < M / 16; task += 4 * F.G) {
                const int tok0 = task * 16;
                const GAS f32x4* arow = (const GAS f32x4*)(hbuf + (size_t)(tok0 + r) * DM) + kq + khalf * 128;
                const GAS f32x4* WRP = WRP0 + khalf * (32 * 3 * 64);
                f32x4 acc0 = {0.f, 0.f, 0.f, 0.f}, acc1 = acc0, acc2 = acc0; float ssq = 0.f;
                f32x4 ca0, ca1, ca2, ca3, cb0, cb1, cb2, cb3, cb4, cb5, cb6, cb7, cb8, cb9, cb10, cb11;
                f32x4 na0, na1, na2, na3, nb0, nb1, nb2, nb3, nb4, nb5, nb6, nb7, nb8, nb9, nb10, nb11;
#define RT_LD1(A_, B0_, B1_, B2_, sg_) do { A_ = arow[4 * (sg_)]; B0_ = WRP[((sg_) * 3 + 0) * 64 + lane]; B1_ = WRP[((sg_) * 3 + 1) * 64 + lane]; B2_ = WRP[((sg_) * 3 + 2) * 64 + lane]; } while (0)
#define RT_MM1(A_, B0_, B1_, B2_) do { ssq += (A_.x * A_.x + A_.y * A_.y) + (A_.z * A_.z + A_.w * A_.w); \
        acc0 = __builtin_amdgcn_mfma_f32_16x16x4f32(A_.x, B0_.x, acc0, 0, 0, 0); acc1 = __builtin_amdgcn_mfma_f32_16x16x4f32(A_.x, B1_.x, acc1, 0, 0, 0); acc2 = __builtin_amdgcn_mfma_f32_16x16x4f32(A_.x, B2_.x, acc2, 0, 0, 0); \
        acc0 = __builtin_amdgcn_mfma_f32_16x16x4f32(A_.y, B0_.y, acc0, 0, 0, 0); acc1 = __builtin_amdgcn_mfma_f32_16x16x4f32(A_.y, B1_.y, acc1, 0, 0, 0); acc2 = __builtin_amdgcn_mfma_f32_16x16x4f32(A_.y, B2_.y, acc2, 0, 0, 0); \
        acc0 = __builtin_amdgcn_mfma_f32_16x16x4f32(A_.z, B0_.z, acc0, 0, 0, 0); acc1 = __builtin_amdgcn_mfma_f32_16x16x4f32(A_.z, B1_.z, acc1, 0, 0, 0); acc2 = __builtin_amdgcn_mfma_f32_16x16x4f32(A_.z, B2_.z, acc2, 0, 0, 0); \
        acc0 = __builtin_amdgcn_mfma_f32_16x16x4f32(A_.w, B0_.w, acc0, 0, 0, 0); acc1 = __builtin_amdgcn_mfma_f32_16x16x4f32(A_.w, B1_.w, acc1, 0, 0, 0); acc2 = __builtin_amdgcn_mfma_f32_16x16x4f32(A_.w, B2_.w, acc2, 0, 0, 0); } while (0)
                RT_LD1(ca0, cb0, cb1, cb2, 0); RT_LD1(ca1, cb3, cb4, cb5, 1); RT_LD1(ca2, cb6, cb7, cb8, 2); RT_LD1(ca3, cb9, cb10, cb11, 3);
                for (int g = 0; g < 8; ++g) {
                    const int gn = (g + 1 < 8) ? g + 1 : g;
                    RT_LD1(na0, nb0, nb1, nb2, gn * 4); RT_LD1(na1, nb3, nb4, nb5, gn * 4 + 1); RT_LD1(na2, nb6, nb7, nb8, gn * 4 + 2); RT_LD1(na3, nb9, nb10, nb11, gn * 4 + 3);
                    __builtin_amdgcn_sched_barrier(0);
                    RT_MM1(ca0, cb0, cb1, cb2); RT_MM1(ca1, cb3, cb4, cb5); RT_MM1(ca2, cb6, cb7, cb8); RT_MM1(ca3, cb9, cb10, cb11);
                    __builtin_amdgcn_sched_barrier(0);
                    ca0 = na0; ca1 = na1; ca2 = na2; ca3 = na3; cb0 = nb0; cb1 = nb1; cb2 = nb2; cb3 = nb3; cb4 = nb4; cb5 = nb5; cb6 = nb6; cb7 = nb7; cb8 = nb8; cb9 = nb9; cb10 = nb10; cb11 = nb11;
                }
#undef RT_LD1
#undef RT_MM1
                ssq += __shfl_xor(ssq, 16); ssq += __shfl_xor(ssq, 32);
                LAS float* LGT = (LAS float*)(F.lds + RING_OFF + (F.wave & 3) * 8192);
                LAS float* LGh = LGT + khalf * 768;
#pragma unroll
                for (int q = 0; q < 4; ++q) { const int row = 4 * kq + q; LGh[row * 48 + r] = acc0[q]; LGh[row * 48 + 16 + r] = acc1[q]; LGh[row * 48 + 32 + r] = acc2[q]; }
                if (lane < 16) LGT[1536 + khalf * 16 + lane] = ssq;
                LAS unsigned* hist = (LAS unsigned*)(F.lds + RING_OFF + 32768); LAS unsigned* hbase = hist + 32;
                if (F.tid < 32) hist[F.tid] = 0u;
                __syncthreads();
                int ea = 0, eb = 0; unsigned la = 0u, lb = 0u; float ga = 0.f, gb = 0.f;
                if (khalf == 0 && lane < 16) {
                    const LAS float* lg = LGT + lane * 48; const LAS float* lh = LGT + 768 + lane * 48;
                    const float rs = 1.f / sqrtf((LGT[1536 + lane] + LGT[1552 + lane]) * (1.f / DM) + 1e-6f);
                    const float lg0 = (lg[32] + lh[32]) * rs + brg[0], lg1 = (lg[33] + lh[33]) * rs + brg[1], lg2 = (lg[34] + lh[34]) * rs + brg[2], lg3 = (lg[35] + lh[35]) * rs + brg[3];
                    int gs = 0; float gm = lg0;
                    if (lg1 > gm) { gm = lg1; gs = 1; }
                    if (lg2 > gm) { gm = lg2; gs = 2; }
                    if (lg3 > gm) { gm = lg3; gs = 3; }
                    const float pgroup = 1.0f / (expf(lg0 - gm) + expf(lg1 - gm) + expf(lg2 - gm) + expf(lg3 - gm));
                    int i1 = 0, i2 = -1; float v1 = -3.0e38f, v2 = -3.0e38f;
                    for (int q = 0; q < 8; ++q) { const float x = (lg[gs * 8 + q] + lh[gs * 8 + q]) * rs + bre[gs * 8 + q];
                        if (x > v1) { v2 = v1; i2 = i1; v1 = x; i1 = q; } else if (x > v2) { v2 = x; i2 = q; } }
                    if (i2 < 0 || i2 == i1) i2 = (i1 + 1) & 7;
                    const float e2 = expf(v2 - v1);
                    ea = gs * 8 + i1; eb = gs * 8 + i2; ga = pgroup / (1.0f + e2); gb = pgroup * e2 / (1.0f + e2);
                    la = __hip_atomic_fetch_add(hist + ea, 1u, __ATOMIC_RELAXED, __HIP_MEMORY_SCOPE_WORKGROUP);
                    lb = __hip_atomic_fetch_add(hist + eb, 1u, __ATOMIC_RELAXED, __HIP_MEMORY_SCOPE_WORKGROUP);
                }
                __syncthreads();
                if (F.tid < 32) { const unsigned n = hist[F.tid]; hbase[F.tid] = n ? __hip_atomic_fetch_add(cnt + 64 * F.tid, n, __ATOMIC_RELAXED, __HIP_MEMORY_SCOPE_AGENT) : 0u; }
                __syncthreads();
                if (khalf == 0 && lane < 16) {
                    const int tok = tok0 + lane;
                    slot_e[tok * 2] = ea; slot_p[tok * 2] = (int)(hbase[ea] + la); slot_g[tok * 2] = ga;
                    slot_e[tok * 2 + 1] = eb; slot_p[tok * 2 + 1] = (int)(hbase[eb] + lb); slot_g[tok * 2 + 1] = gb;
                }
                __syncthreads();
            }
        }
        STAMP(15);
        if (BOTH(7)) xcd_barrier(bar); STAMP(8);
    }
    if (IN(8)) {
        unsigned char* ws = ARG_WS; const int lane = F.lane;
        const bf16* T = (const bf16*)(ws + WS_T); bf16* XS = (bf16*)(ws + WS_XS);
        const int* slot_e = (const int*)(ws + WS_SLOT_E); const int* slot_p = (const int*)(ws + WS_SLOT_P); const float* slot_g = (const float*)(ws + WS_SLOT_G);
        int* rowslot = (int*)(ws + WS_ROWSLOT); float* rowgate = (float*)(ws + WS_ROWGATE);
        const int gw = F.vcu * NWAVES + F.wave, NGW = F.G * NWAVES;
        const int mycnt = lane < 32 ? (int)__hip_atomic_load((unsigned*)(F.ctl + CW_CNT) + 64 * lane, __ATOMIC_RELAXED, __HIP_MEMORY_SCOPE_AGENT) : 0;
        const int mypad = (mycnt + 255) & ~255;
        int incl = mypad;
#pragma unroll
        for (int o = 1; o < 32; o <<= 1) { const int t = __shfl_up(incl, o); if (lane >= o) incl += t; }
        const int myoff = incl - mypad;
        for (int sl = gw; sl < 2 * M; sl += NGW) {
            const int e = slot_e[sl], p = slot_p[sl]; const int dest = __shfl(myoff, e) + p;
            const GAS v4u* src = (const GAS v4u*)(T + (size_t)(sl >> 1) * DM) + lane * 2; GAS v4u* dst = (GAS v4u*)(XS + (size_t)dest * DM) + lane * 2;
            const v4u a = src[0], b = src[1]; dst[0] = a; dst[1] = b;
            if (lane == 0) { rowslot[dest] = sl; rowgate[dest] = slot_g[sl]; }
        }
        for (int idx = gw; idx < 32 * 256; idx += NGW) {
            const int e = idx >> 8, j = idx & 255; const int c = __shfl(mycnt, e), pd = __shfl(mypad, e), of = __shfl(myoff, e);
            if (c + j < pd) { const int dest = of + c + j; GAS v4u* dst = (GAS v4u*)(XS + (size_t)dest * DM) + lane * 2; const v4u z = {0u, 0u, 0u, 0u}; dst[0] = z; dst[1] = z;
                if (lane == 0) { rowslot[dest] = -1; rowgate[dest] = 0.f; } }
        }
        if (BOTH(8)) xcd_barrier(bar); STAMP(9);
    }
    if (IN(9) || IN(10)) {
        LAS int* tile_e = (LAS int*)(F.lds + TILE_E_OFF);
        int ntiles;
        {   const int lane = F.lane;
            const int mycnt = lane < 32 ? (int)__hip_atomic_load((unsigned*)(F.ctl + CW_CNT) + 64 * lane, __ATOMIC_RELAXED, __HIP_MEMORY_SCOPE_AGENT) : 0;
            const int myt = (mycnt + 255) >> 8;
            int incl = myt;
#pragma unroll
            for (int o = 1; o < 32; o <<= 1) { const int t = __shfl_up(incl, o); if (lane >= o) incl += t; }
            ntiles = __shfl(incl, 31);
            if (F.wave == 0 && lane < 32) { for (int j = 0; j < myt; ++j) tile_e[incl - myt + j] = lane; }
            __syncthreads();
        }
        unsigned char* ws = ARG_WS;
        if (IN(9)) {
            pg8::Gemm g{(const bf16*)(ws + WS_XS), (const bf16*)(ws + WS_WGU), 0, 0, DM}; pg8::MoeOrder S{ntiles, F.G, F.vcu, tile_e};
            pg8::EpiSwiGLU E{(bf16*)(ws + WS_ACT)};
            pg8::gemm_phase<pg8::EpiSwiGLU, pg8::MoeOrder, PG8_ALIGN, PG8_SP2>(F.lds + RING_OFF, g, S, E);
            if (BOTH(9)) xcd_barrier(bar); STAMP(10);
        }
        if (IN(10)) {
            pg8::Gemm g{(const bf16*)(ws + WS_ACT), (const bf16*)(ws + WS_WD), 0, 0, DEXP}; pg8::MoeOrder S{ntiles, F.G, F.vcu, tile_e};
            pg8::EpiScatter E{(bf16*)(ws + WS_YB), (const int*)(ws + WS_ROWSLOT), (const float*)(ws + WS_ROWGATE)};
            pg8::gemm_phase<pg8::EpiScatter, pg8::MoeOrder, PG8_ALIGN, PG8_SP2>(F.lds + RING_OFF, g, S, E);
            if (BOTH(10)) xcd_barrier(bar); STAMP(11);
        }
    }
    if (IN(11)) {
        unsigned char* ws = ARG_WS; float* outp = (float*)ARG_OUT; const bf16* YB = (const bf16*)(ws + WS_YB); const int lane = F.lane;
        const int gw = F.vcu * NWAVES + F.wave, NGW = F.G * NWAVES;
        float dscale = 1.0f;
        if (RWKV_DBG) { const float dd = __hip_atomic_load((float*)(F.ctl + CW_DBG), __ATOMIC_RELAXED, __HIP_MEMORY_SCOPE_AGENT), rr = __hip_atomic_load((float*)(F.ctl + CW_DBG + 1), __ATOMIC_RELAXED, __HIP_MEMORY_SCOPE_AGENT);
            dscale = 1.0f + sqrtf(fminf(dd / fmaxf(rr, 1e-30f), 1e6f)); }
        {
            f32x4 ch[4]; unsigned long long ca[4], cb[4];
#define P11_LOAD(H_, A_, B_, tok_) do { const GAS f32x4* or_ = (const GAS f32x4*)(outp + (size_t)(tok_) * DM); \
                const GAS unsigned long long* y0_ = (const GAS unsigned long long*)(YB + (size_t)(2 * (tok_)) * DM), *y1_ = (const GAS unsigned long long*)(YB + (size_t)(2 * (tok_) + 1) * DM); \
                _Pragma("unroll") for (int j_ = 0; j_ < 4; ++j_) { H_[j_] = or_[64 * j_ + lane]; A_[j_] = y0_[64 * j_ + lane]; B_[j_] = y1_[64 * j_ + lane]; } } while (0)
            if (gw < M) P11_LOAD(ch, ca, cb, gw);
            for (int tok = gw; tok < M; tok += NGW) {
                f32x4 nh[4]; unsigned long long na[4], nb[4];
#pragma unroll
                for (int j = 0; j < 4; ++j) { nh[j] = ch[j]; na[j] = ca[j]; nb[j] = cb[j]; }
                if (tok + NGW < M) P11_LOAD(nh, na, nb, tok + NGW);
                GAS f32x4* orow = (GAS f32x4*)(outp + (size_t)tok * DM);
#pragma unroll
                for (int j = 0; j < 4; ++j) { const int q = 64 * j + lane; f32x4 h = ch[j]; const unsigned long long a = ca[j], b = cb[j];
                    h.x += __uint_as_float((unsigned)a << 16) + __uint_as_float((unsigned)b << 16);
                    h.y += __uint_as_float((unsigned)a & 0xffff0000u) + __uint_as_float((unsigned)b & 0xffff0000u);
                    h.z += __uint_as_float((unsigned)(a >> 32) << 16) + __uint_as_float((unsigned)(b >> 32) << 16);
                    h.w += __uint_as_float((unsigned)(a >> 32) & 0xffff0000u) + __uint_as_float((unsigned)(b >> 32) & 0xffff0000u);
                    if (RWKV_DBG) h = h * dscale;
                    orow[q] = h; }
#pragma unroll
                for (int j = 0; j < 4; ++j) { ch[j] = nh[j]; ca[j] = na[j]; cb[j] = nb[j]; }
            }
#undef P11_LOAD
        }
    }
    STAMP(12);
#ifndef PROBE_MULT
#define PROBE_MULT 4
#endif
    if (PROBE_K >= 0 && blockIdx.x == 0 && F.tid == 0) {
        const GAS unsigned long long* ts = (const GAS unsigned long long*)(F.ctl + CW_TS);
#ifndef PROBE_A
#define PROBE_A PROBE_K
#define PROBE_B (PROBE_K + 1)
#endif
        const unsigned long long d = (ts[PROBE_B] - ts[PROBE_A]) * PROBE_MULT, t0 = rt();
        while (rt() - t0 < d) __builtin_amdgcn_s_sleep(8);
    }
#undef IN
#undef BOTH
}

extern "C" void kernel_launch(void* const* d_in, const int* in_sizes, int n_in, void* d_out, int out_size, void* d_ws, size_t ws_size, hipStream_t stream) {
    static int grid = 0;
    if (grid == 0) {
        int dev = 0, cus = 0;
        if (hipGetDevice(&dev) != hipSuccess || hipDeviceGetAttribute(&cus, hipDeviceAttributeMultiprocessorCount, dev) != hipSuccess) { grid = -1; return; }
        if (hipFuncSetAttribute((const void*)skel_fwd, hipFuncAttributeMaxDynamicSharedMemorySize, LDS_BYTES) != hipSuccess) { grid = -1; return; }
        grid = cus;
        if (n_in != 30 || ws_size < WS_TOTAL || out_size != M * DM) { fprintf(stderr, "kernel_launch: unexpected problem (n_in %d, ws %zu, out %d)\n", n_in, ws_size, out_size); grid = -1; return; }
        if (grid != 256) fprintf(stderr, "kernel_launch: %d CUs; the phase programs assume 256\n", grid);
    }
    if (grid < 0) return;
    (void)hipMemsetAsync((char*)d_ws + WS_CTL, 0, CTL_ZERO_BYTES, stream);
    Args a{};
    for (int i = 0; i < 30; ++i) a.in[i] = (const float*)d_in[i];
    a.out = (float*)d_out; a.ws = (unsigned char*)d_ws; a.ph_lo = 0; a.ph_hi = 12;
    hipLaunchKernelGGL(skel_fwd, dim3(grid), dim3(NWAVES * 64), LDS_BYTES, stream, a);
}
```

```cpp
#include <hip/hip_runtime.h>
#include <cstdio>
#include <cstdint>
namespace pg8 {
#define PG8_LAS __attribute__((address_space(3)))
typedef unsigned short bf16_t;
typedef short bf16x8 __attribute__((ext_vector_type(8)));
typedef float f32x4 __attribute__((ext_vector_type(4)));
typedef unsigned u32x4 __attribute__((ext_vector_type(4)));
constexpr int BM = 256, BK = 64, HALF = 128, HTB = HALF * BK * 2  , STAGE_BYTES = 8 * HTB, NXCD = 8, WGM = 8;

__host__ __device__ __forceinline__ int lds_byte(int r, int c) { const int st = (r >> 4) * 2 + (c >> 5), rr = r & 15, cc = c & 31, ob = rr * 64 + cc * 2; return st * 1024 + (ob ^ (((ob >> 9) & 1) << 5)); }
__host__ __device__ __forceinline__ void stage_rc(int b, int& R, int& C) { const int st = b / 1024, sb = b % 1024, swz = sb ^ (((sb >> 9) & 1) << 5); R = (st >> 1) * 16 + swz / 64; C = (st & 1) * 32 + (swz % 64) / 2; }
__host__ __device__ __forceinline__ int perm32(int rho) { const int n = rho >> 4, i = rho & 15; return 8 * (i >> 2) + 4 * n + (i & 3); }

struct Unit { int pm, pn; };
struct Gemm { const bf16_t* A; const bf16_t* Bt; int M, N, K; };

struct StaticOrder {
    int nM, nN, nwg, G, c;
    __host__ __device__ void init(int M, int N, int G_, int c_) { nM = M / BM; nN = N / BM; nwg = nM * nN; G = G_; c = c_; }
    __host__ __device__ bool next(int i, Unit& u) const {
        const long L = (long)i * G + c; if (L >= nwg) return false;
        int wgid = (int)L; { const int q = nwg / NXCD, r = nwg % NXCD, xcd = wgid % NXCD, off = wgid / NXCD; wgid = (xcd < r ? xcd * (q + 1) : r * (q + 1) + (xcd - r) * q) + off; }
        const int nig = WGM * nN, gid = wgid / nig, fm = gid * WGM, gsz = (nM - fm) < WGM ? (nM - fm) : WGM;
        u.pm = fm + ((wgid % nig) % gsz); u.pn = (wgid % nig) / gsz; return true;
    }
    __device__ __forceinline__ void a_ready(const Unit&) const {}
    __device__ __forceinline__ void done(const Unit&) const {}
};

__device__ __forceinline__ unsigned cvt_pk_bf16(float lo, float hi) { unsigned r; asm volatile("v_cvt_pk_bf16_f32 %0, %1, %2" : "=v"(r) : "v"(lo), "v"(hi)); return r; }
typedef float f32x2 __attribute__((ext_vector_type(2)));
__device__ __forceinline__ f32x2 gelu_pk(f32x2 v) {
    const f32x2 av = __builtin_elementwise_abs(v), d = av * 0.2316418882f + 1.0f;
    f32x2 t; t.x = __builtin_amdgcn_rcpf(d.x); t.y = __builtin_amdgcn_rcpf(d.y);
    f32x2 q = t * 0.5307027145f + (-0.7265760135f); q = q * t + 0.7107068705f; q = q * t + (-0.142248368f); q = q * t + 0.127414796f; q = q * t;
    const f32x2 s = (v * v) * (-0.72134752044f);
    f32x2 e; e.x = __builtin_amdgcn_exp2f(s.x); e.y = __builtin_amdgcn_exp2f(s.y);
    const f32x2 m = v * (q * e), r = v - m;
    f32x2 o; o.x = v.x < 0.f ? m.x : r.x; o.y = v.y < 0.f ? m.y : r.y; return o;
}

template <int ACT  > struct EpiBf16 {
    static constexpr bool PERM = true, AFTER_DRAIN = false; static_assert(ACT == 0 || ACT == 1, "EpiBf16: ACT is 0 (none) or 1 (gelu_pk)");
    bf16_t* O; int ldc; const float* bias; int split_cols; size_t split_stride; float scale0;
    __device__ __forceinline__ void operator()(const f32x4 (&acc)[2][2][4][2], const Unit& u, int wr, int wc, int fr, int fq) const {
        const int row0 = u.pm * BM + wr * 64 + fr; int colt = u.pn * BM; bf16_t* base = O;
        float sc = 1.f; if (split_cols) { const int t = colt / split_cols; base += (size_t)t * split_stride; colt -= t * split_cols; if (t == 0) sc = scale0; }
        const int col0 = colt + wc * 32 + 8 * fq, bcol0 = u.pn * BM + wc * 32 + 8 * fq;
        f32x4 bv[2][2];
#pragma unroll
        for (int bj = 0; bj < 2; ++bj)
#pragma unroll
            for (int n = 0; n < 2; ++n) bv[bj][n] = bias ? *(const f32x4*)(bias + bcol0 + bj * HALF + 4 * n) : (f32x4){0.f, 0.f, 0.f, 0.f};
#pragma unroll
        for (int ai = 0; ai < 2; ++ai)
#pragma unroll
            for (int m = 0; m < 4; ++m) { bf16_t* rowp = base + (size_t)(row0 + ai * HALF + m * 16) * ldc + col0;
#pragma unroll
                for (int bj = 0; bj < 2; ++bj) { f32x4 v0 = acc[ai][bj][m][0] + bv[bj][0], v1 = acc[ai][bj][m][1] + bv[bj][1];
                    if (ACT == 1) { f32x2 a = gelu_pk((f32x2){v0[0], v0[1]}), b = gelu_pk((f32x2){v0[2], v0[3]}), c = gelu_pk((f32x2){v1[0], v1[1]}), d = gelu_pk((f32x2){v1[2], v1[3]});
                        v0 = (f32x4){a.x, a.y, b.x, b.y}; v1 = (f32x4){c.x, c.y, d.x, d.y}; }
                    v0 = v0 * sc; v1 = v1 * sc; u32x4 w; w.x = cvt_pk_bf16(v0[0], v0[1]); w.y = cvt_pk_bf16(v0[2], v0[3]); w.z = cvt_pk_bf16(v1[0], v1[1]); w.w = cvt_pk_bf16(v1[2], v1[3]);
                    *(u32x4*)(rowp + bj * HALF) = w; } }
    }
};

struct PanelStats {
    unsigned* xbuf;
    unsigned* cnt;
    unsigned* tmo;
    int ntn; float eps;
    unsigned code;
    __device__ __forceinline__ bool run(const f32x4 (&v)[2][2][4][2], const Unit& u, int wr, int wc, int fr, int fq, PG8_LAS unsigned char* lds, int wid, int lane) const {
        typedef float f32x2v __attribute__((ext_vector_type(2)));
        PG8_LAS f32x2v* P = (PG8_LAS f32x2v*)lds;
        PG8_LAS f32x2v* S = (PG8_LAS f32x2v*)(lds + 8192);
        PG8_LAS unsigned* flag = (PG8_LAS unsigned*)(lds + 8192 + 2048);
#pragma unroll
        for (int ai = 0; ai < 2; ++ai)
#pragma unroll
            for (int m = 0; m < 4; ++m) {
                float s = 0.f;
#pragma unroll
                for (int bj = 0; bj < 2; ++bj)
#pragma unroll
                    for (int n = 0; n < 2; ++n) { const f32x4 x = v[ai][bj][m][n]; s += (x[0] + x[1]) + (x[2] + x[3]); }
                s += __shfl_xor(s, 16); s += __shfl_xor(s, 32);
                const float mw = s * (1.0f / 64.0f); float q = 0.f;
#pragma unroll
                for (int bj = 0; bj < 2; ++bj)
#pragma unroll
                    for (int n = 0; n < 2; ++n) { const f32x4 d = v[ai][bj][m][n] - mw; q += (d[0] * d[0] + d[1] * d[1]) + (d[2] * d[2] + d[3] * d[3]); }
                q += __shfl_xor(q, 16); q += __shfl_xor(q, 32);
                if (fq == 0) P[(ai * HALF + wr * 64 + m * 16 + fr) * 4 + wc] = (f32x2v){mw, q};
            }
        asm volatile("s_waitcnt lgkmcnt(0)" ::: "memory"); __builtin_amdgcn_s_barrier(); asm volatile("" ::: "memory");
#if defined(BROKEN_EXCHANGE_NO_WAIT)
#warning BROKEN CONTROL BUILD: the row-statistics exchange does not wait; results are wrong by design
        if (blockIdx.x >= 64) { const long long t0_ = clock64(); while (clock64() - t0_ < 60000) __builtin_amdgcn_s_sleep(8); }
#endif
        const int row = wid * 32 + (lane & 31);
        if (lane < 32) {
            const f32x2v a = P[row * 4 + 0], b = P[row * 4 + 1], c = P[row * 4 + 2], d = P[row * 4 + 3];
            const float mt = (a.x + b.x + c.x + d.x) * 0.25f;
            const float da = a.x - mt, db = b.x - mt, dc = c.x - mt, dd = d.x - mt;
            const float m2 = (a.y + b.y) + (c.y + d.y) + 64.0f * ((da * da + db * db) + (dc * dc + dd * dd));
            unsigned long long* slot = (unsigned long long*)xbuf + ((size_t)(u.pm * BM + row) * 4 + u.pn);
            __hip_atomic_store(slot, ((unsigned long long)__float_as_uint(m2) << 32) | __float_as_uint(mt), __ATOMIC_RELAXED, __HIP_MEMORY_SCOPE_AGENT);
        }
        asm volatile("s_waitcnt vmcnt(0)" ::: "memory");
        if (lane == 0) __hip_atomic_fetch_add(cnt + 64 * u.pm, 1u, __ATOMIC_RELAXED, __HIP_MEMORY_SCOPE_AGENT);
        if (wid == 0) {
            bool dead = false; const unsigned long long t0 = __builtin_amdgcn_s_memrealtime(); const unsigned want = 8u * (unsigned)ntn;
            for (;;) {
#if defined(BROKEN_EXCHANGE_NO_WAIT)
                break;
#endif
                if ((unsigned)__builtin_amdgcn_readfirstlane(__hip_atomic_load(cnt + 64 * u.pm, __ATOMIC_RELAXED, __HIP_MEMORY_SCOPE_AGENT)) >= want) break;
                if (__builtin_amdgcn_s_memrealtime() - t0 > 2000000ull) {
                    if (lane == 0) { unsigned expect = 0u; __hip_atomic_compare_exchange_strong(tmo + 1, &expect, code | (unsigned)(u.pm & 0xff), __ATOMIC_RELAXED, __ATOMIC_RELAXED, __HIP_MEMORY_SCOPE_AGENT);
                                     __hip_atomic_store(tmo, 1u, __ATOMIC_RELAXED, __HIP_MEMORY_SCOPE_AGENT); }
                    dead = true; break; }
                __builtin_amdgcn_s_sleep(2);
            }
            __builtin_amdgcn_fence(__ATOMIC_ACQUIRE, "agent");
            if (lane == 0) flag[0] = dead ? 1u : 0u;
        }
        asm volatile("s_waitcnt vmcnt(0) lgkmcnt(0)" ::: "memory"); __builtin_amdgcn_s_barrier(); asm volatile("" ::: "memory");
        const bool bad = flag[0] != 0u;
        if (lane < 32) {
            const unsigned long long* slot = (const unsigned long long*)xbuf + (size_t)(u.pm * BM + row) * 4; float mt[4], m2[4]; float ms = 0.f;
#pragma unroll
            for (int t = 0; t < 4; ++t) { if (t < ntn) { const unsigned long long w = __hip_atomic_load(slot + t, __ATOMIC_RELAXED, __HIP_MEMORY_SCOPE_AGENT); mt[t] = __uint_as_float((unsigned)w); m2[t] = __uint_as_float((unsigned)(w >> 32)); } else { mt[t] = 0.f; m2[t] = 0.f; } ms += mt[t]; }
            const float mean = ms / (float)ntn; float q = 0.f;
#pragma unroll
            for (int t = 0; t < 4; ++t) if (t < ntn) { const float dm = mt[t] - mean; q += m2[t] + 256.0f * dm * dm; }
            S[row] = (f32x2v){mean, 1.0f / sqrtf(q / (256.0f * (float)ntn) + eps)};
        }
        asm volatile("s_waitcnt lgkmcnt(0)" ::: "memory"); __builtin_amdgcn_s_barrier(); asm volatile("" ::: "memory");
        return bad;
    }
};
struct EpiLnRes {
    static constexpr bool PERM = false, AFTER_DRAIN = true;
    const float* base; float* out; int ldc; const float* bias; PanelStats st; unsigned poison;
    __device__ __forceinline__ void fused(f32x4 (&acc)[2][2][4][2], const Unit& u, int wr, int wc, int fr, int fq, PG8_LAS unsigned char* lds, int wid, int lane) const {
        typedef float f32x2v __attribute__((ext_vector_type(2)));
        const PG8_LAS f32x2v* S = (const PG8_LAS f32x2v*)(lds + 8192);
        const int col0 = u.pn * BM + wc * 32 + 4 * fq;
#pragma unroll
        for (int bj = 0; bj < 2; ++bj)
#pragma unroll
            for (int n = 0; n < 2; ++n) { const f32x4 bv = bias ? *(const f32x4*)(bias + col0 + bj * HALF + n * 16) : (f32x4){0.f, 0.f, 0.f, 0.f};
#pragma unroll
                for (int ai = 0; ai < 2; ++ai)
#pragma unroll
                    for (int m = 0; m < 4; ++m) acc[ai][bj][m][n] += bv; }
        f32x4 pre[4][2][2];
#pragma unroll
        for (int m = 0; m < 4; ++m) { const size_t off = (size_t)(u.pm * BM + wr * 64 + m * 16 + fr) * ldc + col0;
#pragma unroll
            for (int bj = 0; bj < 2; ++bj)
#pragma unroll
                for (int n = 0; n < 2; ++n) pre[m][bj][n] = *(const f32x4*)(base + off + bj * HALF + n * 16); }
        const bool bad = st.run(acc, u, wr, wc, fr, fq, lds, wid, lane) || poison != 0u;
        const float qnan = __builtin_nanf("");
#pragma unroll
        for (int ai = 0; ai < 2; ++ai)
#pragma unroll
            for (int m = 0; m < 4; ++m) { const int r = ai * HALF + wr * 64 + m * 16 + fr; const f32x2v sr = S[r]; const size_t off = (size_t)(u.pm * BM + r) * ldc + col0;
#pragma unroll
                for (int bj = 0; bj < 2; ++bj)
#pragma unroll
                    for (int n = 0; n < 2; ++n) { const f32x4 bs = ai == 0 ? pre[m][bj][n] : *(const f32x4*)(base + off + bj * HALF + n * 16); f32x4 o = bs + (acc[ai][bj][m][n] - sr.x) * sr.y;
                        if (bad) o = (f32x4){qnan, qnan, qnan, qnan}; *(f32x4*)(out + off + bj * HALF + n * 16) = o; }
                if (m & 1) asm volatile("" ::: "memory"); }
    }
};
struct EpiLnResLn {
    static constexpr bool PERM = false, AFTER_DRAIN = true;
    const float* base; float* out; bf16_t* xn; int ldc; const float* bias; PanelStats st1, st2; unsigned poison;
    __device__ __forceinline__ void fused(f32x4 (&acc)[2][2][4][2], const Unit& u, int wr, int wc, int fr, int fq, PG8_LAS unsigned char* lds, int wid, int lane) const {
        typedef float f32x2v __attribute__((ext_vector_type(2))); typedef unsigned u32x2v __attribute__((ext_vector_type(2)));
        const PG8_LAS f32x2v* S = (const PG8_LAS f32x2v*)(lds + 8192);
        const int col0 = u.pn * BM + wc * 32 + 4 * fq;
#pragma unroll
        for (int bj = 0; bj < 2; ++bj)
#pragma unroll
            for (int n = 0; n < 2; ++n) { const f32x4 bv = bias ? *(const f32x4*)(bias + col0 + bj * HALF + n * 16) : (f32x4){0.f, 0.f, 0.f, 0.f};
#pragma unroll
                for (int ai = 0; ai < 2; ++ai)
#pragma unroll
                    for (int m = 0; m < 4; ++m) acc[ai][bj][m][n] += bv; }
        bool bad = st1.run(acc, u, wr, wc, fr, fq, lds, wid, lane) || poison != 0u;
        const float qnan = __builtin_nanf("");
#pragma unroll
        for (int ai = 0; ai < 2; ++ai)
#pragma unroll
            for (int m = 0; m < 4; ++m) { const int r = ai * HALF + wr * 64 + m * 16 + fr; const f32x2v sr = S[r]; const size_t off = (size_t)(u.pm * BM + r) * ldc + col0;
#pragma unroll
                for (int bj = 0; bj < 2; ++bj)
#pragma unroll
                    for (int n = 0; n < 2; ++n) { const f32x4 bs = *(const f32x4*)(base + off + bj * HALF + n * 16); acc[ai][bj][m][n] = bs + (acc[ai][bj][m][n] - sr.x) * sr.y; }
                asm volatile("" : "+v"(acc[ai][0][m][0]), "+v"(acc[ai][0][m][1]), "+v"(acc[ai][1][m][0]), "+v"(acc[ai][1][m][1]));
                if (m & 1) asm volatile("" ::: "memory"); }
        const bool bad1 = bad;
        bad = st2.run(acc, u, wr, wc, fr, fq, lds, wid, lane) || bad;
#pragma unroll
        for (int ai = 0; ai < 2; ++ai)
#pragma unroll
            for (int m = 0; m < 4; ++m) { const int r = ai * HALF + wr * 64 + m * 16 + fr; const f32x2v sr = S[r]; const size_t off = (size_t)(u.pm * BM + r) * ldc + col0;
#pragma unroll
                for (int bj = 0; bj < 2; ++bj)
#pragma unroll
                    for (int n = 0; n < 2; ++n) { const f32x4 x1 = acc[ai][bj][m][n]; *(f32x4*)(out + off + bj * HALF + n * 16) = bad1 ? (f32x4){qnan, qnan, qnan, qnan} : x1;
                        const f32x4 o = (x1 - sr.x) * sr.y; u32x2v w; w.x = cvt_pk_bf16(o[0], o[1]); w.y = cvt_pk_bf16(o[2], o[3]);
                        if (bad) { w.x = 0x7fc07fc0u; w.y = 0x7fc07fc0u; } *(u32x2v*)(xn + off + bj * HALF + n * 16) = w; }
                asm volatile("" ::: "memory"); }
    }
};

template <class Epi, class Sched, bool ALIGN_EPI = false, bool SP2 = false, bool GATHER = false>
__device__ __forceinline__ void gemm_phase(PG8_LAS unsigned char* lds, const Gemm g, const Sched& S, const Epi& E) {
    const int tid = threadIdx.x, wid = __builtin_amdgcn_readfirstlane(tid >> 6), lane = tid & 63, wr = wid >> 2, wc = wid & 3, fr = lane & 15, fq = lane >> 4;
    const int K = g.K, nt = K / BK;
    unsigned voffA[2], voffB[2]; int gR[2], gC[2];
#pragma unroll
    for (int i = 0; i < 2; ++i) { int R, C; stage_rc(tid * 16 + i * 8192, R, C); const int Rb = Epi::PERM ? ((R & ~31) + perm32(R & 31)) : R;
        voffA[i] = (unsigned)(R * K + C) * 2u; voffB[i] = (unsigned)(Rb * K + C) * 2u; gR[i] = R; gC[i] = C * 2; }
    unsigned vA0[2], vA1[2], vN0[2], vN1[2];
#define PG8_GOFF(D0, D1, U_) do { _Pragma("unroll") for (int _i = 0; _i < 2; ++_i) { if constexpr (GATHER) { D0[_i] = S.a_row_off(U_, gR[_i]) + (unsigned)gC[_i]; D1[_i] = S.a_row_off(U_, HALF + gR[_i]) + (unsigned)gC[_i]; } \
        else { D0[_i] = voffA[_i]; D1[_i] = voffA[_i]; } } } while (0)
    const size_t kstep = (size_t)(BK * 2);
    const size_t hstep = (size_t)HALF * K * 2;
    const size_t tstep = 2 * hstep;
    const size_t hstepA = GATHER ? 0 : hstep, tstepA = GATHER ? 0 : tstep;
    const unsigned ldsw = (unsigned)wid * 1024u;
    const int aoff = lds_byte(wr * 64 + fr, fq * 8), boff = lds_byte(wc * 32 + fr, fq * 8);
#define PG8_SA(b, h) (((b) * 2 + (h)) * HTB)
#define PG8_SB(b, h) ((4 + (b) * 2 + (h)) * HTB)
#define PG8_STAGE(bufoff, gbase, voff) do { _Pragma("unroll") for (int _i = 0; _i < 2; ++_i) \
        __builtin_amdgcn_global_load_lds((const unsigned*)((const char*)(gbase) + (voff)[_i]), (PG8_LAS unsigned*)(lds + (bufoff) + ldsw + _i * 8192), 16, 0, 0); } while (0)
#define PG8_LDA(dst, b, h) do { _Pragma("unroll") for (int m = 0; m < 4; ++m) _Pragma("unroll") for (int k = 0; k < 2; ++k) dst[m][k] = *(const PG8_LAS bf16x8*)(lds + PG8_SA(b, h) + aoff + m * 2048 + k * 1024); } while (0)
#define PG8_LDB(dst, b, h) do { _Pragma("unroll") for (int n = 0; n < 2; ++n) _Pragma("unroll") for (int k = 0; k < 2; ++k) dst[n][k] = *(const PG8_LAS bf16x8*)(lds + PG8_SB(b, h) + boff + n * 2048 + k * 1024); } while (0)
#define PG8_MMA(ai, bj, At, Bt) do { __builtin_amdgcn_s_setprio(1); _Pragma("unroll") for (int m = 0; m < 4; ++m) _Pragma("unroll") for (int n = 0; n < 2; ++n) _Pragma("unroll") for (int k = 0; k < 2; ++k) \
        acc[ai][bj][m][n] = __builtin_amdgcn_mfma_f32_16x16x32_bf16(Bt[n][k], At[m][k], acc[ai][bj][m][n], 0, 0, 0); __builtin_amdgcn_s_setprio(0); } while (0)
#define PG8_WAIT_V(n) asm volatile("s_waitcnt vmcnt(" #n ")" ::: "memory")
#define PG8_WAIT_L(n) asm volatile("s_waitcnt lgkmcnt(" #n ")" ::: "memory")
#define PG8_BAR __builtin_amdgcn_s_barrier()
#define PG8_SCHED __builtin_amdgcn_sched_barrier(0)
    Unit cur, nxt; int ui = 0;
    if (!S.next(0, cur)) return;
    f32x4 acc[2][2][4][2];
#pragma unroll
    for (int a = 0; a < 2; ++a)
#pragma unroll
        for (int b = 0; b < 2; ++b)
#pragma unroll
            for (int m = 0; m < 4; ++m)
#pragma unroll
                for (int n = 0; n < 2; ++n) acc[a][b][m][n] = (f32x4){0.f, 0.f, 0.f, 0.f};
    bf16x8 At[4][2], B0[2][2], B1[2][2];
    const char* cA = (const char*)g.A + (size_t)cur.pm * tstepA; const char* cB = (const char*)g.Bt + (size_t)cur.pn * tstep;
    PG8_GOFF(vA0, vA1, cur);
    S.a_ready(cur);
    if constexpr (SP2) {
        PG8_STAGE(PG8_SB(0, 0), cB, voffB); PG8_STAGE(PG8_SB(0, 1), cB + hstep, voffB); PG8_STAGE(PG8_SA(0, 0), cA, vA0); PG8_STAGE(PG8_SA(0, 1), cA + hstepA, vA1);
        if (wr == 1) PG8_BAR;
        PG8_WAIT_V(2); PG8_BAR;
        PG8_STAGE(PG8_SB(1, 0), cB + kstep, voffB); PG8_STAGE(PG8_SA(1, 0), cA + kstep, vA0); PG8_STAGE(PG8_SB(1, 1), cB + hstep + kstep, voffB);
        PG8_WAIT_V(6); PG8_BAR;
    } else {
        PG8_STAGE(PG8_SB(0, 0), cB, voffB); PG8_STAGE(PG8_SA(0, 0), cA, voffA); PG8_STAGE(PG8_SB(0, 1), cB + hstep, voffB); PG8_STAGE(PG8_SA(0, 1), cA + hstep, voffA);
        if (wr == 1) PG8_BAR;
        PG8_WAIT_V(4); PG8_BAR;
        PG8_STAGE(PG8_SB(1, 0), cB + kstep, voffB); PG8_STAGE(PG8_SA(1, 0), cA + kstep, voffA); PG8_STAGE(PG8_SB(1, 1), cB + hstep + kstep, voffB);
        PG8_WAIT_V(6); PG8_BAR;
    }
    for (;;) {
        const bool has_next = S.next(ui + 1, nxt);
        const char* nA = has_next ? (const char*)g.A + (size_t)nxt.pm * tstepA : cA; const char* nB = has_next ? (const char*)g.Bt + (size_t)nxt.pn * tstep : cB;
        if (has_next) PG8_GOFF(vN0, vN1, nxt); else { vN0[0] = vA0[0]; vN0[1] = vA0[1]; vN1[0] = vA1[0]; vN1[1] = vA1[1]; }
        for (int t = 0; t < nt; t += 2) {
            const bool last = (t == nt - 2);
            const char* a1 = cA + (size_t)(t + 1) * kstep;
            const char* a2 = last ? nA : cA + (size_t)(t + 2) * kstep; const char* b2 = last ? nB : cB + (size_t)(t + 2) * kstep;
            const char* a3 = a2 + kstep; const char* b3 = b2 + kstep;
            if (last && has_next) S.a_ready(nxt);
            unsigned vX0[2], vX1[2];
            vX0[0] = last ? vN0[0] : vA0[0]; vX0[1] = last ? vN0[1] : vA0[1]; vX1[0] = last ? vN1[0] : vA1[0]; vX1[1] = last ? vN1[1] : vA1[1];
            if constexpr (SP2) {
            PG8_LDB(B0, 0, 0); PG8_LDB(B1, 0, 1); PG8_SCHED; PG8_LDA(At, 0, 0); PG8_STAGE(PG8_SA(1, 1), a1 + hstepA, vA1);
            PG8_WAIT_V(8); PG8_WAIT_L(0); PG8_BAR; PG8_MMA(0, 0, At, B0); PG8_MMA(0, 1, At, B1); PG8_BAR; PG8_SCHED;
            PG8_LDA(At, 0, 1); PG8_STAGE(PG8_SB(0, 0), b2, voffB); PG8_STAGE(PG8_SB(0, 1), b2 + hstep, voffB); PG8_STAGE(PG8_SA(0, 0), a2, vX0);
            PG8_WAIT_V(8); PG8_WAIT_L(0); PG8_BAR; PG8_MMA(1, 0, At, B0); PG8_MMA(1, 1, At, B1); PG8_BAR; PG8_SCHED;
            PG8_LDB(B0, 1, 0); PG8_LDB(B1, 1, 1); PG8_SCHED; PG8_LDA(At, 1, 0); PG8_STAGE(PG8_SA(0, 1), a2 + hstepA, vX1);
            PG8_WAIT_V(8); PG8_WAIT_L(0); PG8_BAR; PG8_MMA(0, 0, At, B0); PG8_MMA(0, 1, At, B1); PG8_BAR; PG8_SCHED;
            PG8_LDA(At, 1, 1); PG8_STAGE(PG8_SB(1, 0), b3, voffB); PG8_STAGE(PG8_SB(1, 1), b3 + hstep, voffB); PG8_STAGE(PG8_SA(1, 0), a3, vX0);
            PG8_WAIT_V(8); PG8_WAIT_L(0); PG8_BAR; PG8_MMA(1, 0, At, B0); PG8_MMA(1, 1, At, B1); PG8_BAR; PG8_SCHED;
            } else {
            PG8_LDB(B0, 0, 0); PG8_SCHED; PG8_LDA(At, 0, 0); PG8_STAGE(PG8_SA(1, 1), a1 + hstep, voffA);
            PG8_WAIT_L(8); PG8_BAR; PG8_WAIT_L(0); PG8_MMA(0, 0, At, B0); PG8_BAR; PG8_SCHED;
            PG8_LDB(B1, 0, 1); PG8_STAGE(PG8_SB(0, 0), b2, voffB);
            PG8_BAR; PG8_WAIT_L(0); PG8_MMA(0, 1, At, B1); PG8_BAR;
            PG8_LDA(At, 0, 1); PG8_STAGE(PG8_SA(0, 0), a2, voffA);
            PG8_BAR; PG8_WAIT_L(0); PG8_MMA(1, 0, At, B0); PG8_BAR; PG8_SCHED;
            PG8_STAGE(PG8_SB(0, 1), b2 + hstep, voffB);
            PG8_WAIT_V(6); PG8_BAR; PG8_MMA(1, 1, At, B1); PG8_BAR;
            PG8_LDB(B0, 1, 0); PG8_SCHED; PG8_LDA(At, 1, 0); PG8_STAGE(PG8_SA(0, 1), a2 + hstep, voffA);
            PG8_WAIT_L(8); PG8_BAR; PG8_WAIT_L(0); PG8_MMA(0, 0, At, B0); PG8_BAR; PG8_SCHED;
            PG8_LDB(B1, 1, 1); PG8_STAGE(PG8_SB(1, 0), b3, voffB);
            PG8_BAR; PG8_WAIT_L(0); PG8_MMA(0, 1, At, B1); PG8_BAR;
            PG8_LDA(At, 1, 1); PG8_STAGE(PG8_SA(1, 0), a3, voffA);
            PG8_BAR; PG8_WAIT_L(0); PG8_MMA(1, 0, At, B0); PG8_BAR; PG8_SCHED;
            PG8_STAGE(PG8_SB(1, 1), b3 + hstep, voffB);
            PG8_WAIT_V(6); PG8_BAR; PG8_MMA(1, 1, At, B1); PG8_BAR;
            }
        }
        if constexpr (ALIGN_EPI) { if (wr == 0) PG8_BAR; }
        if constexpr (!Epi::AFTER_DRAIN) { E(acc, cur, wr, wc, fr, fq); S.done(cur); }
        if (!has_next) break;
#pragma unroll
        for (int a = 0; a < 2; ++a)
#pragma unroll
            for (int b = 0; b < 2; ++b)
#pragma unroll
                for (int m = 0; m < 4; ++m)
#pragma unroll
                    for (int n = 0; n < 2; ++n) acc[a][b][m][n] = (f32x4){0.f, 0.f, 0.f, 0.f};
        cur = nxt; cA = nA; cB = nB; ++ui; vA0[0] = vN0[0]; vA0[1] = vN0[1]; vA1[0] = vN1[0]; vA1[1] = vN1[1];
        if constexpr (ALIGN_EPI) { if (wr == 1) PG8_BAR; }
    }
    PG8_WAIT_V(0);
    if constexpr (!ALIGN_EPI) { if (wr == 0) PG8_BAR; }
    PG8_BAR;
    if constexpr (Epi::AFTER_DRAIN) { E.fused(acc, cur, wr, wc, fr, fq, lds, wid, lane); S.done(cur); }
#undef PG8_GOFF
#undef PG8_SA
#undef PG8_SB
#undef PG8_STAGE
#undef PG8_LDA
#undef PG8_LDB
#undef PG8_MMA
#undef PG8_WAIT_V
#undef PG8_WAIT_L
#undef PG8_BAR
#undef PG8_SCHED
}
}

#ifndef PG8_SP2
#define PG8_SP2 true
#endif
#ifndef PG8_ALIGN
#define PG8_ALIGN true
#endif

namespace pg8 {
struct EpiResF32 {
    static constexpr bool PERM = false, AFTER_DRAIN = false;
    const float* base; float* out; int ldc;
    __device__ __forceinline__ void operator()(const f32x4 (&acc)[2][2][4][2], const Unit& u, int wr, int wc, int fr, int fq) const {
        const int col0 = u.pn * BM + wc * 32 + 4 * fq;
#pragma unroll
        for (int ai = 0; ai < 2; ++ai)
#pragma unroll
            for (int m = 0; m < 4; ++m) { const size_t off = (size_t)(u.pm * BM + ai * HALF + wr * 64 + m * 16 + fr) * ldc + col0;
#pragma unroll
                for (int bj = 0; bj < 2; ++bj)
#pragma unroll
                    for (int n = 0; n < 2; ++n) { const f32x4 bs = *(const f32x4*)(base + off + bj * HALF + n * 16); *(f32x4*)(out + off + bj * HALF + n * 16) = bs + acc[ai][bj][m][n]; }
                asm volatile("" ::: "memory"); }
    }
};
struct EpiSwiGLU {
    static constexpr bool PERM = true, AFTER_DRAIN = false;
    bf16_t* O;
    __device__ __forceinline__ void operator()(const f32x4 (&acc)[2][2][4][2], const Unit& u, int wr, int wc, int fr, int fq) const {
        const int row0 = u.pm * BM + wr * 64 + fr; const int col0 = (u.pn & 3) * 128 + wc * 32 + 8 * fq;
#pragma unroll
        for (int ai = 0; ai < 2; ++ai)
#pragma unroll
            for (int m = 0; m < 4; ++m) { bf16_t* rowp = O + (size_t)(row0 + ai * HALF + m * 16) * 512 + col0;
                f32x4 g0 = acc[ai][0][m][0], g1 = acc[ai][0][m][1]; const f32x4 u0 = acc[ai][1][m][0], u1 = acc[ai][1][m][1];
#pragma unroll
                for (int e = 0; e < 4; ++e) { g0[e] = g0[e] * __builtin_amdgcn_rcpf(1.0f + __expf(-g0[e])) * u0[e]; g1[e] = g1[e] * __builtin_amdgcn_rcpf(1.0f + __expf(-g1[e])) * u1[e]; }
                u32x4 w; w.x = cvt_pk_bf16(g0[0], g0[1]); w.y = cvt_pk_bf16(g0[2], g0[3]); w.z = cvt_pk_bf16(g1[0], g1[1]); w.w = cvt_pk_bf16(g1[2], g1[3]);
                *(u32x4*)rowp = w; asm volatile("" ::: "memory"); }
    }
};
struct EpiScatter {
    static constexpr bool PERM = true, AFTER_DRAIN = false;
    bf16_t* Y; const int* rowslot; const float* rowgate;
    __device__ __forceinline__ void operator()(const f32x4 (&acc)[2][2][4][2], const Unit& u, int wr, int wc, int fr, int fq) const {
        const int row0 = u.pm * BM + wr * 64 + fr; const int col0 = (u.pn & 3) * BM + wc * 32 + 8 * fq;
#pragma unroll
        for (int ai = 0; ai < 2; ++ai)
#pragma unroll
            for (int m = 0; m < 4; ++m) { const int r = row0 + ai * HALF + m * 16; const int slot = rowslot[r]; const float gt = rowgate[r];
                if (slot >= 0) { bf16_t* rowp = Y + (size_t)slot * 1024 + col0;
#pragma unroll
                    for (int bj = 0; bj < 2; ++bj) { const f32x4 v0 = acc[ai][bj][m][0] * gt, v1 = acc[ai][bj][m][1] * gt;
                        u32x4 w; w.x = cvt_pk_bf16(v0[0], v0[1]); w.y = cvt_pk_bf16(v0[2], v0[3]); w.z = cvt_pk_bf16(v1[0], v1[1]); w.w = cvt_pk_bf16(v1[2], v1[3]);
                        *(u32x4*)(rowp + bj * HALF) = w; } }
                asm volatile("" ::: "memory"); }
    }
};
struct MoeOrder {
    int ntiles, G, c; const PG8_LAS int* tile_e; const int* rowtok;
    __device__ __forceinline__ unsigned a_row_off(const Unit& u, int r) const { const int tk = rowtok[u.pm * BM + r]; return (unsigned)(tk < 0 ? 0 : tk) * 2048u; }
    __device__ __forceinline__ bool next(int i, Unit& u) const {
        const int L = i * G + c; if (L >= ntiles * 4) return false;
        const int ti = L >> 2; const int e = __builtin_amdgcn_readfirstlane(tile_e[ti]);
        u.pm = ti; u.pn = e * 4 + (L & 3); return true;
    }
    __device__ __forceinline__ void a_ready(const Unit&) const {}
    __device__ __forceinline__ void done(const Unit&) const {}
};
struct G1Order : StaticOrder {
    __device__ __forceinline__ bool next(int i, Unit& u) const { if (!StaticOrder::next(i, u)) return false; if (u.pn >= 11) u.pn = 12; return true; }
};
struct P3Order {
    int c;
    __device__ __forceinline__ bool next(int i, Unit& u) const {
        if (c < 64) { if (i > 0) return false; u.pm = c; u.pn = 11; return true; }
        const int L = i * 192 + (c - 64); if (L >= 384) return false; u.pm = L / 6; u.pn = L % 6; return true; }
    __device__ __forceinline__ void a_ready(const Unit&) const {}
    __device__ __forceinline__ void done(const Unit&) const {}
};
}


#include <hip/hip_bf16.h>
#include <cmath>
namespace attn_body {
using bf16=__hip_bfloat16;
using bf16x8=__attribute__((ext_vector_type(8)))short;
using s16x4=__attribute__((ext_vector_type(4)))short;
using f32x16=__attribute__((ext_vector_type(16)))float;
using u32x4=__attribute__((ext_vector_type(4)))unsigned;
constexpr int BATCH=8,NHEAD=16,SEQ=2048,D=64,QP=3328,OP=1024;
constexpr int NW=8,QBLK=32,QB=QBLK*NW,KVBLK=64,NQB=SEQ/QB;
constexpr int ATTN_UNIT_ROWS=QB;
__device__ __forceinline__ int crow(int r,int hi){return (r&3)+8*(r>>2)+4*hi;}
#define SBAR() __builtin_amdgcn_sched_barrier(0)
__device__ __forceinline__ void cmask(f32x16&p0,f32x16&p1,int jb,int qrel,int hi){
  const float NEG=-INFINITY;
  if(jb>(qrel>>6)){
  #pragma unroll
  for(int r=0;r<16;++r){p0[r]=NEG;p1[r]=NEG;}}
}

constexpr int NSLOT=3, SLOTB=8192;
constexpr int LDS_K=0, LDS_V=NSLOT*SLOTB, LDS_WS=2*NSLOT*SLOTB, LDS_OST=LDS_WS+NW*64*4, LDS_BYTES=LDS_OST+NW*4096;
constexpr float C2=0.125f*1.4426950408889634f;
__device__ __forceinline__ void glds16(const void*gsrc,unsigned lds_dst){unsigned keep;
  asm volatile("s_mov_b32 %0, m0\n\ts_mov_b32 m0, %2\n\ts_nop 0\n\tglobal_load_lds_dwordx4 %1, off\n\ts_mov_b32 m0, %0":"=&s"(keep):"v"(gsrc),"s"(lds_dst):"memory");}
__device__ __forceinline__ float max3f(float a,float b,float c){float r;asm("v_max3_f32 %0, %1, %2, %3":"=v"(r):"v"(a),"v"(b),"v"(c));return r;}
__device__ __forceinline__ float max2f(float a,float b){float r;asm("v_max_f32_e32 %0, %1, %2":"=v"(r):"v"(a),"v"(b));return r;}
__device__ __forceinline__ float fadd_s(float a,float b){float r;asm("v_add_f32_e32 %0, %1, %2":"=v"(r):"v"(a),"v"(b));return r;}
__device__ __forceinline__ float fsub_s(float a,float b){float r;asm("v_sub_f32_e32 %0, %1, %2":"=v"(r):"v"(a),"v"(b));return r;}
typedef float f32x2_t __attribute__((ext_vector_type(2))); typedef __bf16 bf16x2_t __attribute__((ext_vector_type(2)));
__device__ __forceinline__ unsigned cvtpk_s(float lo,float hi){f32x2_t v={lo,hi};bf16x2_t b=__builtin_convertvector(v,bf16x2_t);return __builtin_bit_cast(unsigned,b);}
#define WAIT_BAR(N) asm volatile("s_waitcnt vmcnt(" #N ") lgkmcnt(0)\n\ts_barrier":::"memory")

__device__ __forceinline__ void qkt(f32x16&p0,f32x16&p1,const char*Kslot,const bf16x8*qr,const f32x16&negm,int r32,int hi){
  const char*kb=Kslot+hi*1024+r32*16;
  #pragma unroll
  for(int d0=0;d0<4;++d0){
    const bf16x8 b0=*reinterpret_cast<const bf16x8*>(kb+d0*2048);
    const bf16x8 b1=*reinterpret_cast<const bf16x8*>(kb+d0*2048+512);
    if(d0==0){p0=__builtin_amdgcn_mfma_f32_32x32x16_bf16(b0,qr[0],negm,0,0,0);p1=__builtin_amdgcn_mfma_f32_32x32x16_bf16(b1,qr[0],negm,0,0,0);}
    else{p0=__builtin_amdgcn_mfma_f32_32x32x16_bf16(b0,qr[d0],p0,0,0,0);p1=__builtin_amdgcn_mfma_f32_32x32x16_bf16(b1,qr[d0],p1,0,0,0);}}
}
typedef __attribute__((address_space(3))) const char* lds_cptr;
typedef short v4i16_t __attribute__((ext_vector_type(4)));
__device__ __forceinline__ void kload8(bf16x8*kf,lds_cptr kp){
  kf[0]=*(const __attribute__((address_space(3))) bf16x8*)(kp);      kf[1]=*(const __attribute__((address_space(3))) bf16x8*)(kp+512);
  kf[2]=*(const __attribute__((address_space(3))) bf16x8*)(kp+2048); kf[3]=*(const __attribute__((address_space(3))) bf16x8*)(kp+2560);
  kf[4]=*(const __attribute__((address_space(3))) bf16x8*)(kp+4096); kf[5]=*(const __attribute__((address_space(3))) bf16x8*)(kp+4608);
  kf[6]=*(const __attribute__((address_space(3))) bf16x8*)(kp+6144); kf[7]=*(const __attribute__((address_space(3))) bf16x8*)(kp+6656);
}
__device__ __forceinline__ void kload2(bf16x8*kf,lds_cptr kp,int j){ kf[2*j]=*(const __attribute__((address_space(3))) bf16x8*)(kp+j*2048); kf[2*j+1]=*(const __attribute__((address_space(3))) bf16x8*)(kp+j*2048+512); }
__device__ __forceinline__ s16x4 vtr(lds_cptr p){ return __builtin_bit_cast(s16x4,__builtin_amdgcn_ds_read_tr16_b64_v4i16((__attribute__((address_space(3))) v4i16_t*)p)); }
__device__ __forceinline__ float rowmax(const f32x16&p0,const f32x16&p1){
  float a=max3f(p0[0],p0[1],p1[0]),b=max3f(p0[2],p0[3],p1[1]);a=max3f(a,p1[2],p1[3]);
  #pragma unroll
  for(int r=4;r<16;r+=4){a=max3f(a,p0[r],p0[r+1]);b=max3f(b,p0[r+2],p0[r+3]);a=max3f(a,p1[r],p1[r+1]);b=max3f(b,p1[r+2],p1[r+3]);}
  const float m=max2f(a,b);
  auto rr=__builtin_amdgcn_permlane32_swap(__float_as_uint(m),__float_as_uint(m),false,false);
  return max2f(__uint_as_float(rr[0]),__uint_as_float(rr[1]));
}
__device__ __forceinline__ void pv(f32x16*o,int vb,bf16x8 pa0,bf16x8 pa1,bf16x8 pa2,bf16x8 pa3){
  #pragma unroll
  for(int d0=0;d0<2;++d0){s16x4 lo[4],hi[4];
    #pragma unroll
    for(int ks=0;ks<4;++ks){
      asm volatile("ds_read_b64_tr_b16 %0,%1 offset:%c2":"=&v"(lo[ks]):"v"(vb),"i"(d0*4096+ks*1024):"memory");
      asm volatile("ds_read_b64_tr_b16 %0,%1 offset:%c2":"=&v"(hi[ks]):"v"(vb),"i"(d0*4096+ks*1024+512):"memory");}
    asm volatile("s_waitcnt lgkmcnt(0)":::"memory");SBAR();
    #define PK(k) (bf16x8){lo[k][0],lo[k][1],lo[k][2],lo[k][3],hi[k][0],hi[k][1],hi[k][2],hi[k][3]}
    o[d0]=__builtin_amdgcn_mfma_f32_32x32x16_bf16(pa0,PK(0),o[d0],0,0,0);
    o[d0]=__builtin_amdgcn_mfma_f32_32x32x16_bf16(pa1,PK(1),o[d0],0,0,0);
    o[d0]=__builtin_amdgcn_mfma_f32_32x32x16_bf16(pa2,PK(2),o[d0],0,0,0);
    o[d0]=__builtin_amdgcn_mfma_f32_32x32x16_bf16(pa3,PK(3),o[d0],0,0,0);
    #undef PK
  }
}

#ifndef ATTN_STORE16
#define ATTN_STORE16(p,v) (*(u32x4*)(p)=(v))
#endif
template<int THRL> __device__ __forceinline__ void attn_unit(int b,int qb,const bf16*Q,const bf16*__restrict__ K,const bf16*__restrict__ V,bf16*O,char*shm){
  const int tid=threadIdx.x,lane=tid&63,r32=lane&31,hi=lane>>5; const int wid=__builtin_amdgcn_readfirstlane(tid>>6);
  const long rowbase=(long)b*SEQ; const int q0=qb*QB;
  const bf16*Qw=Q+(rowbase+q0+wid*QBLK)*QP;
  const bf16*Kh=K+rowbase*QP,*Vh=V+rowbase*QP;
  const unsigned lds0=(unsigned)(uintptr_t)shm;
  float*wsf=(float*)(shm+LDS_WS)+wid*64;
  const bf16*ksrc=Kh+(long)lane*QP+wid*8;
  const bf16*vsrc=Vh+(long)(16*(wid&3)+(lane>>2))*QP+(wid>>2)*32+(lane&3)*8;
  const unsigned kdst=lds0+LDS_K+wid*1024, vdst=lds0+LDS_V+wid*1024;
  #define DMA_K(t,slot) glds16(ksrc+(long)(t)*KVBLK*QP,(unsigned)__builtin_amdgcn_readfirstlane(kdst+(slot)))
  #define DMA_V(t,slot) glds16(vsrc+(long)(t)*KVBLK*QP,(unsigned)__builtin_amdgcn_readfirstlane(vdst+(slot)))
  const int vb0=(int)(lds0+LDS_V)+((lane>>4)&1)*32+(lane&3)*8+(4*hi+((lane&15)>>2))*64;
  const char*Kbase=shm+LDS_K; bf16x8 kf[8];
  const lds_cptr shm3=(lds_cptr)shm; const lds_cptr kp0=shm3+LDS_K+hi*1024+r32*16; const lds_cptr vp0=shm3+LDS_V+((lane>>4)&1)*32+(lane&3)*8+(4*hi+((lane&15)>>2))*64;
  const int NT=(q0+QB)/KVBLK;
  DMA_K(0,0);DMA_V(0,0);DMA_K(1,SLOTB);
  bf16x8 qr[4];
  #pragma unroll
  for(int d0=0;d0<4;++d0)qr[d0]=*reinterpret_cast<const bf16x8*>(&Qw[(long)r32*QP+d0*16+hi*8]);
  float mhat=0.f,l_reg=0.f;f32x16 o[2];o[0]=f32x16{};o[1]=f32x16{};f32x16 negm=f32x16{};asm volatile("":"+v"(negm));
  const int qrel=wid*QBLK+r32;
  #define CMASK(P0,P1,t) do{int jb_=(t)-(NT-4); if(jb_>=0)cmask(P0,P1,jb_,qrel,hi);}while(0)
  bool resc=false;
  #define START(P0,P1) do{ const float rm=rowmax(P0,P1); resc=false; \
    { const float dl=rm; mhat=fadd_s(mhat,dl); \
      _Pragma("unroll") for(int r=0;r<16;++r){P0[r]=fsub_s(P0[r],dl);P1[r]=fsub_s(P1[r],dl);} \
      _Pragma("unroll") for(int r=0;r<16;++r)negm[r]=-mhat; asm volatile("":"+v"(negm)); } \
    _Pragma("unroll") for(int r=0;r<16;++r)P0[r]=__builtin_amdgcn_exp2f(P0[r]); }while(0)
  #define RESC() do{ if(resc){ asm volatile("s_waitcnt lgkmcnt(0)":::"memory"); \
      _Pragma("unroll") for(int d_=0;d_<2;++d_) _Pragma("unroll") for(int r=0;r<16;++r)o[d_][r]*=wsf[crow(r,hi)]; } }while(0)
  f32x16 pA0,pA1,pB0,pB1;
  int sl_prev=0,sl_cur=0,sl_next=SLOTB;
  #define ROT() do{sl_prev=sl_cur;sl_cur=sl_next;sl_next=(sl_next==(NSLOT-1)*SLOTB)?0:sl_next+SLOTB;}while(0)
  DMA_K(2,2*SLOTB);
  WAIT_BAR(3);
  qkt(pA0,pA1,Kbase,qr,negm,r32,hi);asm volatile("s_nop 15\n\ts_nop 7":"+v"(pA0),"+v"(pA1));CMASK(pA0,pA1,0);
  START(pA0,pA1);
  _Pragma("unroll") for(int r=0;r<16;++r)pA1[r]=__builtin_amdgcn_exp2f(pA1[r]);
  WAIT_BAR(0);
  DMA_K(3,0);DMA_V(1,SLOTB);
  ROT();
  kload8(kf,kp0+sl_cur);
  WAIT_BAR(2);
  s16x4 vlo[8],vhi[8]; u32x4 pw0,pw1,pw2,pw3;
  #define PKW(P,B) cvtpk_s(P[B],P[B+1])
  #define PAF(k) __builtin_bit_cast(bf16x8,pw##k)
  #define VFR(i) (bf16x8){vlo[i][0],vlo[i][1],vlo[i][2],vlo[i][3],vhi[i][0],vhi[i][1],vhi[i][2],vhi[i][3]}
  #define PIN(x) asm volatile("":"+v"(x))
  #define MX3(a,b,c) __builtin_fmaxf(__builtin_fmaxf((a),(b)),(c))
  #define GAPA(MF,A0,A1,A2,A3,W0,W1,PW) do{ MF; sacc+=A0; sacc+=A1; sacc+=A2; sacc+=A3; PIN(sacc); W0; W1; PIN(PW); SBAR(); }while(0)
  #define EX(v) __builtin_amdgcn_exp2f(v)
  #define GAPB(MF,X,B) do{ MF; X[B]=EX(X[B]); X[B+1]=EX(X[B+1]); X[B+2]=EX(X[B+2]); X[B+3]=EX(X[B+3]); PIN(X); SBAR(); }while(0)
  #define VRD(i) do{ vlo[i]=vtr(vp_+(((i)>>2)*4096+((i)&3)*1024)); vhi[i]=vtr(vp_+(((i)>>2)*4096+((i)&3)*1024+512)); }while(0)
  #define KRD(G,j) do{ if(G){ kload2(kf,kp0+sl_next,j); SBAR(); } }while(0)
  #define STEP(C0,C1,P0,P1,t,GK,GV,GL) do{ SBAR(); \
    const lds_cptr vp_=vp0+sl_prev; \
    VRD(0); SBAR(); float sacc=(P0[0]+P0[1]); \
    GAPA(C0=__builtin_amdgcn_mfma_f32_32x32x16_bf16(kf[0],qr[0],negm,0,0,0), P0[2],P0[3],P0[4],P0[5],     pw0[0]=PKW(P0,0), pw0[1]=PKW(P0,2), pw0); \
    VRD(4); SBAR(); GAPA(C1=__builtin_amdgcn_mfma_f32_32x32x16_bf16(kf[1],qr[0],negm,0,0,0), P0[6],P0[7],P0[8],P0[9],     pw0[2]=PKW(P0,4), pw0[3]=PKW(P0,6), pw0); \
    VRD(1); SBAR(); GAPA(C0=__builtin_amdgcn_mfma_f32_32x32x16_bf16(kf[2],qr[1],C0,0,0,0),   P0[10],P0[11],P0[12],P0[13], pw1[0]=PKW(P0,8), pw1[1]=PKW(P0,10), pw1); \
    VRD(5); SBAR(); GAPA(C1=__builtin_amdgcn_mfma_f32_32x32x16_bf16(kf[3],qr[1],C1,0,0,0),   P0[14],P0[15],P1[0],P1[1],   pw1[2]=PKW(P0,12),pw1[3]=PKW(P0,14), pw1); \
    VRD(2); SBAR(); GAPA(C0=__builtin_amdgcn_mfma_f32_32x32x16_bf16(kf[4],qr[2],C0,0,0,0),   P1[2],P1[3],P1[4],P1[5],     pw2[0]=PKW(P1,0), pw2[1]=PKW(P1,2), pw2); \
    VRD(6); SBAR(); GAPA(C1=__builtin_amdgcn_mfma_f32_32x32x16_bf16(kf[5],qr[2],C1,0,0,0),   P1[6],P1[7],P1[8],P1[9],     pw2[2]=PKW(P1,4), pw2[3]=PKW(P1,6), pw2); \
    VRD(3); SBAR(); GAPA(C0=__builtin_amdgcn_mfma_f32_32x32x16_bf16(kf[6],qr[3],C0,0,0,0),   P1[10],P1[11],P1[12],P1[13], pw3[0]=PKW(P1,8), pw3[1]=PKW(P1,10), pw3); \
    VRD(7); SBAR(); GAPA(C1=__builtin_amdgcn_mfma_f32_32x32x16_bf16(kf[7],qr[3],C1,0,0,0),   P1[14],P1[15],0.f,0.f,       pw3[2]=PKW(P1,12),pw3[3]=PKW(P1,14), pw3); \
    l_reg+=sacc; \
    if(GK){DMA_K((t)+3,sl_cur);} if(GV){DMA_V((t)+1,sl_next);} \
    CMASK(C0,C1,t); \
    { float a=MX3(C0[0],C0[1],C1[0]),b=MX3(C0[2],C0[3],C1[1]); a=MX3(a,C1[2],C1[3]); \
      _Pragma("unroll") for(int r=4;r<16;r+=4){a=MX3(a,C0[r],C0[r+1]);b=MX3(b,C0[r+2],C0[r+3]);a=MX3(a,C1[r],C1[r+1]);b=MX3(b,C1[r+2],C1[r+3]);} \
      float rm=__builtin_fmaxf(a,b); { auto rr=__builtin_amdgcn_permlane32_swap(__float_as_uint(rm),__float_as_uint(rm),false,false); rm=__builtin_fmaxf(__uint_as_float(rr[0]),__uint_as_float(rr[1])); } \
      resc=false; \
      if(__builtin_expect(__any(rm>(float)THRL),0)){ const float dl=__builtin_fmaxf(rm,0.f); mhat+=dl; \
        _Pragma("unroll") for(int r=0;r<16;++r){C0[r]-=dl;C1[r]-=dl;} \
        _Pragma("unroll") for(int r=0;r<16;++r)negm[r]=-mhat; asm volatile("":"+v"(negm)); \
        const float f=__builtin_amdgcn_exp2f(-dl); l_reg*=f; if(hi==0)wsf[r32]=f; resc=true; } } \
    SBAR(); \
    GAPB(o[0]=__builtin_amdgcn_mfma_f32_32x32x16_bf16(PAF(0),VFR(0),o[0],0,0,0), C0,0); \
    GAPB(o[1]=__builtin_amdgcn_mfma_f32_32x32x16_bf16(PAF(0),VFR(4),o[1],0,0,0), C0,4); \
    KRD(GL,0); GAPB(o[0]=__builtin_amdgcn_mfma_f32_32x32x16_bf16(PAF(1),VFR(1),o[0],0,0,0), C0,8); \
    KRD(GL,1); GAPB(o[1]=__builtin_amdgcn_mfma_f32_32x32x16_bf16(PAF(1),VFR(5),o[1],0,0,0), C0,12); \
    KRD(GL,2); GAPB(o[0]=__builtin_amdgcn_mfma_f32_32x32x16_bf16(PAF(2),VFR(2),o[0],0,0,0), C1,0); \
    KRD(GL,3); GAPB(o[1]=__builtin_amdgcn_mfma_f32_32x32x16_bf16(PAF(2),VFR(6),o[1],0,0,0), C1,4); \
    GAPB(o[0]=__builtin_amdgcn_mfma_f32_32x32x16_bf16(PAF(3),VFR(3),o[0],0,0,0), C1,8); \
    GAPB(o[1]=__builtin_amdgcn_mfma_f32_32x32x16_bf16(PAF(3),VFR(7),o[1],0,0,0), C1,12); \
    }while(0)
  int t=1;
  #undef CMASK
  #define CMASK(P0,P1,t) do{}while(0)
  for(;t+5<NT;t+=2){
    STEP(pB0,pB1,pA0,pA1,t,true,true,true);     WAIT_BAR(2); RESC(); ROT();
    STEP(pA0,pA1,pB0,pB1,t+1,true,true,true);   WAIT_BAR(2); RESC(); ROT();
  }
  #undef CMASK
  #define CMASK(P0,P1,t) do{int jb_=(t)-(NT-4); if(jb_>=0)cmask(P0,P1,jb_,qrel,hi);}while(0)
  #define ENDW(tt) do{ if((tt)+3<NT){WAIT_BAR(2);} else if((tt)+2<NT){WAIT_BAR(1);} else {WAIT_BAR(0);} }while(0)
  for(;t+1<NT;t+=2){
    STEP(pB0,pB1,pA0,pA1,t,(t+3<NT),(t+1<NT),(t+1<NT));       ENDW(t);   RESC(); ROT();
    STEP(pA0,pA1,pB0,pB1,t+1,(t+4<NT),(t+2<NT),(t+2<NT));     ENDW(t+1); RESC(); ROT();
  }
  STEP(pB0,pB1,pA0,pA1,NT-1,false,false,false); RESC();
  { float sacc=pB0[0]+pB0[1]; _Pragma("unroll") for(int r=2;r<16;++r)sacc+=pB0[r]; _Pragma("unroll") for(int r=0;r<16;++r)sacc+=pB1[r]; l_reg+=sacc;
    pw0=(u32x4){PKW(pB0,0),PKW(pB0,2),PKW(pB0,4),PKW(pB0,6)};pw1=(u32x4){PKW(pB0,8),PKW(pB0,10),PKW(pB0,12),PKW(pB0,14)};pw2=(u32x4){PKW(pB1,0),PKW(pB1,2),PKW(pB1,4),PKW(pB1,6)};pw3=(u32x4){PKW(pB1,8),PKW(pB1,10),PKW(pB1,12),PKW(pB1,14)};
    SBAR(); pv(o,vb0+sl_cur,PAF(0),PAF(1),PAF(2),PAF(3)); }
  #undef PKW
  #undef PAF
  #undef VFR
  #undef PIN
  #undef MX3
  #undef GAPA
  #undef GAPB
  #undef EX
  #undef VRD
  #undef KRD
  #undef STEP
  #undef ENDW
  {auto rr=__builtin_amdgcn_permlane32_swap(__float_as_uint(l_reg),__float_as_uint(l_reg),false,false);l_reg=__uint_as_float(rr[0])+__uint_as_float(rr[1]);}
  if(hi==0)wsf[32+r32]=l_reg;asm volatile("s_waitcnt lgkmcnt(0)":::"memory");
  float rli[16];
  #pragma unroll
  for(int r=0;r<16;++r)rli[r]=__builtin_amdgcn_rcpf(wsf[32+crow(r,hi)]);
  bf16*Ow=O+(rowbase+q0+wid*QBLK)*OP;
  { bf16*stg=(bf16*)(shm+LDS_OST)+wid*2048;
    #pragma unroll
    for(int r=0;r<16;++r){const int orow=crow(r,hi);
      #pragma unroll
      for(int d0=0;d0<2;++d0)stg[orow*64+d0*32+r32]=__float2bfloat16(o[d0][r]*rli[r]);}
    asm volatile("s_waitcnt lgkmcnt(0)":::"memory");
    #pragma unroll
    for(int i=0;i<4;++i){const int row=i*8+(lane>>3),ch=lane&7; const u32x4 v=*(const u32x4*)(stg+row*64+ch*8); ATTN_STORE16(Ow+(long)row*OP+ch*8,v);} }
  asm volatile("s_waitcnt lgkmcnt(0)\n\ts_barrier":::"memory");
  #undef DMA_K
  #undef DMA_V
  #undef CMASK
  #undef START
  #undef RESC
  #undef ROT
}
constexpr int ATTN_LDS_BYTES=LDS_BYTES;
struct AttnTensors { const bf16* U; bf16* O; };
__device__ __forceinline__ void attn_phase_static(char*lds,const AttnTensors&T,int vcu){
  if(vcu>=256)return; const int s=vcu&1,pr=vcu>>1; const int b=pr>>4,ph=pr&15; const int h=ph>>2,c=(ph>>1)&1,vh=ph&1;
  for(int i=0;i<4;++i){ const int qb=(i==0)?(7-s):(i==1)?s:(i==2)?(4+s):(3-s);
    attn_unit<8>(b,qb,T.U+h*128+c*64,T.U+512+h*128+c*64,T.U+1024+h*128+vh*64,T.O+ph*64,lds); }
}
template<int THRL=8> __device__ __forceinline__ void attn_phase_dyn(char*lds,const AttnTensors&T,unsigned*ctr,volatile __attribute__((address_space(3))) unsigned*bcast,int q0){
  for(int dq=0;dq<8;++dq){ const int q=(q0+dq)&7;
    for(;;){
      if(threadIdx.x==0) bcast[0]=__hip_atomic_fetch_add(ctr+64*q,1u,__ATOMIC_RELAXED,__HIP_MEMORY_SCOPE_AGENT);
      __syncthreads(); const unsigned j=bcast[0]; __syncthreads();
      if(j>=128u)break;
      const int pr=q*16+(int)(j>>3),qb=7-(int)(j&7); const int b=pr>>4,ph=pr&15; const int h=ph>>2,c=(ph>>1)&1,vh=ph&1;
      attn_unit<THRL>(b,qb,T.U+h*128+c*64,T.U+512+h*128+c*64,T.U+1024+h*128+vh*64,T.O+ph*64,lds);
    }
  }
}
#undef SBAR
#undef WAIT_BAR
}

namespace scan_body {
#define SLDS __attribute__((address_space(3)))
typedef float sf4 __attribute__((ext_vector_type(4)));
typedef float sf2 __attribute__((ext_vector_type(2)));
typedef unsigned su2 __attribute__((ext_vector_type(2)));
constexpr int TB = 16;
constexpr int OFF_NKK = 0, OFF_DEC = TB * 64, OFF_BB = 2 * TB * 64, OFF_KM = 3 * TB * 64, OFF_RR = 4 * TB * 64, OFF_VV = 5 * TB * 64, IN_FLOATS = 5 * TB * 64 + TB * 32, YP_FLOATS = TB * 512;
constexpr int OFF_YP = 2 * IN_FLOATS;
constexpr int SCAN_LDS_BYTES = (2 * IN_FLOATS + 2 * YP_FLOATS) * 4;
__device__ __forceinline__ float bf_lo(unsigned w) { return __uint_as_float(w << 16); }
__device__ __forceinline__ float bf_hi(unsigned w) { return __uint_as_float(w & 0xffff0000u); }
__device__ __forceinline__ unsigned pk_bf(float lo, float hi) { unsigned a = __builtin_bit_cast(unsigned, lo), b = __builtin_bit_cast(unsigned, hi);
    a = (a + 0x7fffu + ((a >> 16) & 1u)) >> 16; b = (b + 0x7fffu + ((b >> 16) & 1u)) & 0xffff0000u; return a | b; }
template <int CTRL> __device__ __forceinline__ float dpp_add(float x) {
    return x + __builtin_bit_cast(float, __builtin_amdgcn_mov_dpp(__builtin_bit_cast(int, x), CTRL, 0xF, 0xF, true));
}
__device__ __forceinline__ float reduce16(float x) {
    x = dpp_add<0xB1>(x);
    x = dpp_add<0x4E>(x);
    x = dpp_add<0x124>(x);
    x = dpp_add<0x128>(x);
    return x;
}
struct ScanArgs { const unsigned short* U; const unsigned short* E; unsigned short* Y; unsigned short* BT; const float* mu; const float* k_k; const float* k_a; const float* r_k; const float* w0; const float* a0; };
struct PrepRegs { su2 rc, kc, vc, rp, kp, vp, ew, ea; };

__device__ __forceinline__ void prep_load(PrepRegs& R, const ScanArgs& A, int b, int h, int blk, int tid) {
    const int i = tid >> 4, c = h * 64 + (tid & 15) * 4, t = blk * TB + i;
    const size_t tok = (size_t)b * 2048 + t;
    const unsigned short* ur = A.U + tok * 3328 + 1536 + c;
    R.rc = *(const su2*)ur; R.kc = *(const su2*)(ur + 512); R.vc = *(const su2*)(ur + 1024);
    const unsigned short* up = (t > 0) ? ur - 3328 : ur;
    R.rp = *(const su2*)up; R.kp = *(const su2*)(up + 512); R.vp = *(const su2*)(up + 1024);
    R.ew = *(const su2*)(A.E + tok * 1536 + c); R.ea = *(const su2*)(A.E + tok * 1536 + 512 + c);
}
__device__ __forceinline__ void prep_compute(SLDS float* buf, const PrepRegs& R, const ScanArgs& A, int b, int h, int hf, int blk, int tid,
                                             const sf4& mu_r, const sf4& mu_k, const sf4& mu_v, const sf4& kkw, const sf4& kaw, const sf4& rkw, const sf4& w0c, const sf4& a0c) {
    const int i = tid >> 4, sl = tid & 15, t = blk * TB + i;
    const float pz = (t > 0) ? 1.0f : 0.0f;
    sf4 rc = {bf_lo(R.rc.x), bf_hi(R.rc.x), bf_lo(R.rc.y), bf_hi(R.rc.y)}, kc = {bf_lo(R.kc.x), bf_hi(R.kc.x), bf_lo(R.kc.y), bf_hi(R.kc.y)}, vc = {bf_lo(R.vc.x), bf_hi(R.vc.x), bf_lo(R.vc.y), bf_hi(R.vc.y)};
    sf4 rp = {bf_lo(R.rp.x), bf_hi(R.rp.x), bf_lo(R.rp.y), bf_hi(R.rp.y)}, kp = {bf_lo(R.kp.x), bf_hi(R.kp.x), bf_lo(R.kp.y), bf_hi(R.kp.y)}, vp = {bf_lo(R.vp.x), bf_hi(R.vp.x), bf_lo(R.vp.y), bf_hi(R.vp.y)};
    rp = rp * pz; kp = kp * pz; vp = vp * pz;
    const sf4 r = rc + (rp - rc) * mu_r, k = kc + (kp - kc) * mu_k, v = vc + (vp - vc) * mu_v;
    const sf4 zw = w0c + (sf4){bf_lo(R.ew.x), bf_hi(R.ew.x), bf_lo(R.ew.y), bf_hi(R.ew.y)}, za = a0c + (sf4){bf_lo(R.ea.x), bf_hi(R.ea.x), bf_lo(R.ea.y), bf_hi(R.ea.y)};
    sf4 dec, a;
#pragma unroll
    for (int e = 0; e < 4; ++e) { const float nx = -zw[e]; const float sp = fmaxf(nx, 0.f) + __logf(1.0f + __expf(-fabsf(nx)));
        dec[e] = __expf(-__expf(-sp - 0.5f));
        a[e] = __builtin_amdgcn_rcpf(1.0f + __expf(-za[e])); }
    const sf4 kkr = k * kkw;
    const float n2 = reduce16((kkr.x * kkr.x + kkr.y * kkr.y) + (kkr.z * kkr.z + kkr.w * kkr.w));
    const sf4 kk = kkr * (1.0f / fmaxf(sqrtf(n2), 1e-12f));
    const sf4 km = k * (1.0f + (a - 1.0f) * kaw);
    const sf4 rkm = r * km * rkw;
    const float bon = reduce16((rkm.x + rkm.y) + (rkm.z + rkm.w));
    *(SLDS sf4*)&buf[OFF_NKK + i * 64 + sl * 4] = -kk;
    *(SLDS sf4*)&buf[OFF_DEC + i * 64 + sl * 4] = dec;
    *(SLDS sf4*)&buf[OFF_BB + i * 64 + sl * 4] = kk * a;
    *(SLDS sf4*)&buf[OFF_KM + i * 64 + sl * 4] = km;
    *(SLDS sf4*)&buf[OFF_RR + i * 64 + sl * 4] = r;
    if ((sl >> 3) == hf) {
        SLDS float* vv = &buf[OFF_VV + i * 32 + ((sl & 7) >> 1) * 8 + (sl & 1)];
        vv[0] = v.x; vv[2] = v.y; vv[4] = v.z; vv[6] = v.w;
        const sf4 bt = v * bon; su2 o; o.x = pk_bf(bt.x, bt.y); o.y = pk_bf(bt.z, bt.w);
        *(su2*)(A.BT + ((size_t)b * 2048 + t) * 512 + h * 64 + sl * 4) = o;
    }
}
struct StepOps { sf4 nk, dc, bb, km, rr; sf2 v; };
__device__ __forceinline__ void step_load(StepOps& o, const SLDS float* L, int i, int kq, int vo) {
    o.nk = *(const SLDS sf4*)&L[OFF_NKK + i * 64 + kq]; o.dc = *(const SLDS sf4*)&L[OFF_DEC + i * 64 + kq]; o.bb = *(const SLDS sf4*)&L[OFF_BB + i * 64 + kq];
    o.km = *(const SLDS sf4*)&L[OFF_KM + i * 64 + kq]; o.rr = *(const SLDS sf4*)&L[OFF_RR + i * 64 + kq]; o.v = *(const SLDS sf2*)&L[OFF_VV + i * 32 + vo];
}
__device__ __forceinline__ void step_compute(const StepOps& o, sf2& a01, sf2& a23, sf2& b01, sf2& b23, SLDS sf2* yp) {
    const sf2 pa = a01 * o.nk.xy + a23 * o.nk.zw, pb = b01 * o.nk.xy + b23 * o.nk.zw;
    const sf2 va = {o.v.x, o.v.x}, vb = {o.v.y, o.v.y};
    const float sa = reduce16(pa.x + pa.y), sb = reduce16(pb.x + pb.y);
    const sf2 sa2 = {sa, sa}, sb2 = {sb, sb};
    a01 = a01 * o.dc.xy + (sa2 * o.bb.xy + va * o.km.xy);
    a23 = a23 * o.dc.zw + (sa2 * o.bb.zw + va * o.km.zw);
    b01 = b01 * o.dc.xy + (sb2 * o.bb.xy + vb * o.km.xy);
    b23 = b23 * o.dc.zw + (sb2 * o.bb.zw + vb * o.km.zw);
    const sf2 qa = a01 * o.rr.xy + a23 * o.rr.zw, qb = b01 * o.rr.xy + b23 * o.rr.zw;
    *yp = (sf2){qa.x + qa.y, qb.x + qb.y};
}
__device__ __forceinline__ void flush_block(const SLDS float* YPb, const ScanArgs& A, int b, int h, int hf, int blk, int ptid) {
    const int i = ptid >> 4, w = (ptid >> 2) & 3, g = ptid & 3;
    const SLDS sf4* pp = (const SLDS sf4*)&YPb[i * 512 + (w * 64 + g * 16) * 2];
    sf4 acc = pp[0];
#pragma unroll
    for (int q = 1; q < 8; ++q) acc = acc + pp[q];
    unsigned short* yr = A.Y + ((size_t)b * 2048 + blk * TB + i) * 512 + h * 64 + hf * 32 + w * 8 + g;
    const unsigned pk = pk_bf(acc.x + acc.z, acc.y + acc.w);
    yr[0] = (unsigned short)(pk & 0xffffu); yr[4] = (unsigned short)(pk >> 16);
}
__device__ __forceinline__ void scan_unit(SLDS float* L, const ScanArgs& A, int b, int h, int hf) {
    const int tid = threadIdx.x, lane = tid & 63; const int wid = __builtin_amdgcn_readfirstlane(tid >> 6);
    constexpr int NBLK = 2048 / TB;
    if (wid >= 4) {
        const int ptid = tid - 256;
        const int c0 = h * 64 + (ptid & 15) * 4;
        const sf4 mu_r = *(const sf4*)(A.mu + c0), mu_k = *(const sf4*)(A.mu + 512 + c0), mu_v = *(const sf4*)(A.mu + 1024 + c0);
        const sf4 kkw = *(const sf4*)(A.k_k + c0), kaw = *(const sf4*)(A.k_a + c0), rkw = *(const sf4*)(A.r_k + c0), w0c = *(const sf4*)(A.w0 + c0), a0c = *(const sf4*)(A.a0 + c0);
        PrepRegs R;
        prep_load(R, A, b, h, 0, ptid);
        prep_compute(L, R, A, b, h, hf, 0, ptid, mu_r, mu_k, mu_v, kkw, kaw, rkw, w0c, a0c);
        prep_load(R, A, b, h, 1, ptid);
        __syncthreads();
        for (int blk = 0; blk < NBLK; ++blk) {
            if (blk + 1 < NBLK) prep_compute(L + ((blk + 1) & 1) * IN_FLOATS, R, A, b, h, hf, blk + 1, ptid, mu_r, mu_k, mu_v, kkw, kaw, rkw, w0c, a0c);
            if (blk + 2 < NBLK) prep_load(R, A, b, h, blk + 2, ptid);
            if (blk >= 1) flush_block(L + OFF_YP + ((blk - 1) & 1) * YP_FLOATS, A, b, h, hf, blk - 1, ptid);
            __syncthreads();
        }
        flush_block(L + OFF_YP + ((NBLK - 1) & 1) * YP_FLOATS, A, b, h, hf, NBLK - 1, ptid);
    } else {
        sf2 a01 = {0.f, 0.f}, a23 = {0.f, 0.f}, b01 = {0.f, 0.f}, b23 = {0.f, 0.f};
        const int kq = (lane & 15) * 4, vo = wid * 8 + (lane >> 4) * 2;
        __syncthreads();
        for (int blk = 0; blk < NBLK; ++blk) {
            const SLDS float* IN = L + (blk & 1) * IN_FLOATS;
            SLDS sf2* ypl = (SLDS sf2*)(L + OFF_YP + (blk & 1) * YP_FLOATS) + tid;
            StepOps oa, ob, na, nb;
            step_load(oa, IN, 0, kq, vo); step_load(ob, IN, 1, kq, vo);
#pragma unroll
            for (int i = 0; i < TB; i += 2) {
                if (i + 2 < TB) { step_load(na, IN, i + 2, kq, vo); step_load(nb, IN, i + 3, kq, vo); }
                __builtin_amdgcn_sched_barrier(0);
                step_compute(oa, a01, a23, b01, b23, ypl + i * 256);
                step_compute(ob, a01, a23, b01, b23, ypl + (i + 1) * 256);
                __builtin_amdgcn_sched_barrier(0);
                oa = na; ob = nb;
            }
            __syncthreads();
        }
    }
    __syncthreads();
}
}

#ifndef RW_STAGE
#define RW_STAGE 0
#endif
#ifndef PROBE_K
#define PROBE_K (-1)
#endif
namespace rwkv_body {
#ifndef RWS_C
#define RWS_C 0
#endif
#define RWSTAMP(k) do { if (PROBE_K >= 0 && blockIdx.x == 0 && threadIdx.x == 0 && c == RWS_C) tsp[k] = __builtin_amdgcn_s_memrealtime(); } while (0)
#define RL __attribute__((address_space(3)))
#define RWBAR() do { asm volatile("s_waitcnt lgkmcnt(0)" ::: "memory"); __builtin_amdgcn_s_barrier(); asm volatile("" ::: "memory"); } while (0)
typedef short h8 __attribute__((ext_vector_type(8)));
typedef float f4 __attribute__((ext_vector_type(4)));
typedef unsigned u2 __attribute__((ext_vector_type(2)));
typedef unsigned u4 __attribute__((ext_vector_type(4)));
constexpr int ST = 72, SB = ST * 2, MBY = 64 * SB;
constexpr int O_AH = 0, O_BH = MBY, O_KH = 2 * MBY, O_RH = 3 * MBY, O_KHT = 4 * MBY, O_BHT = 5 * MBY, O_VMT = 6 * MBY, O_YT = 7 * MBY  ,
              O_MP0 = 9 * MBY, O_MPT0 = 10 * MBY, O_MP1 = 11 * MBY, O_MPT1 = 12 * MBY, O_OT = 13 * MBY, O_PC = O_OT + 2048, O_KC = O_PC + 256  , RWKV_LDS_BYTES = O_KC + 2048;
constexpr int O_CL = O_MP0;
constexpr int O_VM = O_MP1;
__device__ __forceinline__ float bflo(unsigned w) { return __uint_as_float(w << 16); }
__device__ __forceinline__ float bfhi(unsigned w) { return __uint_as_float(w & 0xffff0000u); }
typedef float f2t_ __attribute__((ext_vector_type(2))); typedef __bf16 b2t_ __attribute__((ext_vector_type(2)));
__device__ __forceinline__ unsigned pkbf(float lo, float hi) { const f2t_ v = {lo, hi}; const b2t_ b = __builtin_convertvector(v, b2t_); return __builtin_bit_cast(unsigned, b); }
template <int CTRL> __device__ __forceinline__ float dppadd(float x) { return x + __builtin_bit_cast(float, __builtin_amdgcn_mov_dpp(__builtin_bit_cast(int, x), CTRL, 0xF, 0xF, true)); }
__device__ __forceinline__ float reduce8(float x) { x = dppadd<0xB1>(x); x = dppadd<0x4E>(x); x = dppadd<0x141>(x); return x; }
__device__ __forceinline__ h8 ldfrag(const RL char* base, int row0, int ks, int lane) { return *(const RL h8*)(base + (row0 + (lane & 15)) * SB + ks * 64 + (lane >> 4) * 16); }
__device__ __forceinline__ void mma2(f4& acc, const RL char* A, int am0, const RL char* B, int bn0, int lane) {
    acc = __builtin_amdgcn_mfma_f32_16x16x32_bf16(ldfrag(A, am0, 0, lane), ldfrag(B, bn0, 0, lane), acc, 0, 0, 0);
    acc = __builtin_amdgcn_mfma_f32_16x16x32_bf16(ldfrag(A, am0, 1, lane), ldfrag(B, bn0, 1, lane), acc, 0, 0, 0);
}
__device__ __forceinline__ void mma2p(f4& acc0, f4& acc1, const RL char* A, int am0, const RL char* B, int bn0, int lane) {
    const h8 a0 = ldfrag(A, am0, 0, lane), a1 = ldfrag(A, am0, 1, lane);
    acc0 = __builtin_amdgcn_mfma_f32_16x16x32_bf16(a0, ldfrag(B, bn0, 0, lane), acc0, 0, 0, 0); acc1 = __builtin_amdgcn_mfma_f32_16x16x32_bf16(a0, ldfrag(B, bn0 + 16, 0, lane), acc1, 0, 0, 0);
    acc0 = __builtin_amdgcn_mfma_f32_16x16x32_bf16(a1, ldfrag(B, bn0, 1, lane), acc0, 0, 0, 0); acc1 = __builtin_amdgcn_mfma_f32_16x16x32_bf16(a1, ldfrag(B, bn0 + 16, 1, lane), acc1, 0, 0, 0);
}
__device__ __forceinline__ void storeT(RL char* dst, int m0, int n0, const f4& acc, int lane) {
    u2 w; w.x = pkbf(acc[0], acc[1]); w.y = pkbf(acc[2], acc[3]);
    *(RL u2*)(dst + (n0 + (lane & 15)) * SB + (m0 + 4 * (lane >> 4)) * 2) = w;
}
struct Args { unsigned long long* tsp_; const unsigned short* U; const unsigned short* E; unsigned short* Y; unsigned short* BT; unsigned char* GH; unsigned char* Q1; unsigned char* Q2;
              const float* mu; const float* k_k; const float* k_a; const float* r_k; const float* w0; const float* a0; };
__device__ __forceinline__ unsigned char* qptr(const Args& A, int cid) { return cid < 1024 ? A.Q1 + (size_t)cid * 8192 : A.Q2 + (size_t)(cid - 1024) * 8192; }

struct ChunkLoads { u4 rc, kc, vc, rp, kp, vp, ew, ea; };
__device__ __forceinline__ void chunk_consts_to_lds(RL char* L, const Args& A, int h) {
    const int tid = threadIdx.x; RL float* kc = (RL float*)(L + O_KC);
    if (tid < 64) { const int c = h * 64 + tid; kc[tid] = A.mu[c]; kc[64 + tid] = A.mu[512 + c]; kc[128 + tid] = A.mu[1024 + c]; kc[192 + tid] = A.k_k[c]; kc[256 + tid] = A.k_a[c]; kc[320 + tid] = A.r_k[c]; kc[384 + tid] = A.w0[c]; kc[448 + tid] = A.a0[c]; }
}
__device__ __forceinline__ void chunk_load(ChunkLoads& R, const Args& A, int b, int h, int c) {
    const int tid = threadIdx.x, ti = tid >> 3, ch0 = 8 * (tid & 7), t = c * 64 + ti;
    const size_t tok = (size_t)b * 2048 + t;
    const unsigned short* ur = A.U + tok * 3328 + 1536 + h * 64 + ch0;
    R.rc = *(const u4*)ur; R.kc = *(const u4*)(ur + 512); R.vc = *(const u4*)(ur + 1024);
    const unsigned short* up = (t > 0) ? ur - 3328 : ur;
    R.rp = *(const u4*)up; R.kp = *(const u4*)(up + 512); R.vp = *(const u4*)(up + 1024);
    R.ew = *(const u4*)(A.E + tok * 1536 + h * 64 + ch0); R.ea = *(const u4*)(A.E + tok * 1536 + 512 + h * 64 + ch0);
}
#define CVT_LOAD(P_, N_) const f4 cv0 = *(const f4*)(P_), cv1 = *(const f4*)((P_) + (size_t)(N_)), cv2 = *(const f4*)((P_) + (size_t)2 * (N_)), cv3 = *(const f4*)((P_) + (size_t)3 * (N_)), \
                               cv4 = *(const f4*)((P_) + (size_t)4 * (N_)), cv5 = *(const f4*)((P_) + (size_t)5 * (N_)), cv6 = *(const f4*)((P_) + (size_t)6 * (N_)), cv7 = *(const f4*)((P_) + (size_t)7 * (N_))
#define CVT_STORE(Q_, K_) do { _Pragma("unroll") for (int e_ = 0; e_ < 4; ++e_) *(u4*)((Q_) + (size_t)e_ * (K_)) = (u4){pkbf(cv0[e_], cv1[e_]), pkbf(cv2[e_], cv3[e_]), pkbf(cv4[e_], cv5[e_]), pkbf(cv6[e_], cv7[e_])}; } while (0)
__device__ __forceinline__ void rwkv_chunk_task(RL char* L, const Args& A, const ChunkLoads& LD, ChunkLoads& NEXT, bool has_next, int b, int h, int c, int cnext, const float* jWg, const float* jWu, unsigned short* jWGU, int jitem) {
    const int tid = threadIdx.x, lane = tid & 63; const int wid = __builtin_amdgcn_readfirstlane(tid >> 6);
    const int cid = (b * 8 + h) * 32 + c; unsigned long long* tsp = A.tsp_;
    RWSTAMP(17);
    const int ti = tid >> 3, ch0 = 8 * (tid & 7), t = c * 64 + ti;
    const size_t tok = (size_t)b * 2048 + t;
    float r8[8], km8[8], b8[8], nk8[8], v8[8], lw8[8];
    {
        const u4 rc = LD.rc, kc = LD.kc, vc = LD.vc, rp = LD.rp, kp = LD.kp, vp = LD.vp, ew = LD.ew, ea = LD.ea;
        const float pz = (t > 0) ? 1.0f : 0.0f;
        const RL float* kcst = (const RL float*)(L + O_KC) + ch0;
        float cmr[8], cmk[8], cmv[8], ckk[8], cka[8], crk[8], cw0[8], ca0[8];
#define LDC8(dst, off) do { const f4 t0_ = *(const RL f4*)(kcst + (off)), t1_ = *(const RL f4*)(kcst + (off) + 4); dst[0] = t0_[0]; dst[1] = t0_[1]; dst[2] = t0_[2]; dst[3] = t0_[3]; dst[4] = t1_[0]; dst[5] = t1_[1]; dst[6] = t1_[2]; dst[7] = t1_[3]; } while (0)
        LDC8(cmr, 0); LDC8(cmk, 64); LDC8(cmv, 128); LDC8(ckk, 192); LDC8(cka, 256); LDC8(crk, 320); LDC8(cw0, 384); LDC8(ca0, 448);
#undef LDC8
        float kkr[8], ag[8]; float n2 = 0.f, bon = 0.f;
#pragma unroll
        for (int e = 0; e < 8; ++e) {
            const unsigned wr = rc[e >> 1], wk = kc[e >> 1], wv = vc[e >> 1], pr = rp[e >> 1], pk = kp[e >> 1], pv = vp[e >> 1], we = ew[e >> 1], wa = ea[e >> 1];
            const float rcur = (e & 1) ? bfhi(wr) : bflo(wr), kcur = (e & 1) ? bfhi(wk) : bflo(wk), vcur = (e & 1) ? bfhi(wv) : bflo(wv);
            const float rprv = ((e & 1) ? bfhi(pr) : bflo(pr)) * pz, kprv = ((e & 1) ? bfhi(pk) : bflo(pk)) * pz, vprv = ((e & 1) ? bfhi(pv) : bflo(pv)) * pz;
            const float rr = rcur + (rprv - rcur) * cmr[e], kk_ = kcur + (kprv - kcur) * cmk[e], vv = vcur + (vprv - vcur) * cmv[e];
            const float zw = cw0[e] + ((e & 1) ? bfhi(we) : bflo(we)), za = ca0[e] + ((e & 1) ? bfhi(wa) : bflo(wa));
            const float nx = -zw; const float sp = fmaxf(nx, 0.f) + __logf(1.0f + __expf(-fabsf(nx)));
            lw8[e] = -__expf(-sp - 0.5f);
            ag[e] = __builtin_amdgcn_rcpf(1.0f + __expf(-za));
            kkr[e] = kk_ * ckk[e]; n2 += kkr[e] * kkr[e];
            km8[e] = kk_ * (1.0f + (ag[e] - 1.0f) * cka[e]);
            r8[e] = rr; v8[e] = vv; bon += rr * km8[e] * crk[e];
        }
        n2 = reduce8(n2); bon = reduce8(bon);
        const float inv = 1.0f / fmaxf(sqrtf(n2), 1e-12f);
#pragma unroll
        for (int e = 0; e < 8; ++e) { const float kk = kkr[e] * inv; nk8[e] = -kk; b8[e] = kk * ag[e]; }
        u4 bo; bo.x = pkbf(bon * v8[0], bon * v8[1]); bo.y = pkbf(bon * v8[2], bon * v8[3]); bo.z = pkbf(bon * v8[4], bon * v8[5]); bo.w = pkbf(bon * v8[6], bon * v8[7]);
        *(u4*)(A.BT + tok * 512 + h * 64 + ch0) = bo;
        RL float* cl = (RL float*)(L + O_CL) + ti * 64 + ch0;
        *(RL f4*)cl = (f4){lw8[0], lw8[1], lw8[2], lw8[3]}; *(RL f4*)(cl + 4) = (f4){lw8[4], lw8[5], lw8[6], lw8[7]};
    }
    if (has_next) chunk_load(NEXT, A, b, h, cnext);
    const int citem = jitem >= 0 ? jitem : 0;
    const int ce_ = citem >> 9, cmat = (citem >> 8) & 1, cit = citem & 255; const int ck0 = 64 * (cit >> 4), cn0 = 32 * (cit & 15);
    const float* cvp = (cmat ? jWu : jWg) + (size_t)ce_ * 1024 * 512 + (size_t)(ck0 + 8 * (lane >> 3)) * 512 + cn0 + 4 * (lane & 7);
    CVT_LOAD(cvp, 512);
    RWBAR();
    {
        RL float* cl = (RL float*)(L + O_CL); RL float* ot = (RL float*)(L + O_OT);
        const int ch = tid & 63, oc = tid >> 6;
        float run = 0.f;
#pragma unroll
        for (int j = 0; j < 8; ++j) { run += cl[(8 * oc + j) * 64 + ch]; cl[(8 * oc + j) * 64 + ch] = run; }
        ot[oc * 64 + ch] = run;
    }
    RWBAR();
    {
        const RL float* cl = (const RL float*)(L + O_CL) + ti * 64 + ch0; const RL float* ot = (const RL float*)(L + O_OT) + ch0;
        f4 c0 = *(const RL f4*)cl, c1 = *(const RL f4*)(cl + 4);
#pragma unroll 1
        for (int o = 0; o < wid; ++o) { c0 = c0 + *(const RL f4*)(ot + o * 64); c1 = c1 + *(const RL f4*)(ot + o * 64 + 4); }
        if (ti == 63) { RL float* pc = (RL float*)(L + O_PC) + ch0; *(RL f4*)pc = (f4){__expf(c0[0]), __expf(c0[1]), __expf(c0[2]), __expf(c0[3])}; *(RL f4*)(pc + 4) = (f4){__expf(c1[0]), __expf(c1[1]), __expf(c1[2]), __expf(c1[3])}; }
        const float cl8[8] = {c0[0], c0[1], c0[2], c0[3], c1[0], c1[1], c1[2], c1[3]};
        float ah[8], bh[8], kh[8], rh[8];
#pragma unroll
        for (int e = 0; e < 8; ++e) { const float P = __expf(cl8[e]), Pp = __expf(cl8[e] - lw8[e]), iP = __expf(-cl8[e]);
            ah[e] = nk8[e] * Pp; bh[e] = b8[e] * iP; kh[e] = km8[e] * iP; rh[e] = r8[e] * P; }
        const int off = ti * SB + ch0 * 2;
        *(RL u4*)(L + O_AH + off) = (u4){pkbf(ah[0], ah[1]), pkbf(ah[2], ah[3]), pkbf(ah[4], ah[5]), pkbf(ah[6], ah[7])};
        *(RL u4*)(L + O_BH + off) = (u4){pkbf(bh[0], bh[1]), pkbf(bh[2], bh[3]), pkbf(bh[4], bh[5]), pkbf(bh[6], bh[7])};
        *(RL u4*)(L + O_KH + off) = (u4){pkbf(kh[0], kh[1]), pkbf(kh[2], kh[3]), pkbf(kh[4], kh[5]), pkbf(kh[6], kh[7])};
        *(RL u4*)(L + O_RH + off) = (u4){pkbf(rh[0], rh[1]), pkbf(rh[2], rh[3]), pkbf(rh[4], rh[5]), pkbf(rh[6], rh[7])};
        *(RL u4*)(L + O_VM + off) = (u4){pkbf(v8[0], v8[1]), pkbf(v8[2], v8[3]), pkbf(v8[4], v8[5]), pkbf(v8[6], v8[7])};
    }
    RWBAR();
    {
        const int k = tid & 63, og = tid >> 6;
        const int srcs[4] = {O_KH, O_BH, O_VM, O_AH}, dsts[4] = {O_KHT, O_BHT, O_VMT, O_YT};
#pragma unroll
        for (int q = 0; q < 4; ++q) {
            unsigned short e[8];
#pragma unroll
            for (int j = 0; j < 8; ++j) e[j] = *(const RL unsigned short*)(L + srcs[q] + (8 * og + j) * SB + k * 2);
            *(RL u4*)(L + dsts[q] + k * SB + og * 16) = (u4){(unsigned)e[0] | ((unsigned)e[1] << 16), (unsigned)e[2] | ((unsigned)e[3] << 16), (unsigned)e[4] | ((unsigned)e[5] << 16), (unsigned)e[6] | ((unsigned)e[7] << 16)};
        }
    }
    RWBAR(); RWSTAMP(18);
    const int mb = wid & 3, nb0 = 2 * (wid >> 2);
    const int lm = 4 * (lane >> 4), ln = lane & 15;
    {
        const int m_ = 16 * mb + lm, na = 16 * nb0 + ln, nb_ = na + 16;
        f4 c1a = {0.f, 0.f, 0.f, 0.f}, c1b = c1a, c2a = c1a, c2b = c1a, c3a = c1a, c3b = c1a;
        mma2p(c1a, c1b, L + O_BH, 16 * mb, L + O_AH, 16 * nb0, lane);
        mma2p(c2a, c2b, L + O_AH, 16 * mb, L + O_BH, 16 * nb0, lane);
        mma2p(c3a, c3b, L + O_KH, 16 * mb, L + O_AH, 16 * nb0, lane);
#pragma unroll
        for (int q = 0; q < 4; ++q) { if (!(na > m_ + q)) { c1a[q] = 0.f; c3a[q] = 0.f; } if (!(m_ + q > na)) c2a[q] = 0.f;
                                      if (!(nb_ > m_ + q)) { c1b[q] = 0.f; c3b[q] = 0.f; } if (!(m_ + q > nb_)) c2b[q] = 0.f; }
        storeT(L + O_MP0, 16 * mb, 16 * nb0, c1a, lane); storeT(L + O_MPT0, 16 * mb, 16 * nb0, c2a, lane); storeT(L + O_MP1, 16 * mb, 16 * nb0, c3a, lane);
        storeT(L + O_MP0, 16 * mb, 16 * nb0 + 16, c1b, lane); storeT(L + O_MPT0, 16 * mb, 16 * nb0 + 16, c2b, lane); storeT(L + O_MP1, 16 * mb, 16 * nb0 + 16, c3b, lane);
    }
    RWBAR();
    {   f4 cxa = {0.f, 0.f, 0.f, 0.f}, cxb = cxa; mma2p(cxa, cxb, L + O_MP1, 16 * mb, L + O_VMT, 16 * nb0, lane);
        storeT(L + O_YT + 64 * SB, 16 * mb, 16 * nb0, cxa, lane); storeT(L + O_YT + 64 * SB, 16 * mb, 16 * nb0 + 16, cxb, lane); }
    RWBAR();
    {
        f4 acc[2][4];
        if (wid < 4) {
#pragma unroll
            for (int cbk = 0; cbk < 2; ++cbk) { const RL char* yrow = L + O_YT + (32 * wid + 16 * cbk + ln) * SB;
#pragma unroll
                for (int ib = 0; ib < 4; ++ib) { const u2 w = *(const RL u2*)(yrow + (16 * ib + lm) * 2); acc[cbk][ib] = (f4){bflo(w.x), bfhi(w.x), bflo(w.y), bfhi(w.y)}; } }
        }
#pragma unroll
        for (int lev = 0; lev < 6; ++lev) {
            const RL char* Mp = L + ((lev & 1) ? O_MP1 : O_MP0); const RL char* MpT = L + ((lev & 1) ? O_MPT1 : O_MPT0);
            RL char* Mn = L + ((lev & 1) ? O_MP0 : O_MP1); RL char* MnT = L + ((lev & 1) ? O_MPT0 : O_MPT1);
            if (wid < 4) {
                const h8 ya0 = ldfrag(L + O_YT, 32 * wid, 0, lane), ya1 = ldfrag(L + O_YT, 32 * wid, 1, lane), yb0 = ldfrag(L + O_YT, 32 * wid + 16, 0, lane), yb1 = ldfrag(L + O_YT, 32 * wid + 16, 1, lane);
#pragma unroll
                for (int ib = 0; ib < 4; ++ib) {
                    const h8 m0 = ldfrag(Mp, 16 * ib, 0, lane), m1 = ldfrag(Mp, 16 * ib, 1, lane);
                    acc[0][ib] = __builtin_amdgcn_mfma_f32_16x16x32_bf16(m0, ya0, acc[0][ib], 0, 0, 0); acc[1][ib] = __builtin_amdgcn_mfma_f32_16x16x32_bf16(m0, yb0, acc[1][ib], 0, 0, 0);
                    acc[0][ib] = __builtin_amdgcn_mfma_f32_16x16x32_bf16(m1, ya1, acc[0][ib], 0, 0, 0); acc[1][ib] = __builtin_amdgcn_mfma_f32_16x16x32_bf16(m1, yb1, acc[1][ib], 0, 0, 0);
                }
#pragma unroll
                for (int cbk = 0; cbk < 2; ++cbk)
#pragma unroll
                    for (int ib = 0; ib < 4; ++ib) storeT(L + O_YT, 16 * ib, 32 * wid + 16 * cbk, acc[cbk][ib], lane);
            } else if (lev < 5) {
                const int sm = wid - 4;
                const h8 t0 = ldfrag(MpT, 16 * sm, 0, lane), t1 = ldfrag(MpT, 16 * sm, 1, lane), p0 = ldfrag(Mp, 16 * sm, 0, lane), p1 = ldfrag(Mp, 16 * sm, 1, lane);
#pragma unroll
                for (int nb = 0; nb < 4; ++nb) {
                    const h8 bp0 = ldfrag(Mp, 16 * nb, 0, lane), bp1 = ldfrag(Mp, 16 * nb, 1, lane), bt0 = ldfrag(MpT, 16 * nb, 0, lane), bt1 = ldfrag(MpT, 16 * nb, 1, lane);
                    f4 s1 = {0.f, 0.f, 0.f, 0.f}, s2 = s1;
                    s1 = __builtin_amdgcn_mfma_f32_16x16x32_bf16(t0, bp0, s1, 0, 0, 0); s2 = __builtin_amdgcn_mfma_f32_16x16x32_bf16(p0, bt0, s2, 0, 0, 0);
                    s1 = __builtin_amdgcn_mfma_f32_16x16x32_bf16(t1, bp1, s1, 0, 0, 0); s2 = __builtin_amdgcn_mfma_f32_16x16x32_bf16(p1, bt1, s2, 0, 0, 0);
                    storeT(Mn, 16 * sm, 16 * nb, s1, lane);
                    storeT(MnT, 16 * sm, 16 * nb, s2, lane);
                }
            }
            RWBAR();
        }
    }
    RWSTAMP(19);
    {
        const int m_ = 16 * mb + lm, na = 16 * nb0 + ln, nb_ = na + 16;
        f4 c3a = {0.f, 0.f, 0.f, 0.f}, c3b = c3a, c4a = c3a, c4b = c3a;
        mma2p(c3a, c3b, L + O_KH, 16 * mb, L + O_RH, 16 * nb0, lane); mma2p(c4a, c4b, L + O_BH, 16 * mb, L + O_RH, 16 * nb0, lane);
#pragma unroll
        for (int q = 0; q < 4; ++q) { if (!(m_ + q <= na)) { c3a[q] = 0.f; c4a[q] = 0.f; } if (!(m_ + q <= nb_)) { c3b[q] = 0.f; c4b[q] = 0.f; } }
        storeT(L + O_MP0, 16 * mb, 16 * nb0, c3a, lane); storeT(L + O_MPT0, 16 * mb, 16 * nb0, c4a, lane); storeT(L + O_MP0, 16 * mb, 16 * nb0 + 16, c3b, lane); storeT(L + O_MPT0, 16 * mb, 16 * nb0 + 16, c4b, lane);
    }
    if (jitem >= 0) { unsigned short* cvq = jWGU + (size_t)(ce_ * 1024 + (cn0 >> 7) * 256 + (cn0 & 127) + cmat * 128 + 4 * (lane & 7)) * 1024 + ck0 + 8 * (lane >> 3); CVT_STORE(cvq, 1024); }
    RWBAR();
    RWSTAMP(20);
    {
        unsigned char* gh = A.GH + (size_t)cid * 16384; unsigned char* qq = qptr(A, cid);
        const RL float* pc = (const RL float*)(L + O_PC);
        const RL char* AtT = L + O_YT; const RL char* WT = L + O_YT + 64 * SB;
#pragma unroll
        for (int tt = 0; tt < 2; ++tt) {
            const int nb = nb0 + tt; const int m_ = 16 * mb + lm, n_ = 16 * nb + ln;
            const float pcn = pc[n_];
            f4 g = {0.f, 0.f, 0.f, 0.f}; mma2(g, AtT, 16 * mb, L + O_BHT, 16 * nb, lane);
#pragma unroll
            for (int q = 0; q < 4; ++q) g[q] = (g[q] + ((m_ + q == n_) ? 1.0f : 0.0f)) * pcn;
            *(u2*)(gh + (size_t)n_ * 128 + (size_t)m_ * 2) = (u2){pkbf(g[0], g[1]), pkbf(g[2], g[3])};
            f4 hh = {0.f, 0.f, 0.f, 0.f}; mma2(hh, L + O_VMT, 16 * mb, L + O_KHT, 16 * nb, lane); mma2(hh, WT, 16 * mb, L + O_BHT, 16 * nb, lane);
            *(u2*)(gh + 8192 + ((size_t)(wid * 2 + tt) * 64 + lane) * 8) = (u2){pkbf(hh[0] * pcn, hh[1] * pcn), pkbf(hh[2] * pcn, hh[3] * pcn)};
            f4 qv; { const u2 w = *(const RL u2*)(L + O_RH + n_ * SB + m_ * 2); qv = (f4){bflo(w.x), bfhi(w.x), bflo(w.y), bfhi(w.y)}; }
            mma2(qv, AtT, 16 * mb, L + O_MPT0, 16 * nb, lane);
            *(u2*)(qq + (size_t)n_ * 128 + (size_t)m_ * 2) = (u2){pkbf(qv[0], qv[1]), pkbf(qv[2], qv[3])};
            f4 y0 = {0.f, 0.f, 0.f, 0.f};
            if (RW_STAGE == 0 || RW_STAGE == 1) mma2(y0, L + O_VMT, 16 * mb, L + O_MP0, 16 * nb, lane);
            if (RW_STAGE == 0 || RW_STAGE == 2) mma2(y0, WT, 16 * mb, L + O_MPT0, 16 * nb, lane);
            if (RW_STAGE == 7) mma2(y0, L + O_VMT, 16 * mb, L + O_VMT, 16 * nb, lane);
            if (RW_STAGE == 8) mma2(y0, L + O_VMT, 16 * mb, L + O_RH, 16 * nb, lane);
            if (RW_STAGE == 3) { const u2 w = *(const RL u2*)(L + O_MP0 + n_ * SB + m_ * 2); y0 = (f4){bflo(w.x), bfhi(w.x), bflo(w.y), bfhi(w.y)}; }
            if (RW_STAGE == 4) { const u2 w = *(const RL u2*)(WT + n_ * SB + m_ * 2); y0 = (f4){bflo(w.x), bfhi(w.x), bflo(w.y), bfhi(w.y)}; }
            if (RW_STAGE == 5) { const u2 w = *(const RL u2*)(L + O_VMT + n_ * SB + m_ * 2); y0 = (f4){bflo(w.x), bfhi(w.x), bflo(w.y), bfhi(w.y)}; }
            if (RW_STAGE == 6) { const u2 w = *(const RL u2*)(L + O_RH + n_ * SB + m_ * 2); y0 = (f4){bflo(w.x), bfhi(w.x), bflo(w.y), bfhi(w.y)}; }
            *(u2*)(A.Y + ((size_t)b * 2048 + c * 64 + n_) * 512 + h * 64 + m_) = (u2){pkbf(y0[0], y0[1]), pkbf(y0[2], y0[3])};
        }
    }
    RWBAR();
}

__device__ __forceinline__ void rwkv_seq_head(RL char* L, const Args& A, int b, int h, int mb) {
    const int tid = threadIdx.x, lane = tid & 63; const int wid = __builtin_amdgcn_readfirstlane(tid >> 6);
    const int lm = 4 * (lane >> 4), ln = lane & 15; const bool isS = wid < 4; const int nb = wid & 3;
    RL char* Sb = L;
    for (int i = tid; i < 16 * SB / 4; i += 512) ((RL unsigned*)Sb)[i] = 0u;
    RWBAR();
    const int cid0 = (b * 8 + h) * 32;
    const int hdump = ((4 * (nb >> 1) + mb) * 2 + (nb & 1)) * 64 + lane;
    struct Ops { h8 f0, f1; u2 x; };
#define RB_LOAD(O_, c_) do { const unsigned char* gh_ = A.GH + (size_t)(cid0 + (c_)) * 16384; \
        const unsigned char* src_ = (isS ? gh_ : qptr(A, cid0 + (c_))) + (size_t)(16 * nb + ln) * 128 + (lane >> 4) * 16; \
        O_.f0 = *(const h8*)src_; O_.f1 = *(const h8*)(src_ + 64); \
        O_.x = isS ? *(const u2*)(gh_ + 8192 + (size_t)hdump * 8) : *(const u2*)(A.Y + ((size_t)b * 2048 + (c_) * 64 + 16 * nb + ln) * 512 + h * 64 + 16 * mb + lm); } while (0)
#define RB_STEP(O_, c_) do { \
        const h8 a0 = ldfrag(Sb, 0, 0, lane), a1 = ldfrag(Sb, 0, 1, lane); \
        f4 r = {bflo(O_.x.x), bfhi(O_.x.x), bflo(O_.x.y), bfhi(O_.x.y)}; \
        r = __builtin_amdgcn_mfma_f32_16x16x32_bf16(a0, O_.f0, r, 0, 0, 0); r = __builtin_amdgcn_mfma_f32_16x16x32_bf16(a1, O_.f1, r, 0, 0, 0); \
        if (!isS) *(u2*)(A.Y + ((size_t)b * 2048 + (c_) * 64 + 16 * nb + ln) * 512 + h * 64 + 16 * mb + lm) = (u2){pkbf(r[0], r[1]), pkbf(r[2], r[3])}; \
        if ((c_) + 2 < 32) RB_LOAD(O_, (c_) + 2);                       \
        RWBAR();                                                      \
        if (isS) { RL unsigned short* sp = (RL unsigned short*)(Sb + lm * SB) + 16 * nb + ln; \
            _Pragma("unroll") for (int q = 0; q < 4; ++q) sp[q * ST] = (unsigned short)(pkbf(r[q], 0.f) & 0xffffu); } \
        RWBAR(); } while (0)
    Ops OA_, OB_;
    RB_LOAD(OA_, 0); RB_LOAD(OB_, 1);
    for (int c = 0; c < 32; c += 2) { RB_STEP(OA_, c); RB_STEP(OB_, c + 1); }
#undef RB_LOAD
#undef RB_STEP
}
}


#define GAS __attribute__((address_space(1)))
#define LAS __attribute__((address_space(3)))
typedef unsigned short bf16;
typedef unsigned v4u __attribute__((ext_vector_type(4)));
typedef float f32x4 __attribute__((ext_vector_type(4)));
typedef short bf16x8 __attribute__((ext_vector_type(8)));
typedef GAS unsigned gu32;
typedef GAS unsigned long long gu64;
#define RLX_AGENT __ATOMIC_RELAXED, __HIP_MEMORY_SCOPE_AGENT
#define LDS_WAIT() asm volatile("s_waitcnt lgkmcnt(0)" ::: "memory")
#define VM_WAIT() asm volatile("s_waitcnt vmcnt(0)" ::: "memory")
__device__ __forceinline__ unsigned long long rt() { return __builtin_amdgcn_s_memrealtime(); }
__device__ __forceinline__ unsigned f2bf(float f) { unsigned u = __builtin_bit_cast(unsigned, f); return (u + 0x7fffu + ((u >> 16) & 1u)) >> 16; }
__device__ __forceinline__ unsigned pk2(float lo, float hi) { return f2bf(lo) | (f2bf(hi) << 16); }

#define XB_TMO      128
#define XB_XCNT(j)  (256  + 64 * (j))
#define XB_XSUB(j)  (1280 + 64 * (j))
#define XB_XGEN(j)  (2304 + 64 * (j))
#define XB_TOP      3328
#define XB_TOPGEN   3392
#define XCD_BAR_WORDS 3456
#define XB_SPIN_CAP (1u << 18)

__device__ __forceinline__ unsigned xb_ld(unsigned* p)              { return __hip_atomic_load(p, __ATOMIC_RELAXED, __HIP_MEMORY_SCOPE_AGENT); }
__device__ __forceinline__ unsigned xb_add(unsigned* p, unsigned v) { return __hip_atomic_fetch_add(p, v, __ATOMIC_RELAXED, __HIP_MEMORY_SCOPE_AGENT); }
__device__ __forceinline__ unsigned xb_xcc_id() { return (unsigned)__builtin_amdgcn_s_getreg((3 << 11) | 20) & 0xFu; }
#define XB_SPIN(cond, bar) do { unsigned _sp = 0; while (cond) { __builtin_amdgcn_s_sleep(1); \
    if ((++_sp & 255u) == 0u) { if (xb_ld(&(bar)[XB_TMO])) break; if (_sp > XB_SPIN_CAP) { atomicAdd(&(bar)[XB_TMO], 1u); break; } } } } while (0)

struct XcdBarrier {
    unsigned* bar; unsigned x;
    volatile LAS unsigned* st;
};

__device__ __forceinline__ XcdBarrier xcd_barrier_post(unsigned* bar, volatile LAS unsigned* st) {
    XcdBarrier b; b.bar = bar; b.x = xb_xcc_id(); b.st = st;
    if (threadIdx.x == 0) (void)xb_add(&bar[XB_XCNT(b.x)], 1u);
    return b;
}
__device__ __forceinline__ void xcd_barrier_complete(unsigned* bar, unsigned x, unsigned& nloc, unsigned& nx) {
    const unsigned G = gridDim.x * gridDim.y * gridDim.z;
    unsigned sum, cnt, mine, sp = 0u;
    for (;;) {
        sum = 0u; cnt = 0u; mine = 0u;
#pragma unroll
        for (unsigned j = 0; j < 16; ++j) { const unsigned c = xb_ld(&bar[XB_XCNT(j)]); sum += c; cnt += (c > 0u) ? 1u : 0u; mine = (j == x) ? c : mine; }
        if (sum == G) break;
        __builtin_amdgcn_s_sleep(1);
        if ((++sp & 255u) == 0u) { if (xb_ld(&bar[XB_TMO])) break; if (sp > XB_SPIN_CAP) { atomicAdd(&bar[XB_TMO], 1u); break; } }
    }
    nloc = mine > 0u ? mine : 1u; nx = cnt > 0u ? cnt : 1u;
}

__device__ __forceinline__ void xcd_barrier(const XcdBarrier& b) {
    asm volatile("s_waitcnt vmcnt(0)" ::: "memory");
    __syncthreads();
    if (threadIdx.x == 0) {
        unsigned* bar = b.bar;
        __builtin_amdgcn_s_waitcnt(0);
        unsigned nloc = b.st[0], nx = b.st[1];
        if (nloc == 0u) { xcd_barrier_complete(bar, b.x, nloc, nx); b.st[0] = nloc; b.st[1] = nx; }
        const unsigned old = xb_add(&bar[XB_XSUB(b.x)], 1u);
        const unsigned gen = old / nloc;
        if (old + 1u == (gen + 1u) * nloc) {
            __builtin_amdgcn_fence(__ATOMIC_RELEASE, "agent");
            asm volatile("s_waitcnt vmcnt(0)" ::: "memory");
            const unsigned og = xb_add(&bar[XB_TOP], 1u);
            const unsigned tg = og / nx;
            if (og + 1u == (tg + 1u) * nx) xb_add(&bar[XB_TOPGEN], 1u);
            else XB_SPIN(xb_ld(&bar[XB_TOPGEN]) == tg, bar);
            __builtin_amdgcn_fence(__ATOMIC_ACQUIRE, "agent");
            xb_add(&bar[XB_XGEN(b.x)], 1u);
            asm volatile("s_waitcnt vmcnt(0)" ::: "memory");
        } else {
            XB_SPIN(xb_ld(&bar[XB_XGEN(b.x)]) == gen, bar);
            __builtin_amdgcn_fence(__ATOMIC_ACQUIRE, "agent");
            asm volatile("s_waitcnt vmcnt(0)" ::: "memory");
        }
    }
    __syncthreads();
}


constexpr int BATCH = 8, SEQ = 2048, DM = 1024, M = BATCH * SEQ;
constexpr int DIN = 3328, DRW = 512, RC = 1792;
constexpr int NEXP = 32, DEXP = 512;
constexpr int NWAVES = 8;
constexpr int RING_OFF = 0, RING_BYTES = 131072;
constexpr int LDSCTL_OFF = RING_BYTES, MISC_OFF = LDSCTL_OFF + 320;
constexpr int LDS_BYTES = 147456;
constexpr size_t MBy = 1000000;
constexpr size_t WS_CTL = 0, CTL_ZERO_BYTES = 1 << 20;
constexpr int CW_TMO = 0, CW_CODE = 1, CW_BAR = 4096;

struct Frame {
    LAS unsigned char* lds;
    volatile LAS unsigned* MISC;
    gu32* ctl;
    int tid, lane, wave;
    int vcu, G;
};

__device__ __forceinline__ float wave_sum(float v) {
#pragma unroll
    for (int o = 1; o < 64; o <<= 1) v += __shfl_xor(v, o);
    return v;
}
__device__ __forceinline__ void p0_transpose_item(const float* W, int K, int N, bf16* WT, int row_off, LAS float* scr, int item, int lane) {
    const int nblk = N / 32, kb = item / nblk, nb = item % nblk, k0 = 64 * kb, n0 = 32 * nb;
#pragma unroll 8
    for (int i = 0; i < 32; ++i) { const int kk = 2 * i + (lane >> 5); scr[kk * 33 + (lane & 31)] = W[(size_t)(k0 + kk) * N + n0 + (lane & 31)]; }
    LDS_WAIT(); asm volatile("" ::: "memory");
    const int c = lane & 7;
#pragma unroll
    for (int j = 0; j < 4; ++j) { const int n = (lane >> 3) + 8 * j; const LAS float* s = scr + (8 * c) * 33 + n;
        v4u o; o.x = pk2(s[0 * 33], s[1 * 33]); o.y = pk2(s[2 * 33], s[3 * 33]); o.z = pk2(s[4 * 33], s[5 * 33]); o.w = pk2(s[6 * 33], s[7 * 33]);
        *(GAS v4u*)(WT + (size_t)(row_off + n0 + n) * K + k0 + 8 * c) = o; }
    LDS_WAIT(); asm volatile("" ::: "memory");
}
__device__ __forceinline__ void rms_row_to_bf16(int lane, const float* xrow, const float* g, bf16* orow, float eps) {
    const GAS f32x4* xr = (const GAS f32x4*)xrow + lane;
    const GAS f32x4* gr = (const GAS f32x4*)g + lane;
    f32x4 v[4]; float s = 0.f;
#pragma unroll
    for (int j = 0; j < 4; ++j) { v[j] = xr[64 * j]; s += (v[j].x * v[j].x + v[j].y * v[j].y) + (v[j].z * v[j].z + v[j].w * v[j].w); }
    const float rstd = 1.f / sqrtf(wave_sum(s) * (1.f / DM) + eps);
    GAS unsigned long long* o8 = (GAS unsigned long long*)orow + lane;
#pragma unroll
    for (int j = 0; j < 4; ++j) { const f32x4 gv = gr[64 * j];
        o8[64 * j] = (unsigned long long)pk2(v[j].x * rstd * gv.x, v[j].y * rstd * gv.y) | ((unsigned long long)pk2(v[j].z * rstd * gv.z, v[j].w * rstd * gv.w) << 32); }
}

__device__ __forceinline__ void rms_rows_pipelined(int lane, const float* x, const float* g, bf16* out, int first, int stride, float eps) {
    const GAS f32x4* gr = (const GAS f32x4*)g + lane;
    const f32x4 g0 = gr[0], g1 = gr[64], g2 = gr[128], g3 = gr[192];
    f32x4 c0, c1, c2, c3;
    if (first < M) { const GAS f32x4* xr = (const GAS f32x4*)(x + (size_t)first * DM) + lane; c0 = xr[0]; c1 = xr[64]; c2 = xr[128]; c3 = xr[192]; }
    for (int m = first; m < M; m += stride) {
        f32x4 n0 = c0, n1 = c1, n2 = c2, n3 = c3;
        if (m + stride < M) { const GAS f32x4* xr = (const GAS f32x4*)(x + (size_t)(m + stride) * DM) + lane; n0 = xr[0]; n1 = xr[64]; n2 = xr[128]; n3 = xr[192]; }
        const float ssq = ((c0.x * c0.x + c0.y * c0.y) + (c0.z * c0.z + c0.w * c0.w)) + ((c1.x * c1.x + c1.y * c1.y) + (c1.z * c1.z + c1.w * c1.w))
                        + ((c2.x * c2.x + c2.y * c2.y) + (c2.z * c2.z + c2.w * c2.w)) + ((c3.x * c3.x + c3.y * c3.y) + (c3.z * c3.z + c3.w * c3.w));
        const float rstd = 1.f / sqrtf(wave_sum(ssq) * (1.f / DM) + eps);
        GAS unsigned long long* o8 = (GAS unsigned long long*)(out + (size_t)m * DM) + lane;
        o8[0]   = (unsigned long long)pk2(c0.x * rstd * g0.x, c0.y * rstd * g0.y) | ((unsigned long long)pk2(c0.z * rstd * g0.z, c0.w * rstd * g0.w) << 32);
        o8[64]  = (unsigned long long)pk2(c1.x * rstd * g1.x, c1.y * rstd * g1.y) | ((unsigned long long)pk2(c1.z * rstd * g1.z, c1.w * rstd * g1.w) << 32);
        o8[128] = (unsigned long long)pk2(c2.x * rstd * g2.x, c2.y * rstd * g2.y) | ((unsigned long long)pk2(c2.z * rstd * g2.z, c2.w * rstd * g2.w) << 32);
        o8[192] = (unsigned long long)pk2(c3.x * rstd * g3.x, c3.y * rstd * g3.y) | ((unsigned long long)pk2(c3.z * rstd * g3.z, c3.w * rstd * g3.w) << 32);
        c0 = n0; c1 = n1; c2 = n2; c3 = n3;
    }
}
struct Args { const float* in[30]; float* out; unsigned char* ws; int ph_lo, ph_hi; };
constexpr size_t WS_U = 2 * MBy;
constexpr size_t DO_XN = 0, DO_WIN = 34 * MBy;
constexpr size_t DO_O = 0;
constexpr size_t DO_Y = 33554432, DO_BT = 50331648;
constexpr size_t WS_E = 112 * MBy;
constexpr size_t WS_LA = 163 * MBy;
constexpr size_t WS_WL = 172 * MBy;
constexpr size_t WS_WOUT = 163 * MBy;
constexpr size_t WS_MIX = 2 * MBy;
constexpr size_t WS_T = WS_MIX;
constexpr size_t WS_WGU = 173 * MBy;
constexpr size_t WS_WD = 241 * MBy;
constexpr size_t WS_ACT = 120 * MBy;
constexpr size_t WS_XS = 36 * MBy;
constexpr size_t WS_YB = 36 * MBy;
constexpr size_t WS_ROWSLOT = 275 * MBy;
constexpr size_t WS_ROWGATE = WS_ROWSLOT + 40960 * 4;
constexpr size_t WS_SLOT_E = WS_ROWGATE + 40960 * 4;
constexpr size_t WS_SLOT_P = WS_SLOT_E + 32768 * 4;
constexpr size_t WS_SLOT_G = WS_SLOT_P + 32768 * 4;
constexpr size_t WS_WRP = 65536;
constexpr size_t WS_ROWTOK = WS_SLOT_G + 32768 * 4;
constexpr size_t WS_END = WS_ROWTOK + 40960 * 4;
constexpr size_t WS_GH = 241 * MBy;
constexpr size_t WS_Q1 = (size_t)162500000;
constexpr size_t WS_Q2 = (size_t)274600000;
constexpr size_t WS_TOTAL = 274600000 + 8388608;
static_assert(WS_END <= WS_TOTAL && WS_GH + 33554432 <= WS_Q2 && WS_Q1 + 8388608 <= 172 * MBy, "ws map");
constexpr int CW_DBG = 10240;
constexpr int CW_AQ = 8192;
constexpr int CW_CNT = 2048;
constexpr int TILE_E_OFF = LDSCTL_OFF + 1024;
constexpr size_t WS_ROPE = 512 * 1024;
constexpr float QSCALE = 0.125f * 1.4426950408889634f;

__device__ __forceinline__ unsigned long long ldarg(int byte_off) {
    const __attribute__((address_space(4))) unsigned char* kp = (const __attribute__((address_space(4))) unsigned char*)__builtin_amdgcn_kernarg_segment_ptr();
    return *(const volatile __attribute__((address_space(4))) unsigned long long*)(kp + byte_off);
}
#define ARG_IN(i) ((const float*)(const GAS float*)ldarg(8 * (i)))
#define ARG_OUT ((unsigned char*)(GAS unsigned char*)ldarg(240))
#define ARG_WS ((unsigned char*)(GAS unsigned char*)ldarg(248))
static_assert(sizeof(Args) == 264, "Args layout vs ldarg offsets");
__global__ void __launch_bounds__(NWAVES * 64, 2) skel_fwd(Args args) {
    extern __shared__ __attribute__((aligned(16))) unsigned char lds[];
    Frame F;
    F.lds = (LAS unsigned char*)lds;
    F.MISC = (volatile LAS unsigned*)(F.lds + MISC_OFF);
    F.tid = threadIdx.x; F.lane = F.tid & 63; F.wave = __builtin_amdgcn_readfirstlane(F.tid >> 6);
    F.G = gridDim.x; { const int bx = blockIdx.x; F.vcu = (F.G % 8 == 0) ? (bx % 8) * (F.G / 8) + bx / 8 : bx; }
    F.ctl = (gu32*)(ARG_WS + WS_CTL);
    for (int u = F.tid; u < (LDS_BYTES - LDSCTL_OFF) / 4; u += NWAVES * 64) ((LAS unsigned*)(F.lds + LDSCTL_OFF))[u] = 0u;
    __syncthreads();
    XcdBarrier bar = xcd_barrier_post((unsigned*)(F.ctl + CW_BAR), F.MISC + 8);
    const int lo = args.ph_lo, hi = args.ph_hi;
#ifndef PROBE_K
#define PROBE_K (-1)
#endif
#ifndef RWKV_DBG
#define RWKV_DBG 0
#endif
#ifndef RW_STAGE
#define RW_STAGE 0
#endif
    constexpr int CW_TS = 9216;
#define STAMP(k) do { if (PROBE_K >= 0 && blockIdx.x == 0 && F.tid == 0) ((GAS unsigned long long*)(F.ctl + CW_TS))[k] = rt(); } while (0)
    STAMP(0);
#define P_U ((bf16*)(ARG_WS + WS_U))
#define IN(k) (lo <= (k) && (k) < hi)
#define BOTH(k) (IN(k) && IN((k) + 1))
    if (IN(0)) {
        unsigned char* ws = ARG_WS; unsigned char* dout = ARG_OUT;
        const float* x = ARG_IN(0); const float* ln1_g = ARG_IN(1); const float* w_in = ARG_IN(2);
        bf16* XN = (bf16*)(dout + DO_XN); bf16* Wt_in = (bf16*)(dout + DO_WIN); float2* rope = (float2*)(ws + WS_ROPE);
        bf16* WL = (bf16*)(ws + WS_WL);
        LAS float* scr = (LAS float*)(F.lds + RING_OFF + F.wave * 16384);
        const int gw = F.vcu * NWAVES + F.wave, NGW = F.G * NWAVES;
        constexpr int I_IN = (DM / 64) * (DIN / 32);
        for (int it = gw; it < I_IN; it += NGW) p0_transpose_item(w_in, DM, DIN, Wt_in, 0, scr, it, F.lane);
        rms_rows_pipelined(F.lane, x, ln1_g, XN, gw, NGW, 1e-6f);
        {   const float* wup = ARG_IN(12); const float* aup = ARG_IN(14); const float* gup = ARG_IN(15);
            for (int idx = gw * 64 + F.lane; idx < 1536 * 256; idx += NGW * 64) {
                const int n = idx >> 8, j = idx & 255; float v = 0.f;
                if (n < 512) { if (j < 64) v = wup[j * 512 + n]; }
                else if (n < 1024) { if (j >= 64 && j < 128) v = aup[(j - 64) * 512 + (n - 512)]; }
                else { if (j >= 128) v = gup[(j - 128) * 512 + (n - 1024)]; }
                WL[idx] = (bf16)f2bf(v);
            }
        }
        {   const float* g2 = ARG_IN(22); const float* wrg = ARG_IN(23); const float* wre = ARG_IN(25); float* WRP = (float*)(ws + WS_WRP);
            for (int idx = gw * 64 + F.lane; idx < 64 * 3 * 64 * 4; idx += NGW * 64) {
                const int i = idx & 3, l = (idx >> 2) & 63, nt = (idx >> 8) % 3, sgrp = idx / 768;
                const int k = 16 * sgrp + 4 * (l >> 4) + i, n = nt * 16 + (l & 15);
                float v = 0.f; if (n < 32) v = wre[k * 32 + n]; else if (n < 36) v = wrg[k * 4 + (n - 32)];
                WRP[idx] = v * g2[k];
            }
        }
        for (int idx = gw * 64 + F.lane; idx < SEQ * 8; idx += NGW * 64) {
            const int pos = idx >> 3, j = idx & 7;
            const double invrev = j == 0 ? 0.15915494309189535 : j == 1 ? 0.03086376340470123 : j == 2 ? 0.005985185712713705 : j == 3 ? 0.001160663641240061 :
                                  j == 4 ? 0.00022507907903927653 : j == 5 ? 4.364795279280289e-05 : j == 6 ? 8.464330808241401e-06 : 1.6414262627950345e-06;
            const double tr = (double)pos * invrev; const float fr = (float)(tr - floor(tr));
            rope[idx] = make_float2(__builtin_amdgcn_cosf(fr), __builtin_amdgcn_sinf(fr));
        }
        if (BOTH(0)) xcd_barrier(bar); STAMP(1);
    }
    if (IN(1)) {
        unsigned char* dout = ARG_OUT; bf16* XN = (bf16*)(dout + DO_XN); bf16* Wt_in = (bf16*)(dout + DO_WIN); bf16* U = P_U;
        pg8::Gemm g{XN, Wt_in, M, DIN, DM}; pg8::G1Order S; S.init(M, DIN - 256, F.G, (int)blockIdx.x);
        pg8::EpiBf16<0> E{U, DIN, nullptr, 0, 0, 1.f};
        pg8::gemm_phase<pg8::EpiBf16<0>, pg8::G1Order, PG8_ALIGN, PG8_SP2>(F.lds + RING_OFF, g, S, E);
        if (BOTH(1)) xcd_barrier(bar); STAMP(2);
    }
    if (IN(2)) {
        unsigned char* ws = ARG_WS; bf16* U = P_U; const float* qg = ARG_IN(3); const float* kg = ARG_IN(4); const float* mu = ARG_IN(10);
        const float2* rope = (const float2*)(ws + WS_ROPE); bf16* LA = (bf16*)(ws + WS_LA);
        const int gw = F.vcu * NWAVES + F.wave, NGW = F.G * NWAVES;
        const int lane = F.lane;
        for (int t = gw; t < M; t += NGW) {
            const int pos = t & (SEQ - 1);
            GAS v4u* rowp = (GAS v4u*)(U + (size_t)t * DIN + lane * 16);
            const v4u wa = rowp[0], wb = rowp[1];
            float v[16];
            v[0] = __uint_as_float(wa.x << 16); v[1] = __uint_as_float(wa.x & 0xffff0000u); v[2] = __uint_as_float(wa.y << 16); v[3] = __uint_as_float(wa.y & 0xffff0000u);
            v[4] = __uint_as_float(wa.z << 16); v[5] = __uint_as_float(wa.z & 0xffff0000u); v[6] = __uint_as_float(wa.w << 16); v[7] = __uint_as_float(wa.w & 0xffff0000u);
            v[8] = __uint_as_float(wb.x << 16); v[9] = __uint_as_float(wb.x & 0xffff0000u); v[10] = __uint_as_float(wb.y << 16); v[11] = __uint_as_float(wb.y & 0xffff0000u);
            v[12] = __uint_as_float(wb.z << 16); v[13] = __uint_as_float(wb.z & 0xffff0000u); v[14] = __uint_as_float(wb.w << 16); v[15] = __uint_as_float(wb.w & 0xffff0000u);
            float ss = 0.f;
#pragma unroll
            for (int i = 0; i < 16; ++i) ss += v[i] * v[i];
            ss += __shfl_xor(ss, 1); ss += __shfl_xor(ss, 2);
            const float rstd = 1.0f / sqrtf(ss * (1.0f / 64.0f) + 1e-6f);
            const float* gp = (lane < 32 ? qg : kg) + (lane & 3) * 16;
#pragma unroll
            for (int i = 0; i < 16; ++i) v[i] *= rstd * gp[i];
            if ((lane & 3) == 0) {
#pragma unroll
                for (int j = 0; j < 8; ++j) { const float2 cs = rope[pos * 8 + j]; const float x1 = v[j], x2 = v[j + 8]; v[j] = x1 * cs.x - x2 * cs.y; v[j + 8] = x2 * cs.x + x1 * cs.y; }
            }
            if (lane < 32) {
#pragma unroll
                for (int i = 0; i < 16; ++i) v[i] *= QSCALE;
            }
            v4u oa, ob;
            oa.x = pk2(v[0], v[1]); oa.y = pk2(v[2], v[3]); oa.z = pk2(v[4], v[5]); oa.w = pk2(v[6], v[7]);
            ob.x = pk2(v[8], v[9]); ob.y = pk2(v[10], v[11]); ob.z = pk2(v[12], v[13]); ob.w = pk2(v[14], v[15]);
            rowp[0] = oa; rowp[1] = ob;
            {   typedef unsigned u32x2v __attribute__((ext_vector_type(2)));
                const GAS u32x2v* lp = (const GAS u32x2v*)(U + (size_t)t * DIN + 3072 + lane * 4);
                const u32x2v cw = lp[0]; u32x2v pw = cw; if (pos > 0) pw = *(const GAS u32x2v*)(U + (size_t)(t - 1) * DIN + 3072 + lane * 4);
                const f32x4 m4 = *(const GAS f32x4*)(mu + 1536 + lane * 4);
                float c4[4] = {__uint_as_float(cw.x << 16), __uint_as_float(cw.x & 0xffff0000u), __uint_as_float(cw.y << 16), __uint_as_float(cw.y & 0xffff0000u)};
                float p4[4] = {__uint_as_float(pw.x << 16), __uint_as_float(pw.x & 0xffff0000u), __uint_as_float(pw.y << 16), __uint_as_float(pw.y & 0xffff0000u)};
                if (pos == 0) { p4[0] = 0.f; p4[1] = 0.f; p4[2] = 0.f; p4[3] = 0.f; }
                float o4[4];
#pragma unroll
                for (int i = 0; i < 4; ++i) { const float xs = c4[i] + (p4[i] - c4[i]) * m4[i];
                    float r = xs;
                    if (lane < 16) { const float e2 = __expf(-2.0f * fabsf(xs)); const float th = (1.0f - e2) / (1.0f + e2); r = xs < 0.f ? -th : th; }
                    else if (lane >= 32) r = 1.0f / (1.0f + __expf(-xs));
                    o4[i] = r; }
                u32x2v ow; ow.x = pk2(o4[0], o4[1]); ow.y = pk2(o4[2], o4[3]);
                *(GAS u32x2v*)(LA + (size_t)t * 256 + lane * 4) = ow;
            }
        }
        if (BOTH(2)) xcd_barrier(bar); STAMP(3);
    }
    if (IN(3)) {
        unsigned char* ws = ARG_WS; bf16* LA = (bf16*)(ws + WS_LA); bf16* WL = (bf16*)(ws + WS_WL); bf16* EB = (bf16*)(ws + WS_E);
        {
            unsigned char* dout = ARG_OUT; const bool big = F.vcu < 64;
            pg8::Gemm g{big ? (const bf16*)(dout + DO_XN) : (const bf16*)LA, big ? (const bf16*)(dout + DO_WIN) : (const bf16*)WL, M, big ? DIN : 1536, big ? DM : 256}; pg8::P3Order S{F.vcu};
            pg8::EpiBf16<0> E{big ? P_U : EB, big ? DIN : 1536, nullptr, 0, 0, 1.f};
            pg8::gemm_phase<pg8::EpiBf16<0>, pg8::P3Order, PG8_ALIGN, PG8_SP2>(F.lds + RING_OFF, g, S, E);
        }
        if (BOTH(3)) xcd_barrier(bar); STAMP(4);
    }
    if (IN(4)) {
        static_assert(attn_body::ATTN_LDS_BYTES <= RING_BYTES && rwkv_body::RWKV_LDS_BYTES <= RING_BYTES, "phase body LDS vs frame");
        {
            unsigned char* ws = ARG_WS; unsigned char* dout = ARG_OUT;
            const rwkv_body::Args RA{(unsigned long long*)(F.ctl + 9216), P_U, (bf16*)(ws + WS_E), RWKV_DBG ? (bf16*)(ws + WS_WGU) : (bf16*)(dout + DO_Y), RWKV_DBG ? (bf16*)(ws + WS_WGU + 16777216) : (bf16*)(dout + DO_BT), ws + WS_GH, ws + WS_Q1, ws + WS_Q2, ARG_IN(10), ARG_IN(16), ARG_IN(17), ARG_IN(18), ARG_IN(11), ARG_IN(13)};
            if (F.vcu < 256) {
                const int hd = F.vcu >> 2;
                rwkv_body::chunk_consts_to_lds((LAS char*)(F.lds + RING_OFF), RA, hd & 7); __syncthreads();
                rwkv_body::ChunkLoads LA_, LB_; const int c0 = (F.vcu & 3) * 8;
                rwkv_body::chunk_load(LA_, RA, hd >> 3, hd & 7, c0);
#pragma unroll 1
                for (int j = 0; j < 8; j += 2) {
                    const int gwv = F.vcu * NWAVES + F.wave; const float* jWg = ARG_IN(27); const float* jWu = ARG_IN(28); bf16* jWGU = (bf16*)(ws + WS_WGU);
                    rwkv_body::rwkv_chunk_task((LAS char*)(F.lds + RING_OFF), RA, LA_, LB_, true, hd >> 3, hd & 7, c0 + j, c0 + j + 1, jWg, jWu, jWGU, RWKV_DBG ? -1 : j * 2048 + gwv);
                    rwkv_body::rwkv_chunk_task((LAS char*)(F.lds + RING_OFF), RA, LB_, LA_, j + 2 < 8, hd >> 3, hd & 7, c0 + j + 1, c0 + j + 2, jWg, jWu, jWGU, RWKV_DBG ? -1 : (j + 1) * 2048 + gwv);
                }
            }
            xcd_barrier(bar); STAMP(13);
            if (RWKV_DBG != 3 && F.vcu < 256) { const int hd = F.vcu >> 2; rwkv_body::rwkv_seq_head((LAS char*)(F.lds + RING_OFF), RA, hd >> 3, hd & 7, F.vcu & 3); }
            STAMP(16);
        }
        if (RWKV_DBG && (F.vcu & 1) == 0 && F.vcu < 256) {
            unsigned char* ws = ARG_WS; unsigned char* dout = ARG_OUT; const int un = F.vcu >> 1;
            const scan_body::ScanArgs SA{P_U, (bf16*)(ws + WS_E), (bf16*)(dout + DO_Y), (bf16*)(dout + DO_BT), ARG_IN(10), ARG_IN(16), ARG_IN(17), ARG_IN(18), ARG_IN(11), ARG_IN(13)};
            scan_body::scan_unit((LAS float*)(F.lds + RING_OFF), SA, un >> 4, (un >> 1) & 7, un & 1);
        }
        {
        bf16* U = P_U; bf16* OA = (bf16*)(ARG_OUT + DO_O);
        const attn_body::AttnTensors AT{(const attn_body::bf16*)U, (attn_body::bf16*)OA};
        if (RWKV_DBG) attn_body::attn_phase_dyn<8>((char*)lds + RING_OFF, AT, (unsigned*)(F.ctl + CW_AQ), F.MISC, (int)(bar.x & 7u));
        else attn_body::attn_phase_static((char*)lds + RING_OFF, AT, F.vcu);
        }
        if (0) {
            unsigned char* ws = ARG_WS; const int lane = F.lane;
            const int gw = ((F.vcu >> 2) * 3 + (F.vcu & 3) - 1) * NWAVES + F.wave, NGW = (F.G >> 2) * 3 * NWAVES;
            LAS float* scr = (LAS float*)(F.lds + RING_OFF + F.wave * 16384);
            const float* Wg = ARG_IN(27); const float* Wu = ARG_IN(28);
            bf16* WGU = (bf16*)(ws + WS_WGU);
            for (int it = gw; it < 16384; it += NGW) { const int e = it >> 9, mat = (it >> 8) & 1, item = it & 255; const int n0 = 32 * (item & 15);
                p0_transpose_item((mat ? Wu : Wg) + (size_t)e * DM * DEXP, DM, DEXP, WGU, e * 1024 + (n0 >> 7) * 256 + (n0 & 127) - n0 + mat * 128, scr, item, lane); }
        }
        if (BOTH(4)) xcd_barrier(bar); STAMP(5);
    }
    if (IN(5)) {
        unsigned char* ws = ARG_WS; unsigned char* dout = ARG_OUT;
        const bf16* OA = (const bf16*)(dout + DO_O); const bf16* YB = (const bf16*)(dout + DO_Y); const bf16* BT = (const bf16*)(dout + DO_BT);
        const bf16* EB = (const bf16*)(ws + WS_E); bf16* MIX = (bf16*)(ws + WS_MIX);
        const int gw = F.vcu * NWAVES + F.wave, NGW = F.G * NWAVES; const int lane = F.lane;
        const float lam = __expf(wave_sum(ARG_IN(5)[lane] * ARG_IN(6)[lane])) - __expf(wave_sum(ARG_IN(7)[lane] * ARG_IN(8)[lane])) + 0.2f;
        const float* subg = ARG_IN(9); const float* lng = ARG_IN(19); const float* lnb = ARG_IN(20);
        const f32x4 sgA = *(const GAS f32x4*)(subg + 8 * (lane & 15)), sgB = *(const GAS f32x4*)(subg + 8 * (lane & 15) + 4);
        const f32x4 lgA = *(const GAS f32x4*)(lng + 8 * lane), lgB = *(const GAS f32x4*)(lng + 8 * lane + 4), lbA = *(const GAS f32x4*)(lnb + 8 * lane), lbB = *(const GAS f32x4*)(lnb + 8 * lane + 4);
#define UNPK8(W_, F_) do { F_[0] = __uint_as_float(W_[0] << 16); F_[1] = __uint_as_float(W_[0] & 0xffff0000u); F_[2] = __uint_as_float(W_[1] << 16); F_[3] = __uint_as_float(W_[1] & 0xffff0000u); \
                           F_[4] = __uint_as_float(W_[2] << 16); F_[5] = __uint_as_float(W_[2] & 0xffff0000u); F_[6] = __uint_as_float(W_[3] << 16); F_[7] = __uint_as_float(W_[3] & 0xffff0000u); } while (0)
        float dbg_d = 0.f, dbg_r = 0.f;
        for (int t = gw; t < M; t += NGW) {
            const int h = lane >> 4, e0 = 8 * (lane & 15);
            const v4u w0 = *(const GAS v4u*)(OA + (size_t)t * 1024 + h * 256 + e0), w1 = *(const GAS v4u*)(OA + (size_t)t * 1024 + h * 256 + 128 + e0);
            const v4u wy = *(const GAS v4u*)(YB + (size_t)t * 512 + 8 * lane), wb = *(const GAS v4u*)(BT + (size_t)t * 512 + 8 * lane), wg = *(const GAS v4u*)(EB + (size_t)t * 1536 + 1024 + 8 * lane);
            float o0[8], o1[8], o[8];
            UNPK8(w0, o0); UNPK8(w1, o1);
            float ss = 0.f;
#pragma unroll
            for (int i = 0; i < 8; ++i) { o[i] = o0[i] - lam * o1[i]; ss += o[i] * o[i]; }
            ss = scan_body::reduce16(ss);
            const float rs = 0.8f / sqrtf(ss * (1.0f / 128.0f) + 1e-5f);
            v4u mo; mo.x = pk2(o[0] * rs * sgA.x, o[1] * rs * sgA.y); mo.y = pk2(o[2] * rs * sgA.z, o[3] * rs * sgA.w); mo.z = pk2(o[4] * rs * sgB.x, o[5] * rs * sgB.y); mo.w = pk2(o[6] * rs * sgB.z, o[7] * rs * sgB.w);
            *(GAS v4u*)(MIX + (size_t)t * DM + h * 128 + e0) = mo;
            float y[8], bt[8], gt[8];
            UNPK8(wy, y); UNPK8(wb, bt); UNPK8(wg, gt);
            float sm = ((y[0] + y[1]) + (y[2] + y[3])) + ((y[4] + y[5]) + (y[6] + y[7]));
            sm = scan_body::dpp_add<0xB1>(sm); sm = scan_body::dpp_add<0x4E>(sm); sm = scan_body::dpp_add<0x141>(sm);
            const float mean = sm * (1.0f / 64.0f);
            float sq = 0.f;
#pragma unroll
            for (int i = 0; i < 8; ++i) { y[i] -= mean; sq += y[i] * y[i]; }
            sq = scan_body::dpp_add<0xB1>(sq); sq = scan_body::dpp_add<0x4E>(sq); sq = scan_body::dpp_add<0x141>(sq);
            const float rv = 1.0f / sqrtf(sq * (1.0f / 64.0f) + 64e-5f);
            const float lg8[8] = {lgA.x, lgA.y, lgA.z, lgA.w, lgB.x, lgB.y, lgB.z, lgB.w}, lb8[8] = {lbA.x, lbA.y, lbA.z, lbA.w, lbB.x, lbB.y, lbB.z, lbB.w};
            float r8[8];
#pragma unroll
            for (int i = 0; i < 8; ++i) r8[i] = (y[i] * rv * lg8[i] + lb8[i] + bt[i]) * gt[i];
            v4u ro; ro.x = pk2(r8[0], r8[1]); ro.y = pk2(r8[2], r8[3]); ro.z = pk2(r8[4], r8[5]); ro.w = pk2(r8[6], r8[7]);
            *(GAS v4u*)(MIX + (size_t)t * DM + 512 + 8 * lane) = ro;
            if (RWKV_DBG) {
                const bf16* S2 = (const bf16*)(ws + WS_WGU) + (RWKV_DBG == 2 ? 8388608 : 0); const bool dsel = (RWKV_DBG < 3) || ((t & 2047) < 64);
                const v4u w2 = *(const GAS v4u*)(S2 + (size_t)t * 512 + 8 * lane); const v4u w1_ = (RWKV_DBG == 2) ? wb : wy;
                float a2[8], a1[8]; UNPK8(w2, a2); UNPK8(w1_, a1);
                float dd = 0.f, rr = 0.f;
#pragma unroll
                for (int i = 0; i < 8; ++i) { const float df = a2[i] - a1[i]; dd += (df == df && fabsf(df) < 1e30f) ? df * df : 1e30f; rr += a1[i] * a1[i]; }
                if (dsel) { dbg_d += dd; dbg_r += rr; }
            }
        }
        if (RWKV_DBG) { dbg_d = wave_sum(dbg_d); dbg_r = wave_sum(dbg_r);
            if (lane == 0) { atomicAdd((float*)(F.ctl + CW_DBG), dbg_d); atomicAdd((float*)(F.ctl + CW_DBG + 1), dbg_r); } }
#undef UNPK8
        {
            LAS float* scr = (LAS float*)(F.lds + RING_OFF + F.wave * 16384);
            const float* Wd = ARG_IN(29); bf16* WDT = (bf16*)(ws + WS_WD);
            for (int it = gw; it < 8192; it += NGW) { const int e = it >> 8, item = it & 255; p0_transpose_item(Wd + (size_t)e * DEXP * DM, DEXP, DM, WDT, e * 1024, scr, item, lane); }
            if (RWKV_DBG) { const float* Wg = ARG_IN(27); const float* Wu = ARG_IN(28); bf16* WGU = (bf16*)(ws + WS_WGU);
                __syncthreads();
                for (int it = gw; it < 16384; it += NGW) { const int e = it >> 9, mat = (it >> 8) & 1, item = it & 255; const int n0 = 32 * (item & 15);
                    p0_transpose_item((mat ? Wu : Wg) + (size_t)e * DM * DEXP, DM, DEXP, WGU, e * 1024 + (n0 >> 7) * 256 + (n0 & 127) - n0 + mat * 128, scr, item, lane); } }
            const float* w_out = ARG_IN(21); bf16* Wt_out = (bf16*)(ws + WS_WOUT);
            for (int it = gw; it < (DM / 64) * (DM / 32); it += NGW) p0_transpose_item(w_out, DM, DM, Wt_out, 0, scr, it, lane);
        }
        if (BOTH(5)) xcd_barrier(bar); STAMP(6);
    }
    if (IN(6)) {
        unsigned char* ws = ARG_WS;
        pg8::Gemm g{(const bf16*)(ws + WS_MIX), (const bf16*)(ws + WS_WOUT), M, DM, DM}; pg8::StaticOrder S; S.init(M, DM, F.G, (int)blockIdx.x);
        pg8::EpiResF32 E{ARG_IN(0), (float*)ARG_OUT, DM};
        pg8::gemm_phase<pg8::EpiResF32, pg8::StaticOrder, false, PG8_SP2>(F.lds + RING_OFF, g, S, E);
        if (BOTH(6)) xcd_barrier(bar); STAMP(7);
    }
    if (IN(7)) {
        unsigned char* ws = ARG_WS; const float* hbuf = (const float*)ARG_OUT; const int lane = F.lane;
        const int gw = F.vcu * NWAVES + F.wave, NGW = F.G * NWAVES;
        {   const float* g2 = ARG_IN(22); bf16* T = (bf16*)(ws + WS_T);
            rms_rows_pipelined(lane, hbuf, g2, T, gw, NGW, 1e-6f); }
        STAMP(14);
        {   const float* brg = ARG_IN(24); const float* bre = ARG_IN(26); const GAS f32x4* WRP0 = (const GAS f32x4*)(ws + WS_WRP);
            int* slot_e = (int*)(ws + WS_SLOT_E); int* slot_p = (int*)(ws + WS_SLOT_P); float* slot_g = (float*)(ws + WS_SLOT_G);
            unsigned* cnt = (unsigned*)(F.ctl + CW_CNT);
            const int r = lane & 15, kq = lane >> 4;
            const int khalf = F.wave >> 2;
            for (int task = (F.wave & 3) * F.G + F.vcu; task < M / 16; task += 4 * F.G) {
                const int tok0 = task * 16;
                const GAS f32x4* arow = (const GAS f32x4*)(hbuf + (size_t)(tok0 + r) * DM) + kq + khalf * 128;
                const GAS f32x4* WRP = WRP0 + khalf * (32 * 3 * 64);
                f32x4 acc0 = {0.f, 0.f, 0.f, 0.f}, acc1 = acc0, acc2 = acc0; float ssq = 0.f;
                f32x4 ca0, ca1, ca2, ca3, cb0, cb1, cb2, cb3, cb4, cb5, cb6, cb7, cb8, cb9, cb10, cb11;
                f32x4 na0, na1, na2, na3, nb0, nb1, nb2, nb3, nb4, nb5, nb6, nb7, nb8, nb9, nb10, nb11;
#define RT_LD1(A_, B0_, B1_, B2_, sg_) do { A_ = arow[4 * (sg_)]; B0_ = WRP[((sg_) * 3 + 0) * 64 + lane]; B1_ = WRP[((sg_) * 3 + 1) * 64 + lane]; B2_ = WRP[((sg_) * 3 + 2) * 64 + lane]; } while (0)
#define RT_MM1(A_, B0_, B1_, B2_) do { ssq += (A_.x * A_.x + A_.y * A_.y) + (A_.z * A_.z + A_.w * A_.w); \
        acc0 = __builtin_amdgcn_mfma_f32_16x16x4f32(A_.x, B0_.x, acc0, 0, 0, 0); acc1 = __builtin_amdgcn_mfma_f32_16x16x4f32(A_.x, B1_.x, acc1, 0, 0, 0); acc2 = __builtin_amdgcn_mfma_f32_16x16x4f32(A_.x, B2_.x, acc2, 0, 0, 0); \
        acc0 = __builtin_amdgcn_mfma_f32_16x16x4f32(A_.y, B0_.y, acc0, 0, 0, 0); acc1 = __builtin_amdgcn_mfma_f32_16x16x4f32(A_.y, B1_.y, acc1, 0, 0, 0); acc2 = __builtin_amdgcn_mfma_f32_16x16x4f32(A_.y, B2_.y, acc2, 0, 0, 0); \
        acc0 = __builtin_amdgcn_mfma_f32_16x16x4f32(A_.z, B0_.z, acc0, 0, 0, 0); acc1 = __builtin_amdgcn_mfma_f32_16x16x4f32(A_.z, B1_.z, acc1, 0, 0, 0); acc2 = __builtin_amdgcn_mfma_f32_16x16x4f32(A_.z, B2_.z, acc2, 0, 0, 0); \
        acc0 = __builtin_amdgcn_mfma_f32_16x16x4f32(A_.w, B0_.w, acc0, 0, 0, 0); acc1 = __builtin_amdgcn_mfma_f32_16x16x4f32(A_.w, B1_.w, acc1, 0, 0, 0); acc2 = __builtin_amdgcn_mfma_f32_16x16x4f32(A_.w, B2_.w, acc2, 0, 0, 0); } while (0)
                RT_LD1(ca0, cb0, cb1, cb2, 0); RT_LD1(ca1, cb3, cb4, cb5, 1); RT_LD1(ca2, cb6, cb7, cb8, 2); RT_LD1(ca3, cb9, cb10, cb11, 3);
                for (int g = 0; g < 8; ++g) {
                    const int gn = (g + 1 < 8) ? g + 1 : g;
                    RT_LD1(na0, nb0, nb1, nb2, gn * 4); RT_LD1(na1, nb3, nb4, nb5, gn * 4 + 1); RT_LD1(na2, nb6, nb7, nb8, gn * 4 + 2); RT_LD1(na3, nb9, nb10, nb11, gn * 4 + 3);
                    __builtin_amdgcn_sched_barrier(0);
                    RT_MM1(ca0, cb0, cb1, cb2); RT_MM1(ca1, cb3, cb4, cb5); RT_MM1(ca2, cb6, cb7, cb8); RT_MM1(ca3, cb9, cb10, cb11);
                    __builtin_amdgcn_sched_barrier(0);
                    ca0 = na0; ca1 = na1; ca2 = na2; ca3 = na3; cb0 = nb0; cb1 = nb1; cb2 = nb2; cb3 = nb3; cb4 = nb4; cb5 = nb5; cb6 = nb6; cb7 = nb7; cb8 = nb8; cb9 = nb9; cb10 = nb10; cb11 = nb11;
                }
#undef RT_LD1
#undef RT_MM1
                ssq += __shfl_xor(ssq, 16); ssq += __shfl_xor(ssq, 32);
                LAS float* LGT = (LAS float*)(F.lds + RING_OFF + (F.wave & 3) * 8192);
                LAS float* LGh = LGT + khalf * 768;
#pragma unroll
                for (int q = 0; q < 4; ++q) { const int row = 4 * kq + q; LGh[row * 48 + r] = acc0[q]; LGh[row * 48 + 16 + r] = acc1[q]; LGh[row * 48 + 32 + r] = acc2[q]; }
                if (lane < 16) LGT[1536 + khalf * 16 + lane] = ssq;
                LAS unsigned* hist = (LAS unsigned*)(F.lds + RING_OFF + 32768); LAS unsigned* hbase = hist + 32;
                if (F.tid < 32) hist[F.tid] = 0u;
                __syncthreads();
                int ea = 0, eb = 0; unsigned la = 0u, lb = 0u; float ga = 0.f, gb = 0.f;
                if (khalf == 0 && lane < 16) {
                    const LAS float* lg = LGT + lane * 48; const LAS float* lh = LGT + 768 + lane * 48;
                    const float rs = 1.f / sqrtf((LGT[1536 + lane] + LGT[1552 + lane]) * (1.f / DM) + 1e-6f);
                    const float lg0 = (lg[32] + lh[32]) * rs + brg[0], lg1 = (lg[33] + lh[33]) * rs + brg[1], lg2 = (lg[34] + lh[34]) * rs + brg[2], lg3 = (lg[35] + lh[35]) * rs + brg[3];
                    int gs = 0; float gm = lg0;
                    if (lg1 > gm) { gm = lg1; gs = 1; }
                    if (lg2 > gm) { gm = lg2; gs = 2; }
                    if (lg3 > gm) { gm = lg3; gs = 3; }
                    const float pgroup = 1.0f / (expf(lg0 - gm) + expf(lg1 - gm) + expf(lg2 - gm) + expf(lg3 - gm));
                    int i1 = 0, i2 = -1; float v1 = -3.0e38f, v2 = -3.0e38f;
                    for (int q = 0; q < 8; ++q) { const float x = (lg[gs * 8 + q] + lh[gs * 8 + q]) * rs + bre[gs * 8 + q];
                        if (x > v1) { v2 = v1; i2 = i1; v1 = x; i1 = q; } else if (x > v2) { v2 = x; i2 = q; } }
                    if (i2 < 0 || i2 == i1) i2 = (i1 + 1) & 7;
                    const float e2 = expf(v2 - v1);
                    ea = gs * 8 + i1; eb = gs * 8 + i2; ga = pgroup / (1.0f + e2); gb = pgroup * e2 / (1.0f + e2);
                    la = __hip_atomic_fetch_add(hist + ea, 1u, __ATOMIC_RELAXED, __HIP_MEMORY_SCOPE_WORKGROUP);
                    lb = __hip_atomic_fetch_add(hist + eb, 1u, __ATOMIC_RELAXED, __HIP_MEMORY_SCOPE_WORKGROUP);
                }
                __syncthreads();
                if (F.tid < 32) { const unsigned n = hist[F.tid]; hbase[F.tid] = n ? __hip_atomic_fetch_add(cnt + 64 * F.tid, n, __ATOMIC_RELAXED, __HIP_MEMORY_SCOPE_AGENT) : 0u; }
                __syncthreads();
                if (khalf == 0 && lane < 16) {
                    const int tok = tok0 + lane;
                    slot_e[tok * 2] = ea; slot_p[tok * 2] = (int)(hbase[ea] + la); slot_g[tok * 2] = ga;
                    slot_e[tok * 2 + 1] = eb; slot_p[tok * 2 + 1] = (int)(hbase[eb] + lb); slot_g[tok * 2 + 1] = gb;
                }
                __syncthreads();
            }
        }
        STAMP(15);
        if (BOTH(7)) xcd_barrier(bar); STAMP(8);
    }
    if (IN(8)) {
        unsigned char* ws = ARG_WS; const int lane = F.lane;
        const int* slot_e = (const int*)(ws + WS_SLOT_E); const int* slot_p = (const int*)(ws + WS_SLOT_P); const float* slot_g = (const float*)(ws + WS_SLOT_G);
        int* rowslot = (int*)(ws + WS_ROWSLOT); float* rowgate = (float*)(ws + WS_ROWGATE); int* rowtok = (int*)(ws + WS_ROWTOK);
        const int gw = F.vcu * NWAVES + F.wave, NGW = F.G * NWAVES;
        const int mycnt = lane < 32 ? (int)__hip_atomic_load((unsigned*)(F.ctl + CW_CNT) + 64 * lane, __ATOMIC_RELAXED, __HIP_MEMORY_SCOPE_AGENT) : 0;
        const int mypad = (mycnt + 255) & ~255;
        int incl = mypad;
#pragma unroll
        for (int o = 1; o < 32; o <<= 1) { const int t = __shfl_up(incl, o); if (lane >= o) incl += t; }
        const int myoff = incl - mypad;
        for (int sl = gw * 64 + lane; sl < 2 * M; sl += NGW * 64) {
            const int e = slot_e[sl], p = slot_p[sl]; const int dest = __shfl(myoff, e) + p;
            rowslot[dest] = sl; rowgate[dest] = slot_g[sl]; rowtok[dest] = sl >> 1;
        }
        for (int idx = gw * 64 + lane; idx < 32 * 256; idx += NGW * 64) {
            const int e = idx >> 8, j = idx & 255; const int c = __shfl(mycnt, e), pd = __shfl(mypad, e), of = __shfl(myoff, e);
            if (c + j < pd) { const int dest = of + c + j; rowslot[dest] = -1; rowgate[dest] = 0.f; rowtok[dest] = -1; }
        }
        if (BOTH(8)) xcd_barrier(bar); STAMP(9);
    }
    if (IN(9) || IN(10)) {
        LAS int* tile_e = (LAS int*)(F.lds + TILE_E_OFF);
        int ntiles;
        {   const int lane = F.lane;
            const int mycnt = lane < 32 ? (int)__hip_atomic_load((unsigned*)(F.ctl + CW_CNT) + 64 * lane, __ATOMIC_RELAXED, __HIP_MEMORY_SCOPE_AGENT) : 0;
            const int myt = (mycnt + 255) >> 8;
            int incl = myt;
#pragma unroll
            for (int o = 1; o < 32; o <<= 1) { const int t = __shfl_up(incl, o); if (lane >= o) incl += t; }
            ntiles = __shfl(incl, 31);
            if (F.wave == 0 && lane < 32) { for (int j = 0; j < myt; ++j) tile_e[incl - myt + j] = lane; }
            __syncthreads();
        }
        unsigned char* ws = ARG_WS;
        if (IN(9)) {
            pg8::Gemm g{(const bf16*)(ws + WS_T), (const bf16*)(ws + WS_WGU), 0, 0, DM}; pg8::MoeOrder S{ntiles, F.G, F.vcu, tile_e, (const int*)(ws + WS_ROWTOK)};
            pg8::EpiSwiGLU E{(bf16*)(ws + WS_ACT)};
            pg8::gemm_phase<pg8::EpiSwiGLU, pg8::MoeOrder, PG8_ALIGN, PG8_SP2, true>(F.lds + RING_OFF, g, S, E);
            if (BOTH(9)) xcd_barrier(bar); STAMP(10);
        }
        if (IN(10)) {
            pg8::Gemm g{(const bf16*)(ws + WS_ACT), (const bf16*)(ws + WS_WD), 0, 0, DEXP}; pg8::MoeOrder S{ntiles, F.G, F.vcu, tile_e, nullptr};
            pg8::EpiScatter E{(bf16*)(ws + WS_YB), (const int*)(ws + WS_ROWSLOT), (const float*)(ws + WS_ROWGATE)};
            pg8::gemm_phase<pg8::EpiScatter, pg8::MoeOrder, PG8_ALIGN, PG8_SP2>(F.lds + RING_OFF, g, S, E);
            if (BOTH(10)) xcd_barrier(bar); STAMP(11);
        }
    }
    if (IN(11)) {
        unsigned char* ws = ARG_WS; float* outp = (float*)ARG_OUT; const bf16* YB = (const bf16*)(ws + WS_YB); const int lane = F.lane;
        const int gw = F.vcu * NWAVES + F.wave, NGW = F.G * NWAVES;
        float dscale = 1.0f;
        if (RWKV_DBG) { const float dd = __hip_atomic_load((float*)(F.ctl + CW_DBG), __ATOMIC_RELAXED, __HIP_MEMORY_SCOPE_AGENT), rr = __hip_atomic_load((float*)(F.ctl + CW_DBG + 1), __ATOMIC_RELAXED, __HIP_MEMORY_SCOPE_AGENT);
            dscale = 1.0f + sqrtf(fminf(dd / fmaxf(rr, 1e-30f), 1e6f)); }
        {
            f32x4 ch[4]; unsigned long long ca[4], cb[4];
#define P11_LOAD(H_, A_, B_, tok_) do { const GAS f32x4* or_ = (const GAS f32x4*)(outp + (size_t)(tok_) * DM); \
                const GAS unsigned long long* y0_ = (const GAS unsigned long long*)(YB + (size_t)(2 * (tok_)) * DM), *y1_ = (const GAS unsigned long long*)(YB + (size_t)(2 * (tok_) + 1) * DM); \
                _Pragma("unroll") for (int j_ = 0; j_ < 4; ++j_) { H_[j_] = or_[64 * j_ + lane]; A_[j_] = y0_[64 * j_ + lane]; B_[j_] = y1_[64 * j_ + lane]; } } while (0)
            if (gw < M) P11_LOAD(ch, ca, cb, gw);
            for (int tok = gw; tok < M; tok += NGW) {
                f32x4 nh[4]; unsigned long long na[4], nb[4];
#pragma unroll
                for (int j = 0; j < 4; ++j) { nh[j] = ch[j]; na[j] = ca[j]; nb[j] = cb[j]; }
                if (tok + NGW < M) P11_LOAD(nh, na, nb, tok + NGW);
                GAS f32x4* orow = (GAS f32x4*)(outp + (size_t)tok * DM);
#pragma unroll
                for (int j = 0; j < 4; ++j) { const int q = 64 * j + lane; f32x4 h = ch[j]; const unsigned long long a = ca[j], b = cb[j];
                    h.x += __uint_as_float((unsigned)a << 16) + __uint_as_float((unsigned)b << 16);
                    h.y += __uint_as_float((unsigned)a & 0xffff0000u) + __uint_as_float((unsigned)b & 0xffff0000u);
                    h.z += __uint_as_float((unsigned)(a >> 32) << 16) + __uint_as_float((unsigned)(b >> 32) << 16);
                    h.w += __uint_as_float((unsigned)(a >> 32) & 0xffff0000u) + __uint_as_float((unsigned)(b >> 32) & 0xffff0000u);
                    if (RWKV_DBG) h = h * dscale;
                    orow[q] = h; }
#pragma unroll
                for (int j = 0; j < 4; ++j) { ch[j] = nh[j]; ca[j] = na[j]; cb[j] = nb[j]; }
            }
#undef P11_LOAD
        }
    }
    STAMP(12);
#ifndef PROBE_MULT
#define PROBE_MULT 4
#endif
    if (PROBE_K >= 0 && blockIdx.x == 0 && F.tid == 0) {
        const GAS unsigned long long* ts = (const GAS unsigned long long*)(F.ctl + CW_TS);
#ifndef PROBE_A
#define PROBE_A PROBE_K
#define PROBE_B (PROBE_K + 1)
#endif
        const unsigned long long d = (ts[PROBE_B] - ts[PROBE_A]) * PROBE_MULT, t0 = rt();
        while (rt() - t0 < d) __builtin_amdgcn_s_sleep(8);
    }
#undef IN
#undef BOTH
}

extern "C" void kernel_launch(void* const* d_in, const int* in_sizes, int n_in, void* d_out, int out_size, void* d_ws, size_t ws_size, hipStream_t stream) {
    static int grid = 0;
    if (grid == 0) {
        int dev = 0, cus = 0;
        if (hipGetDevice(&dev) != hipSuccess || hipDeviceGetAttribute(&cus, hipDeviceAttributeMultiprocessorCount, dev) != hipSuccess) { grid = -1; return; }
        if (hipFuncSetAttribute((const void*)skel_fwd, hipFuncAttributeMaxDynamicSharedMemorySize, LDS_BYTES) != hipSuccess) { grid = -1; return; }
        grid = cus;
        if (n_in != 30 || ws_size < WS_TOTAL || out_size != M * DM) { fprintf(stderr, "kernel_launch: unexpected problem (n_in %d, ws %zu, out %d)\n", n_in, ws_size, out_size); grid = -1; return; }
        if (grid != 256) fprintf(stderr, "kernel_launch: %d CUs; the phase programs assume 256\n", grid);
    }
    if (grid < 0) return;
    (void)hipMemsetAsync((char*)d_ws + WS_CTL, 0, CTL_ZERO_BYTES, stream);
    Args a{};
    for (int i = 0; i < 30; ++i) a.in[i] = (const float*)d_in[i];
    a.out = (float*)d_out; a.ws = (unsigned char*)d_ws; a.ph_lo = 0; a.ph_hi = 12;
    hipLaunchKernelGGL(skel_fwd, dim3(grid), dim3(NWAVES * 64), LDS_BYTES, stream, a);
}
```

```cpp
#include <hip/hip_runtime.h>
#include <cstdio>
#include <cstdint>
namespace pg8 {
#define PG8_LAS __attribute__((address_space(3)))
typedef unsigned short bf16_t;
typedef short bf16x8 __attribute__((ext_vector_type(8)));
typedef float f32x4 __attribute__((ext_vector_type(4)));
typedef unsigned u32x4 __attribute__((ext_vector_type(4)));
constexpr int BM = 256, BK = 64, HALF = 128, HTB = HALF * BK * 2  , STAGE_BYTES = 8 * HTB, NXCD = 8, WGM = 8;

__host__ __device__ __forceinline__ int lds_byte(int r, int c) { const int st = (r >> 4) * 2 + (c >> 5), rr = r & 15, cc = c & 31, ob = rr * 64 + cc * 2; return st * 1024 + (ob ^ (((ob >> 9) & 1) << 5)); }
__host__ __device__ __forceinline__ void stage_rc(int b, int& R, int& C) { const int st = b / 1024, sb = b % 1024, swz = sb ^ (((sb >> 9) & 1) << 5); R = (st >> 1) * 16 + swz / 64; C = (st & 1) * 32 + (swz % 64) / 2; }
__host__ __device__ __forceinline__ int perm32(int rho) { const int n = rho >> 4, i = rho & 15; return 8 * (i >> 2) + 4 * n + (i & 3); }

struct Unit { int pm, pn; };
struct Gemm { const bf16_t* A; const bf16_t* Bt; int M, N, K; };

struct StaticOrder {
    int nM, nN, nwg, G, c;
    __host__ __device__ void init(int M, int N, int G_, int c_) { nM = M / BM; nN = N / BM; nwg = nM * nN; G = G_; c = c_; }
    __host__ __device__ bool next(int i, Unit& u) const {
        const long L = (long)i * G + c; if (L >= nwg) return false;
        int wgid = (int)L; { const int q = nwg / NXCD, r = nwg % NXCD, xcd = wgid % NXCD, off = wgid / NXCD; wgid = (xcd < r ? xcd * (q + 1) : r * (q + 1) + (xcd - r) * q) + off; }
        const int nig = WGM * nN, gid = wgid / nig, fm = gid * WGM, gsz = (nM - fm) < WGM ? (nM - fm) : WGM;
        u.pm = fm + ((wgid % nig) % gsz); u.pn = (wgid % nig) / gsz; return true;
    }
    __device__ __forceinline__ void a_ready(const Unit&) const {}
    __device__ __forceinline__ void done(const Unit&) const {}
};

__device__ __forceinline__ unsigned cvt_pk_bf16(float lo, float hi) { unsigned r; asm volatile("v_cvt_pk_bf16_f32 %0, %1, %2" : "=v"(r) : "v"(lo), "v"(hi)); return r; }
typedef float f32x2 __attribute__((ext_vector_type(2)));
__device__ __forceinline__ f32x2 gelu_pk(f32x2 v) {
    const f32x2 av = __builtin_elementwise_abs(v), d = av * 0.2316418882f + 1.0f;
    f32x2 t; t.x = __builtin_amdgcn_rcpf(d.x); t.y = __builtin_amdgcn_rcpf(d.y);
    f32x2 q = t * 0.5307027145f + (-0.7265760135f); q = q * t + 0.7107068705f; q = q * t + (-0.142248368f); q = q * t + 0.127414796f; q = q * t;
    const f32x2 s = (v * v) * (-0.72134752044f);
    f32x2 e; e.x = __builtin_amdgcn_exp2f(s.x); e.y = __builtin_amdgcn_exp2f(s.y);
    const f32x2 m = v * (q * e), r = v - m;
    f32x2 o; o.x = v.x < 0.f ? m.x : r.x; o.y = v.y < 0.f ? m.y : r.y; return o;
}

template <int ACT  > struct EpiBf16 {
    static constexpr bool PERM = true, AFTER_DRAIN = false; static_assert(ACT == 0 || ACT == 1, "EpiBf16: ACT is 0 (none) or 1 (gelu_pk)");
    bf16_t* O; int ldc; const float* bias; int split_cols; size_t split_stride; float scale0;
    __device__ __forceinline__ void operator()(const f32x4 (&acc)[2][2][4][2], const Unit& u, int wr, int wc, int fr, int fq) const {
        const int row0 = u.pm * BM + wr * 64 + fr; int colt = u.pn * BM; bf16_t* base = O;
        float sc = 1.f; if (split_cols) { const int t = colt / split_cols; base += (size_t)t * split_stride; colt -= t * split_cols; if (t == 0) sc = scale0; }
        const int col0 = colt + wc * 32 + 8 * fq, bcol0 = u.pn * BM + wc * 32 + 8 * fq;
        f32x4 bv[2][2];
#pragma unroll
        for (int bj = 0; bj < 2; ++bj)
#pragma unroll
            for (int n = 0; n < 2; ++n) bv[bj][n] = bias ? *(const f32x4*)(bias + bcol0 + bj * HALF + 4 * n) : (f32x4){0.f, 0.f, 0.f, 0.f};
#pragma unroll
        for (int ai = 0; ai < 2; ++ai)
#pragma unroll
            for (int m = 0; m < 4; ++m) { bf16_t* rowp = base + (size_t)(row0 + ai * HALF + m * 16) * ldc + col0;
#pragma unroll
                for (int bj = 0; bj < 2; ++bj) { f32x4 v0 = acc[ai][bj][m][0] + bv[bj][0], v1 = acc[ai][bj][m][1] + bv[bj][1];
                    if (ACT == 1) { f32x2 a = gelu_pk((f32x2){v0[0], v0[1]}), b = gelu_pk((f32x2){v0[2], v0[3]}), c = gelu_pk((f32x2){v1[0], v1[1]}), d = gelu_pk((f32x2){v1[2], v1[3]});
                        v0 = (f32x4){a.x, a.y, b.x, b.y}; v1 = (f32x4){c.x, c.y, d.x, d.y}; }
                    v0 = v0 * sc; v1 = v1 * sc; u32x4 w; w.x = cvt_pk_bf16(v0[0], v0[1]); w.y = cvt_pk_bf16(v0[2], v0[3]); w.z = cvt_pk_bf16(v1[0], v1[1]); w.w = cvt_pk_bf16(v1[2], v1[3]);
                    *(u32x4*)(rowp + bj * HALF) = w; } }
    }
};

struct PanelStats {
    unsigned* xbuf;
    unsigned* cnt;
    unsigned* tmo;
    int ntn; float eps;
    unsigned code;
    __device__ __forceinline__ bool run(const f32x4 (&v)[2][2][4][2], const Unit& u, int wr, int wc, int fr, int fq, PG8_LAS unsigned char* lds, int wid, int lane) const {
        typedef float f32x2v __attribute__((ext_vector_type(2)));
        PG8_LAS f32x2v* P = (PG8_LAS f32x2v*)lds;
        PG8_LAS f32x2v* S = (PG8_LAS f32x2v*)(lds + 8192);
        PG8_LAS unsigned* flag = (PG8_LAS unsigned*)(lds + 8192 + 2048);
#pragma unroll
        for (int ai = 0; ai < 2; ++ai)
#pragma unroll
            for (int m = 0; m < 4; ++m) {
                float s = 0.f;
#pragma unroll
                for (int bj = 0; bj < 2; ++bj)
#pragma unroll
                    for (int n = 0; n < 2; ++n) { const f32x4 x = v[ai][bj][m][n]; s += (x[0] + x[1]) + (x[2] + x[3]); }
                s += __shfl_xor(s, 16); s += __shfl_xor(s, 32);
                const float mw = s * (1.0f / 64.0f); float q = 0.f;
#pragma unroll
                for (int bj = 0; bj < 2; ++bj)
#pragma unroll
                    for (int n = 0; n < 2; ++n) { const f32x4 d = v[ai][bj][m][n] - mw; q += (d[0] * d[0] + d[1] * d[1]) + (d[2] * d[2] + d[3] * d[3]); }
                q += __shfl_xor(q, 16); q += __shfl_xor(q, 32);
                if (fq == 0) P[(ai * HALF + wr * 64 + m * 16 + fr) * 4 + wc] = (f32x2v){mw, q};
            }
        asm volatile("s_waitcnt lgkmcnt(0)" ::: "memory"); __builtin_amdgcn_s_barrier(); asm volatile("" ::: "memory");
#if defined(BROKEN_EXCHANGE_NO_WAIT)
#warning BROKEN CONTROL BUILD: the row-statistics exchange does not wait; results are wrong by design
        if (blockIdx.x >= 64) { const long long t0_ = clock64(); while (clock64() - t0_ < 60000) __builtin_amdgcn_s_sleep(8); }
#endif
        const int row = wid * 32 + (lane & 31);
        if (lane < 32) {
            const f32x2v a = P[row * 4 + 0], b = P[row * 4 + 1], c = P[row * 4 + 2], d = P[row * 4 + 3];
            const float mt = (a.x + b.x + c.x + d.x) * 0.25f;
            const float da = a.x - mt, db = b.x - mt, dc = c.x - mt, dd = d.x - mt;
            const float m2 = (a.y + b.y) + (c.y + d.y) + 64.0f * ((da * da + db * db) + (dc * dc + dd * dd));
            unsigned long long* slot = (unsigned long long*)xbuf + ((size_t)(u.pm * BM + row) * 4 + u.pn);
            __hip_atomic_store(slot, ((unsigned long long)__float_as_uint(m2) << 32) | __float_as_uint(mt), __ATOMIC_RELAXED, __HIP_MEMORY_SCOPE_AGENT);
        }
        asm volatile("s_waitcnt vmcnt(0)" ::: "memory");
        if (lane == 0) __hip_atomic_fetch_add(cnt + 64 * u.pm, 1u, __ATOMIC_RELAXED, __HIP_MEMORY_SCOPE_AGENT);
        if (wid == 0) {
            bool dead = false; const unsigned long long t0 = __builtin_amdgcn_s_memrealtime(); const unsigned want = 8u * (unsigned)ntn;
            for (;;) {
#if defined(BROKEN_EXCHANGE_NO_WAIT)
                break;
#endif
                if ((unsigned)__builtin_amdgcn_readfirstlane(__hip_atomic_load(cnt + 64 * u.pm, __ATOMIC_RELAXED, __HIP_MEMORY_SCOPE_AGENT)) >= want) break;
                if (__builtin_amdgcn_s_memrealtime() - t0 > 2000000ull) {
                    if (lane == 0) { unsigned expect = 0u; __hip_atomic_compare_exchange_strong(tmo + 1, &expect, code | (unsigned)(u.pm & 0xff), __ATOMIC_RELAXED, __ATOMIC_RELAXED, __HIP_MEMORY_SCOPE_AGENT);
                                     __hip_atomic_store(tmo, 1u, __ATOMIC_RELAXED, __HIP_MEMORY_SCOPE_AGENT); }
                    dead = true; break; }
                __builtin_amdgcn_s_sleep(2);
            }
            __builtin_amdgcn_fence(__ATOMIC_ACQUIRE, "agent");
            if (lane == 0) flag[0] = dead ? 1u : 0u;
        }
        asm volatile("s_waitcnt vmcnt(0) lgkmcnt(0)" ::: "memory"); __builtin_amdgcn_s_barrier(); asm volatile("" ::: "memory");
        const bool bad = flag[0] != 0u;
        if (lane < 32) {
            const unsigned long long* slot = (const unsigned long long*)xbuf + (size_t)(u.pm * BM + row) * 4; float mt[4], m2[4]; float ms = 0.f;
#pragma unroll
            for (int t = 0; t < 4; ++t) { if (t < ntn) { const unsigned long long w = __hip_atomic_load(slot + t, __ATOMIC_RELAXED, __HIP_MEMORY_SCOPE_AGENT); mt[t] = __uint_as_float((unsigned)w); m2[t] = __uint_as_float((unsigned)(w >> 32)); } else { mt[t] = 0.f; m2[t] = 0.f; } ms += mt[t]; }
            const float mean = ms / (float)ntn; float q = 0.f;
#pragma unroll
            for (int t = 0; t < 4; ++t) if (t < ntn) { const float dm = mt[t] - mean; q += m2[t] + 256.0f * dm * dm; }
            S[row] = (f32x2v){mean, 1.0f / sqrtf(q / (256.0f * (float)ntn) + eps)};
        }
        asm volatile("s_waitcnt lgkmcnt(0)" ::: "memory"); __builtin_amdgcn_s_barrier(); asm volatile("" ::: "memory");
        return bad;
    }
};
struct EpiLnRes {
    static constexpr bool PERM = false, AFTER_DRAIN = true;
    const float* base; float* out; int ldc; const float* bias; PanelStats st; unsigned poison;
    __device__ __forceinline__ void fused(f32x4 (&acc)[2][2][4][2], const Unit& u, int wr, int wc, int fr, int fq, PG8_LAS unsigned char* lds, int wid, int lane) const {
        typedef float f32x2v __attribute__((ext_vector_type(2)));
        const PG8_LAS f32x2v* S = (const PG8_LAS f32x2v*)(lds + 8192);
        const int col0 = u.pn * BM + wc * 32 + 4 * fq;
#pragma unroll
        for (int bj = 0; bj < 2; ++bj)
#pragma unroll
            for (int n = 0; n < 2; ++n) { const f32x4 bv = bias ? *(const f32x4*)(bias + col0 + bj * HALF + n * 16) : (f32x4){0.f, 0.f, 0.f, 0.f};
#pragma unroll
                for (int ai = 0; ai < 2; ++ai)
#pragma unroll
                    for (int m = 0; m < 4; ++m) acc[ai][bj][m][n] += bv; }
        f32x4 pre[4][2][2];
#pragma unroll
        for (int m = 0; m < 4; ++m) { const size_t off = (size_t)(u.pm * BM + wr * 64 + m * 16 + fr) * ldc + col0;
#pragma unroll
            for (int bj = 0; bj < 2; ++bj)
#pragma unroll
                for (int n = 0; n < 2; ++n) pre[m][bj][n] = *(const f32x4*)(base + off + bj * HALF + n * 16); }
        const bool bad = st.run(acc, u, wr, wc, fr, fq, lds, wid, lane) || poison != 0u;
        const float qnan = __builtin_nanf("");
#pragma unroll
        for (int ai = 0; ai < 2; ++ai)
#pragma unroll
            for (int m = 0; m < 4; ++m) { const int r = ai * HALF + wr * 64 + m * 16 + fr; const f32x2v sr = S[r]; const size_t off = (size_t)(u.pm * BM + r) * ldc + col0;
#pragma unroll
                for (int bj = 0; bj < 2; ++bj)
#pragma unroll
                    for (int n = 0; n < 2; ++n) { const f32x4 bs = ai == 0 ? pre[m][bj][n] : *(const f32x4*)(base + off + bj * HALF + n * 16); f32x4 o = bs + (acc[ai][bj][m][n] - sr.x) * sr.y;
                        if (bad) o = (f32x4){qnan, qnan, qnan, qnan}; *(f32x4*)(out + off + bj * HALF + n * 16) = o; }
                if (m & 1) asm volatile("" ::: "memory"); }
    }
};
struct EpiLnResLn {
    static constexpr bool PERM = false, AFTER_DRAIN = true;
    const float* base; float* out; bf16_t* xn; int ldc; const float* bias; PanelStats st1, st2; unsigned poison;
    __device__ __forceinline__ void fused(f32x4 (&acc)[2][2][4][2], const Unit& u, int wr, int wc, int fr, int fq, PG8_LAS unsigned char* lds, int wid, int lane) const {
        typedef float f32x2v __attribute__((ext_vector_type(2))); typedef unsigned u32x2v __attribute__((ext_vector_type(2)));
        const PG8_LAS f32x2v* S = (const PG8_LAS f32x2v*)(lds + 8192);
        const int col0 = u.pn * BM + wc * 32 + 4 * fq;
#pragma unroll
        for (int bj = 0; bj < 2; ++bj)
#pragma unroll
            for (int n = 0; n < 2; ++n) { const f32x4 bv = bias ? *(const f32x4*)(bias + col0 + bj * HALF + n * 16) : (f32x4){0.f, 0.f, 0.f, 0.f};
#pragma unroll
                for (int ai = 0; ai < 2; ++ai)
#pragma unroll
                    for (int m = 0; m < 4; ++m) acc[ai][bj][m][n] += bv; }
        bool bad = st1.run(acc, u, wr, wc, fr, fq, lds, wid, lane) || poison != 0u;
        const float qnan = __builtin_nanf("");
#pragma unroll
        for (int ai = 0; ai < 2; ++ai)
#pragma unroll
            for (int m = 0; m < 4; ++m) { const int r = ai * HALF + wr * 64 + m * 16 + fr; const f32x2v sr = S[r]; const size_t off = (size_t)(u.pm * BM + r) * ldc + col0;
#pragma unroll
                for (int bj = 0; bj < 2; ++bj)
#pragma unroll
                    for (int n = 0; n < 2; ++n) { const f32x4 bs = *(const f32x4*)(base + off + bj * HALF + n * 16); acc[ai][bj][m][n] = bs + (acc[ai][bj][m][n] - sr.x) * sr.y; }
                asm volatile("" : "+v"(acc[ai][0][m][0]), "+v"(acc[ai][0][m][1]), "+v"(acc[ai][1][m][0]), "+v"(acc[ai][1][m][1]));
                if (m & 1) asm volatile("" ::: "memory"); }
        const bool bad1 = bad;
        bad = st2.run(acc, u, wr, wc, fr, fq, lds, wid, lane) || bad;
#pragma unroll
        for (int ai = 0; ai < 2; ++ai)
#pragma unroll
            for (int m = 0; m < 4; ++m) { const int r = ai * HALF + wr * 64 + m * 16 + fr; const f32x2v sr = S[r]; const size_t off = (size_t)(u.pm * BM + r) * ldc + col0;
#pragma unroll
                for (int bj = 0; bj < 2; ++bj)
#pragma unroll
                    for (int n = 0; n < 2; ++n) { const f32x4 x1 = acc[ai][bj][m][n]; *(f32x4*)(out + off + bj * HALF + n * 16) = bad1 ? (f32x4){qnan, qnan, qnan, qnan} : x1;
                        const f32x4 o = (x1 - sr.x) * sr.y; u32x2v w; w.x = cvt_pk_bf16(o[0], o[1]); w.y = cvt_pk_bf16(o[2], o[3]);
                        if (bad) { w.x = 0x7fc07fc0u; w.y = 0x7fc07fc0u; } *(u32x2v*)(xn + off + bj * HALF + n * 16) = w; }
                asm volatile("" ::: "memory"); }
    }
};

template <class Epi, class Sched, bool ALIGN_EPI = false, bool SP2 = false, bool GATHER = false>
__device__ __forceinline__ void gemm_phase(PG8_LAS unsigned char* lds, const Gemm g, const Sched& S, const Epi& E) {
    const int tid = threadIdx.x, wid = __builtin_amdgcn_readfirstlane(tid >> 6), lane = tid & 63, wr = wid >> 2, wc = wid & 3, fr = lane & 15, fq = lane >> 4;
    const int K = g.K, nt = K / BK;
    unsigned voffA[2], voffB[2]; int gR[2], gC[2];
#pragma unroll
    for (int i = 0; i < 2; ++i) { int R, C; stage_rc(tid * 16 + i * 8192, R, C); const int Rb = Epi::PERM ? ((R & ~31) + perm32(R & 31)) : R;
        voffA[i] = (unsigned)(R * K + C) * 2u; voffB[i] = (unsigned)(Rb * K + C) * 2u; gR[i] = R; gC[i] = C * 2; }
    unsigned vA0[2], vA1[2], vN0[2], vN1[2];
#define PG8_GOFF(D0, D1, U_) do { _Pragma("unroll") for (int _i = 0; _i < 2; ++_i) { if constexpr (GATHER) { D0[_i] = S.a_row_off(U_, gR[_i]) + (unsigned)gC[_i]; D1[_i] = S.a_row_off(U_, HALF + gR[_i]) + (unsigned)gC[_i]; } \
        else { D0[_i] = voffA[_i]; D1[_i] = voffA[_i]; } } } while (0)
    const size_t kstep = (size_t)(BK * 2);
    const size_t hstep = (size_t)HALF * K * 2;
    const size_t tstep = 2 * hstep;
    const size_t hstepA = GATHER ? 0 : hstep, tstepA = GATHER ? 0 : tstep;
    const unsigned ldsw = (unsigned)wid * 1024u;
    const int aoff = lds_byte(wr * 64 + fr, fq * 8), boff = lds_byte(wc * 32 + fr, fq * 8);
#define PG8_SA(b, h) (((b) * 2 + (h)) * HTB)
#define PG8_SB(b, h) ((4 + (b) * 2 + (h)) * HTB)
#define PG8_STAGE(bufoff, gbase, voff) do { _Pragma("unroll") for (int _i = 0; _i < 2; ++_i) \
        __builtin_amdgcn_global_load_lds((const unsigned*)((const char*)(gbase) + (voff)[_i]), (PG8_LAS unsigned*)(lds + (bufoff) + ldsw + _i * 8192), 16, 0, 0); } while (0)
#define PG8_LDA(dst, b, h) do { _Pragma("unroll") for (int m = 0; m < 4; ++m) _Pragma("unroll") for (int k = 0; k < 2; ++k) dst[m][k] = *(const PG8_LAS bf16x8*)(lds + PG8_SA(b, h) + aoff + m * 2048 + k * 1024); } while (0)
#define PG8_LDB(dst, b, h) do { _Pragma("unroll") for (int n = 0; n < 2; ++n) _Pragma("unroll") for (int k = 0; k < 2; ++k) dst[n][k] = *(const PG8_LAS bf16x8*)(lds + PG8_SB(b, h) + boff + n * 2048 + k * 1024); } while (0)
#define PG8_MMA(ai, bj, At, Bt) do { __builtin_amdgcn_s_setprio(1); _Pragma("unroll") for (int m = 0; m < 4; ++m) _Pragma("unroll") for (int n = 0; n < 2; ++n) _Pragma("unroll") for (int k = 0; k < 2; ++k) \
        acc[ai][bj][m][n] = __builtin_amdgcn_mfma_f32_16x16x32_bf16(Bt[n][k], At[m][k], acc[ai][bj][m][n], 0, 0, 0); __builtin_amdgcn_s_setprio(0); } while (0)
#define PG8_WAIT_V(n) asm volatile("s_waitcnt vmcnt(" #n ")" ::: "memory")
#define PG8_WAIT_L(n) asm volatile("s_waitcnt lgkmcnt(" #n ")" ::: "memory")
#define PG8_BAR __builtin_amdgcn_s_barrier()
#define PG8_SCHED __builtin_amdgcn_sched_barrier(0)
    Unit cur, nxt; int ui = 0;
    if (!S.next(0, cur)) return;
    f32x4 acc[2][2][4][2];
#pragma unroll
    for (int a = 0; a < 2; ++a)
#pragma unroll
        for (int b = 0; b < 2; ++b)
#pragma unroll
            for (int m = 0; m < 4; ++m)
#pragma unroll
                for (int n = 0; n < 2; ++n) acc[a][b][m][n] = (f32x4){0.f, 0.f, 0.f, 0.f};
    bf16x8 At[4][2], B0[2][2], B1[2][2];
    const char* cA = (const char*)g.A + (size_t)cur.pm * tstepA; const char* cB = (const char*)g.Bt + (size_t)cur.pn * tstep;
    PG8_GOFF(vA0, vA1, cur);
    S.a_ready(cur);
    if constexpr (SP2) {
        PG8_STAGE(PG8_SB(0, 0), cB, voffB); PG8_STAGE(PG8_SB(0, 1), cB + hstep, voffB); PG8_STAGE(PG8_SA(0, 0), cA, vA0); PG8_STAGE(PG8_SA(0, 1), cA + hstepA, vA1);
        if (wr == 1) PG8_BAR;
        PG8_WAIT_V(2); PG8_BAR;
        PG8_STAGE(PG8_SB(1, 0), cB + kstep, voffB); PG8_STAGE(PG8_SA(1, 0), cA + kstep, vA0); PG8_STAGE(PG8_SB(1, 1), cB + hstep + kstep, voffB);
        PG8_WAIT_V(6); PG8_BAR;
    } else {
        PG8_STAGE(PG8_SB(0, 0), cB, voffB); PG8_STAGE(PG8_SA(0, 0), cA, voffA); PG8_STAGE(PG8_SB(0, 1), cB + hstep, voffB); PG8_STAGE(PG8_SA(0, 1), cA + hstep, voffA);
        if (wr == 1) PG8_BAR;
        PG8_WAIT_V(4); PG8_BAR;
        PG8_STAGE(PG8_SB(1, 0), cB + kstep, voffB); PG8_STAGE(PG8_SA(1, 0), cA + kstep, voffA); PG8_STAGE(PG8_SB(1, 1), cB + hstep + kstep, voffB);
        PG8_WAIT_V(6); PG8_BAR;
    }
    for (;;) {
        const bool has_next = S.next(ui + 1, nxt);
        const char* nA = has_next ? (const char*)g.A + (size_t)nxt.pm * tstepA : cA; const char* nB = has_next ? (const char*)g.Bt + (size_t)nxt.pn * tstep : cB;
        if (has_next) PG8_GOFF(vN0, vN1, nxt); else { vN0[0] = vA0[0]; vN0[1] = vA0[1]; vN1[0] = vA1[0]; vN1[1] = vA1[1]; }
        for (int t = 0; t < nt; t += 2) {
            const bool last = (t == nt - 2);
            const char* a1 = cA + (size_t)(t + 1) * kstep;
            const char* a2 = last ? nA : cA + (size_t)(t + 2) * kstep; const char* b2 = last ? nB : cB + (size_t)(t + 2) * kstep;
            const char* a3 = a2 + kstep; const char* b3 = b2 + kstep;
            if (last && has_next) S.a_ready(nxt);
            unsigned vX0[2], vX1[2];
            vX0[0] = last ? vN0[0] : vA0[0]; vX0[1] = last ? vN0[1] : vA0[1]; vX1[0] = last ? vN1[0] : vA1[0]; vX1[1] = last ? vN1[1] : vA1[1];
            if constexpr (SP2) {
            PG8_LDB(B0, 0, 0); PG8_LDB(B1, 0, 1); PG8_SCHED; PG8_LDA(At, 0, 0); PG8_STAGE(PG8_SA(1, 1), a1 + hstepA, vA1);
            PG8_WAIT_V(8); PG8_WAIT_L(0); PG8_BAR; PG8_MMA(0, 0, At, B0); PG8_MMA(0, 1, At, B1); PG8_BAR; PG8_SCHED;
            PG8_LDA(At, 0, 1); PG8_STAGE(PG8_SB(0, 0), b2, voffB); PG8_STAGE(PG8_SB(0, 1), b2 + hstep, voffB); PG8_STAGE(PG8_SA(0, 0), a2, vX0);
            PG8_WAIT_V(8); PG8_WAIT_L(0); PG8_BAR; PG8_MMA(1, 0, At, B0); PG8_MMA(1, 1, At, B1); PG8_BAR; PG8_SCHED;
            PG8_LDB(B0, 1, 0); PG8_LDB(B1, 1, 1); PG8_SCHED; PG8_LDA(At, 1, 0); PG8_STAGE(PG8_SA(0, 1), a2 + hstepA, vX1);
            PG8_WAIT_V(8); PG8_WAIT_L(0); PG8_BAR; PG8_MMA(0, 0, At, B0); PG8_MMA(0, 1, At, B1); PG8_BAR; PG8_SCHED;
            PG8_LDA(At, 1, 1); PG8_STAGE(PG8_SB(1, 0), b3, voffB); PG8_STAGE(PG8_SB(1, 1), b3 + hstep, voffB); PG8_STAGE(PG8_SA(1, 0), a3, vX0);
            PG8_WAIT_V(8); PG8_WAIT_L(0); PG8_BAR; PG8_MMA(1, 0, At, B0); PG8_MMA(1, 1, At, B1); PG8_BAR; PG8_SCHED;
            } else {
            PG8_LDB(B0, 0, 0); PG8_SCHED; PG8_LDA(At, 0, 0); PG8_STAGE(PG8_SA(1, 1), a1 + hstep, voffA);
            PG8_WAIT_L(8); PG8_BAR; PG8_WAIT_L(0); PG8_MMA(0, 0, At, B0); PG8_BAR; PG8_SCHED;
            PG8_LDB(B1, 0, 1); PG8_STAGE(PG8_SB(0, 0), b2, voffB);
            PG8_BAR; PG8_WAIT_L(0); PG8_MMA(0, 1, At, B1); PG8_BAR;
            PG8_LDA(At, 0, 1); PG8_STAGE(PG8_SA(0, 0), a2, voffA);
            PG8_BAR; PG8_WAIT_L(0); PG8_MMA(1, 0, At, B0); PG8_BAR; PG8_SCHED;
            PG8_STAGE(PG8_SB(0, 1), b2 + hstep, voffB);
            PG8_WAIT_V(6); PG8_BAR; PG8_MMA(1, 1, At, B1); PG8_BAR;
            PG8_LDB(B0, 1, 0); PG8_SCHED; PG8_LDA(At, 1, 0); PG8_STAGE(PG8_SA(0, 1), a2 + hstep, voffA);
            PG8_WAIT_L(8); PG8_BAR; PG8_WAIT_L(0); PG8_MMA(0, 0, At, B0); PG8_BAR; PG8_SCHED;
            PG8_LDB(B1, 1, 1); PG8_STAGE(PG8_SB(1, 0), b3, voffB);
            PG8_BAR; PG8_WAIT_L(0); PG8_MMA(0, 1, At, B1); PG8_BAR;
            PG8_LDA(At, 1, 1); PG8_STAGE(PG8_SA(1, 0), a3, voffA);
            PG8_BAR; PG8_WAIT_L(0); PG8_MMA(1, 0, At, B0); PG8_BAR; PG8_SCHED;
            PG8_STAGE(PG8_SB(1, 1), b3 + hstep, voffB);
            PG8_WAIT_V(6); PG8_BAR; PG8_MMA(1, 1, At, B1); PG8_BAR;
            }
        }
        if constexpr (ALIGN_EPI) { if (wr == 0) PG8_BAR; }
        if constexpr (!Epi::AFTER_DRAIN) { E(acc, cur, wr, wc, fr, fq); S.done(cur); }
        if (!has_next) break;
#pragma unroll
        for (int a = 0; a < 2; ++a)
#pragma unroll
            for (int b = 0; b < 2; ++b)
#pragma unroll
                for (int m = 0; m < 4; ++m)
#pragma unroll
                    for (int n = 0; n < 2; ++n) acc[a][b][m][n] = (f32x4){0.f, 0.f, 0.f, 0.f};
        cur = nxt; cA = nA; cB = nB; ++ui; vA0[0] = vN0[0]; vA0[1] = vN0[1]; vA1[0] = vN1[0]; vA1[1] = vN1[1];
        if constexpr (ALIGN_EPI) { if (wr == 1) PG8_BAR; }
    }
    PG8_WAIT_V(0);
    if constexpr (!ALIGN_EPI) { if (wr == 0) PG8_BAR; }
    PG8_BAR;
    if constexpr (Epi::AFTER_DRAIN) { E.fused(acc, cur, wr, wc, fr, fq, lds, wid, lane); S.done(cur); }
#undef PG8_GOFF
#undef PG8_SA
#undef PG8_SB
#undef PG8_STAGE
#undef PG8_LDA
#undef PG8_LDB
#undef PG8_MMA
#undef PG8_WAIT_V
#undef PG8_WAIT_L
#undef PG8_BAR
#undef PG8_SCHED
}
}

#ifndef PG8_SP2
#define PG8_SP2 true
#endif
#ifndef PG8_ALIGN
#define PG8_ALIGN true
#endif

namespace pg8 {
struct EpiResF32 {
    static constexpr bool PERM = false, AFTER_DRAIN = false;
    const float* base; float* out; int ldc;
    __device__ __forceinline__ void operator()(const f32x4 (&acc)[2][2][4][2], const Unit& u, int wr, int wc, int fr, int fq) const {
        const int col0 = u.pn * BM + wc * 32 + 4 * fq;
#pragma unroll
        for (int ai = 0; ai < 2; ++ai)
#pragma unroll
            for (int m = 0; m < 4; ++m) { const size_t off = (size_t)(u.pm * BM + ai * HALF + wr * 64 + m * 16 + fr) * ldc + col0;
#pragma unroll
                for (int bj = 0; bj < 2; ++bj)
#pragma unroll
                    for (int n = 0; n < 2; ++n) { const f32x4 bs = *(const f32x4*)(base + off + bj * HALF + n * 16); *(f32x4*)(out + off + bj * HALF + n * 16) = bs + acc[ai][bj][m][n]; }
                asm volatile("" ::: "memory"); }
    }
};
struct EpiSwiGLU {
    static constexpr bool PERM = true, AFTER_DRAIN = false;
    bf16_t* O;
    __device__ __forceinline__ void operator()(const f32x4 (&acc)[2][2][4][2], const Unit& u, int wr, int wc, int fr, int fq) const {
        const int row0 = u.pm * BM + wr * 64 + fr; const int col0 = (u.pn & 3) * 128 + wc * 32 + 8 * fq;
#pragma unroll
        for (int ai = 0; ai < 2; ++ai)
#pragma unroll
            for (int m = 0; m < 4; ++m) { bf16_t* rowp = O + (size_t)(row0 + ai * HALF + m * 16) * 512 + col0;
                f32x4 g0 = acc[ai][0][m][0], g1 = acc[ai][0][m][1]; const f32x4 u0 = acc[ai][1][m][0], u1 = acc[ai][1][m][1];
#pragma unroll
                for (int e = 0; e < 4; ++e) { g0[e] = g0[e] * __builtin_amdgcn_rcpf(1.0f + __expf(-g0[e])) * u0[e]; g1[e] = g1[e] * __builtin_amdgcn_rcpf(1.0f + __expf(-g1[e])) * u1[e]; }
                u32x4 w; w.x = cvt_pk_bf16(g0[0], g0[1]); w.y = cvt_pk_bf16(g0[2], g0[3]); w.z = cvt_pk_bf16(g1[0], g1[1]); w.w = cvt_pk_bf16(g1[2], g1[3]);
                *(u32x4*)rowp = w; asm volatile("" ::: "memory"); }
    }
};
struct EpiScatter {
    static constexpr bool PERM = true, AFTER_DRAIN = false;
    bf16_t* Y; const int* lists; const float* slot_g; const PG8_LAS int* tile_e;
    __device__ __forceinline__ void operator()(const f32x4 (&acc)[2][2][4][2], const Unit& u, int wr, int wc, int fr, int fq) const {
        const int row0 = wr * 64 + fr; const int col0 = (u.pn & 3) * BM + wc * 32 + 8 * fq;
        const int e = u.pn >> 2, base = tile_e[160 + u.pm], ne = tile_e[320 + e];
#pragma unroll
        for (int ai = 0; ai < 2; ++ai)
#pragma unroll
            for (int m = 0; m < 4; ++m) { const int idx = base + row0 + ai * HALF + m * 16; const bool ok = idx < ne; const int slot = ok ? lists[e * 16384 + idx] : 0; const float gt = ok ? slot_g[slot] : 0.f;
                if (ok) { bf16_t* rowp = Y + (size_t)slot * 1024 + col0;
#pragma unroll
                    for (int bj = 0; bj < 2; ++bj) { const f32x4 v0 = acc[ai][bj][m][0] * gt, v1 = acc[ai][bj][m][1] * gt;
                        u32x4 w; w.x = cvt_pk_bf16(v0[0], v0[1]); w.y = cvt_pk_bf16(v0[2], v0[3]); w.z = cvt_pk_bf16(v1[0], v1[1]); w.w = cvt_pk_bf16(v1[2], v1[3]);
                        *(u32x4*)(rowp + bj * HALF) = w; } }
                asm volatile("" ::: "memory"); }
    }
};
struct MoeOrder {
    int ntiles, G, c; const PG8_LAS int* tile_e; const int* lists;
    __device__ __forceinline__ unsigned a_row_off(const Unit& u, int r) const {
        const int e = u.pn >> 2, idx = tile_e[160 + u.pm] + r; const int sl = idx < tile_e[320 + e] ? lists[e * 16384 + idx] : 0; return (unsigned)(sl >> 1) * 2048u; }
    __device__ __forceinline__ bool next(int i, Unit& u) const {
        const int L = i * G + c; if (L >= ntiles * 4) return false;
        const int ti = L >> 2; const int e = __builtin_amdgcn_readfirstlane(tile_e[ti]);
        u.pm = ti; u.pn = e * 4 + (L & 3); return true;
    }
    __device__ __forceinline__ void a_ready(const Unit&) const {}
    __device__ __forceinline__ void done(const Unit&) const {}
};
struct G1Order : StaticOrder {
    __device__ __forceinline__ bool next(int i, Unit& u) const { if (!StaticOrder::next(i, u)) return false; if (u.pn >= 11) u.pn = 12; return true; }
};
struct P3Order {
    int c;
    __device__ __forceinline__ bool next(int i, Unit& u) const {
        if (c < 64) { if (i > 0) return false; u.pm = c; u.pn = 11; return true; }
        const int L = i * 192 + (c - 64); if (L >= 384) return false; u.pm = L / 6; u.pn = L % 6; return true; }
    __device__ __forceinline__ void a_ready(const Unit&) const {}
    __device__ __forceinline__ void done(const Unit&) const {}
};
}


#include <hip/hip_bf16.h>
#include <cmath>
namespace attn_body {
using bf16=__hip_bfloat16;
using bf16x8=__attribute__((ext_vector_type(8)))short;
using s16x4=__attribute__((ext_vector_type(4)))short;
using f32x16=__attribute__((ext_vector_type(16)))float;
using u32x4=__attribute__((ext_vector_type(4)))unsigned;
constexpr int BATCH=8,NHEAD=16,SEQ=2048,D=64,QP=3328,OP=1024;
constexpr int NW=8,QBLK=32,QB=QBLK*NW,KVBLK=64,NQB=SEQ/QB;
constexpr int ATTN_UNIT_ROWS=QB;
__device__ __forceinline__ int crow(int r,int hi){return (r&3)+8*(r>>2)+4*hi;}
#define SBAR() __builtin_amdgcn_sched_barrier(0)
__device__ __forceinline__ void cmask(f32x16&p0,f32x16&p1,int jb,int qrel,int hi){
  const float NEG=-INFINITY;
  if(jb>(qrel>>6)){
  #pragma unroll
  for(int r=0;r<16;++r){p0[r]=NEG;p1[r]=NEG;}}
}

constexpr int NSLOT=3, SLOTB=8192;
constexpr int LDS_K=0, LDS_V=NSLOT*SLOTB, LDS_WS=2*NSLOT*SLOTB, LDS_OST=LDS_WS+NW*64*4, LDS_BYTES=LDS_OST+NW*4096;
constexpr float C2=0.125f*1.4426950408889634f;
__device__ __forceinline__ void glds16(const void*gsrc,unsigned lds_dst){unsigned keep;
  asm volatile("s_mov_b32 %0, m0\n\ts_mov_b32 m0, %2\n\ts_nop 0\n\tglobal_load_lds_dwordx4 %1, off\n\ts_mov_b32 m0, %0":"=&s"(keep):"v"(gsrc),"s"(lds_dst):"memory");}
__device__ __forceinline__ float max3f(float a,float b,float c){float r;asm("v_max3_f32 %0, %1, %2, %3":"=v"(r):"v"(a),"v"(b),"v"(c));return r;}
__device__ __forceinline__ float max2f(float a,float b){float r;asm("v_max_f32_e32 %0, %1, %2":"=v"(r):"v"(a),"v"(b));return r;}
__device__ __forceinline__ float fadd_s(float a,float b){float r;asm("v_add_f32_e32 %0, %1, %2":"=v"(r):"v"(a),"v"(b));return r;}
__device__ __forceinline__ float fsub_s(float a,float b){float r;asm("v_sub_f32_e32 %0, %1, %2":"=v"(r):"v"(a),"v"(b));return r;}
typedef float f32x2_t __attribute__((ext_vector_type(2))); typedef __bf16 bf16x2_t __attribute__((ext_vector_type(2)));
__device__ __forceinline__ unsigned cvtpk_s(float lo,float hi){f32x2_t v={lo,hi};bf16x2_t b=__builtin_convertvector(v,bf16x2_t);return __builtin_bit_cast(unsigned,b);}
#define WAIT_BAR(N) asm volatile("s_waitcnt vmcnt(" #N ") lgkmcnt(0)\n\ts_barrier":::"memory")

__device__ __forceinline__ void qkt(f32x16&p0,f32x16&p1,const char*Kslot,const bf16x8*qr,const f32x16&negm,int r32,int hi){
  const char*kb=Kslot+hi*1024+r32*16;
  #pragma unroll
  for(int d0=0;d0<4;++d0){
    const bf16x8 b0=*reinterpret_cast<const bf16x8*>(kb+d0*2048);
    const bf16x8 b1=*reinterpret_cast<const bf16x8*>(kb+d0*2048+512);
    if(d0==0){p0=__builtin_amdgcn_mfma_f32_32x32x16_bf16(b0,qr[0],negm,0,0,0);p1=__builtin_amdgcn_mfma_f32_32x32x16_bf16(b1,qr[0],negm,0,0,0);}
    else{p0=__builtin_amdgcn_mfma_f32_32x32x16_bf16(b0,qr[d0],p0,0,0,0);p1=__builtin_amdgcn_mfma_f32_32x32x16_bf16(b1,qr[d0],p1,0,0,0);}}
}
typedef __attribute__((address_space(3))) const char* lds_cptr;
typedef short v4i16_t __attribute__((ext_vector_type(4)));
__device__ __forceinline__ void kload8(bf16x8*kf,lds_cptr kp){
  kf[0]=*(const __attribute__((address_space(3))) bf16x8*)(kp);      kf[1]=*(const __attribute__((address_space(3))) bf16x8*)(kp+512);
  kf[2]=*(const __attribute__((address_space(3))) bf16x8*)(kp+2048); kf[3]=*(const __attribute__((address_space(3))) bf16x8*)(kp+2560);
  kf[4]=*(const __attribute__((address_space(3))) bf16x8*)(kp+4096); kf[5]=*(const __attribute__((address_space(3))) bf16x8*)(kp+4608);
  kf[6]=*(const __attribute__((address_space(3))) bf16x8*)(kp+6144); kf[7]=*(const __attribute__((address_space(3))) bf16x8*)(kp+6656);
}
__device__ __forceinline__ void kload2(bf16x8*kf,lds_cptr kp,int j){ kf[2*j]=*(const __attribute__((address_space(3))) bf16x8*)(kp+j*2048); kf[2*j+1]=*(const __attribute__((address_space(3))) bf16x8*)(kp+j*2048+512); }
__device__ __forceinline__ s16x4 vtr(lds_cptr p){ return __builtin_bit_cast(s16x4,__builtin_amdgcn_ds_read_tr16_b64_v4i16((__attribute__((address_space(3))) v4i16_t*)p)); }
__device__ __forceinline__ float rowmax(const f32x16&p0,const f32x16&p1){
  float a=max3f(p0[0],p0[1],p1[0]),b=max3f(p0[2],p0[3],p1[1]);a=max3f(a,p1[2],p1[3]);
  #pragma unroll
  for(int r=4;r<16;r+=4){a=max3f(a,p0[r],p0[r+1]);b=max3f(b,p0[r+2],p0[r+3]);a=max3f(a,p1[r],p1[r+1]);b=max3f(b,p1[r+2],p1[r+3]);}
  const float m=max2f(a,b);
  auto rr=__builtin_amdgcn_permlane32_swap(__float_as_uint(m),__float_as_uint(m),false,false);
  return max2f(__uint_as_float(rr[0]),__uint_as_float(rr[1]));
}
__device__ __forceinline__ void pv(f32x16*o,int vb,bf16x8 pa0,bf16x8 pa1,bf16x8 pa2,bf16x8 pa3){
  #pragma unroll
  for(int d0=0;d0<2;++d0){s16x4 lo[4],hi[4];
    #pragma unroll
    for(int ks=0;ks<4;++ks){
      asm volatile("ds_read_b64_tr_b16 %0,%1 offset:%c2":"=&v"(lo[ks]):"v"(vb),"i"(d0*4096+ks*1024):"memory");
      asm volatile("ds_read_b64_tr_b16 %0,%1 offset:%c2":"=&v"(hi[ks]):"v"(vb),"i"(d0*4096+ks*1024+512):"memory");}
    asm volatile("s_waitcnt lgkmcnt(0)":::"memory");SBAR();
    #define PK(k) (bf16x8){lo[k][0],lo[k][1],lo[k][2],lo[k][3],hi[k][0],hi[k][1],hi[k][2],hi[k][3]}
    o[d0]=__builtin_amdgcn_mfma_f32_32x32x16_bf16(pa0,PK(0),o[d0],0,0,0);
    o[d0]=__builtin_amdgcn_mfma_f32_32x32x16_bf16(pa1,PK(1),o[d0],0,0,0);
    o[d0]=__builtin_amdgcn_mfma_f32_32x32x16_bf16(pa2,PK(2),o[d0],0,0,0);
    o[d0]=__builtin_amdgcn_mfma_f32_32x32x16_bf16(pa3,PK(3),o[d0],0,0,0);
    #undef PK
  }
}

#ifndef ATTN_STORE16
#define ATTN_STORE16(p,v) (*(u32x4*)(p)=(v))
#endif
template<int THRL> __device__ __forceinline__ void attn_unit(int b,int qb,const bf16*Q,const bf16*__restrict__ K,const bf16*__restrict__ V,bf16*O,char*shm){
  const int tid=threadIdx.x,lane=tid&63,r32=lane&31,hi=lane>>5; const int wid=__builtin_amdgcn_readfirstlane(tid>>6);
  const long rowbase=(long)b*SEQ; const int q0=qb*QB;
  const bf16*Qw=Q+(rowbase+q0+wid*QBLK)*QP;
  const bf16*Kh=K+rowbase*QP,*Vh=V+rowbase*QP;
  const unsigned lds0=(unsigned)(uintptr_t)shm;
  float*wsf=(float*)(shm+LDS_WS)+wid*64;
  const bf16*ksrc=Kh+(long)lane*QP+wid*8;
  const bf16*vsrc=Vh+(long)(16*(wid&3)+(lane>>2))*QP+(wid>>2)*32+(lane&3)*8;
  const unsigned kdst=lds0+LDS_K+wid*1024, vdst=lds0+LDS_V+wid*1024;
  #define DMA_K(t,slot) glds16(ksrc+(long)(t)*KVBLK*QP,(unsigned)__builtin_amdgcn_readfirstlane(kdst+(slot)))
  #define DMA_V(t,slot) glds16(vsrc+(long)(t)*KVBLK*QP,(unsigned)__builtin_amdgcn_readfirstlane(vdst+(slot)))
  const int vb0=(int)(lds0+LDS_V)+((lane>>4)&1)*32+(lane&3)*8+(4*hi+((lane&15)>>2))*64;
  const char*Kbase=shm+LDS_K; bf16x8 kf[8];
  const lds_cptr shm3=(lds_cptr)shm; const lds_cptr kp0=shm3+LDS_K+hi*1024+r32*16; const lds_cptr vp0=shm3+LDS_V+((lane>>4)&1)*32+(lane&3)*8+(4*hi+((lane&15)>>2))*64;
  const int NT=(q0+QB)/KVBLK;
  DMA_K(0,0);DMA_V(0,0);DMA_K(1,SLOTB);
  bf16x8 qr[4];
  #pragma unroll
  for(int d0=0;d0<4;++d0)qr[d0]=*reinterpret_cast<const bf16x8*>(&Qw[(long)r32*QP+d0*16+hi*8]);
  float mhat=0.f,l_reg=0.f;f32x16 o[2];o[0]=f32x16{};o[1]=f32x16{};f32x16 negm=f32x16{};asm volatile("":"+v"(negm));
  const int qrel=wid*QBLK+r32;
  #define CMASK(P0,P1,t) do{int jb_=(t)-(NT-4); if(jb_>=0)cmask(P0,P1,jb_,qrel,hi);}while(0)
  bool resc=false;
  #define START(P0,P1) do{ const float rm=rowmax(P0,P1); resc=false; \
    { const float dl=rm; mhat=fadd_s(mhat,dl); \
      _Pragma("unroll") for(int r=0;r<16;++r){P0[r]=fsub_s(P0[r],dl);P1[r]=fsub_s(P1[r],dl);} \
      _Pragma("unroll") for(int r=0;r<16;++r)negm[r]=-mhat; asm volatile("":"+v"(negm)); } \
    _Pragma("unroll") for(int r=0;r<16;++r)P0[r]=__builtin_amdgcn_exp2f(P0[r]); }while(0)
  #define RESC() do{ if(resc){ asm volatile("s_waitcnt lgkmcnt(0)":::"memory"); \
      _Pragma("unroll") for(int d_=0;d_<2;++d_) _Pragma("unroll") for(int r=0;r<16;++r)o[d_][r]*=wsf[crow(r,hi)]; } }while(0)
  f32x16 pA0,pA1,pB0,pB1;
  int sl_prev=0,sl_cur=0,sl_next=SLOTB;
  #define ROT() do{sl_prev=sl_cur;sl_cur=sl_next;sl_next=(sl_next==(NSLOT-1)*SLOTB)?0:sl_next+SLOTB;}while(0)
  DMA_K(2,2*SLOTB);
  WAIT_BAR(3);
  qkt(pA0,pA1,Kbase,qr,negm,r32,hi);asm volatile("s_nop 15\n\ts_nop 7":"+v"(pA0),"+v"(pA1));CMASK(pA0,pA1,0);
  START(pA0,pA1);
  _Pragma("unroll") for(int r=0;r<16;++r)pA1[r]=__builtin_amdgcn_exp2f(pA1[r]);
  WAIT_BAR(0);
  DMA_K(3,0);DMA_V(1,SLOTB);
  ROT();
  kload8(kf,kp0+sl_cur);
  WAIT_BAR(2);
  s16x4 vlo[8],vhi[8]; u32x4 pw0,pw1,pw2,pw3;
  #define PKW(P,B) cvtpk_s(P[B],P[B+1])
  #define PAF(k) __builtin_bit_cast(bf16x8,pw##k)
  #define VFR(i) (bf16x8){vlo[i][0],vlo[i][1],vlo[i][2],vlo[i][3],vhi[i][0],vhi[i][1],vhi[i][2],vhi[i][3]}
  #define PIN(x) asm volatile("":"+v"(x))
  #define MX3(a,b,c) __builtin_fmaxf(__builtin_fmaxf((a),(b)),(c))
  #define GAPA(MF,A0,A1,A2,A3,W0,W1,PW) do{ MF; sacc+=A0; sacc+=A1; sacc+=A2; sacc+=A3; PIN(sacc); W0; W1; PIN(PW); SBAR(); }while(0)
  #define EX(v) __builtin_amdgcn_exp2f(v)
  #define GAPB(MF,X,B) do{ MF; X[B]=EX(X[B]); X[B+1]=EX(X[B+1]); X[B+2]=EX(X[B+2]); X[B+3]=EX(X[B+3]); PIN(X); SBAR(); }while(0)
  #define VRD(i) do{ vlo[i]=vtr(vp_+(((i)>>2)*4096+((i)&3)*1024)); vhi[i]=vtr(vp_+(((i)>>2)*4096+((i)&3)*1024+512)); }while(0)
  #define KRD(G,j) do{ if(G){ kload2(kf,kp0+sl_next,j); SBAR(); } }while(0)
  #define STEP(C0,C1,P0,P1,t,GK,GV,GL) do{ SBAR(); \
    const lds_cptr vp_=vp0+sl_prev; \
    VRD(0); SBAR(); float sacc=(P0[0]+P0[1]); \
    GAPA(C0=__builtin_amdgcn_mfma_f32_32x32x16_bf16(kf[0],qr[0],negm,0,0,0), P0[2],P0[3],P0[4],P0[5],     pw0[0]=PKW(P0,0), pw0[1]=PKW(P0,2), pw0); \
    VRD(4); SBAR(); GAPA(C1=__builtin_amdgcn_mfma_f32_32x32x16_bf16(kf[1],qr[0],negm,0,0,0), P0[6],P0[7],P0[8],P0[9],     pw0[2]=PKW(P0,4), pw0[3]=PKW(P0,6), pw0); \
    VRD(1); SBAR(); GAPA(C0=__builtin_amdgcn_mfma_f32_32x32x16_bf16(kf[2],qr[1],C0,0,0,0),   P0[10],P0[11],P0[12],P0[13], pw1[0]=PKW(P0,8), pw1[1]=PKW(P0,10), pw1); \
    VRD(5); SBAR(); GAPA(C1=__builtin_amdgcn_mfma_f32_32x32x16_bf16(kf[3],qr[1],C1,0,0,0),   P0[14],P0[15],P1[0],P1[1],   pw1[2]=PKW(P0,12),pw1[3]=PKW(P0,14), pw1); \
    VRD(2); SBAR(); GAPA(C0=__builtin_amdgcn_mfma_f32_32x32x16_bf16(kf[4],qr[2],C0,0,0,0),   P1[2],P1[3],P1[4],P1[5],     pw2[0]=PKW(P1,0), pw2[1]=PKW(P1,2), pw2); \
    VRD(6); SBAR(); GAPA(C1=__builtin_amdgcn_mfma_f32_32x32x16_bf16(kf[5],qr[2],C1,0,0,0),   P1[6],P1[7],P1[8],P1[9],     pw2[2]=PKW(P1,4), pw2[3]=PKW(P1,6), pw2); \
    VRD(3); SBAR(); GAPA(C0=__builtin_amdgcn_mfma_f32_32x32x16_bf16(kf[6],qr[3],C0,0,0,0),   P1[10],P1[11],P1[12],P1[13], pw3[0]=PKW(P1,8), pw3[1]=PKW(P1,10), pw3); \
    VRD(7); SBAR(); GAPA(C1=__builtin_amdgcn_mfma_f32_32x32x16_bf16(kf[7],qr[3],C1,0,0,0),   P1[14],P1[15],0.f,0.f,       pw3[2]=PKW(P1,12),pw3[3]=PKW(P1,14), pw3); \
    l_reg+=sacc; \
    if(GK){DMA_K((t)+3,sl_cur);} if(GV){DMA_V((t)+1,sl_next);} \
    CMASK(C0,C1,t); \
    { float a=MX3(C0[0],C0[1],C1[0]),b=MX3(C0[2],C0[3],C1[1]); a=MX3(a,C1[2],C1[3]); \
      _Pragma("unroll") for(int r=4;r<16;r+=4){a=MX3(a,C0[r],C0[r+1]);b=MX3(b,C0[r+2],C0[r+3]);a=MX3(a,C1[r],C1[r+1]);b=MX3(b,C1[r+2],C1[r+3]);} \
      float rm=__builtin_fmaxf(a,b); { auto rr=__builtin_amdgcn_permlane32_swap(__float_as_uint(rm),__float_as_uint(rm),false,false); rm=__builtin_fmaxf(__uint_as_float(rr[0]),__uint_as_float(rr[1])); } \
      resc=false; \
      if(__builtin_expect(__any(rm>(float)THRL),0)){ const float dl=__builtin_fmaxf(rm,0.f); mhat+=dl; \
        _Pragma("unroll") for(int r=0;r<16;++r){C0[r]-=dl;C1[r]-=dl;} \
        _Pragma("unroll") for(int r=0;r<16;++r)negm[r]=-mhat; asm volatile("":"+v"(negm)); \
        const float f=__builtin_amdgcn_exp2f(-dl); l_reg*=f; if(hi==0)wsf[r32]=f; resc=true; } } \
    SBAR(); \
    GAPB(o[0]=__builtin_amdgcn_mfma_f32_32x32x16_bf16(PAF(0),VFR(0),o[0],0,0,0), C0,0); \
    GAPB(o[1]=__builtin_amdgcn_mfma_f32_32x32x16_bf16(PAF(0),VFR(4),o[1],0,0,0), C0,4); \
    KRD(GL,0); GAPB(o[0]=__builtin_amdgcn_mfma_f32_32x32x16_bf16(PAF(1),VFR(1),o[0],0,0,0), C0,8); \
    KRD(GL,1); GAPB(o[1]=__builtin_amdgcn_mfma_f32_32x32x16_bf16(PAF(1),VFR(5),o[1],0,0,0), C0,12); \
    KRD(GL,2); GAPB(o[0]=__builtin_amdgcn_mfma_f32_32x32x16_bf16(PAF(2),VFR(2),o[0],0,0,0), C1,0); \
    KRD(GL,3); GAPB(o[1]=__builtin_amdgcn_mfma_f32_32x32x16_bf16(PAF(2),VFR(6),o[1],0,0,0), C1,4); \
    GAPB(o[0]=__builtin_amdgcn_mfma_f32_32x32x16_bf16(PAF(3),VFR(3),o[0],0,0,0), C1,8); \
    GAPB(o[1]=__builtin_amdgcn_mfma_f32_32x32x16_bf16(PAF(3),VFR(7),o[1],0,0,0), C1,12); \
    }while(0)
  int t=1;
  #undef CMASK
  #define CMASK(P0,P1,t) do{}while(0)
  for(;t+5<NT;t+=2){
    STEP(pB0,pB1,pA0,pA1,t,true,true,true);     WAIT_BAR(2); RESC(); ROT();
    STEP(pA0,pA1,pB0,pB1,t+1,true,true,true);   WAIT_BAR(2); RESC(); ROT();
  }
  #undef CMASK
  #define CMASK(P0,P1,t) do{int jb_=(t)-(NT-4); if(jb_>=0)cmask(P0,P1,jb_,qrel,hi);}while(0)
  #define ENDW(tt) do{ if((tt)+3<NT){WAIT_BAR(2);} else if((tt)+2<NT){WAIT_BAR(1);} else {WAIT_BAR(0);} }while(0)
  for(;t+1<NT;t+=2){
    STEP(pB0,pB1,pA0,pA1,t,(t+3<NT),(t+1<NT),(t+1<NT));       ENDW(t);   RESC(); ROT();
    STEP(pA0,pA1,pB0,pB1,t+1,(t+4<NT),(t+2<NT),(t+2<NT));     ENDW(t+1); RESC(); ROT();
  }
  STEP(pB0,pB1,pA0,pA1,NT-1,false,false,false); RESC();
  { float sacc=pB0[0]+pB0[1]; _Pragma("unroll") for(int r=2;r<16;++r)sacc+=pB0[r]; _Pragma("unroll") for(int r=0;r<16;++r)sacc+=pB1[r]; l_reg+=sacc;
    pw0=(u32x4){PKW(pB0,0),PKW(pB0,2),PKW(pB0,4),PKW(pB0,6)};pw1=(u32x4){PKW(pB0,8),PKW(pB0,10),PKW(pB0,12),PKW(pB0,14)};pw2=(u32x4){PKW(pB1,0),PKW(pB1,2),PKW(pB1,4),PKW(pB1,6)};pw3=(u32x4){PKW(pB1,8),PKW(pB1,10),PKW(pB1,12),PKW(pB1,14)};
    SBAR(); pv(o,vb0+sl_cur,PAF(0),PAF(1),PAF(2),PAF(3)); }
  #undef PKW
  #undef PAF
  #undef VFR
  #undef PIN
  #undef MX3
  #undef GAPA
  #undef GAPB
  #undef EX
  #undef VRD
  #undef KRD
  #undef STEP
  #undef ENDW
  {auto rr=__builtin_amdgcn_permlane32_swap(__float_as_uint(l_reg),__float_as_uint(l_reg),false,false);l_reg=__uint_as_float(rr[0])+__uint_as_float(rr[1]);}
  if(hi==0)wsf[32+r32]=l_reg;asm volatile("s_waitcnt lgkmcnt(0)":::"memory");
  float rli[16];
  #pragma unroll
  for(int r=0;r<16;++r)rli[r]=__builtin_amdgcn_rcpf(wsf[32+crow(r,hi)]);
  bf16*Ow=O+(rowbase+q0+wid*QBLK)*OP;
  { bf16*stg=(bf16*)(shm+LDS_OST)+wid*2048;
    #pragma unroll
    for(int r=0;r<16;++r){const int orow=crow(r,hi);
      #pragma unroll
      for(int d0=0;d0<2;++d0)stg[orow*64+d0*32+r32]=__float2bfloat16(o[d0][r]*rli[r]);}
    asm volatile("s_waitcnt lgkmcnt(0)":::"memory");
    #pragma unroll
    for(int i=0;i<4;++i){const int row=i*8+(lane>>3),ch=lane&7; const u32x4 v=*(const u32x4*)(stg+row*64+ch*8); ATTN_STORE16(Ow+(long)row*OP+ch*8,v);} }
  asm volatile("s_waitcnt lgkmcnt(0)\n\ts_barrier":::"memory");
  #undef DMA_K
  #undef DMA_V
  #undef CMASK
  #undef START
  #undef RESC
  #undef ROT
}
constexpr int ATTN_LDS_BYTES=LDS_BYTES;
struct AttnTensors { const bf16* U; bf16* O; };
__device__ __forceinline__ void attn_phase_static(char*lds,const AttnTensors&T,int vcu){
  if(vcu>=256)return; const int s=vcu&1,pr=vcu>>1; const int b=pr>>4,ph=pr&15; const int h=ph>>2,c=(ph>>1)&1,vh=ph&1;
  for(int i=0;i<4;++i){ const int qb=(i==0)?(7-s):(i==1)?s:(i==2)?(4+s):(3-s);
    attn_unit<8>(b,qb,T.U+h*128+c*64,T.U+512+h*128+c*64,T.U+1024+h*128+vh*64,T.O+ph*64,lds); }
}
template<int THRL=8> __device__ __forceinline__ void attn_phase_dyn(char*lds,const AttnTensors&T,unsigned*ctr,volatile __attribute__((address_space(3))) unsigned*bcast,int q0){
  for(int dq=0;dq<8;++dq){ const int q=(q0+dq)&7;
    for(;;){
      if(threadIdx.x==0) bcast[0]=__hip_atomic_fetch_add(ctr+64*q,1u,__ATOMIC_RELAXED,__HIP_MEMORY_SCOPE_AGENT);
      __syncthreads(); const unsigned j=bcast[0]; __syncthreads();
      if(j>=128u)break;
      const int pr=q*16+(int)(j>>3),qb=7-(int)(j&7); const int b=pr>>4,ph=pr&15; const int h=ph>>2,c=(ph>>1)&1,vh=ph&1;
      attn_unit<THRL>(b,qb,T.U+h*128+c*64,T.U+512+h*128+c*64,T.U+1024+h*128+vh*64,T.O+ph*64,lds);
    }
  }
}
#undef SBAR
#undef WAIT_BAR
}

namespace scan_body {
#define SLDS __attribute__((address_space(3)))
typedef float sf4 __attribute__((ext_vector_type(4)));
typedef float sf2 __attribute__((ext_vector_type(2)));
typedef unsigned su2 __attribute__((ext_vector_type(2)));
constexpr int TB = 16;
constexpr int OFF_NKK = 0, OFF_DEC = TB * 64, OFF_BB = 2 * TB * 64, OFF_KM = 3 * TB * 64, OFF_RR = 4 * TB * 64, OFF_VV = 5 * TB * 64, IN_FLOATS = 5 * TB * 64 + TB * 32, YP_FLOATS = TB * 512;
constexpr int OFF_YP = 2 * IN_FLOATS;
constexpr int SCAN_LDS_BYTES = (2 * IN_FLOATS + 2 * YP_FLOATS) * 4;
__device__ __forceinline__ float bf_lo(unsigned w) { return __uint_as_float(w << 16); }
__device__ __forceinline__ float bf_hi(unsigned w) { return __uint_as_float(w & 0xffff0000u); }
__device__ __forceinline__ unsigned pk_bf(float lo, float hi) { unsigned a = __builtin_bit_cast(unsigned, lo), b = __builtin_bit_cast(unsigned, hi);
    a = (a + 0x7fffu + ((a >> 16) & 1u)) >> 16; b = (b + 0x7fffu + ((b >> 16) & 1u)) & 0xffff0000u; return a | b; }
template <int CTRL> __device__ __forceinline__ float dpp_add(float x) {
    return x + __builtin_bit_cast(float, __builtin_amdgcn_mov_dpp(__builtin_bit_cast(int, x), CTRL, 0xF, 0xF, true));
}
__device__ __forceinline__ float reduce16(float x) {
    x = dpp_add<0xB1>(x);
    x = dpp_add<0x4E>(x);
    x = dpp_add<0x124>(x);
    x = dpp_add<0x128>(x);
    return x;
}
struct ScanArgs { const unsigned short* U; const unsigned short* E; unsigned short* Y; unsigned short* BT; const float* mu; const float* k_k; const float* k_a; const float* r_k; const float* w0; const float* a0; };
struct PrepRegs { su2 rc, kc, vc, rp, kp, vp, ew, ea; };

__device__ __forceinline__ void prep_load(PrepRegs& R, const ScanArgs& A, int b, int h, int blk, int tid) {
    const int i = tid >> 4, c = h * 64 + (tid & 15) * 4, t = blk * TB + i;
    const size_t tok = (size_t)b * 2048 + t;
    const unsigned short* ur = A.U + tok * 3328 + 1536 + c;
    R.rc = *(const su2*)ur; R.kc = *(const su2*)(ur + 512); R.vc = *(const su2*)(ur + 1024);
    const unsigned short* up = (t > 0) ? ur - 3328 : ur;
    R.rp = *(const su2*)up; R.kp = *(const su2*)(up + 512); R.vp = *(const su2*)(up + 1024);
    R.ew = *(const su2*)(A.E + tok * 1536 + c); R.ea = *(const su2*)(A.E + tok * 1536 + 512 + c);
}
__device__ __forceinline__ void prep_compute(SLDS float* buf, const PrepRegs& R, const ScanArgs& A, int b, int h, int hf, int blk, int tid,
                                             const sf4& mu_r, const sf4& mu_k, const sf4& mu_v, const sf4& kkw, const sf4& kaw, const sf4& rkw, const sf4& w0c, const sf4& a0c) {
    const int i = tid >> 4, sl = tid & 15, t = blk * TB + i;
    const float pz = (t > 0) ? 1.0f : 0.0f;
    sf4 rc = {bf_lo(R.rc.x), bf_hi(R.rc.x), bf_lo(R.rc.y), bf_hi(R.rc.y)}, kc = {bf_lo(R.kc.x), bf_hi(R.kc.x), bf_lo(R.kc.y), bf_hi(R.kc.y)}, vc = {bf_lo(R.vc.x), bf_hi(R.vc.x), bf_lo(R.vc.y), bf_hi(R.vc.y)};
    sf4 rp = {bf_lo(R.rp.x), bf_hi(R.rp.x), bf_lo(R.rp.y), bf_hi(R.rp.y)}, kp = {bf_lo(R.kp.x), bf_hi(R.kp.x), bf_lo(R.kp.y), bf_hi(R.kp.y)}, vp = {bf_lo(R.vp.x), bf_hi(R.vp.x), bf_lo(R.vp.y), bf_hi(R.vp.y)};
    rp = rp * pz; kp = kp * pz; vp = vp * pz;
    const sf4 r = rc + (rp - rc) * mu_r, k = kc + (kp - kc) * mu_k, v = vc + (vp - vc) * mu_v;
    const sf4 zw = w0c + (sf4){bf_lo(R.ew.x), bf_hi(R.ew.x), bf_lo(R.ew.y), bf_hi(R.ew.y)}, za = a0c + (sf4){bf_lo(R.ea.x), bf_hi(R.ea.x), bf_lo(R.ea.y), bf_hi(R.ea.y)};
    sf4 dec, a;
#pragma unroll
    for (int e = 0; e < 4; ++e) { const float nx = -zw[e]; const float sp = fmaxf(nx, 0.f) + __logf(1.0f + __expf(-fabsf(nx)));
        dec[e] = __expf(-__expf(-sp - 0.5f));
        a[e] = __builtin_amdgcn_rcpf(1.0f + __expf(-za[e])); }
    const sf4 kkr = k * kkw;
    const float n2 = reduce16((kkr.x * kkr.x + kkr.y * kkr.y) + (kkr.z * kkr.z + kkr.w * kkr.w));
    const sf4 kk = kkr * (1.0f / fmaxf(sqrtf(n2), 1e-12f));
    const sf4 km = k * (1.0f + (a - 1.0f) * kaw);
    const sf4 rkm = r * km * rkw;
    const float bon = reduce16((rkm.x + rkm.y) + (rkm.z + rkm.w));
    *(SLDS sf4*)&buf[OFF_NKK + i * 64 + sl * 4] = -kk;
    *(SLDS sf4*)&buf[OFF_DEC + i * 64 + sl * 4] = dec;
    *(SLDS sf4*)&buf[OFF_BB + i * 64 + sl * 4] = kk * a;
    *(SLDS sf4*)&buf[OFF_KM + i * 64 + sl * 4] = km;
    *(SLDS sf4*)&buf[OFF_RR + i * 64 + sl * 4] = r;
    if ((sl >> 3) == hf) {
        SLDS float* vv = &buf[OFF_VV + i * 32 + ((sl & 7) >> 1) * 8 + (sl & 1)];
        vv[0] = v.x; vv[2] = v.y; vv[4] = v.z; vv[6] = v.w;
        const sf4 bt = v * bon; su2 o; o.x = pk_bf(bt.x, bt.y); o.y = pk_bf(bt.z, bt.w);
        *(su2*)(A.BT + ((size_t)b * 2048 + t) * 512 + h * 64 + sl * 4) = o;
    }
}
struct StepOps { sf4 nk, dc, bb, km, rr; sf2 v; };
__device__ __forceinline__ void step_load(StepOps& o, const SLDS float* L, int i, int kq, int vo) {
    o.nk = *(const SLDS sf4*)&L[OFF_NKK + i * 64 + kq]; o.dc = *(const SLDS sf4*)&L[OFF_DEC + i * 64 + kq]; o.bb = *(const SLDS sf4*)&L[OFF_BB + i * 64 + kq];
    o.km = *(const SLDS sf4*)&L[OFF_KM + i * 64 + kq]; o.rr = *(const SLDS sf4*)&L[OFF_RR + i * 64 + kq]; o.v = *(const SLDS sf2*)&L[OFF_VV + i * 32 + vo];
}
__device__ __forceinline__ void step_compute(const StepOps& o, sf2& a01, sf2& a23, sf2& b01, sf2& b23, SLDS sf2* yp) {
    const sf2 pa = a01 * o.nk.xy + a23 * o.nk.zw, pb = b01 * o.nk.xy + b23 * o.nk.zw;
    const sf2 va = {o.v.x, o.v.x}, vb = {o.v.y, o.v.y};
    const float sa = reduce16(pa.x + pa.y), sb = reduce16(pb.x + pb.y);
    const sf2 sa2 = {sa, sa}, sb2 = {sb, sb};
    a01 = a01 * o.dc.xy + (sa2 * o.bb.xy + va * o.km.xy);
    a23 = a23 * o.dc.zw + (sa2 * o.bb.zw + va * o.km.zw);
    b01 = b01 * o.dc.xy + (sb2 * o.bb.xy + vb * o.km.xy);
    b23 = b23 * o.dc.zw + (sb2 * o.bb.zw + vb * o.km.zw);
    const sf2 qa = a01 * o.rr.xy + a23 * o.rr.zw, qb = b01 * o.rr.xy + b23 * o.rr.zw;
    *yp = (sf2){qa.x + qa.y, qb.x + qb.y};
}
__device__ __forceinline__ void flush_block(const SLDS float* YPb, const ScanArgs& A, int b, int h, int hf, int blk, int ptid) {
    const int i = ptid >> 4, w = (ptid >> 2) & 3, g = ptid & 3;
    const SLDS sf4* pp = (const SLDS sf4*)&YPb[i * 512 + (w * 64 + g * 16) * 2];
    sf4 acc = pp[0];
#pragma unroll
    for (int q = 1; q < 8; ++q) acc = acc + pp[q];
    unsigned short* yr = A.Y + ((size_t)b * 2048 + blk * TB + i) * 512 + h * 64 + hf * 32 + w * 8 + g;
    const unsigned pk = pk_bf(acc.x + acc.z, acc.y + acc.w);
    yr[0] = (unsigned short)(pk & 0xffffu); yr[4] = (unsigned short)(pk >> 16);
}
__device__ __forceinline__ void scan_unit(SLDS float* L, const ScanArgs& A, int b, int h, int hf) {
    const int tid = threadIdx.x, lane = tid & 63; const int wid = __builtin_amdgcn_readfirstlane(tid >> 6);
    constexpr int NBLK = 2048 / TB;
    if (wid >= 4) {
        const int ptid = tid - 256;
        const int c0 = h * 64 + (ptid & 15) * 4;
        const sf4 mu_r = *(const sf4*)(A.mu + c0), mu_k = *(const sf4*)(A.mu + 512 + c0), mu_v = *(const sf4*)(A.mu + 1024 + c0);
        const sf4 kkw = *(const sf4*)(A.k_k + c0), kaw = *(const sf4*)(A.k_a + c0), rkw = *(const sf4*)(A.r_k + c0), w0c = *(const sf4*)(A.w0 + c0), a0c = *(const sf4*)(A.a0 + c0);
        PrepRegs R;
        prep_load(R, A, b, h, 0, ptid);
        prep_compute(L, R, A, b, h, hf, 0, ptid, mu_r, mu_k, mu_v, kkw, kaw, rkw, w0c, a0c);
        prep_load(R, A, b, h, 1, ptid);
        __syncthreads();
        for (int blk = 0; blk < NBLK; ++blk) {
            if (blk + 1 < NBLK) prep_compute(L + ((blk + 1) & 1) * IN_FLOATS, R, A, b, h, hf, blk + 1, ptid, mu_r, mu_k, mu_v, kkw, kaw, rkw, w0c, a0c);
            if (blk + 2 < NBLK) prep_load(R, A, b, h, blk + 2, ptid);
            if (blk >= 1) flush_block(L + OFF_YP + ((blk - 1) & 1) * YP_FLOATS, A, b, h, hf, blk - 1, ptid);
            __syncthreads();
        }
        flush_block(L + OFF_YP + ((NBLK - 1) & 1) * YP_FLOATS, A, b, h, hf, NBLK - 1, ptid);
    } else {
        sf2 a01 = {0.f, 0.f}, a23 = {0.f, 0.f}, b01 = {0.f, 0.f}, b23 = {0.f, 0.f};
        const int kq = (lane & 15) * 4, vo = wid * 8 + (lane >> 4) * 2;
        __syncthreads();
        for (int blk = 0; blk < NBLK; ++blk) {
            const SLDS float* IN = L + (blk & 1) * IN_FLOATS;
            SLDS sf2* ypl = (SLDS sf2*)(L + OFF_YP + (blk & 1) * YP_FLOATS) + tid;
            StepOps oa, ob, na, nb;
            step_load(oa, IN, 0, kq, vo); step_load(ob, IN, 1, kq, vo);
#pragma unroll
            for (int i = 0; i < TB; i += 2) {
                if (i + 2 < TB) { step_load(na, IN, i + 2, kq, vo); step_load(nb, IN, i + 3, kq, vo); }
                __builtin_amdgcn_sched_barrier(0);
                step_compute(oa, a01, a23, b01, b23, ypl + i * 256);
                step_compute(ob, a01, a23, b01, b23, ypl + (i + 1) * 256);
                __builtin_amdgcn_sched_barrier(0);
                oa = na; ob = nb;
            }
            __syncthreads();
        }
    }
    __syncthreads();
}
}

#ifndef RW_STAGE
#define RW_STAGE 0
#endif
#ifndef PROBE_K
#define PROBE_K (-1)
#endif
namespace rwkv_body {
#ifndef RWS_C
#define RWS_C 0
#endif
#ifndef RWS_C
#define RWS_C 0
#endif
#define RWSTAMP(k) do { if (PROBE_K >= 0 && blockIdx.x == 0 && threadIdx.x == 0 && c == RWS_C) tsp[k] = __builtin_amdgcn_s_memrealtime(); } while (0)
#define RL __attribute__((address_space(3)))
#define RWBAR() do { asm volatile("s_waitcnt lgkmcnt(0)" ::: "memory"); __builtin_amdgcn_s_barrier(); asm volatile("" ::: "memory"); } while (0)
typedef short h8 __attribute__((ext_vector_type(8)));
typedef float f4 __attribute__((ext_vector_type(4)));
typedef unsigned u2 __attribute__((ext_vector_type(2)));
typedef unsigned u4 __attribute__((ext_vector_type(4)));
constexpr int ST = 72, SB = ST * 2, MBY = 64 * SB;
constexpr int O_AH = 0, O_BH = MBY, O_KH = 2 * MBY, O_RH = 3 * MBY, O_KHT = 4 * MBY, O_BHT = 5 * MBY, O_VMT = 6 * MBY, O_YT = 7 * MBY  ,
              O_MP0 = 9 * MBY, O_MPT0 = 10 * MBY, O_MP1 = 11 * MBY, O_MPT1 = 12 * MBY, O_OT = 13 * MBY, O_PC = O_OT + 2048, O_KC = O_PC + 256  , RWKV_LDS_BYTES = O_KC + 2048;
constexpr int O_CL = O_MP0;
constexpr int O_VM = O_MP1;
__device__ __forceinline__ float bflo(unsigned w) { return __uint_as_float(w << 16); }
__device__ __forceinline__ float bfhi(unsigned w) { return __uint_as_float(w & 0xffff0000u); }
typedef float f2t_ __attribute__((ext_vector_type(2))); typedef __bf16 b2t_ __attribute__((ext_vector_type(2)));
__device__ __forceinline__ unsigned pkbf(float lo, float hi) { const f2t_ v = {lo, hi}; const b2t_ b = __builtin_convertvector(v, b2t_); return __builtin_bit_cast(unsigned, b); }
template <int CTRL> __device__ __forceinline__ float dppadd(float x) { return x + __builtin_bit_cast(float, __builtin_amdgcn_mov_dpp(__builtin_bit_cast(int, x), CTRL, 0xF, 0xF, true)); }
__device__ __forceinline__ float reduce8(float x) { x = dppadd<0xB1>(x); x = dppadd<0x4E>(x); x = dppadd<0x141>(x); return x; }
__device__ __forceinline__ h8 ldfrag(const RL char* base, int row0, int ks, int lane) { return *(const RL h8*)(base + (row0 + (lane & 15)) * SB + ks * 64 + (lane >> 4) * 16); }
__device__ __forceinline__ void mma2(f4& acc, const RL char* A, int am0, const RL char* B, int bn0, int lane) {
    acc = __builtin_amdgcn_mfma_f32_16x16x32_bf16(ldfrag(A, am0, 0, lane), ldfrag(B, bn0, 0, lane), acc, 0, 0, 0);
    acc = __builtin_amdgcn_mfma_f32_16x16x32_bf16(ldfrag(A, am0, 1, lane), ldfrag(B, bn0, 1, lane), acc, 0, 0, 0);
}
__device__ __forceinline__ void mma2p(f4& acc0, f4& acc1, const RL char* A, int am0, const RL char* B, int bn0, int lane) {
    const h8 a0 = ldfrag(A, am0, 0, lane), a1 = ldfrag(A, am0, 1, lane);
    acc0 = __builtin_amdgcn_mfma_f32_16x16x32_bf16(a0, ldfrag(B, bn0, 0, lane), acc0, 0, 0, 0); acc1 = __builtin_amdgcn_mfma_f32_16x16x32_bf16(a0, ldfrag(B, bn0 + 16, 0, lane), acc1, 0, 0, 0);
    acc0 = __builtin_amdgcn_mfma_f32_16x16x32_bf16(a1, ldfrag(B, bn0, 1, lane), acc0, 0, 0, 0); acc1 = __builtin_amdgcn_mfma_f32_16x16x32_bf16(a1, ldfrag(B, bn0 + 16, 1, lane), acc1, 0, 0, 0);
}
__device__ __forceinline__ void storeT(RL char* dst, int m0, int n0, const f4& acc, int lane) {
    u2 w; w.x = pkbf(acc[0], acc[1]); w.y = pkbf(acc[2], acc[3]);
    *(RL u2*)(dst + (n0 + (lane & 15)) * SB + (m0 + 4 * (lane >> 4)) * 2) = w;
}
struct Args { unsigned long long* tsp_; const unsigned short* U; const unsigned short* E; unsigned short* Y; unsigned short* BT; unsigned char* GH; unsigned char* Q1; unsigned char* Q2;
              const float* mu; const float* k_k; const float* k_a; const float* r_k; const float* w0; const float* a0; };
__device__ __forceinline__ unsigned char* qptr(const Args& A, int cid) { return cid < 1024 ? A.Q1 + (size_t)cid * 8192 : A.Q2 + (size_t)(cid - 1024) * 8192; }

struct ChunkLoads { u4 rc, kc, vc, rp, kp, vp, ew, ea; };
__device__ __forceinline__ void chunk_consts_to_lds(RL char* L, const Args& A, int h) {
    const int tid = threadIdx.x; RL float* kc = (RL float*)(L + O_KC);
    if (tid < 64) { const int c = h * 64 + tid; kc[tid] = A.mu[c]; kc[64 + tid] = A.mu[512 + c]; kc[128 + tid] = A.mu[1024 + c]; kc[192 + tid] = A.k_k[c]; kc[256 + tid] = A.k_a[c]; kc[320 + tid] = A.r_k[c]; kc[384 + tid] = A.w0[c]; kc[448 + tid] = A.a0[c]; }
}
__device__ __forceinline__ void chunk_load(ChunkLoads& R, const Args& A, int b, int h, int c) {
    const int tid = threadIdx.x, ti = tid >> 3, ch0 = 8 * (tid & 7), t = c * 64 + ti;
    const size_t tok = (size_t)b * 2048 + t;
    const unsigned short* ur = A.U + tok * 3328 + 1536 + h * 64 + ch0;
    R.rc = *(const u4*)ur; R.kc = *(const u4*)(ur + 512); R.vc = *(const u4*)(ur + 1024);
    const unsigned short* up = (t > 0) ? ur - 3328 : ur;
    R.rp = *(const u4*)up; R.kp = *(const u4*)(up + 512); R.vp = *(const u4*)(up + 1024);
    R.ew = *(const u4*)(A.E + tok * 1536 + h * 64 + ch0); R.ea = *(const u4*)(A.E + tok * 1536 + 512 + h * 64 + ch0);
}
#define CVT_LOAD(P_, N_) const f4 cv0 = *(const f4*)(P_), cv1 = *(const f4*)((P_) + (size_t)(N_)), cv2 = *(const f4*)((P_) + (size_t)2 * (N_)), cv3 = *(const f4*)((P_) + (size_t)3 * (N_)), \
                               cv4 = *(const f4*)((P_) + (size_t)4 * (N_)), cv5 = *(const f4*)((P_) + (size_t)5 * (N_)), cv6 = *(const f4*)((P_) + (size_t)6 * (N_)), cv7 = *(const f4*)((P_) + (size_t)7 * (N_))
#define CVT_STORE(Q_, K_) do { _Pragma("unroll") for (int e_ = 0; e_ < 4; ++e_) *(u4*)((Q_) + (size_t)e_ * (K_)) = (u4){pkbf(cv0[e_], cv1[e_]), pkbf(cv2[e_], cv3[e_]), pkbf(cv4[e_], cv5[e_]), pkbf(cv6[e_], cv7[e_])}; } while (0)
__device__ __forceinline__ void rwkv_chunk_task(RL char* L, const Args& A, const ChunkLoads& LD, ChunkLoads& NEXT, bool has_next, int b, int h, int c, int cnext, const float* jWg, const float* jWu, unsigned short* jWGU, int jitem) {
    const int tid = threadIdx.x, lane = tid & 63; const int wid = __builtin_amdgcn_readfirstlane(tid >> 6);
    const int cid = (b * 8 + h) * 32 + c; unsigned long long* tsp = A.tsp_;
    RWSTAMP(17);
    const int ti = tid >> 3, ch0 = 8 * (tid & 7), t = c * 64 + ti;
    const size_t tok = (size_t)b * 2048 + t;
    float r8[8], km8[8], b8[8], nk8[8], v8[8], lw8[8];
    {
        const u4 rc = LD.rc, kc = LD.kc, vc = LD.vc, rp = LD.rp, kp = LD.kp, vp = LD.vp, ew = LD.ew, ea = LD.ea;
        const float pz = (t > 0) ? 1.0f : 0.0f;
        const RL float* kcst = (const RL float*)(L + O_KC) + ch0;
        float cmr[8], cmk[8], cmv[8], ckk[8], cka[8], crk[8], cw0[8], ca0[8];
#define LDC8(dst, off) do { const f4 t0_ = *(const RL f4*)(kcst + (off)), t1_ = *(const RL f4*)(kcst + (off) + 4); dst[0] = t0_[0]; dst[1] = t0_[1]; dst[2] = t0_[2]; dst[3] = t0_[3]; dst[4] = t1_[0]; dst[5] = t1_[1]; dst[6] = t1_[2]; dst[7] = t1_[3]; } while (0)
        LDC8(cmr, 0); LDC8(cmk, 64); LDC8(cmv, 128); LDC8(ckk, 192); LDC8(cka, 256); LDC8(crk, 320); LDC8(cw0, 384); LDC8(ca0, 448);
#undef LDC8
        float kkr[8], ag[8]; float n2 = 0.f, bon = 0.f;
#pragma unroll
        for (int e = 0; e < 8; ++e) {
            const unsigned wr = rc[e >> 1], wk = kc[e >> 1], wv = vc[e >> 1], pr = rp[e >> 1], pk = kp[e >> 1], pv = vp[e >> 1], we = ew[e >> 1], wa = ea[e >> 1];
            const float rcur = (e & 1) ? bfhi(wr) : bflo(wr), kcur = (e & 1) ? bfhi(wk) : bflo(wk), vcur = (e & 1) ? bfhi(wv) : bflo(wv);
            const float rprv = ((e & 1) ? bfhi(pr) : bflo(pr)) * pz, kprv = ((e & 1) ? bfhi(pk) : bflo(pk)) * pz, vprv = ((e & 1) ? bfhi(pv) : bflo(pv)) * pz;
            const float rr = rcur + (rprv - rcur) * cmr[e], kk_ = kcur + (kprv - kcur) * cmk[e], vv = vcur + (vprv - vcur) * cmv[e];
            const float zw = cw0[e] + ((e & 1) ? bfhi(we) : bflo(we)), za = ca0[e] + ((e & 1) ? bfhi(wa) : bflo(wa));
            const float nx = -zw; const float sp = fmaxf(nx, 0.f) + __logf(1.0f + __expf(-fabsf(nx)));
            lw8[e] = -__expf(-sp - 0.5f);
            ag[e] = __builtin_amdgcn_rcpf(1.0f + __expf(-za));
            kkr[e] = kk_ * ckk[e]; n2 += kkr[e] * kkr[e];
            km8[e] = kk_ * (1.0f + (ag[e] - 1.0f) * cka[e]);
            r8[e] = rr; v8[e] = vv; bon += rr * km8[e] * crk[e];
        }
        n2 = reduce8(n2); bon = reduce8(bon);
        const float inv = 1.0f / fmaxf(sqrtf(n2), 1e-12f);
#pragma unroll
        for (int e = 0; e < 8; ++e) { const float kk = kkr[e] * inv; nk8[e] = -kk; b8[e] = kk * ag[e]; }
        u4 bo; bo.x = pkbf(bon * v8[0], bon * v8[1]); bo.y = pkbf(bon * v8[2], bon * v8[3]); bo.z = pkbf(bon * v8[4], bon * v8[5]); bo.w = pkbf(bon * v8[6], bon * v8[7]);
        *(u4*)(A.BT + tok * 512 + h * 64 + ch0) = bo;
        RL float* cl = (RL float*)(L + O_CL) + ti * 64 + ch0;
        *(RL f4*)cl = (f4){lw8[0], lw8[1], lw8[2], lw8[3]}; *(RL f4*)(cl + 4) = (f4){lw8[4], lw8[5], lw8[6], lw8[7]};
    }
    if (has_next) chunk_load(NEXT, A, b, h, cnext);
    const int citem = jitem >= 0 ? jitem : 0;
    const int ce_ = citem >> 9, cmat = (citem >> 8) & 1, cit = citem & 255; const int ck0 = 64 * (cit >> 4), cn0 = 32 * (cit & 15);
    const float* cvp = (cmat ? jWu : jWg) + (size_t)ce_ * 1024 * 512 + (size_t)(ck0 + 8 * (lane >> 3)) * 512 + cn0 + 4 * (lane & 7);
    CVT_LOAD(cvp, 512);
    RWBAR(); RWSTAMP(23);
    {
        RL float* cl = (RL float*)(L + O_CL); RL float* ot = (RL float*)(L + O_OT);
        const int ch = tid & 63, oc = tid >> 6;
        float run = 0.f;
#pragma unroll
        for (int j = 0; j < 8; ++j) { run += cl[(8 * oc + j) * 64 + ch]; cl[(8 * oc + j) * 64 + ch] = run; }
        ot[oc * 64 + ch] = run;
    }
    RWBAR(); RWSTAMP(24);
    {
        const RL float* cl = (const RL float*)(L + O_CL) + ti * 64 + ch0; const RL float* ot = (const RL float*)(L + O_OT) + ch0;
        f4 c0 = *(const RL f4*)cl, c1 = *(const RL f4*)(cl + 4);
#pragma unroll 1
        for (int o = 0; o < wid; ++o) { c0 = c0 + *(const RL f4*)(ot + o * 64); c1 = c1 + *(const RL f4*)(ot + o * 64 + 4); }
        if (ti == 63) { RL float* pc = (RL float*)(L + O_PC) + ch0; *(RL f4*)pc = (f4){__expf(c0[0]), __expf(c0[1]), __expf(c0[2]), __expf(c0[3])}; *(RL f4*)(pc + 4) = (f4){__expf(c1[0]), __expf(c1[1]), __expf(c1[2]), __expf(c1[3])}; }
        const float cl8[8] = {c0[0], c0[1], c0[2], c0[3], c1[0], c1[1], c1[2], c1[3]};
        float ah[8], bh[8], kh[8], rh[8];
#pragma unroll
        for (int e = 0; e < 8; ++e) { const float P = __expf(cl8[e]), Pp = __expf(cl8[e] - lw8[e]), iP = __expf(-cl8[e]);
            ah[e] = nk8[e] * Pp; bh[e] = b8[e] * iP; kh[e] = km8[e] * iP; rh[e] = r8[e] * P; }
        const int off = ti * SB + ch0 * 2;
        *(RL u4*)(L + O_AH + off) = (u4){pkbf(ah[0], ah[1]), pkbf(ah[2], ah[3]), pkbf(ah[4], ah[5]), pkbf(ah[6], ah[7])};
        *(RL u4*)(L + O_BH + off) = (u4){pkbf(bh[0], bh[1]), pkbf(bh[2], bh[3]), pkbf(bh[4], bh[5]), pkbf(bh[6], bh[7])};
        *(RL u4*)(L + O_KH + off) = (u4){pkbf(kh[0], kh[1]), pkbf(kh[2], kh[3]), pkbf(kh[4], kh[5]), pkbf(kh[6], kh[7])};
        *(RL u4*)(L + O_RH + off) = (u4){pkbf(rh[0], rh[1]), pkbf(rh[2], rh[3]), pkbf(rh[4], rh[5]), pkbf(rh[6], rh[7])};
        *(RL u4*)(L + O_VM + off) = (u4){pkbf(v8[0], v8[1]), pkbf(v8[2], v8[3]), pkbf(v8[4], v8[5]), pkbf(v8[6], v8[7])};
    }
    RWBAR(); RWSTAMP(25);
    {
        const int k = tid & 63, og = tid >> 6;
        const int srcs[4] = {O_KH, O_BH, O_VM, O_AH}, dsts[4] = {O_KHT, O_BHT, O_VMT, O_YT};
#pragma unroll
        for (int q = 0; q < 4; ++q) {
            unsigned short e[8];
#pragma unroll
            for (int j = 0; j < 8; ++j) e[j] = *(const RL unsigned short*)(L + srcs[q] + (8 * og + j) * SB + k * 2);
            *(RL u4*)(L + dsts[q] + k * SB + og * 16) = (u4){(unsigned)e[0] | ((unsigned)e[1] << 16), (unsigned)e[2] | ((unsigned)e[3] << 16), (unsigned)e[4] | ((unsigned)e[5] << 16), (unsigned)e[6] | ((unsigned)e[7] << 16)};
        }
    }
    RWBAR(); RWSTAMP(18);
    const int mb = wid & 3, nb0 = 2 * (wid >> 2);
    const int lm = 4 * (lane >> 4), ln = lane & 15;
    {
        const int m_ = 16 * mb + lm, na = 16 * nb0 + ln, nb_ = na + 16;
        f4 c1a = {0.f, 0.f, 0.f, 0.f}, c1b = c1a, c2a = c1a, c2b = c1a, c3a = c1a, c3b = c1a;
        mma2p(c1a, c1b, L + O_BH, 16 * mb, L + O_AH, 16 * nb0, lane);
        mma2p(c2a, c2b, L + O_AH, 16 * mb, L + O_BH, 16 * nb0, lane);
        mma2p(c3a, c3b, L + O_KH, 16 * mb, L + O_AH, 16 * nb0, lane);
#pragma unroll
        for (int q = 0; q < 4; ++q) { if (!(na > m_ + q)) { c1a[q] = 0.f; c3a[q] = 0.f; } if (!(m_ + q > na)) c2a[q] = 0.f;
                                      if (!(nb_ > m_ + q)) { c1b[q] = 0.f; c3b[q] = 0.f; } if (!(m_ + q > nb_)) c2b[q] = 0.f; }
        storeT(L + O_MP0, 16 * mb, 16 * nb0, c1a, lane); storeT(L + O_MPT0, 16 * mb, 16 * nb0, c2a, lane); storeT(L + O_MP1, 16 * mb, 16 * nb0, c3a, lane);
        storeT(L + O_MP0, 16 * mb, 16 * nb0 + 16, c1b, lane); storeT(L + O_MPT0, 16 * mb, 16 * nb0 + 16, c2b, lane); storeT(L + O_MP1, 16 * mb, 16 * nb0 + 16, c3b, lane);
    }
    RWBAR();
    {   f4 cxa = {0.f, 0.f, 0.f, 0.f}, cxb = cxa; mma2p(cxa, cxb, L + O_MP1, 16 * mb, L + O_VMT, 16 * nb0, lane);
        storeT(L + O_YT + 64 * SB, 16 * mb, 16 * nb0, cxa, lane); storeT(L + O_YT + 64 * SB, 16 * mb, 16 * nb0 + 16, cxb, lane); }
    RWBAR();
    {
        f4 acc[2][4];
        if (wid < 4) {
#pragma unroll
            for (int cbk = 0; cbk < 2; ++cbk) { const RL char* yrow = L + O_YT + (32 * wid + 16 * cbk + ln) * SB;
#pragma unroll
                for (int ib = 0; ib < 4; ++ib) { const u2 w = *(const RL u2*)(yrow + (16 * ib + lm) * 2); acc[cbk][ib] = (f4){bflo(w.x), bfhi(w.x), bflo(w.y), bfhi(w.y)}; } }
        }
#pragma unroll
        for (int lev = 0; lev < 6; ++lev) {
            const RL char* Mp = L + ((lev & 1) ? O_MP1 : O_MP0); const RL char* MpT = L + ((lev & 1) ? O_MPT1 : O_MPT0);
            RL char* Mn = L + ((lev & 1) ? O_MP0 : O_MP1); RL char* MnT = L + ((lev & 1) ? O_MPT0 : O_MPT1);
            if (wid < 4) {
                const h8 ya0 = ldfrag(L + O_YT, 32 * wid, 0, lane), ya1 = ldfrag(L + O_YT, 32 * wid, 1, lane), yb0 = ldfrag(L + O_YT, 32 * wid + 16, 0, lane), yb1 = ldfrag(L + O_YT, 32 * wid + 16, 1, lane);
#pragma unroll
                for (int ib = 0; ib < 4; ++ib) {
                    const h8 m0 = ldfrag(Mp, 16 * ib, 0, lane), m1 = ldfrag(Mp, 16 * ib, 1, lane);
                    acc[0][ib] = __builtin_amdgcn_mfma_f32_16x16x32_bf16(m0, ya0, acc[0][ib], 0, 0, 0); acc[1][ib] = __builtin_amdgcn_mfma_f32_16x16x32_bf16(m0, yb0, acc[1][ib], 0, 0, 0);
                    acc[0][ib] = __builtin_amdgcn_mfma_f32_16x16x32_bf16(m1, ya1, acc[0][ib], 0, 0, 0); acc[1][ib] = __builtin_amdgcn_mfma_f32_16x16x32_bf16(m1, yb1, acc[1][ib], 0, 0, 0);
                }
#pragma unroll
                for (int cbk = 0; cbk < 2; ++cbk)
#pragma unroll
                    for (int ib = 0; ib < 4; ++ib) storeT(L + O_YT, 16 * ib, 32 * wid + 16 * cbk, acc[cbk][ib], lane);
            } else if (lev < 5) {
                const int sm = wid - 4;
                const h8 t0 = ldfrag(MpT, 16 * sm, 0, lane), t1 = ldfrag(MpT, 16 * sm, 1, lane), p0 = ldfrag(Mp, 16 * sm, 0, lane), p1 = ldfrag(Mp, 16 * sm, 1, lane);
#pragma unroll
                for (int nb = 0; nb < 4; ++nb) {
                    const h8 bp0 = ldfrag(Mp, 16 * nb, 0, lane), bp1 = ldfrag(Mp, 16 * nb, 1, lane), bt0 = ldfrag(MpT, 16 * nb, 0, lane), bt1 = ldfrag(MpT, 16 * nb, 1, lane);
                    f4 s1 = {0.f, 0.f, 0.f, 0.f}, s2 = s1;
                    s1 = __builtin_amdgcn_mfma_f32_16x16x32_bf16(t0, bp0, s1, 0, 0, 0); s2 = __builtin_amdgcn_mfma_f32_16x16x32_bf16(p0, bt0, s2, 0, 0, 0);
                    s1 = __builtin_amdgcn_mfma_f32_16x16x32_bf16(t1, bp1, s1, 0, 0, 0); s2 = __builtin_amdgcn_mfma_f32_16x16x32_bf16(p1, bt1, s2, 0, 0, 0);
                    storeT(Mn, 16 * sm, 16 * nb, s1, lane);
                    storeT(MnT, 16 * sm, 16 * nb, s2, lane);
                }
            }
            RWBAR();
        }
    }
    RWSTAMP(19);
    {
        const int m_ = 16 * mb + lm, na = 16 * nb0 + ln, nb_ = na + 16;
        f4 c3a = {0.f, 0.f, 0.f, 0.f}, c3b = c3a, c4a = c3a, c4b = c3a;
        mma2p(c3a, c3b, L + O_KH, 16 * mb, L + O_RH, 16 * nb0, lane); mma2p(c4a, c4b, L + O_BH, 16 * mb, L + O_RH, 16 * nb0, lane);
#pragma unroll
        for (int q = 0; q < 4; ++q) { if (!(m_ + q <= na)) { c3a[q] = 0.f; c4a[q] = 0.f; } if (!(m_ + q <= nb_)) { c3b[q] = 0.f; c4b[q] = 0.f; } }
        storeT(L + O_MP0, 16 * mb, 16 * nb0, c3a, lane); storeT(L + O_MPT0, 16 * mb, 16 * nb0, c4a, lane); storeT(L + O_MP0, 16 * mb, 16 * nb0 + 16, c3b, lane); storeT(L + O_MPT0, 16 * mb, 16 * nb0 + 16, c4b, lane);
    }
    if (jitem >= 0) { unsigned short* cvq = jWGU + (size_t)(ce_ * 1024 + (cn0 >> 7) * 256 + (cn0 & 127) + cmat * 128 + 4 * (lane & 7)) * 1024 + ck0 + 8 * (lane >> 3); CVT_STORE(cvq, 1024); }
    RWBAR();
    RWSTAMP(20);
    {
        unsigned char* gh = A.GH + (size_t)cid * 16384; unsigned char* qq = qptr(A, cid);
        const RL float* pc = (const RL float*)(L + O_PC);
        const RL char* AtT = L + O_YT; const RL char* WT = L + O_YT + 64 * SB;
#pragma unroll
        for (int tt = 0; tt < 2; ++tt) {
            const int nb = nb0 + tt; const int m_ = 16 * mb + lm, n_ = 16 * nb + ln;
            const float pcn = pc[n_];
            f4 g = {0.f, 0.f, 0.f, 0.f}; mma2(g, AtT, 16 * mb, L + O_BHT, 16 * nb, lane);
#pragma unroll
            for (int q = 0; q < 4; ++q) g[q] = (g[q] + ((m_ + q == n_) ? 1.0f : 0.0f)) * pcn;
            *(u2*)(gh + (size_t)n_ * 128 + (size_t)m_ * 2) = (u2){pkbf(g[0], g[1]), pkbf(g[2], g[3])};
            f4 hh = {0.f, 0.f, 0.f, 0.f}; mma2(hh, L + O_VMT, 16 * mb, L + O_KHT, 16 * nb, lane); mma2(hh, WT, 16 * mb, L + O_BHT, 16 * nb, lane);
            *(u2*)(gh + 8192 + ((size_t)(wid * 2 + tt) * 64 + lane) * 8) = (u2){pkbf(hh[0] * pcn, hh[1] * pcn), pkbf(hh[2] * pcn, hh[3] * pcn)};
            f4 qv; { const u2 w = *(const RL u2*)(L + O_RH + n_ * SB + m_ * 2); qv = (f4){bflo(w.x), bfhi(w.x), bflo(w.y), bfhi(w.y)}; }
            mma2(qv, AtT, 16 * mb, L + O_MPT0, 16 * nb, lane);
            *(u2*)(qq + (size_t)n_ * 128 + (size_t)m_ * 2) = (u2){pkbf(qv[0], qv[1]), pkbf(qv[2], qv[3])};
            f4 y0 = {0.f, 0.f, 0.f, 0.f};
            if (RW_STAGE == 0 || RW_STAGE == 1) mma2(y0, L + O_VMT, 16 * mb, L + O_MP0, 16 * nb, lane);
            if (RW_STAGE == 0 || RW_STAGE == 2) mma2(y0, WT, 16 * mb, L + O_MPT0, 16 * nb, lane);
            if (RW_STAGE == 7) mma2(y0, L + O_VMT, 16 * mb, L + O_VMT, 16 * nb, lane);
            if (RW_STAGE == 8) mma2(y0, L + O_VMT, 16 * mb, L + O_RH, 16 * nb, lane);
            if (RW_STAGE == 3) { const u2 w = *(const RL u2*)(L + O_MP0 + n_ * SB + m_ * 2); y0 = (f4){bflo(w.x), bfhi(w.x), bflo(w.y), bfhi(w.y)}; }
            if (RW_STAGE == 4) { const u2 w = *(const RL u2*)(WT + n_ * SB + m_ * 2); y0 = (f4){bflo(w.x), bfhi(w.x), bflo(w.y), bfhi(w.y)}; }
            if (RW_STAGE == 5) { const u2 w = *(const RL u2*)(L + O_VMT + n_ * SB + m_ * 2); y0 = (f4){bflo(w.x), bfhi(w.x), bflo(w.y), bfhi(w.y)}; }
            if (RW_STAGE == 6) { const u2 w = *(const RL u2*)(L + O_RH + n_ * SB + m_ * 2); y0 = (f4){bflo(w.x), bfhi(w.x), bflo(w.y), bfhi(w.y)}; }
            *(u2*)(A.Y + ((size_t)b * 2048 + c * 64 + n_) * 512 + h * 64 + m_) = (u2){pkbf(y0[0], y0[1]), pkbf(y0[2], y0[3])};
        }
    }
    RWBAR();
}

__device__ __forceinline__ void rwkv_seq_head(RL char* L, const Args& A, int b, int h, int mb) {
    const int tid = threadIdx.x, lane = tid & 63; const int wid = __builtin_amdgcn_readfirstlane(tid >> 6);
    const int lm = 4 * (lane >> 4), ln = lane & 15; const bool isS = wid < 4; const int nb = wid & 3;
    RL char* Sb = L;
    for (int i = tid; i < 16 * SB / 4; i += 512) ((RL unsigned*)Sb)[i] = 0u;
    RWBAR();
    const int cid0 = (b * 8 + h) * 32;
    const int hdump = ((4 * (nb >> 1) + mb) * 2 + (nb & 1)) * 64 + lane;
    struct Ops { h8 f0, f1; u2 x; };
#define RB_LOAD(O_, c_) do { const unsigned char* gh_ = A.GH + (size_t)(cid0 + (c_)) * 16384; \
        const unsigned char* src_ = (isS ? gh_ : qptr(A, cid0 + (c_))) + (size_t)(16 * nb + ln) * 128 + (lane >> 4) * 16; \
        O_.f0 = *(const h8*)src_; O_.f1 = *(const h8*)(src_ + 64); \
        O_.x = isS ? *(const u2*)(gh_ + 8192 + (size_t)hdump * 8) : *(const u2*)(A.Y + ((size_t)b * 2048 + (c_) * 64 + 16 * nb + ln) * 512 + h * 64 + 16 * mb + lm); } while (0)
#define RB_STEP(O_, c_) do { \
        const h8 a0 = ldfrag(Sb, 0, 0, lane), a1 = ldfrag(Sb, 0, 1, lane); \
        f4 r = {bflo(O_.x.x), bfhi(O_.x.x), bflo(O_.x.y), bfhi(O_.x.y)}; \
        r = __builtin_amdgcn_mfma_f32_16x16x32_bf16(a0, O_.f0, r, 0, 0, 0); r = __builtin_amdgcn_mfma_f32_16x16x32_bf16(a1, O_.f1, r, 0, 0, 0); \
        if (!isS) *(u2*)(A.Y + ((size_t)b * 2048 + (c_) * 64 + 16 * nb + ln) * 512 + h * 64 + 16 * mb + lm) = (u2){pkbf(r[0], r[1]), pkbf(r[2], r[3])}; \
        if ((c_) + 2 < 32) RB_LOAD(O_, (c_) + 2);                       \
        RWBAR();                                                      \
        if (isS) { RL unsigned short* sp = (RL unsigned short*)(Sb + lm * SB) + 16 * nb + ln; \
            _Pragma("unroll") for (int q = 0; q < 4; ++q) sp[q * ST] = (unsigned short)(pkbf(r[q], 0.f) & 0xffffu); } \
        RWBAR(); } while (0)
    Ops OA_, OB_;
    RB_LOAD(OA_, 0); RB_LOAD(OB_, 1);
    for (int c = 0; c < 32; c += 2) { RB_STEP(OA_, c); RB_STEP(OB_, c + 1); }
#undef RB_LOAD
#undef RB_STEP
}
}


#define GAS __attribute__((address_space(1)))
#define LAS __attribute__((address_space(3)))
typedef unsigned short bf16;
typedef unsigned v4u __attribute__((ext_vector_type(4)));
typedef float f32x4 __attribute__((ext_vector_type(4)));
typedef short bf16x8 __attribute__((ext_vector_type(8)));
typedef GAS unsigned gu32;
typedef GAS unsigned long long gu64;
#define RLX_AGENT __ATOMIC_RELAXED, __HIP_MEMORY_SCOPE_AGENT
#define LDS_WAIT() asm volatile("s_waitcnt lgkmcnt(0)" ::: "memory")
#define VM_WAIT() asm volatile("s_waitcnt vmcnt(0)" ::: "memory")
__device__ __forceinline__ unsigned long long rt() { return __builtin_amdgcn_s_memrealtime(); }
__device__ __forceinline__ unsigned f2bf(float f) { unsigned u = __builtin_bit_cast(unsigned, f); return (u + 0x7fffu + ((u >> 16) & 1u)) >> 16; }
__device__ __forceinline__ unsigned pk2(float lo, float hi) { return f2bf(lo) | (f2bf(hi) << 16); }

#define XB_TMO      128
#define XB_XCNT(j)  (256  + 64 * (j))
#define XB_XSUB(j)  (1280 + 64 * (j))
#define XB_XGEN(j)  (2304 + 64 * (j))
#define XB_TOP      3328
#define XB_TOPGEN   3392
#define XCD_BAR_WORDS 3456
#define XB_SPIN_CAP (1u << 18)

__device__ __forceinline__ unsigned xb_ld(unsigned* p)              { return __hip_atomic_load(p, __ATOMIC_RELAXED, __HIP_MEMORY_SCOPE_AGENT); }
__device__ __forceinline__ unsigned xb_add(unsigned* p, unsigned v) { return __hip_atomic_fetch_add(p, v, __ATOMIC_RELAXED, __HIP_MEMORY_SCOPE_AGENT); }
__device__ __forceinline__ unsigned xb_xcc_id() { return (unsigned)__builtin_amdgcn_s_getreg((3 << 11) | 20) & 0xFu; }
#define XB_SPIN(cond, bar) do { unsigned _sp = 0; while (cond) { __builtin_amdgcn_s_sleep(1); \
    if ((++_sp & 255u) == 0u) { if (xb_ld(&(bar)[XB_TMO])) break; if (_sp > XB_SPIN_CAP) { atomicAdd(&(bar)[XB_TMO], 1u); break; } } } } while (0)

struct XcdBarrier {
    unsigned* bar; unsigned x;
    volatile LAS unsigned* st;
};

__device__ __forceinline__ XcdBarrier xcd_barrier_post(unsigned* bar, volatile LAS unsigned* st) {
    XcdBarrier b; b.bar = bar; b.x = xb_xcc_id(); b.st = st;
    if (threadIdx.x == 0) (void)xb_add(&bar[XB_XCNT(b.x)], 1u);
    return b;
}
__device__ __forceinline__ void xcd_barrier_complete(unsigned* bar, unsigned x, unsigned& nloc, unsigned& nx) {
    const unsigned G = gridDim.x * gridDim.y * gridDim.z;
    unsigned sum, cnt, mine, sp = 0u;
    for (;;) {
        sum = 0u; cnt = 0u; mine = 0u;
#pragma unroll
        for (unsigned j = 0; j < 16; ++j) { const unsigned c = xb_ld(&bar[XB_XCNT(j)]); sum += c; cnt += (c > 0u) ? 1u : 0u; mine = (j == x) ? c : mine; }
        if (sum == G) break;
        __builtin_amdgcn_s_sleep(1);
        if ((++sp & 255u) == 0u) { if (xb_ld(&bar[XB_TMO])) break; if (sp > XB_SPIN_CAP) { atomicAdd(&bar[XB_TMO], 1u); break; } }
    }
    nloc = mine > 0u ? mine : 1u; nx = cnt > 0u ? cnt : 1u;
}

__device__ __forceinline__ void xcd_barrier(const XcdBarrier& b) {
    asm volatile("s_waitcnt vmcnt(0)" ::: "memory");
    __syncthreads();
    if (threadIdx.x == 0) {
        unsigned* bar = b.bar;
        __builtin_amdgcn_s_waitcnt(0);
        unsigned nloc = b.st[0], nx = b.st[1];
        if (nloc == 0u) { xcd_barrier_complete(bar, b.x, nloc, nx); b.st[0] = nloc; b.st[1] = nx; }
        const unsigned old = xb_add(&bar[XB_XSUB(b.x)], 1u);
        const unsigned gen = old / nloc;
        if (old + 1u == (gen + 1u) * nloc) {
            __builtin_amdgcn_fence(__ATOMIC_RELEASE, "agent");
            asm volatile("s_waitcnt vmcnt(0)" ::: "memory");
            const unsigned og = xb_add(&bar[XB_TOP], 1u);
            const unsigned tg = og / nx;
            if (og + 1u == (tg + 1u) * nx) xb_add(&bar[XB_TOPGEN], 1u);
            else XB_SPIN(xb_ld(&bar[XB_TOPGEN]) == tg, bar);
            __builtin_amdgcn_fence(__ATOMIC_ACQUIRE, "agent");
            xb_add(&bar[XB_XGEN(b.x)], 1u);
            asm volatile("s_waitcnt vmcnt(0)" ::: "memory");
        } else {
            XB_SPIN(xb_ld(&bar[XB_XGEN(b.x)]) == gen, bar);
            __builtin_amdgcn_fence(__ATOMIC_ACQUIRE, "agent");
            asm volatile("s_waitcnt vmcnt(0)" ::: "memory");
        }
    }
    __syncthreads();
}


constexpr int BATCH = 8, SEQ = 2048, DM = 1024, M = BATCH * SEQ;
constexpr int DIN = 3328, DRW = 512, RC = 1792;
constexpr int NEXP = 32, DEXP = 512;
constexpr int NWAVES = 8;
constexpr int RING_OFF = 0, RING_BYTES = 131072;
constexpr int LDSCTL_OFF = RING_BYTES, MISC_OFF = LDSCTL_OFF + 320;
constexpr int LDS_BYTES = 147456;
constexpr size_t MBy = 1000000;
constexpr size_t WS_CTL = 0, CTL_ZERO_BYTES = 1 << 20;
constexpr int CW_TMO = 0, CW_CODE = 1, CW_BAR = 4096;

struct Frame {
    LAS unsigned char* lds;
    volatile LAS unsigned* MISC;
    gu32* ctl;
    int tid, lane, wave;
    int vcu, G;
};

__device__ __forceinline__ float wave_sum(float v) {
#pragma unroll
    for (int o = 1; o < 64; o <<= 1) v += __shfl_xor(v, o);
    return v;
}
__device__ __forceinline__ void p0_transpose_item(const float* W, int K, int N, bf16* WT, int row_off, LAS float* scr, int item, int lane) {
    const int nblk = N / 32, kb = item / nblk, nb = item % nblk, k0 = 64 * kb, n0 = 32 * nb;
#pragma unroll 8
    for (int i = 0; i < 32; ++i) { const int kk = 2 * i + (lane >> 5); scr[kk * 33 + (lane & 31)] = W[(size_t)(k0 + kk) * N + n0 + (lane & 31)]; }
    LDS_WAIT(); asm volatile("" ::: "memory");
    const int c = lane & 7;
#pragma unroll
    for (int j = 0; j < 4; ++j) { const int n = (lane >> 3) + 8 * j; const LAS float* s = scr + (8 * c) * 33 + n;
        v4u o; o.x = pk2(s[0 * 33], s[1 * 33]); o.y = pk2(s[2 * 33], s[3 * 33]); o.z = pk2(s[4 * 33], s[5 * 33]); o.w = pk2(s[6 * 33], s[7 * 33]);
        *(GAS v4u*)(WT + (size_t)(row_off + n0 + n) * K + k0 + 8 * c) = o; }
    LDS_WAIT(); asm volatile("" ::: "memory");
}
__device__ __forceinline__ void rms_row_to_bf16(int lane, const float* xrow, const float* g, bf16* orow, float eps) {
    const GAS f32x4* xr = (const GAS f32x4*)xrow + lane;
    const GAS f32x4* gr = (const GAS f32x4*)g + lane;
    f32x4 v[4]; float s = 0.f;
#pragma unroll
    for (int j = 0; j < 4; ++j) { v[j] = xr[64 * j]; s += (v[j].x * v[j].x + v[j].y * v[j].y) + (v[j].z * v[j].z + v[j].w * v[j].w); }
    const float rstd = 1.f / sqrtf(wave_sum(s) * (1.f / DM) + eps);
    GAS unsigned long long* o8 = (GAS unsigned long long*)orow + lane;
#pragma unroll
    for (int j = 0; j < 4; ++j) { const f32x4 gv = gr[64 * j];
        o8[64 * j] = (unsigned long long)pk2(v[j].x * rstd * gv.x, v[j].y * rstd * gv.y) | ((unsigned long long)pk2(v[j].z * rstd * gv.z, v[j].w * rstd * gv.w) << 32); }
}

__device__ __forceinline__ void rms_rows_pipelined(int lane, const float* x, const float* g, bf16* out, int first, int stride, float eps) {
    const GAS f32x4* gr = (const GAS f32x4*)g + lane;
    const f32x4 g0 = gr[0], g1 = gr[64], g2 = gr[128], g3 = gr[192];
    f32x4 c0, c1, c2, c3;
    if (first < M) { const GAS f32x4* xr = (const GAS f32x4*)(x + (size_t)first * DM) + lane; c0 = xr[0]; c1 = xr[64]; c2 = xr[128]; c3 = xr[192]; }
    for (int m = first; m < M; m += stride) {
        f32x4 n0 = c0, n1 = c1, n2 = c2, n3 = c3;
        if (m + stride < M) { const GAS f32x4* xr = (const GAS f32x4*)(x + (size_t)(m + stride) * DM) + lane; n0 = xr[0]; n1 = xr[64]; n2 = xr[128]; n3 = xr[192]; }
        const float ssq = ((c0.x * c0.x + c0.y * c0.y) + (c0.z * c0.z + c0.w * c0.w)) + ((c1.x * c1.x + c1.y * c1.y) + (c1.z * c1.z + c1.w * c1.w))
                        + ((c2.x * c2.x + c2.y * c2.y) + (c2.z * c2.z + c2.w * c2.w)) + ((c3.x * c3.x + c3.y * c3.y) + (c3.z * c3.z + c3.w * c3.w));
        const float rstd = 1.f / sqrtf(wave_sum(ssq) * (1.f / DM) + eps);
        GAS unsigned long long* o8 = (GAS unsigned long long*)(out + (size_t)m * DM) + lane;
        o8[0]   = (unsigned long long)pk2(c0.x * rstd * g0.x, c0.y * rstd * g0.y) | ((unsigned long long)pk2(c0.z * rstd * g0.z, c0.w * rstd * g0.w) << 32);
        o8[64]  = (unsigned long long)pk2(c1.x * rstd * g1.x, c1.y * rstd * g1.y) | ((unsigned long long)pk2(c1.z * rstd * g1.z, c1.w * rstd * g1.w) << 32);
        o8[128] = (unsigned long long)pk2(c2.x * rstd * g2.x, c2.y * rstd * g2.y) | ((unsigned long long)pk2(c2.z * rstd * g2.z, c2.w * rstd * g2.w) << 32);
        o8[192] = (unsigned long long)pk2(c3.x * rstd * g3.x, c3.y * rstd * g3.y) | ((unsigned long long)pk2(c3.z * rstd * g3.z, c3.w * rstd * g3.w) << 32);
        c0 = n0; c1 = n1; c2 = n2; c3 = n3;
    }
}
struct Args { const float* in[30]; float* out; unsigned char* ws; int ph_lo, ph_hi; };
constexpr size_t WS_U = 2 * MBy;
constexpr size_t DO_XN = 0, DO_WIN = 34 * MBy;
constexpr size_t DO_O = 0;
constexpr size_t DO_Y = 33554432, DO_BT = 50331648;
constexpr size_t WS_E = 112 * MBy;
constexpr size_t WS_LA = 163 * MBy;
constexpr size_t WS_WL = 172 * MBy;
constexpr size_t WS_WOUT = 163 * MBy;
constexpr size_t WS_MIX = 2 * MBy;
constexpr size_t WS_T = WS_MIX;
constexpr size_t WS_WGU = 173 * MBy;
constexpr size_t WS_WD = 241 * MBy;
constexpr size_t WS_ACT = 120 * MBy;
constexpr size_t WS_XS = 36 * MBy;
constexpr size_t WS_YB = 36 * MBy;
constexpr size_t WS_ROWSLOT = 275 * MBy;
constexpr size_t WS_ROWGATE = WS_ROWSLOT + 40960 * 4;
constexpr size_t WS_SLOT_E = WS_ROWGATE + 40960 * 4;
constexpr size_t WS_SLOT_P = WS_SLOT_E + 32768 * 4;
constexpr size_t WS_SLOT_G = WS_SLOT_P + 32768 * 4;
constexpr size_t WS_WRP = 65536;
constexpr size_t WS_ROWTOK = WS_SLOT_G + 32768 * 4;
constexpr size_t WS_LISTS = 277 * MBy;
constexpr size_t WS_END = WS_LISTS + 32 * 16384 * 4;
constexpr size_t WS_GH = 241 * MBy;
constexpr size_t WS_Q1 = (size_t)162500000;
constexpr size_t WS_Q2 = (size_t)274600000;
constexpr size_t WS_TOTAL = 274600000 + 8388608;
static_assert(WS_END <= WS_TOTAL && WS_GH + 33554432 <= WS_Q2 && WS_Q1 + 8388608 <= 172 * MBy, "ws map");
constexpr int CW_DBG = 10240;
constexpr int CW_AQ = 8192;
constexpr int CW_CNT = 2048;
constexpr int TILE_E_OFF = LDSCTL_OFF + 1024;
constexpr size_t WS_ROPE = 512 * 1024;
constexpr float QSCALE = 0.125f * 1.4426950408889634f;

__device__ __forceinline__ unsigned long long ldarg(int byte_off) {
    const __attribute__((address_space(4))) unsigned char* kp = (const __attribute__((address_space(4))) unsigned char*)__builtin_amdgcn_kernarg_segment_ptr();
    return *(const volatile __attribute__((address_space(4))) unsigned long long*)(kp + byte_off);
}
#define ARG_IN(i) ((const float*)(const GAS float*)ldarg(8 * (i)))
#define ARG_OUT ((unsigned char*)(GAS unsigned char*)ldarg(240))
#define ARG_WS ((unsigned char*)(GAS unsigned char*)ldarg(248))
static_assert(sizeof(Args) == 264, "Args layout vs ldarg offsets");
__global__ void __launch_bounds__(NWAVES * 64, 2) skel_fwd(Args args) {
    extern __shared__ __attribute__((aligned(16))) unsigned char lds[];
    Frame F;
    F.lds = (LAS unsigned char*)lds;
    F.MISC = (volatile LAS unsigned*)(F.lds + MISC_OFF);
    F.tid = threadIdx.x; F.lane = F.tid & 63; F.wave = __builtin_amdgcn_readfirstlane(F.tid >> 6);
    F.G = gridDim.x; { const int bx = blockIdx.x; F.vcu = (F.G % 8 == 0) ? (bx % 8) * (F.G / 8) + bx / 8 : bx; }
    F.ctl = (gu32*)(ARG_WS + WS_CTL);
    for (int u = F.tid; u < (LDS_BYTES - LDSCTL_OFF) / 4; u += NWAVES * 64) ((LAS unsigned*)(F.lds + LDSCTL_OFF))[u] = 0u;
    __syncthreads();
    XcdBarrier bar = xcd_barrier_post((unsigned*)(F.ctl + CW_BAR), F.MISC + 8);
    const int lo = args.ph_lo, hi = args.ph_hi;
#ifndef PROBE_K
#define PROBE_K (-1)
#endif
#ifndef RWKV_DBG
#define RWKV_DBG 0
#endif
#ifndef RW_STAGE
#define RW_STAGE 0
#endif
    constexpr int CW_TS = 9216;
#define STAMP(k) do { if (PROBE_K >= 0 && blockIdx.x == 0 && F.tid == 0) ((GAS unsigned long long*)(F.ctl + CW_TS))[k] = rt(); } while (0)
    STAMP(0);
#define P_U ((bf16*)(ARG_WS + WS_U))
#define IN(k) (lo <= (k) && (k) < hi)
#define BOTH(k) (IN(k) && IN((k) + 1))
    if (IN(0)) {
        unsigned char* ws = ARG_WS; unsigned char* dout = ARG_OUT;
        const float* x = ARG_IN(0); const float* ln1_g = ARG_IN(1); const float* w_in = ARG_IN(2);
        bf16* XN = (bf16*)(dout + DO_XN); bf16* Wt_in = (bf16*)(dout + DO_WIN); float2* rope = (float2*)(ws + WS_ROPE);
        bf16* WL = (bf16*)(ws + WS_WL);
        LAS float* scr = (LAS float*)(F.lds + RING_OFF + F.wave * 16384);
        const int gw = F.vcu * NWAVES + F.wave, NGW = F.G * NWAVES;
        constexpr int I_IN = (DM / 64) * (DIN / 32);
        for (int it = gw; it < I_IN; it += NGW) p0_transpose_item(w_in, DM, DIN, Wt_in, 0, scr, it, F.lane);
        rms_rows_pipelined(F.lane, x, ln1_g, XN, gw, NGW, 1e-6f);
        {   const float* wup = ARG_IN(12); const float* aup = ARG_IN(14); const float* gup = ARG_IN(15);
            for (int idx = gw * 64 + F.lane; idx < 1536 * 256; idx += NGW * 64) {
                const int n = idx >> 8, j = idx & 255; float v = 0.f;
                if (n < 512) { if (j < 64) v = wup[j * 512 + n]; }
                else if (n < 1024) { if (j >= 64 && j < 128) v = aup[(j - 64) * 512 + (n - 512)]; }
                else { if (j >= 128) v = gup[(j - 128) * 512 + (n - 1024)]; }
                WL[idx] = (bf16)f2bf(v);
            }
        }
        {   const float* g2 = ARG_IN(22); const float* wrg = ARG_IN(23); const float* wre = ARG_IN(25); float* WRP = (float*)(ws + WS_WRP);
            for (int idx = gw * 64 + F.lane; idx < 64 * 3 * 64 * 4; idx += NGW * 64) {
                const int i = idx & 3, l = (idx >> 2) & 63, nt = (idx >> 8) % 3, sgrp = idx / 768;
                const int k = 16 * sgrp + 4 * (l >> 4) + i, n = nt * 16 + (l & 15);
                float v = 0.f; if (n < 32) v = wre[k * 32 + n]; else if (n < 36) v = wrg[k * 4 + (n - 32)];
                WRP[idx] = v * g2[k];
            }
        }
        for (int idx = gw * 64 + F.lane; idx < SEQ * 8; idx += NGW * 64) {
            const int pos = idx >> 3, j = idx & 7;
            const double invrev = j == 0 ? 0.15915494309189535 : j == 1 ? 0.03086376340470123 : j == 2 ? 0.005985185712713705 : j == 3 ? 0.001160663641240061 :
                                  j == 4 ? 0.00022507907903927653 : j == 5 ? 4.364795279280289e-05 : j == 6 ? 8.464330808241401e-06 : 1.6414262627950345e-06;
            const double tr = (double)pos * invrev; const float fr = (float)(tr - floor(tr));
            rope[idx] = make_float2(__builtin_amdgcn_cosf(fr), __builtin_amdgcn_sinf(fr));
        }
        if (BOTH(0)) xcd_barrier(bar); STAMP(1);
    }
    if (IN(1)) {
        unsigned char* dout = ARG_OUT; bf16* XN = (bf16*)(dout + DO_XN); bf16* Wt_in = (bf16*)(dout + DO_WIN); bf16* U = P_U;
        pg8::Gemm g{XN, Wt_in, M, DIN, DM}; pg8::G1Order S; S.init(M, DIN - 256, F.G, (int)blockIdx.x);
        pg8::EpiBf16<0> E{U, DIN, nullptr, 0, 0, 1.f};
        pg8::gemm_phase<pg8::EpiBf16<0>, pg8::G1Order, PG8_ALIGN, PG8_SP2>(F.lds + RING_OFF, g, S, E);
        if (BOTH(1)) xcd_barrier(bar); STAMP(2);
    }
    if (IN(2)) {
        unsigned char* ws = ARG_WS; bf16* U = P_U; const float* qg = ARG_IN(3); const float* kg = ARG_IN(4); const float* mu = ARG_IN(10);
        const float2* rope = (const float2*)(ws + WS_ROPE); bf16* LA = (bf16*)(ws + WS_LA);
        const int gw = F.vcu * NWAVES + F.wave, NGW = F.G * NWAVES;
        const int lane = F.lane;
        for (int t = gw; t < M; t += NGW) {
            const int pos = t & (SEQ - 1);
            GAS v4u* rowp = (GAS v4u*)(U + (size_t)t * DIN + lane * 16);
            const v4u wa = rowp[0], wb = rowp[1];
            float v[16];
            v[0] = __uint_as_float(wa.x << 16); v[1] = __uint_as_float(wa.x & 0xffff0000u); v[2] = __uint_as_float(wa.y << 16); v[3] = __uint_as_float(wa.y & 0xffff0000u);
            v[4] = __uint_as_float(wa.z << 16); v[5] = __uint_as_float(wa.z & 0xffff0000u); v[6] = __uint_as_float(wa.w << 16); v[7] = __uint_as_float(wa.w & 0xffff0000u);
            v[8] = __uint_as_float(wb.x << 16); v[9] = __uint_as_float(wb.x & 0xffff0000u); v[10] = __uint_as_float(wb.y << 16); v[11] = __uint_as_float(wb.y & 0xffff0000u);
            v[12] = __uint_as_float(wb.z << 16); v[13] = __uint_as_float(wb.z & 0xffff0000u); v[14] = __uint_as_float(wb.w << 16); v[15] = __uint_as_float(wb.w & 0xffff0000u);
            float ss = 0.f;
#pragma unroll
            for (int i = 0; i < 16; ++i) ss += v[i] * v[i];
            ss += __shfl_xor(ss, 1); ss += __shfl_xor(ss, 2);
            const float rstd = 1.0f / sqrtf(ss * (1.0f / 64.0f) + 1e-6f);
            const float* gp = (lane < 32 ? qg : kg) + (lane & 3) * 16;
#pragma unroll
            for (int i = 0; i < 16; ++i) v[i] *= rstd * gp[i];
            if ((lane & 3) == 0) {
#pragma unroll
                for (int j = 0; j < 8; ++j) { const float2 cs = rope[pos * 8 + j]; const float x1 = v[j], x2 = v[j + 8]; v[j] = x1 * cs.x - x2 * cs.y; v[j + 8] = x2 * cs.x + x1 * cs.y; }
            }
            if (lane < 32) {
#pragma unroll
                for (int i = 0; i < 16; ++i) v[i] *= QSCALE;
            }
            v4u oa, ob;
            oa.x = pk2(v[0], v[1]); oa.y = pk2(v[2], v[3]); oa.z = pk2(v[4], v[5]); oa.w = pk2(v[6], v[7]);
            ob.x = pk2(v[8], v[9]); ob.y = pk2(v[10], v[11]); ob.z = pk2(v[12], v[13]); ob.w = pk2(v[14], v[15]);
            rowp[0] = oa; rowp[1] = ob;
            {   typedef unsigned u32x2v __attribute__((ext_vector_type(2)));
                const GAS u32x2v* lp = (const GAS u32x2v*)(U + (size_t)t * DIN + 3072 + lane * 4);
                const u32x2v cw = lp[0]; u32x2v pw = cw; if (pos > 0) pw = *(const GAS u32x2v*)(U + (size_t)(t - 1) * DIN + 3072 + lane * 4);
                const f32x4 m4 = *(const GAS f32x4*)(mu + 1536 + lane * 4);
                float c4[4] = {__uint_as_float(cw.x << 16), __uint_as_float(cw.x & 0xffff0000u), __uint_as_float(cw.y << 16), __uint_as_float(cw.y & 0xffff0000u)};
                float p4[4] = {__uint_as_float(pw.x << 16), __uint_as_float(pw.x & 0xffff0000u), __uint_as_float(pw.y << 16), __uint_as_float(pw.y & 0xffff0000u)};
                if (pos == 0) { p4[0] = 0.f; p4[1] = 0.f; p4[2] = 0.f; p4[3] = 0.f; }
                float o4[4];
#pragma unroll
                for (int i = 0; i < 4; ++i) { const float xs = c4[i] + (p4[i] - c4[i]) * m4[i];
                    float r = xs;
                    if (lane < 16) { const float e2 = __expf(-2.0f * fabsf(xs)); const float th = (1.0f - e2) / (1.0f + e2); r = xs < 0.f ? -th : th; }
                    else if (lane >= 32) r = 1.0f / (1.0f + __expf(-xs));
                    o4[i] = r; }
                u32x2v ow; ow.x = pk2(o4[0], o4[1]); ow.y = pk2(o4[2], o4[3]);
                *(GAS u32x2v*)(LA + (size_t)t * 256 + lane * 4) = ow;
            }
        }
        if (BOTH(2)) xcd_barrier(bar); STAMP(3);
    }
    if (IN(3)) {
        unsigned char* ws = ARG_WS; bf16* LA = (bf16*)(ws + WS_LA); bf16* WL = (bf16*)(ws + WS_WL); bf16* EB = (bf16*)(ws + WS_E);
        {
            unsigned char* dout = ARG_OUT; const bool big = F.vcu < 64;
            pg8::Gemm g{big ? (const bf16*)(dout + DO_XN) : (const bf16*)LA, big ? (const bf16*)(dout + DO_WIN) : (const bf16*)WL, M, big ? DIN : 1536, big ? DM : 256}; pg8::P3Order S{F.vcu};
            pg8::EpiBf16<0> E{big ? P_U : EB, big ? DIN : 1536, nullptr, 0, 0, 1.f};
            pg8::gemm_phase<pg8::EpiBf16<0>, pg8::P3Order, PG8_ALIGN, PG8_SP2>(F.lds + RING_OFF, g, S, E);
        }
        if (BOTH(3)) xcd_barrier(bar); STAMP(4);
    }
    if (IN(4)) {
        static_assert(attn_body::ATTN_LDS_BYTES <= RING_BYTES && rwkv_body::RWKV_LDS_BYTES <= RING_BYTES, "phase body LDS vs frame");
        {
            unsigned char* ws = ARG_WS; unsigned char* dout = ARG_OUT;
            const rwkv_body::Args RA{(unsigned long long*)(F.ctl + 9216), P_U, (bf16*)(ws + WS_E), RWKV_DBG ? (bf16*)(ws + WS_WGU) : (bf16*)(dout + DO_Y), RWKV_DBG ? (bf16*)(ws + WS_WGU + 16777216) : (bf16*)(dout + DO_BT), ws + WS_GH, ws + WS_Q1, ws + WS_Q2, ARG_IN(10), ARG_IN(16), ARG_IN(17), ARG_IN(18), ARG_IN(11), ARG_IN(13)};
            if (F.vcu < 256) {
                const int hd = F.vcu >> 2;
                rwkv_body::chunk_consts_to_lds((LAS char*)(F.lds + RING_OFF), RA, hd & 7); __syncthreads();
                rwkv_body::ChunkLoads LA_, LB_; const int c0 = (F.vcu & 3) * 8;
                rwkv_body::chunk_load(LA_, RA, hd >> 3, hd & 7, c0);
#pragma unroll 1
                for (int j = 0; j < 8; j += 2) {
                    const int gwv = F.vcu * NWAVES + F.wave; const float* jWg = ARG_IN(27); const float* jWu = ARG_IN(28); bf16* jWGU = (bf16*)(ws + WS_WGU);
                    rwkv_body::rwkv_chunk_task((LAS char*)(F.lds + RING_OFF), RA, LA_, LB_, true, hd >> 3, hd & 7, c0 + j, c0 + j + 1, jWg, jWu, jWGU, RWKV_DBG ? -1 : j * 2048 + gwv);
                    rwkv_body::rwkv_chunk_task((LAS char*)(F.lds + RING_OFF), RA, LB_, LA_, j + 2 < 8, hd >> 3, hd & 7, c0 + j + 1, c0 + j + 2, jWg, jWu, jWGU, RWKV_DBG ? -1 : (j + 1) * 2048 + gwv);
                }
            }
            xcd_barrier(bar); STAMP(13);
            if (RWKV_DBG != 3 && F.vcu < 256) { const int hd = F.vcu >> 2; rwkv_body::rwkv_seq_head((LAS char*)(F.lds + RING_OFF), RA, hd >> 3, hd & 7, F.vcu & 3); }
            STAMP(16);
        }
        if (RWKV_DBG && (F.vcu & 1) == 0 && F.vcu < 256) {
            unsigned char* ws = ARG_WS; unsigned char* dout = ARG_OUT; const int un = F.vcu >> 1;
            const scan_body::ScanArgs SA{P_U, (bf16*)(ws + WS_E), (bf16*)(dout + DO_Y), (bf16*)(dout + DO_BT), ARG_IN(10), ARG_IN(16), ARG_IN(17), ARG_IN(18), ARG_IN(11), ARG_IN(13)};
            scan_body::scan_unit((LAS float*)(F.lds + RING_OFF), SA, un >> 4, (un >> 1) & 7, un & 1);
        }
        {
        bf16* U = P_U; bf16* OA = (bf16*)(ARG_OUT + DO_O);
        const attn_body::AttnTensors AT{(const attn_body::bf16*)U, (attn_body::bf16*)OA};
        if (RWKV_DBG) attn_body::attn_phase_dyn<8>((char*)lds + RING_OFF, AT, (unsigned*)(F.ctl + CW_AQ), F.MISC, (int)(bar.x & 7u));
        else attn_body::attn_phase_static((char*)lds + RING_OFF, AT, F.vcu);
        }
        if (0) {
            unsigned char* ws = ARG_WS; const int lane = F.lane;
            const int gw = ((F.vcu >> 2) * 3 + (F.vcu & 3) - 1) * NWAVES + F.wave, NGW = (F.G >> 2) * 3 * NWAVES;
            LAS float* scr = (LAS float*)(F.lds + RING_OFF + F.wave * 16384);
            const float* Wg = ARG_IN(27); const float* Wu = ARG_IN(28);
            bf16* WGU = (bf16*)(ws + WS_WGU);
            for (int it = gw; it < 16384; it += NGW) { const int e = it >> 9, mat = (it >> 8) & 1, item = it & 255; const int n0 = 32 * (item & 15);
                p0_transpose_item((mat ? Wu : Wg) + (size_t)e * DM * DEXP, DM, DEXP, WGU, e * 1024 + (n0 >> 7) * 256 + (n0 & 127) - n0 + mat * 128, scr, item, lane); }
        }
        if (BOTH(4)) xcd_barrier(bar); STAMP(5);
    }
    if (IN(5)) {
        unsigned char* ws = ARG_WS; unsigned char* dout = ARG_OUT;
        const bf16* OA = (const bf16*)(dout + DO_O); const bf16* YB = (const bf16*)(dout + DO_Y); const bf16* BT = (const bf16*)(dout + DO_BT);
        const bf16* EB = (const bf16*)(ws + WS_E); bf16* MIX = (bf16*)(ws + WS_MIX);
        const int gw = F.vcu * NWAVES + F.wave, NGW = F.G * NWAVES; const int lane = F.lane;
        const float lam = __expf(wave_sum(ARG_IN(5)[lane] * ARG_IN(6)[lane])) - __expf(wave_sum(ARG_IN(7)[lane] * ARG_IN(8)[lane])) + 0.2f;
        const float* subg = ARG_IN(9); const float* lng = ARG_IN(19); const float* lnb = ARG_IN(20);
        const f32x4 sgA = *(const GAS f32x4*)(subg + 8 * (lane & 15)), sgB = *(const GAS f32x4*)(subg + 8 * (lane & 15) + 4);
        const f32x4 lgA = *(const GAS f32x4*)(lng + 8 * lane), lgB = *(const GAS f32x4*)(lng + 8 * lane + 4), lbA = *(const GAS f32x4*)(lnb + 8 * lane), lbB = *(const GAS f32x4*)(lnb + 8 * lane + 4);
#define UNPK8(W_, F_) do { F_[0] = __uint_as_float(W_[0] << 16); F_[1] = __uint_as_float(W_[0] & 0xffff0000u); F_[2] = __uint_as_float(W_[1] << 16); F_[3] = __uint_as_float(W_[1] & 0xffff0000u); \
                           F_[4] = __uint_as_float(W_[2] << 16); F_[5] = __uint_as_float(W_[2] & 0xffff0000u); F_[6] = __uint_as_float(W_[3] << 16); F_[7] = __uint_as_float(W_[3] & 0xffff0000u); } while (0)
        float dbg_d = 0.f, dbg_r = 0.f;
        for (int t = gw; t < M; t += NGW) {
            const int h = lane >> 4, e0 = 8 * (lane & 15);
            const v4u w0 = *(const GAS v4u*)(OA + (size_t)t * 1024 + h * 256 + e0), w1 = *(const GAS v4u*)(OA + (size_t)t * 1024 + h * 256 + 128 + e0);
            const v4u wy = *(const GAS v4u*)(YB + (size_t)t * 512 + 8 * lane), wb = *(const GAS v4u*)(BT + (size_t)t * 512 + 8 * lane), wg = *(const GAS v4u*)(EB + (size_t)t * 1536 + 1024 + 8 * lane);
            float o0[8], o1[8], o[8];
            UNPK8(w0, o0); UNPK8(w1, o1);
            float ss = 0.f;
#pragma unroll
            for (int i = 0; i < 8; ++i) { o[i] = o0[i] - lam * o1[i]; ss += o[i] * o[i]; }
            ss = scan_body::reduce16(ss);
            const float rs = 0.8f / sqrtf(ss * (1.0f / 128.0f) + 1e-5f);
            v4u mo; mo.x = pk2(o[0] * rs * sgA.x, o[1] * rs * sgA.y); mo.y = pk2(o[2] * rs * sgA.z, o[3] * rs * sgA.w); mo.z = pk2(o[4] * rs * sgB.x, o[5] * rs * sgB.y); mo.w = pk2(o[6] * rs * sgB.z, o[7] * rs * sgB.w);
            *(GAS v4u*)(MIX + (size_t)t * DM + h * 128 + e0) = mo;
            float y[8], bt[8], gt[8];
            UNPK8(wy, y); UNPK8(wb, bt); UNPK8(wg, gt);
            float sm = ((y[0] + y[1]) + (y[2] + y[3])) + ((y[4] + y[5]) + (y[6] + y[7]));
            sm = scan_body::dpp_add<0xB1>(sm); sm = scan_body::dpp_add<0x4E>(sm); sm = scan_body::dpp_add<0x141>(sm);
            const float mean = sm * (1.0f / 64.0f);
            float sq = 0.f;
#pragma unroll
            for (int i = 0; i < 8; ++i) { y[i] -= mean; sq += y[i] * y[i]; }
            sq = scan_body::dpp_add<0xB1>(sq); sq = scan_body::dpp_add<0x4E>(sq); sq = scan_body::dpp_add<0x141>(sq);
            const float rv = 1.0f / sqrtf(sq * (1.0f / 64.0f) + 64e-5f);
            const float lg8[8] = {lgA.x, lgA.y, lgA.z, lgA.w, lgB.x, lgB.y, lgB.z, lgB.w}, lb8[8] = {lbA.x, lbA.y, lbA.z, lbA.w, lbB.x, lbB.y, lbB.z, lbB.w};
            float r8[8];
#pragma unroll
            for (int i = 0; i < 8; ++i) r8[i] = (y[i] * rv * lg8[i] + lb8[i] + bt[i]) * gt[i];
            v4u ro; ro.x = pk2(r8[0], r8[1]); ro.y = pk2(r8[2], r8[3]); ro.z = pk2(r8[4], r8[5]); ro.w = pk2(r8[6], r8[7]);
            *(GAS v4u*)(MIX + (size_t)t * DM + 512 + 8 * lane) = ro;
            if (RWKV_DBG) {
                const bf16* S2 = (const bf16*)(ws + WS_WGU) + (RWKV_DBG == 2 ? 8388608 : 0); const bool dsel = (RWKV_DBG < 3) || ((t & 2047) < 64);
                const v4u w2 = *(const GAS v4u*)(S2 + (size_t)t * 512 + 8 * lane); const v4u w1_ = (RWKV_DBG == 2) ? wb : wy;
                float a2[8], a1[8]; UNPK8(w2, a2); UNPK8(w1_, a1);
                float dd = 0.f, rr = 0.f;
#pragma unroll
                for (int i = 0; i < 8; ++i) { const float df = a2[i] - a1[i]; dd += (df == df && fabsf(df) < 1e30f) ? df * df : 1e30f; rr += a1[i] * a1[i]; }
                if (dsel) { dbg_d += dd; dbg_r += rr; }
            }
        }
        if (RWKV_DBG) { dbg_d = wave_sum(dbg_d); dbg_r = wave_sum(dbg_r);
            if (lane == 0) { atomicAdd((float*)(F.ctl + CW_DBG), dbg_d); atomicAdd((float*)(F.ctl + CW_DBG + 1), dbg_r); } }
#undef UNPK8
        {
            LAS float* scr = (LAS float*)(F.lds + RING_OFF + F.wave * 16384);
            if (RWKV_DBG) { const float* Wg = ARG_IN(27); const float* Wu = ARG_IN(28); bf16* WGU = (bf16*)(ws + WS_WGU);
                __syncthreads();
                for (int it = gw; it < 16384; it += NGW) { const int e = it >> 9, mat = (it >> 8) & 1, item = it & 255; const int n0 = 32 * (item & 15);
                    p0_transpose_item((mat ? Wu : Wg) + (size_t)e * DM * DEXP, DM, DEXP, WGU, e * 1024 + (n0 >> 7) * 256 + (n0 & 127) - n0 + mat * 128, scr, item, lane); } }
            const float* w_out = ARG_IN(21); bf16* Wt_out = (bf16*)(ws + WS_WOUT);
            for (int it = gw; it < (DM / 64) * (DM / 32); it += NGW) p0_transpose_item(w_out, DM, DM, Wt_out, 0, scr, it, lane);
        }
        if (BOTH(5)) xcd_barrier(bar); STAMP(6);
    }
    if (IN(6)) {
        unsigned char* ws = ARG_WS;
        pg8::Gemm g{(const bf16*)(ws + WS_MIX), (const bf16*)(ws + WS_WOUT), M, DM, DM}; pg8::StaticOrder S; S.init(M, DM, F.G, (int)blockIdx.x);
        pg8::EpiResF32 E{ARG_IN(0), (float*)ARG_OUT, DM};
        pg8::gemm_phase<pg8::EpiResF32, pg8::StaticOrder, false, PG8_SP2>(F.lds + RING_OFF, g, S, E);
        if (BOTH(6)) xcd_barrier(bar); STAMP(7);
    }
    if (IN(7)) {
        unsigned char* ws = ARG_WS; const float* hbuf = (const float*)ARG_OUT; const int lane = F.lane;
        const int gw = F.vcu * NWAVES + F.wave, NGW = F.G * NWAVES;
        {   const float* g2 = ARG_IN(22); bf16* T = (bf16*)(ws + WS_T);
            rms_rows_pipelined(lane, hbuf, g2, T, gw, NGW, 1e-6f); }
        STAMP(14);
        {   const float* brg = ARG_IN(24); const float* bre = ARG_IN(26); const GAS f32x4* WRP0 = (const GAS f32x4*)(ws + WS_WRP);
            int* lists = (int*)(ws + WS_LISTS); float* slot_g = (float*)(ws + WS_SLOT_G);
            unsigned* cnt = (unsigned*)(F.ctl + CW_CNT);
            const int r = lane & 15, kq = lane >> 4;
            const int khalf = F.wave >> 2;
            for (int task = (F.wave & 3) * F.G + F.vcu; task < M / 16; task += 4 * F.G) {
                const int tok0 = task * 16;
                const GAS f32x4* arow = (const GAS f32x4*)(hbuf + (size_t)(tok0 + r) * DM) + kq + khalf * 128;
                const GAS f32x4* WRP = WRP0 + khalf * (32 * 3 * 64);
                f32x4 acc0 = {0.f, 0.f, 0.f, 0.f}, acc1 = acc0, acc2 = acc0; float ssq = 0.f;
                f32x4 ca0, ca1, ca2, ca3, cb0, cb1, cb2, cb3, cb4, cb5, cb6, cb7, cb8, cb9, cb10, cb11;
                f32x4 na0, na1, na2, na3, nb0, nb1, nb2, nb3, nb4, nb5, nb6, nb7, nb8, nb9, nb10, nb11;
#define RT_LD1(A_, B0_, B1_, B2_, sg_) do { A_ = arow[4 * (sg_)]; B0_ = WRP[((sg_) * 3 + 0) * 64 + lane]; B1_ = WRP[((sg_) * 3 + 1) * 64 + lane]; B2_ = WRP[((sg_) * 3 + 2) * 64 + lane]; } while (0)
#define RT_MM1(A_, B0_, B1_, B2_) do { ssq += (A_.x * A_.x + A_.y * A_.y) + (A_.z * A_.z + A_.w * A_.w); \
        acc0 = __builtin_amdgcn_mfma_f32_16x16x4f32(A_.x, B0_.x, acc0, 0, 0, 0); acc1 = __builtin_amdgcn_mfma_f32_16x16x4f32(A_.x, B1_.x, acc1, 0, 0, 0); acc2 = __builtin_amdgcn_mfma_f32_16x16x4f32(A_.x, B2_.x, acc2, 0, 0, 0); \
        acc0 = __builtin_amdgcn_mfma_f32_16x16x4f32(A_.y, B0_.y, acc0, 0, 0, 0); acc1 = __builtin_amdgcn_mfma_f32_16x16x4f32(A_.y, B1_.y, acc1, 0, 0, 0); acc2 = __builtin_amdgcn_mfma_f32_16x16x4f32(A_.y, B2_.y, acc2, 0, 0, 0); \
        acc0 = __builtin_amdgcn_mfma_f32_16x16x4f32(A_.z, B0_.z, acc0, 0, 0, 0); acc1 = __builtin_amdgcn_mfma_f32_16x16x4f32(A_.z, B1_.z, acc1, 0, 0, 0); acc2 = __builtin_amdgcn_mfma_f32_16x16x4f32(A_.z, B2_.z, acc2, 0, 0, 0); \
        acc0 = __builtin_amdgcn_mfma_f32_16x16x4f32(A_.w, B0_.w, acc0, 0, 0, 0); acc1 = __builtin_amdgcn_mfma_f32_16x16x4f32(A_.w, B1_.w, acc1, 0, 0, 0); acc2 = __builtin_amdgcn_mfma_f32_16x16x4f32(A_.w, B2_.w, acc2, 0, 0, 0); } while (0)
                RT_LD1(ca0, cb0, cb1, cb2, 0); RT_LD1(ca1, cb3, cb4, cb5, 1); RT_LD1(ca2, cb6, cb7, cb8, 2); RT_LD1(ca3, cb9, cb10, cb11, 3);
                for (int g = 0; g < 8; ++g) {
                    const int gn = (g + 1 < 8) ? g + 1 : g;
                    RT_LD1(na0, nb0, nb1, nb2, gn * 4); RT_LD1(na1, nb3, nb4, nb5, gn * 4 + 1); RT_LD1(na2, nb6, nb7, nb8, gn * 4 + 2); RT_LD1(na3, nb9, nb10, nb11, gn * 4 + 3);
                    __builtin_amdgcn_sched_barrier(0);
                    RT_MM1(ca0, cb0, cb1, cb2); RT_MM1(ca1, cb3, cb4, cb5); RT_MM1(ca2, cb6, cb7, cb8); RT_MM1(ca3, cb9, cb10, cb11);
                    __builtin_amdgcn_sched_barrier(0);
                    ca0 = na0; ca1 = na1; ca2 = na2; ca3 = na3; cb0 = nb0; cb1 = nb1; cb2 = nb2; cb3 = nb3; cb4 = nb4; cb5 = nb5; cb6 = nb6; cb7 = nb7; cb8 = nb8; cb9 = nb9; cb10 = nb10; cb11 = nb11;
                }
#undef RT_LD1
#undef RT_MM1
                ssq += __shfl_xor(ssq, 16); ssq += __shfl_xor(ssq, 32);
                LAS float* LGT = (LAS float*)(F.lds + RING_OFF + (F.wave & 3) * 8192);
                LAS float* LGh = LGT + khalf * 768;
#pragma unroll
                for (int q = 0; q < 4; ++q) { const int row = 4 * kq + q; LGh[row * 48 + r] = acc0[q]; LGh[row * 48 + 16 + r] = acc1[q]; LGh[row * 48 + 32 + r] = acc2[q]; }
                if (lane < 16) LGT[1536 + khalf * 16 + lane] = ssq;
                LAS unsigned* hist = (LAS unsigned*)(F.lds + RING_OFF + 32768); LAS unsigned* hbase = hist + 32;
                if (F.tid < 32) hist[F.tid] = 0u;
                __syncthreads();
                int ea = 0, eb = 0; unsigned la = 0u, lb = 0u; float ga = 0.f, gb = 0.f;
                if (khalf == 0 && lane < 16) {
                    const LAS float* lg = LGT + lane * 48; const LAS float* lh = LGT + 768 + lane * 48;
                    const float rs = 1.f / sqrtf((LGT[1536 + lane] + LGT[1552 + lane]) * (1.f / DM) + 1e-6f);
                    const float lg0 = (lg[32] + lh[32]) * rs + brg[0], lg1 = (lg[33] + lh[33]) * rs + brg[1], lg2 = (lg[34] + lh[34]) * rs + brg[2], lg3 = (lg[35] + lh[35]) * rs + brg[3];
                    int gs = 0; float gm = lg0;
                    if (lg1 > gm) { gm = lg1; gs = 1; }
                    if (lg2 > gm) { gm = lg2; gs = 2; }
                    if (lg3 > gm) { gm = lg3; gs = 3; }
                    const float pgroup = 1.0f / (expf(lg0 - gm) + expf(lg1 - gm) + expf(lg2 - gm) + expf(lg3 - gm));
                    int i1 = 0, i2 = -1; float v1 = -3.0e38f, v2 = -3.0e38f;
                    for (int q = 0; q < 8; ++q) { const float x = (lg[gs * 8 + q] + lh[gs * 8 + q]) * rs + bre[gs * 8 + q];
                        if (x > v1) { v2 = v1; i2 = i1; v1 = x; i1 = q; } else if (x > v2) { v2 = x; i2 = q; } }
                    if (i2 < 0 || i2 == i1) i2 = (i1 + 1) & 7;
                    const float e2 = expf(v2 - v1);
                    ea = gs * 8 + i1; eb = gs * 8 + i2; ga = pgroup / (1.0f + e2); gb = pgroup * e2 / (1.0f + e2);
                    la = __hip_atomic_fetch_add(hist + ea, 1u, __ATOMIC_RELAXED, __HIP_MEMORY_SCOPE_WORKGROUP);
                    lb = __hip_atomic_fetch_add(hist + eb, 1u, __ATOMIC_RELAXED, __HIP_MEMORY_SCOPE_WORKGROUP);
                }
                __syncthreads();
                if (F.tid < 32) { const unsigned n = hist[F.tid]; hbase[F.tid] = n ? __hip_atomic_fetch_add(cnt + 64 * F.tid, n, __ATOMIC_RELAXED, __HIP_MEMORY_SCOPE_AGENT) : 0u; }
                __syncthreads();
                if (khalf == 0 && lane < 16) {
                    const int tok = tok0 + lane;
                    lists[ea * 16384 + (int)(hbase[ea] + la)] = tok * 2; slot_g[tok * 2] = ga;
                    lists[eb * 16384 + (int)(hbase[eb] + lb)] = tok * 2 + 1; slot_g[tok * 2 + 1] = gb;
                }
                __syncthreads();
            }
        }
        STAMP(15);
        if (BOTH(7)) xcd_barrier(bar); STAMP(8);
    }
    if (IN(8)) { STAMP(9); }
    if (IN(9) || IN(10)) {
        LAS int* tile_e = (LAS int*)(F.lds + TILE_E_OFF);
        int ntiles;
        {   const int lane = F.lane;
            const int mycnt = lane < 32 ? (int)__hip_atomic_load((unsigned*)(F.ctl + CW_CNT) + 64 * lane, __ATOMIC_RELAXED, __HIP_MEMORY_SCOPE_AGENT) : 0;
            const int myt = (mycnt + 255) >> 8;
            int incl = myt;
#pragma unroll
            for (int o = 1; o < 32; o <<= 1) { const int t = __shfl_up(incl, o); if (lane >= o) incl += t; }
            ntiles = __shfl(incl, 31);
            if (F.wave == 0 && lane < 32) { for (int j = 0; j < myt; ++j) { tile_e[incl - myt + j] = lane; tile_e[160 + incl - myt + j] = 256 * j; } tile_e[320 + lane] = mycnt; }
            __syncthreads();
        }
        unsigned char* ws = ARG_WS;
        if (IN(9)) {
            pg8::Gemm g{(const bf16*)(ws + WS_T), (const bf16*)(ws + WS_WGU), 0, 0, DM}; pg8::MoeOrder S{ntiles, F.G, F.vcu, tile_e, (const int*)(ws + WS_LISTS)};
            pg8::EpiSwiGLU E{(bf16*)(ws + WS_ACT)};
            pg8::gemm_phase<pg8::EpiSwiGLU, pg8::MoeOrder, PG8_ALIGN, PG8_SP2, true>(F.lds + RING_OFF, g, S, E);
            {
                const int total = ntiles * 4, maxn = (total + F.G - 1) / F.G, cut = total - (maxn - 1) * F.G;
                int nid = F.G - cut, k = F.vcu - cut; if (nid < 64) { nid = F.G; k = F.vcu; }
                __syncthreads();
                if (k >= 0) { LAS float* scr = (LAS float*)(F.lds + RING_OFF + F.wave * 16384);
                    const float* Wd = ARG_IN(29); bf16* WDT = (bf16*)(ws + WS_WD);
                    for (int it = k * NWAVES + F.wave; it < 8192; it += nid * NWAVES) { const int e = it >> 8, item = it & 255; p0_transpose_item(Wd + (size_t)e * DEXP * DM, DEXP, DM, WDT, e * 1024, scr, item, F.lane); } }
            }
            if (BOTH(9)) xcd_barrier(bar); STAMP(10);
        }
        if (IN(10)) {
            pg8::Gemm g{(const bf16*)(ws + WS_ACT), (const bf16*)(ws + WS_WD), 0, 0, DEXP}; pg8::MoeOrder S{ntiles, F.G, F.vcu, tile_e, nullptr};
            pg8::EpiScatter E{(bf16*)(ws + WS_YB), (const int*)(ws + WS_LISTS), (const float*)(ws + WS_SLOT_G), tile_e};
            pg8::gemm_phase<pg8::EpiScatter, pg8::MoeOrder, PG8_ALIGN, PG8_SP2>(F.lds + RING_OFF, g, S, E);
            if (BOTH(10)) xcd_barrier(bar); STAMP(11);
        }
    }
    if (IN(11)) {
        unsigned char* ws = ARG_WS; float* outp = (float*)ARG_OUT; const bf16* YB = (const bf16*)(ws + WS_YB); const int lane = F.lane;
        const int gw = F.vcu * NWAVES + F.wave, NGW = F.G * NWAVES;
        float dscale = 1.0f;
        if (RWKV_DBG) { const float dd = __hip_atomic_load((float*)(F.ctl + CW_DBG), __ATOMIC_RELAXED, __HIP_MEMORY_SCOPE_AGENT), rr = __hip_atomic_load((float*)(F.ctl + CW_DBG + 1), __ATOMIC_RELAXED, __HIP_MEMORY_SCOPE_AGENT);
            dscale = 1.0f + sqrtf(fminf(dd / fmaxf(rr, 1e-30f), 1e6f)); }
        {
            f32x4 ch[4]; unsigned long long ca[4], cb[4];
#define P11_LOAD(H_, A_, B_, tok_) do { const GAS f32x4* or_ = (const GAS f32x4*)(outp + (size_t)(tok_) * DM); \
                const GAS unsigned long long* y0_ = (const GAS unsigned long long*)(YB + (size_t)(2 * (tok_)) * DM), *y1_ = (const GAS unsigned long long*)(YB + (size_t)(2 * (tok_) + 1) * DM); \
                _Pragma("unroll") for (int j_ = 0; j_ < 4; ++j_) { H_[j_] = or_[64 * j_ + lane]; A_[j_] = y0_[64 * j_ + lane]; B_[j_] = y1_[64 * j_ + lane]; } } while (0)
            if (gw < M) P11_LOAD(ch, ca, cb, gw);
            for (int tok = gw; tok < M; tok += NGW) {
                f32x4 nh[4]; unsigned long long na[4], nb[4];
#pragma unroll
                for (int j = 0; j < 4; ++j) { nh[j] = ch[j]; na[j] = ca[j]; nb[j] = cb[j]; }
                if (tok + NGW < M) P11_LOAD(nh, na, nb, tok + NGW);
                GAS f32x4* orow = (GAS f32x4*)(outp + (size_t)tok * DM);
#pragma unroll
                for (int j = 0; j < 4; ++j) { const int q = 64 * j + lane; f32x4 h = ch[j]; const unsigned long long a = ca[j], b = cb[j];
                    h.x += __uint_as_float((unsigned)a << 16) + __uint_as_float((unsigned)b << 16);
                    h.y += __uint_as_float((unsigned)a & 0xffff0000u) + __uint_as_float((unsigned)b & 0xffff0000u);
                    h.z += __uint_as_float((unsigned)(a >> 32) << 16) + __uint_as_float((unsigned)(b >> 32) << 16);
                    h.w += __uint_as_float((unsigned)(a >> 32) & 0xffff0000u) + __uint_as_float((unsigned)(b >> 32) & 0xffff0000u);
                    if (RWKV_DBG) h = h * dscale;
                    orow[q] = h; }
#pragma unroll
                for (int j = 0; j < 4; ++j) { ch[j] = nh[j]; ca[j] = na[j]; cb[j] = nb[j]; }
            }
#undef P11_LOAD
        }
    }
    STAMP(12);
#ifndef PROBE_MULT
#define PROBE_MULT 4
#endif
    if (PROBE_K >= 0 && blockIdx.x == 0 && F.tid == 0) {
        const GAS unsigned long long* ts = (const GAS unsigned long long*)(F.ctl + CW_TS);
#ifndef PROBE_A
#define PROBE_A PROBE_K
#define PROBE_B (PROBE_K + 1)
#endif
        const unsigned long long d = (ts[PROBE_B] - ts[PROBE_A]) * PROBE_MULT, t0 = rt();
        while (rt() - t0 < d) __builtin_amdgcn_s_sleep(8);
    }
#undef IN
#undef BOTH
}

extern "C" void kernel_launch(void* const* d_in, const int* in_sizes, int n_in, void* d_out, int out_size, void* d_ws, size_t ws_size, hipStream_t stream) {
    static int grid = 0;
    if (grid == 0) {
        int dev = 0, cus = 0;
        if (hipGetDevice(&dev) != hipSuccess || hipDeviceGetAttribute(&cus, hipDeviceAttributeMultiprocessorCount, dev) != hipSuccess) { grid = -1; return; }
        if (hipFuncSetAttribute((const void*)skel_fwd, hipFuncAttributeMaxDynamicSharedMemorySize, LDS_BYTES) != hipSuccess) { grid = -1; return; }
        grid = cus;
        if (n_in != 30 || ws_size < WS_TOTAL || out_size != M * DM) { fprintf(stderr, "kernel_launch: unexpected problem (n_in %d, ws %zu, out %d)\n", n_in, ws_size, out_size); grid = -1; return; }
        if (grid != 256) fprintf(stderr, "kernel_launch: %d CUs; the phase programs assume 256\n", grid);
    }
    if (grid < 0) return;
    (void)hipMemsetAsync((char*)d_ws + WS_CTL, 0, CTL_ZERO_BYTES, stream);
    Args a{};
    for (int i = 0; i < 30; ++i) a.in[i] = (const float*)d_in[i];
    a.out = (float*)d_out; a.ws = (unsigned char*)d_ws; a.ph_lo = 0; a.ph_hi = 12;
    hipLaunchKernelGGL(skel_fwd, dim3(grid), dim3(NWAVES * 64), LDS_BYTES, stream, a);
}
```

```cpp
#include <hip/hip_runtime.h>
#include <cstdio>
#include <cstdint>
namespace pg8 {
#define PG8_LAS __attribute__((address_space(3)))
typedef unsigned short bf16_t;
typedef short bf16x8 __attribute__((ext_vector_type(8)));
typedef float f32x4 __attribute__((ext_vector_type(4)));
typedef unsigned u32x4 __attribute__((ext_vector_type(4)));
constexpr int BM = 256, BK = 64, HALF = 128, HTB = HALF * BK * 2  , STAGE_BYTES = 8 * HTB, NXCD = 8, WGM = 8;

__host__ __device__ __forceinline__ int lds_byte(int r, int c) { const int st = (r >> 4) * 2 + (c >> 5), rr = r & 15, cc = c & 31, ob = rr * 64 + cc * 2; return st * 1024 + (ob ^ (((ob >> 9) & 1) << 5)); }
__host__ __device__ __forceinline__ void stage_rc(int b, int& R, int& C) { const int st = b / 1024, sb = b % 1024, swz = sb ^ (((sb >> 9) & 1) << 5); R = (st >> 1) * 16 + swz / 64; C = (st & 1) * 32 + (swz % 64) / 2; }
__host__ __device__ __forceinline__ int perm32(int rho) { const int n = rho >> 4, i = rho & 15; return 8 * (i >> 2) + 4 * n + (i & 3); }

struct Unit { int pm, pn; };
struct Gemm { const bf16_t* A; const bf16_t* Bt; int M, N, K; };

struct StaticOrder {
    int nM, nN, nwg, G, c;
    __host__ __device__ void init(int M, int N, int G_, int c_) { nM = M / BM; nN = N / BM; nwg = nM * nN; G = G_; c = c_; }
    __host__ __device__ bool next(int i, Unit& u) const {
        const long L = (long)i * G + c; if (L >= nwg) return false;
        int wgid = (int)L; { const int q = nwg / NXCD, r = nwg % NXCD, xcd = wgid % NXCD, off = wgid / NXCD; wgid = (xcd < r ? xcd * (q + 1) : r * (q + 1) + (xcd - r) * q) + off; }
        const int nig = WGM * nN, gid = wgid / nig, fm = gid * WGM, gsz = (nM - fm) < WGM ? (nM - fm) : WGM;
        u.pm = fm + ((wgid % nig) % gsz); u.pn = (wgid % nig) / gsz; return true;
    }
    __device__ __forceinline__ void a_ready(const Unit&) const {}
    __device__ __forceinline__ void done(const Unit&) const {}
};

__device__ __forceinline__ unsigned cvt_pk_bf16(float lo, float hi) { unsigned r; asm volatile("v_cvt_pk_bf16_f32 %0, %1, %2" : "=v"(r) : "v"(lo), "v"(hi)); return r; }
typedef float f32x2 __attribute__((ext_vector_type(2)));
__device__ __forceinline__ f32x2 gelu_pk(f32x2 v) {
    const f32x2 av = __builtin_elementwise_abs(v), d = av * 0.2316418882f + 1.0f;
    f32x2 t; t.x = __builtin_amdgcn_rcpf(d.x); t.y = __builtin_amdgcn_rcpf(d.y);
    f32x2 q = t * 0.5307027145f + (-0.7265760135f); q = q * t + 0.7107068705f; q = q * t + (-0.142248368f); q = q * t + 0.127414796f; q = q * t;
    const f32x2 s = (v * v) * (-0.72134752044f);
    f32x2 e; e.x = __builtin_amdgcn_exp2f(s.x); e.y = __builtin_amdgcn_exp2f(s.y);
    const f32x2 m = v * (q * e), r = v - m;
    f32x2 o; o.x = v.x < 0.f ? m.x : r.x; o.y = v.y < 0.f ? m.y : r.y; return o;
}

template <int ACT  > struct EpiBf16 {
    static constexpr bool PERM = true, AFTER_DRAIN = false; static_assert(ACT == 0 || ACT == 1, "EpiBf16: ACT is 0 (none) or 1 (gelu_pk)");
    bf16_t* O; int ldc; const float* bias; int split_cols; size_t split_stride; float scale0;
    __device__ __forceinline__ void operator()(const f32x4 (&acc)[2][2][4][2], const Unit& u, int wr, int wc, int fr, int fq) const {
        const int row0 = u.pm * BM + wr * 64 + fr; int colt = u.pn * BM; bf16_t* base = O;
        float sc = 1.f; if (split_cols) { const int t = colt / split_cols; base += (size_t)t * split_stride; colt -= t * split_cols; if (t == 0) sc = scale0; }
        const int col0 = colt + wc * 32 + 8 * fq, bcol0 = u.pn * BM + wc * 32 + 8 * fq;
        f32x4 bv[2][2];
#pragma unroll
        for (int bj = 0; bj < 2; ++bj)
#pragma unroll
            for (int n = 0; n < 2; ++n) bv[bj][n] = bias ? *(const f32x4*)(bias + bcol0 + bj * HALF + 4 * n) : (f32x4){0.f, 0.f, 0.f, 0.f};
#pragma unroll
        for (int ai = 0; ai < 2; ++ai)
#pragma unroll
            for (int m = 0; m < 4; ++m) { bf16_t* rowp = base + (size_t)(row0 + ai * HALF + m * 16) * ldc + col0;
#pragma unroll
                for (int bj = 0; bj < 2; ++bj) { f32x4 v0 = acc[ai][bj][m][0] + bv[bj][0], v1 = acc[ai][bj][m][1] + bv[bj][1];
                    if (ACT == 1) { f32x2 a = gelu_pk((f32x2){v0[0], v0[1]}), b = gelu_pk((f32x2){v0[2], v0[3]}), c = gelu_pk((f32x2){v1[0], v1[1]}), d = gelu_pk((f32x2){v1[2], v1[3]});
                        v0 = (f32x4){a.x, a.y, b.x, b.y}; v1 = (f32x4){c.x, c.y, d.x, d.y}; }
                    v0 = v0 * sc; v1 = v1 * sc; u32x4 w; w.x = cvt_pk_bf16(v0[0], v0[1]); w.y = cvt_pk_bf16(v0[2], v0[3]); w.z = cvt_pk_bf16(v1[0], v1[1]); w.w = cvt_pk_bf16(v1[2], v1[3]);
                    *(u32x4*)(rowp + bj * HALF) = w; } }
    }
};

struct PanelStats {
    unsigned* xbuf;
    unsigned* cnt;
    unsigned* tmo;
    int ntn; float eps;
    unsigned code;
    __device__ __forceinline__ bool run(const f32x4 (&v)[2][2][4][2], const Unit& u, int wr, int wc, int fr, int fq, PG8_LAS unsigned char* lds, int wid, int lane) const {
        typedef float f32x2v __attribute__((ext_vector_type(2)));
        PG8_LAS f32x2v* P = (PG8_LAS f32x2v*)lds;
        PG8_LAS f32x2v* S = (PG8_LAS f32x2v*)(lds + 8192);
        PG8_LAS unsigned* flag = (PG8_LAS unsigned*)(lds + 8192 + 2048);
#pragma unroll
        for (int ai = 0; ai < 2; ++ai)
#pragma unroll
            for (int m = 0; m < 4; ++m) {
                float s = 0.f;
#pragma unroll
                for (int bj = 0; bj < 2; ++bj)
#pragma unroll
                    for (int n = 0; n < 2; ++n) { const f32x4 x = v[ai][bj][m][n]; s += (x[0] + x[1]) + (x[2] + x[3]); }
                s += __shfl_xor(s, 16); s += __shfl_xor(s, 32);
                const float mw = s * (1.0f / 64.0f); float q = 0.f;
#pragma unroll
                for (int bj = 0; bj < 2; ++bj)
#pragma unroll
                    for (int n = 0; n < 2; ++n) { const f32x4 d = v[ai][bj][m][n] - mw; q += (d[0] * d[0] + d[1] * d[1]) + (d[2] * d[2] + d[3] * d[3]); }
                q += __shfl_xor(q, 16); q += __shfl_xor(q, 32);
                if (fq == 0) P[(ai * HALF + wr * 64 + m * 16 + fr) * 4 + wc] = (f32x2v){mw, q};
            }
        asm volatile("s_waitcnt lgkmcnt(0)" ::: "memory"); __builtin_amdgcn_s_barrier(); asm volatile("" ::: "memory");
#if defined(BROKEN_EXCHANGE_NO_WAIT)
#warning BROKEN CONTROL BUILD: the row-statistics exchange does not wait; results are wrong by design
        if (blockIdx.x >= 64) { const long long t0_ = clock64(); while (clock64() - t0_ < 60000) __builtin_amdgcn_s_sleep(8); }
#endif
        const int row = wid * 32 + (lane & 31);
        if (lane < 32) {
            const f32x2v a = P[row * 4 + 0], b = P[row * 4 + 1], c = P[row * 4 + 2], d = P[row * 4 + 3];
            const float mt = (a.x + b.x + c.x + d.x) * 0.25f;
            const float da = a.x - mt, db = b.x - mt, dc = c.x - mt, dd = d.x - mt;
            const float m2 = (a.y + b.y) + (c.y + d.y) + 64.0f * ((da * da + db * db) + (dc * dc + dd * dd));
            unsigned long long* slot = (unsigned long long*)xbuf + ((size_t)(u.pm * BM + row) * 4 + u.pn);
            __hip_atomic_store(slot, ((unsigned long long)__float_as_uint(m2) << 32) | __float_as_uint(mt), __ATOMIC_RELAXED, __HIP_MEMORY_SCOPE_AGENT);
        }
        asm volatile("s_waitcnt vmcnt(0)" ::: "memory");
        if (lane == 0) __hip_atomic_fetch_add(cnt + 64 * u.pm, 1u, __ATOMIC_RELAXED, __HIP_MEMORY_SCOPE_AGENT);
        if (wid == 0) {
            bool dead = false; const unsigned long long t0 = __builtin_amdgcn_s_memrealtime(); const unsigned want = 8u * (unsigned)ntn;
            for (;;) {
#if defined(BROKEN_EXCHANGE_NO_WAIT)
                break;
#endif
                if ((unsigned)__builtin_amdgcn_readfirstlane(__hip_atomic_load(cnt + 64 * u.pm, __ATOMIC_RELAXED, __HIP_MEMORY_SCOPE_AGENT)) >= want) break;
                if (__builtin_amdgcn_s_memrealtime() - t0 > 2000000ull) {
                    if (lane == 0) { unsigned expect = 0u; __hip_atomic_compare_exchange_strong(tmo + 1, &expect, code | (unsigned)(u.pm & 0xff), __ATOMIC_RELAXED, __ATOMIC_RELAXED, __HIP_MEMORY_SCOPE_AGENT);
                                     __hip_atomic_store(tmo, 1u, __ATOMIC_RELAXED, __HIP_MEMORY_SCOPE_AGENT); }
                    dead = true; break; }
                __builtin_amdgcn_s_sleep(2);
            }
            __builtin_amdgcn_fence(__ATOMIC_ACQUIRE, "agent");
            if (lane == 0) flag[0] = dead ? 1u : 0u;
        }
        asm volatile("s_waitcnt vmcnt(0) lgkmcnt(0)" ::: "memory"); __builtin_amdgcn_s_barrier(); asm volatile("" ::: "memory");
        const bool bad = flag[0] != 0u;
        if (lane < 32) {
            const unsigned long long* slot = (const unsigned long long*)xbuf + (size_t)(u.pm * BM + row) * 4; float mt[4], m2[4]; float ms = 0.f;
#pragma unroll
            for (int t = 0; t < 4; ++t) { if (t < ntn) { const unsigned long long w = __hip_atomic_load(slot + t, __ATOMIC_RELAXED, __HIP_MEMORY_SCOPE_AGENT); mt[t] = __uint_as_float((unsigned)w); m2[t] = __uint_as_float((unsigned)(w >> 32)); } else { mt[t] = 0.f; m2[t] = 0.f; } ms += mt[t]; }
            const float mean = ms / (float)ntn; float q = 0.f;
#pragma unroll
            for (int t = 0; t < 4; ++t) if (t < ntn) { const float dm = mt[t] - mean; q += m2[t] + 256.0f * dm * dm; }
            S[row] = (f32x2v){mean, 1.0f / sqrtf(q / (256.0f * (float)ntn) + eps)};
        }
        asm volatile("s_waitcnt lgkmcnt(0)" ::: "memory"); __builtin_amdgcn_s_barrier(); asm volatile("" ::: "memory");
        return bad;
    }
};
struct EpiLnRes {
    static constexpr bool PERM = false, AFTER_DRAIN = true;
    const float* base; float* out; int ldc; const float* bias; PanelStats st; unsigned poison;
    __device__ __forceinline__ void fused(f32x4 (&acc)[2][2][4][2], const Unit& u, int wr, int wc, int fr, int fq, PG8_LAS unsigned char* lds, int wid, int lane) const {
        typedef float f32x2v __attribute__((ext_vector_type(2)));
        const PG8_LAS f32x2v* S = (const PG8_LAS f32x2v*)(lds + 8192);
        const int col0 = u.pn * BM + wc * 32 + 4 * fq;
#pragma unroll
        for (int bj = 0; bj < 2; ++bj)
#pragma unroll
            for (int n = 0; n < 2; ++n) { const f32x4 bv = bias ? *(const f32x4*)(bias + col0 + bj * HALF + n * 16) : (f32x4){0.f, 0.f, 0.f, 0.f};
#pragma unroll
                for (int ai = 0; ai < 2; ++ai)
#pragma unroll
                    for (int m = 0; m < 4; ++m) acc[ai][bj][m][n] += bv; }
        f32x4 pre[4][2][2];
#pragma unroll
        for (int m = 0; m < 4; ++m) { const size_t off = (size_t)(u.pm * BM + wr * 64 + m * 16 + fr) * ldc + col0;
#pragma unroll
            for (int bj = 0; bj < 2; ++bj)
#pragma unroll
                for (int n = 0; n < 2; ++n) pre[m][bj][n] = *(const f32x4*)(base + off + bj * HALF + n * 16); }
        const bool bad = st.run(acc, u, wr, wc, fr, fq, lds, wid, lane) || poison != 0u;
        const float qnan = __builtin_nanf("");
#pragma unroll
        for (int ai = 0; ai < 2; ++ai)
#pragma unroll
            for (int m = 0; m < 4; ++m) { const int r = ai * HALF + wr * 64 + m * 16 + fr; const f32x2v sr = S[r]; const size_t off = (size_t)(u.pm * BM + r) * ldc + col0;
#pragma unroll
                for (int bj = 0; bj < 2; ++bj)
#pragma unroll
                    for (int n = 0; n < 2; ++n) { const f32x4 bs = ai == 0 ? pre[m][bj][n] : *(const f32x4*)(base + off + bj * HALF + n * 16); f32x4 o = bs + (acc[ai][bj][m][n] - sr.x) * sr.y;
                        if (bad) o = (f32x4){qnan, qnan, qnan, qnan}; *(f32x4*)(out + off + bj * HALF + n * 16) = o; }
                if (m & 1) asm volatile("" ::: "memory"); }
    }
};
struct EpiLnResLn {
    static constexpr bool PERM = false, AFTER_DRAIN = true;
    const float* base; float* out; bf16_t* xn; int ldc; const float* bias; PanelStats st1, st2; unsigned poison;
    __device__ __forceinline__ void fused(f32x4 (&acc)[2][2][4][2], const Unit& u, int wr, int wc, int fr, int fq, PG8_LAS unsigned char* lds, int wid, int lane) const {
        typedef float f32x2v __attribute__((ext_vector_type(2))); typedef unsigned u32x2v __attribute__((ext_vector_type(2)));
        const PG8_LAS f32x2v* S = (const PG8_LAS f32x2v*)(lds + 8192);
        const int col0 = u.pn * BM + wc * 32 + 4 * fq;
#pragma unroll
        for (int bj = 0; bj < 2; ++bj)
#pragma unroll
            for (int n = 0; n < 2; ++n) { const f32x4 bv = bias ? *(const f32x4*)(bias + col0 + bj * HALF + n * 16) : (f32x4){0.f, 0.f, 0.f, 0.f};
#pragma unroll
                for (int ai = 0; ai < 2; ++ai)
#pragma unroll
                    for (int m = 0; m < 4; ++m) acc[ai][bj][m][n] += bv; }
        bool bad = st1.run(acc, u, wr, wc, fr, fq, lds, wid, lane) || poison != 0u;
        const float qnan = __builtin_nanf("");
#pragma unroll
        for (int ai = 0; ai < 2; ++ai)
#pragma unroll
            for (int m = 0; m < 4; ++m) { const int r = ai * HALF + wr * 64 + m * 16 + fr; const f32x2v sr = S[r]; const size_t off = (size_t)(u.pm * BM + r) * ldc + col0;
#pragma unroll
                for (int bj = 0; bj < 2; ++bj)
#pragma unroll
                    for (int n = 0; n < 2; ++n) { const f32x4 bs = *(const f32x4*)(base + off + bj * HALF + n * 16); acc[ai][bj][m][n] = bs + (acc[ai][bj][m][n] - sr.x) * sr.y; }
                asm volatile("" : "+v"(acc[ai][0][m][0]), "+v"(acc[ai][0][m][1]), "+v"(acc[ai][1][m][0]), "+v"(acc[ai][1][m][1]));
                if (m & 1) asm volatile("" ::: "memory"); }
        const bool bad1 = bad;
        bad = st2.run(acc, u, wr, wc, fr, fq, lds, wid, lane) || bad;
#pragma unroll
        for (int ai = 0; ai < 2; ++ai)
#pragma unroll
            for (int m = 0; m < 4; ++m) { const int r = ai * HALF + wr * 64 + m * 16 + fr; const f32x2v sr = S[r]; const size_t off = (size_t)(u.pm * BM + r) * ldc + col0;
#pragma unroll
                for (int bj = 0; bj < 2; ++bj)
#pragma unroll
                    for (int n = 0; n < 2; ++n) { const f32x4 x1 = acc[ai][bj][m][n]; *(f32x4*)(out + off + bj * HALF + n * 16) = bad1 ? (f32x4){qnan, qnan, qnan, qnan} : x1;
                        const f32x4 o = (x1 - sr.x) * sr.y; u32x2v w; w.x = cvt_pk_bf16(o[0], o[1]); w.y = cvt_pk_bf16(o[2], o[3]);
                        if (bad) { w.x = 0x7fc07fc0u; w.y = 0x7fc07fc0u; } *(u32x2v*)(xn + off + bj * HALF + n * 16) = w; }
                asm volatile("" ::: "memory"); }
    }
};

template <class Epi, class Sched, bool ALIGN_EPI = false, bool SP2 = false, bool GATHER = false>
__device__ __forceinline__ void gemm_phase(PG8_LAS unsigned char* lds, const Gemm g, const Sched& S, const Epi& E) {
    const int tid = threadIdx.x, wid = __builtin_amdgcn_readfirstlane(tid >> 6), lane = tid & 63, wr = wid >> 2, wc = wid & 3, fr = lane & 15, fq = lane >> 4;
    const int K = g.K, nt = K / BK;
    unsigned voffA[2], voffB[2]; int gR[2], gC[2];
#pragma unroll
    for (int i = 0; i < 2; ++i) { int R, C; stage_rc(tid * 16 + i * 8192, R, C); const int Rb = Epi::PERM ? ((R & ~31) + perm32(R & 31)) : R;
        voffA[i] = (unsigned)(R * K + C) * 2u; voffB[i] = (unsigned)(Rb * K + C) * 2u; gR[i] = R; gC[i] = C * 2; }
    unsigned vA0[2], vA1[2], vN0[2], vN1[2];
#define PG8_GOFF(D0, D1, U_) do { _Pragma("unroll") for (int _i = 0; _i < 2; ++_i) { if constexpr (GATHER) { D0[_i] = S.a_row_off(U_, gR[_i]) + (unsigned)gC[_i]; D1[_i] = S.a_row_off(U_, HALF + gR[_i]) + (unsigned)gC[_i]; } \
        else { D0[_i] = voffA[_i]; D1[_i] = voffA[_i]; } } } while (0)
    const size_t kstep = (size_t)(BK * 2);
    const size_t hstep = (size_t)HALF * K * 2;
    const size_t tstep = 2 * hstep;
    const size_t hstepA = GATHER ? 0 : hstep, tstepA = GATHER ? 0 : tstep;
    const unsigned ldsw = (unsigned)wid * 1024u;
    const int aoff = lds_byte(wr * 64 + fr, fq * 8), boff = lds_byte(wc * 32 + fr, fq * 8);
#define PG8_SA(b, h) (((b) * 2 + (h)) * HTB)
#define PG8_SB(b, h) ((4 + (b) * 2 + (h)) * HTB)
#define PG8_STAGE(bufoff, gbase, voff) do { _Pragma("unroll") for (int _i = 0; _i < 2; ++_i) \
        __builtin_amdgcn_global_load_lds((const unsigned*)((const char*)(gbase) + (voff)[_i]), (PG8_LAS unsigned*)(lds + (bufoff) + ldsw + _i * 8192), 16, 0, 0); } while (0)
#define PG8_LDA(dst, b, h) do { _Pragma("unroll") for (int m = 0; m < 4; ++m) _Pragma("unroll") for (int k = 0; k < 2; ++k) dst[m][k] = *(const PG8_LAS bf16x8*)(lds + PG8_SA(b, h) + aoff + m * 2048 + k * 1024); } while (0)
#define PG8_LDB(dst, b, h) do { _Pragma("unroll") for (int n = 0; n < 2; ++n) _Pragma("unroll") for (int k = 0; k < 2; ++k) dst[n][k] = *(const PG8_LAS bf16x8*)(lds + PG8_SB(b, h) + boff + n * 2048 + k * 1024); } while (0)
#define PG8_MMA(ai, bj, At, Bt) do { __builtin_amdgcn_s_setprio(1); _Pragma("unroll") for (int m = 0; m < 4; ++m) _Pragma("unroll") for (int n = 0; n < 2; ++n) _Pragma("unroll") for (int k = 0; k < 2; ++k) \
        acc[ai][bj][m][n] = __builtin_amdgcn_mfma_f32_16x16x32_bf16(Bt[n][k], At[m][k], acc[ai][bj][m][n], 0, 0, 0); __builtin_amdgcn_s_setprio(0); } while (0)
#define PG8_WAIT_V(n) asm volatile("s_waitcnt vmcnt(" #n ")" ::: "memory")
#define PG8_WAIT_L(n) asm volatile("s_waitcnt lgkmcnt(" #n ")" ::: "memory")
#define PG8_BAR __builtin_amdgcn_s_barrier()
#define PG8_SCHED __builtin_amdgcn_sched_barrier(0)
    Unit cur, nxt; int ui = 0;
    if (!S.next(0, cur)) return;
    f32x4 acc[2][2][4][2];
#pragma unroll
    for (int a = 0; a < 2; ++a)
#pragma unroll
        for (int b = 0; b < 2; ++b)
#pragma unroll
            for (int m = 0; m < 4; ++m)
#pragma unroll
                for (int n = 0; n < 2; ++n) acc[a][b][m][n] = (f32x4){0.f, 0.f, 0.f, 0.f};
    bf16x8 At[4][2], B0[2][2], B1[2][2];
    const char* cA = (const char*)g.A + (size_t)cur.pm * tstepA; const char* cB = (const char*)g.Bt + (size_t)cur.pn * tstep;
    PG8_GOFF(vA0, vA1, cur);
    S.a_ready(cur);
    if constexpr (SP2) {
        PG8_STAGE(PG8_SB(0, 0), cB, voffB); PG8_STAGE(PG8_SB(0, 1), cB + hstep, voffB); PG8_STAGE(PG8_SA(0, 0), cA, vA0); PG8_STAGE(PG8_SA(0, 1), cA + hstepA, vA1);
        if (wr == 1) PG8_BAR;
        PG8_WAIT_V(2); PG8_BAR;
        PG8_STAGE(PG8_SB(1, 0), cB + kstep, voffB); PG8_STAGE(PG8_SA(1, 0), cA + kstep, vA0); PG8_STAGE(PG8_SB(1, 1), cB + hstep + kstep, voffB);
        PG8_WAIT_V(6); PG8_BAR;
    } else {
        PG8_STAGE(PG8_SB(0, 0), cB, voffB); PG8_STAGE(PG8_SA(0, 0), cA, voffA); PG8_STAGE(PG8_SB(0, 1), cB + hstep, voffB); PG8_STAGE(PG8_SA(0, 1), cA + hstep, voffA);
        if (wr == 1) PG8_BAR;
        PG8_WAIT_V(4); PG8_BAR;
        PG8_STAGE(PG8_SB(1, 0), cB + kstep, voffB); PG8_STAGE(PG8_SA(1, 0), cA + kstep, voffA); PG8_STAGE(PG8_SB(1, 1), cB + hstep + kstep, voffB);
        PG8_WAIT_V(6); PG8_BAR;
    }
    for (;;) {
        const bool has_next = S.next(ui + 1, nxt);
        const char* nA = has_next ? (const char*)g.A + (size_t)nxt.pm * tstepA : cA; const char* nB = has_next ? (const char*)g.Bt + (size_t)nxt.pn * tstep : cB;
        if (has_next) PG8_GOFF(vN0, vN1, nxt); else { vN0[0] = vA0[0]; vN0[1] = vA0[1]; vN1[0] = vA1[0]; vN1[1] = vA1[1]; }
        for (int t = 0; t < nt; t += 2) {
            const bool last = (t == nt - 2);
            const char* a1 = cA + (size_t)(t + 1) * kstep;
            const char* a2 = last ? nA : cA + (size_t)(t + 2) * kstep; const char* b2 = last ? nB : cB + (size_t)(t + 2) * kstep;
            const char* a3 = a2 + kstep; const char* b3 = b2 + kstep;
            if (last && has_next) S.a_ready(nxt);
            unsigned vX0[2], vX1[2];
            vX0[0] = last ? vN0[0] : vA0[0]; vX0[1] = last ? vN0[1] : vA0[1]; vX1[0] = last ? vN1[0] : vA1[0]; vX1[1] = last ? vN1[1] : vA1[1];
            if constexpr (SP2) {
            PG8_LDB(B0, 0, 0); PG8_LDB(B1, 0, 1); PG8_SCHED; PG8_LDA(At, 0, 0); PG8_STAGE(PG8_SA(1, 1), a1 + hstepA, vA1);
            PG8_WAIT_V(8); PG8_WAIT_L(0); PG8_BAR; PG8_MMA(0, 0, At, B0); PG8_MMA(0, 1, At, B1); PG8_BAR; PG8_SCHED;
            PG8_LDA(At, 0, 1); PG8_STAGE(PG8_SB(0, 0), b2, voffB); PG8_STAGE(PG8_SB(0, 1), b2 + hstep, voffB); PG8_STAGE(PG8_SA(0, 0), a2, vX0);
            PG8_WAIT_V(8); PG8_WAIT_L(0); PG8_BAR; PG8_MMA(1, 0, At, B0); PG8_MMA(1, 1, At, B1); PG8_BAR; PG8_SCHED;
            PG8_LDB(B0, 1, 0); PG8_LDB(B1, 1, 1); PG8_SCHED; PG8_LDA(At, 1, 0); PG8_STAGE(PG8_SA(0, 1), a2 + hstepA, vX1);
            PG8_WAIT_V(8); PG8_WAIT_L(0); PG8_BAR; PG8_MMA(0, 0, At, B0); PG8_MMA(0, 1, At, B1); PG8_BAR; PG8_SCHED;
            PG8_LDA(At, 1, 1); PG8_STAGE(PG8_SB(1, 0), b3, voffB); PG8_STAGE(PG8_SB(1, 1), b3 + hstep, voffB); PG8_STAGE(PG8_SA(1, 0), a3, vX0);
            PG8_WAIT_V(8); PG8_WAIT_L(0); PG8_BAR; PG8_MMA(1, 0, At, B0); PG8_MMA(1, 1, At, B1); PG8_BAR; PG8_SCHED;
            } else {
            PG8_LDB(B0, 0, 0); PG8_SCHED; PG8_LDA(At, 0, 0); PG8_STAGE(PG8_SA(1, 1), a1 + hstep, voffA);
            PG8_WAIT_L(8); PG8_BAR; PG8_WAIT_L(0); PG8_MMA(0, 0, At, B0); PG8_BAR; PG8_SCHED;
            PG8_LDB(B1, 0, 1); PG8_STAGE(PG8_SB(0, 0), b2, voffB);
            PG8_BAR; PG8_WAIT_L(0); PG8_MMA(0, 1, At, B1); PG8_BAR;
            PG8_LDA(At, 0, 1); PG8_STAGE(PG8_SA(0, 0), a2, voffA);
            PG8_BAR; PG8_WAIT_L(0); PG8_MMA(1, 0, At, B0); PG8_BAR; PG8_SCHED;
            PG8_STAGE(PG8_SB(0, 1), b2 + hstep, voffB);
            PG8_WAIT_V(6); PG8_BAR; PG8_MMA(1, 1, At, B1); PG8_BAR;
            PG8_LDB(B0, 1, 0); PG8_SCHED; PG8_LDA(At, 1, 0); PG8_STAGE(PG8_SA(0, 1), a2 + hstep, voffA);
            PG8_WAIT_L(8); PG8_BAR; PG8_WAIT_L(0); PG8_MMA(0, 0, At, B0); PG8_BAR; PG8_SCHED;
            PG8_LDB(B1, 1, 1); PG8_STAGE(PG8_SB(1, 0), b3, voffB);
            PG8_BAR; PG8_WAIT_L(0); PG8_MMA(0, 1, At, B1); PG8_BAR;
            PG8_LDA(At, 1, 1); PG8_STAGE(PG8_SA(1, 0), a3, voffA);
            PG8_BAR; PG8_WAIT_L(0); PG8_MMA(1, 0, At, B0); PG8_BAR; PG8_SCHED;
            PG8_STAGE(PG8_SB(1, 1), b3 + hstep, voffB);
            PG8_WAIT_V(6); PG8_BAR; PG8_MMA(1, 1, At, B1); PG8_BAR;
            }
        }
        if constexpr (ALIGN_EPI) { if (wr == 0) PG8_BAR; }
        if constexpr (!Epi::AFTER_DRAIN) { E(acc, cur, wr, wc, fr, fq); S.done(cur); }
        if (!has_next) break;
#pragma unroll
        for (int a = 0; a < 2; ++a)
#pragma unroll
            for (int b = 0; b < 2; ++b)
#pragma unroll
                for (int m = 0; m < 4; ++m)
#pragma unroll
                    for (int n = 0; n < 2; ++n) acc[a][b][m][n] = (f32x4){0.f, 0.f, 0.f, 0.f};
        cur = nxt; cA = nA; cB = nB; ++ui; vA0[0] = vN0[0]; vA0[1] = vN0[1]; vA1[0] = vN1[0]; vA1[1] = vN1[1];
        if constexpr (ALIGN_EPI) { if (wr == 1) PG8_BAR; }
    }
    PG8_WAIT_V(0);
    if constexpr (!ALIGN_EPI) { if (wr == 0) PG8_BAR; }
    PG8_BAR;
    if constexpr (Epi::AFTER_DRAIN) { E.fused(acc, cur, wr, wc, fr, fq, lds, wid, lane); S.done(cur); }
#undef PG8_GOFF
#undef PG8_SA
#undef PG8_SB
#undef PG8_STAGE
#undef PG8_LDA
#undef PG8_LDB
#undef PG8_MMA
#undef PG8_WAIT_V
#undef PG8_WAIT_L
#undef PG8_BAR
#undef PG8_SCHED
}
}

#ifndef PG8_SP2
#define PG8_SP2 true
#endif
#ifndef PG8_ALIGN
#define PG8_ALIGN true
#endif

namespace pg8 {
struct EpiResF32 {
    static constexpr bool PERM = false, AFTER_DRAIN = false;
    const float* base; float* out; int ldc;
    __device__ __forceinline__ void operator()(const f32x4 (&acc)[2][2][4][2], const Unit& u, int wr, int wc, int fr, int fq) const {
        const int col0 = u.pn * BM + wc * 32 + 4 * fq;
#pragma unroll
        for (int ai = 0; ai < 2; ++ai)
#pragma unroll
            for (int m = 0; m < 4; ++m) { const size_t off = (size_t)(u.pm * BM + ai * HALF + wr * 64 + m * 16 + fr) * ldc + col0;
#pragma unroll
                for (int bj = 0; bj < 2; ++bj)
#pragma unroll
                    for (int n = 0; n < 2; ++n) { const f32x4 bs = *(const f32x4*)(base + off + bj * HALF + n * 16); *(f32x4*)(out + off + bj * HALF + n * 16) = bs + acc[ai][bj][m][n]; }
                asm volatile("" ::: "memory"); }
    }
};
struct EpiSwiGLU {
    static constexpr bool PERM = true, AFTER_DRAIN = false;
    bf16_t* O;
    __device__ __forceinline__ void operator()(const f32x4 (&acc)[2][2][4][2], const Unit& u, int wr, int wc, int fr, int fq) const {
        const int row0 = u.pm * BM + wr * 64 + fr; const int col0 = (u.pn & 3) * 128 + wc * 32 + 8 * fq;
#pragma unroll
        for (int ai = 0; ai < 2; ++ai)
#pragma unroll
            for (int m = 0; m < 4; ++m) { bf16_t* rowp = O + (size_t)(row0 + ai * HALF + m * 16) * 512 + col0;
                f32x4 g0 = acc[ai][0][m][0], g1 = acc[ai][0][m][1]; const f32x4 u0 = acc[ai][1][m][0], u1 = acc[ai][1][m][1];
#pragma unroll
                for (int e = 0; e < 4; ++e) { g0[e] = g0[e] * __builtin_amdgcn_rcpf(1.0f + __expf(-g0[e])) * u0[e]; g1[e] = g1[e] * __builtin_amdgcn_rcpf(1.0f + __expf(-g1[e])) * u1[e]; }
                u32x4 w; w.x = cvt_pk_bf16(g0[0], g0[1]); w.y = cvt_pk_bf16(g0[2], g0[3]); w.z = cvt_pk_bf16(g1[0], g1[1]); w.w = cvt_pk_bf16(g1[2], g1[3]);
                *(u32x4*)rowp = w; asm volatile("" ::: "memory"); }
    }
};
struct EpiScatter {
    static constexpr bool PERM = true, AFTER_DRAIN = false;
    bf16_t* Y; const int* lists; const float* slot_g; const PG8_LAS int* tile_e;
    __device__ __forceinline__ void operator()(const f32x4 (&acc)[2][2][4][2], const Unit& u, int wr, int wc, int fr, int fq) const {
        const int row0 = wr * 64 + fr; const int col0 = (u.pn & 3) * BM + wc * 32 + 8 * fq;
        const int e = u.pn >> 2, base = tile_e[160 + u.pm], ne = tile_e[320 + e];
#pragma unroll
        for (int ai = 0; ai < 2; ++ai)
#pragma unroll
            for (int m = 0; m < 4; ++m) { const int idx = base + row0 + ai * HALF + m * 16; const bool ok = idx < ne; const int slot = ok ? lists[e * 16384 + idx] : 0; const float gt = ok ? slot_g[slot] : 0.f;
                if (ok) { bf16_t* rowp = Y + (size_t)slot * 1024 + col0;
#pragma unroll
                    for (int bj = 0; bj < 2; ++bj) { const f32x4 v0 = acc[ai][bj][m][0] * gt, v1 = acc[ai][bj][m][1] * gt;
                        u32x4 w; w.x = cvt_pk_bf16(v0[0], v0[1]); w.y = cvt_pk_bf16(v0[2], v0[3]); w.z = cvt_pk_bf16(v1[0], v1[1]); w.w = cvt_pk_bf16(v1[2], v1[3]);
                        *(u32x4*)(rowp + bj * HALF) = w; } }
                asm volatile("" ::: "memory"); }
    }
};
struct MoeOrder {
    int ntiles, G, c; const PG8_LAS int* tile_e; const int* lists;
    __device__ __forceinline__ unsigned a_row_off(const Unit& u, int r) const {
        const int e = u.pn >> 2, idx = tile_e[160 + u.pm] + r; const int sl = idx < tile_e[320 + e] ? lists[e * 16384 + idx] : 0; return (unsigned)(sl >> 1) * 2048u; }
    __device__ __forceinline__ bool next(int i, Unit& u) const {
        const int L = i * G + c; if (L >= ntiles * 4) return false;
        const int ti = L >> 2; const int e = __builtin_amdgcn_readfirstlane(tile_e[ti]);
        u.pm = ti; u.pn = e * 4 + (L & 3); return true;
    }
    __device__ __forceinline__ void a_ready(const Unit&) const {}
    __device__ __forceinline__ void done(const Unit&) const {}
};
struct G1Order : StaticOrder {
    __device__ __forceinline__ bool next(int i, Unit& u) const { if (!StaticOrder::next(i, u)) return false; if (u.pn >= 11) u.pn = 12; return true; }
};
struct P3Order {
    int k, j;
    __device__ __forceinline__ bool next(int i, Unit& u) const {
        if (j < 8) { if (i > 0) return false; u.pm = 8 * k + j; u.pn = 11; return true; }
        const int L = i * 24 + (j - 8); if (L >= 48) return false; u.pm = 8 * k + L / 6; u.pn = L % 6; return true; }
    __device__ __forceinline__ void a_ready(const Unit&) const {}
    __device__ __forceinline__ void done(const Unit&) const {}
};
}


#include <hip/hip_bf16.h>
#include <cmath>
namespace attn_body {
using bf16=__hip_bfloat16;
using bf16x8=__attribute__((ext_vector_type(8)))short;
using s16x4=__attribute__((ext_vector_type(4)))short;
using f32x16=__attribute__((ext_vector_type(16)))float;
using u32x4=__attribute__((ext_vector_type(4)))unsigned;
constexpr int BATCH=8,NHEAD=16,SEQ=2048,D=64,QP=3328,OP=1024;
constexpr int NW=8,QBLK=32,QB=QBLK*NW,KVBLK=64,NQB=SEQ/QB;
constexpr int ATTN_UNIT_ROWS=QB;
__device__ __forceinline__ int crow(int r,int hi){return (r&3)+8*(r>>2)+4*hi;}
#define SBAR() __builtin_amdgcn_sched_barrier(0)
__device__ __forceinline__ void cmask(f32x16&p0,f32x16&p1,int jb,int qrel,int hi){
  const float NEG=-INFINITY;
  if(jb>(qrel>>6)){
  #pragma unroll
  for(int r=0;r<16;++r){p0[r]=NEG;p1[r]=NEG;}}
}

constexpr int NSLOT=3, SLOTB=8192;
constexpr int LDS_K=0, LDS_V=NSLOT*SLOTB, LDS_WS=2*NSLOT*SLOTB, LDS_OST=LDS_WS+NW*64*4, LDS_BYTES=LDS_OST+NW*4096;
constexpr float C2=0.125f*1.4426950408889634f;
__device__ __forceinline__ void glds16(const void*gsrc,unsigned lds_dst){unsigned keep;
  asm volatile("s_mov_b32 %0, m0\n\ts_mov_b32 m0, %2\n\ts_nop 0\n\tglobal_load_lds_dwordx4 %1, off\n\ts_mov_b32 m0, %0":"=&s"(keep):"v"(gsrc),"s"(lds_dst):"memory");}
__device__ __forceinline__ float max3f(float a,float b,float c){float r;asm("v_max3_f32 %0, %1, %2, %3":"=v"(r):"v"(a),"v"(b),"v"(c));return r;}
__device__ __forceinline__ float max2f(float a,float b){float r;asm("v_max_f32_e32 %0, %1, %2":"=v"(r):"v"(a),"v"(b));return r;}
__device__ __forceinline__ float fadd_s(float a,float b){float r;asm("v_add_f32_e32 %0, %1, %2":"=v"(r):"v"(a),"v"(b));return r;}
__device__ __forceinline__ float fsub_s(float a,float b){float r;asm("v_sub_f32_e32 %0, %1, %2":"=v"(r):"v"(a),"v"(b));return r;}
typedef float f32x2_t __attribute__((ext_vector_type(2))); typedef __bf16 bf16x2_t __attribute__((ext_vector_type(2)));
__device__ __forceinline__ unsigned cvtpk_s(float lo,float hi){f32x2_t v={lo,hi};bf16x2_t b=__builtin_convertvector(v,bf16x2_t);return __builtin_bit_cast(unsigned,b);}
#define WAIT_BAR(N) asm volatile("s_waitcnt vmcnt(" #N ") lgkmcnt(0)\n\ts_barrier":::"memory")

__device__ __forceinline__ void qkt(f32x16&p0,f32x16&p1,const char*Kslot,const bf16x8*qr,const f32x16&negm,int r32,int hi){
  const char*kb=Kslot+hi*1024+r32*16;
  #pragma unroll
  for(int d0=0;d0<4;++d0){
    const bf16x8 b0=*reinterpret_cast<const bf16x8*>(kb+d0*2048);
    const bf16x8 b1=*reinterpret_cast<const bf16x8*>(kb+d0*2048+512);
    if(d0==0){p0=__builtin_amdgcn_mfma_f32_32x32x16_bf16(b0,qr[0],negm,0,0,0);p1=__builtin_amdgcn_mfma_f32_32x32x16_bf16(b1,qr[0],negm,0,0,0);}
    else{p0=__builtin_amdgcn_mfma_f32_32x32x16_bf16(b0,qr[d0],p0,0,0,0);p1=__builtin_amdgcn_mfma_f32_32x32x16_bf16(b1,qr[d0],p1,0,0,0);}}
}
typedef __attribute__((address_space(3))) const char* lds_cptr;
typedef short v4i16_t __attribute__((ext_vector_type(4)));
__device__ __forceinline__ void kload8(bf16x8*kf,lds_cptr kp){
  kf[0]=*(const __attribute__((address_space(3))) bf16x8*)(kp);      kf[1]=*(const __attribute__((address_space(3))) bf16x8*)(kp+512);
  kf[2]=*(const __attribute__((address_space(3))) bf16x8*)(kp+2048); kf[3]=*(const __attribute__((address_space(3))) bf16x8*)(kp+2560);
  kf[4]=*(const __attribute__((address_space(3))) bf16x8*)(kp+4096); kf[5]=*(const __attribute__((address_space(3))) bf16x8*)(kp+4608);
  kf[6]=*(const __attribute__((address_space(3))) bf16x8*)(kp+6144); kf[7]=*(const __attribute__((address_space(3))) bf16x8*)(kp+6656);
}
__device__ __forceinline__ void kload2(bf16x8*kf,lds_cptr kp,int j){ kf[2*j]=*(const __attribute__((address_space(3))) bf16x8*)(kp+j*2048); kf[2*j+1]=*(const __attribute__((address_space(3))) bf16x8*)(kp+j*2048+512); }
__device__ __forceinline__ s16x4 vtr(lds_cptr p){ return __builtin_bit_cast(s16x4,__builtin_amdgcn_ds_read_tr16_b64_v4i16((__attribute__((address_space(3))) v4i16_t*)p)); }
__device__ __forceinline__ float rowmax(const f32x16&p0,const f32x16&p1){
  float a=max3f(p0[0],p0[1],p1[0]),b=max3f(p0[2],p0[3],p1[1]);a=max3f(a,p1[2],p1[3]);
  #pragma unroll
  for(int r=4;r<16;r+=4){a=max3f(a,p0[r],p0[r+1]);b=max3f(b,p0[r+2],p0[r+3]);a=max3f(a,p1[r],p1[r+1]);b=max3f(b,p1[r+2],p1[r+3]);}
  const float m=max2f(a,b);
  auto rr=__builtin_amdgcn_permlane32_swap(__float_as_uint(m),__float_as_uint(m),false,false);
  return max2f(__uint_as_float(rr[0]),__uint_as_float(rr[1]));
}
__device__ __forceinline__ void pv(f32x16*o,int vb,bf16x8 pa0,bf16x8 pa1,bf16x8 pa2,bf16x8 pa3){
  #pragma unroll
  for(int d0=0;d0<2;++d0){s16x4 lo[4],hi[4];
    #pragma unroll
    for(int ks=0;ks<4;++ks){
      asm volatile("ds_read_b64_tr_b16 %0,%1 offset:%c2":"=&v"(lo[ks]):"v"(vb),"i"(d0*4096+ks*1024):"memory");
      asm volatile("ds_read_b64_tr_b16 %0,%1 offset:%c2":"=&v"(hi[ks]):"v"(vb),"i"(d0*4096+ks*1024+512):"memory");}
    asm volatile("s_waitcnt lgkmcnt(0)":::"memory");SBAR();
    #define PK(k) (bf16x8){lo[k][0],lo[k][1],lo[k][2],lo[k][3],hi[k][0],hi[k][1],hi[k][2],hi[k][3]}
    o[d0]=__builtin_amdgcn_mfma_f32_32x32x16_bf16(pa0,PK(0),o[d0],0,0,0);
    o[d0]=__builtin_amdgcn_mfma_f32_32x32x16_bf16(pa1,PK(1),o[d0],0,0,0);
    o[d0]=__builtin_amdgcn_mfma_f32_32x32x16_bf16(pa2,PK(2),o[d0],0,0,0);
    o[d0]=__builtin_amdgcn_mfma_f32_32x32x16_bf16(pa3,PK(3),o[d0],0,0,0);
    #undef PK
  }
}

#ifndef ATTN_STORE16
#define ATTN_STORE16(p,v) (*(u32x4*)(p)=(v))
#endif
template<int THRL> __device__ __forceinline__ void attn_unit(int b,int qb,const bf16*Q,const bf16*__restrict__ K,const bf16*__restrict__ V,bf16*O,char*shm){
  const int tid=threadIdx.x,lane=tid&63,r32=lane&31,hi=lane>>5; const int wid=__builtin_amdgcn_readfirstlane(tid>>6);
  const long rowbase=(long)b*SEQ; const int q0=qb*QB;
  const bf16*Qw=Q+(rowbase+q0+wid*QBLK)*QP;
  const bf16*Kh=K+rowbase*QP,*Vh=V+rowbase*QP;
  const unsigned lds0=(unsigned)(uintptr_t)shm;
  float*wsf=(float*)(shm+LDS_WS)+wid*64;
  const bf16*ksrc=Kh+(long)lane*QP+wid*8;
  const bf16*vsrc=Vh+(long)(16*(wid&3)+(lane>>2))*QP+(wid>>2)*32+(lane&3)*8;
  const unsigned kdst=lds0+LDS_K+wid*1024, vdst=lds0+LDS_V+wid*1024;
  #define DMA_K(t,slot) glds16(ksrc+(long)(t)*KVBLK*QP,(unsigned)__builtin_amdgcn_readfirstlane(kdst+(slot)))
  #define DMA_V(t,slot) glds16(vsrc+(long)(t)*KVBLK*QP,(unsigned)__builtin_amdgcn_readfirstlane(vdst+(slot)))
  const int vb0=(int)(lds0+LDS_V)+((lane>>4)&1)*32+(lane&3)*8+(4*hi+((lane&15)>>2))*64;
  const char*Kbase=shm+LDS_K; bf16x8 kf[8];
  const lds_cptr shm3=(lds_cptr)shm; const lds_cptr kp0=shm3+LDS_K+hi*1024+r32*16; const lds_cptr vp0=shm3+LDS_V+((lane>>4)&1)*32+(lane&3)*8+(4*hi+((lane&15)>>2))*64;
  const int NT=(q0+QB)/KVBLK;
  DMA_K(0,0);DMA_V(0,0);DMA_K(1,SLOTB);
  bf16x8 qr[4];
  #pragma unroll
  for(int d0=0;d0<4;++d0)qr[d0]=*reinterpret_cast<const bf16x8*>(&Qw[(long)r32*QP+d0*16+hi*8]);
  float mhat=0.f,l_reg=0.f;f32x16 o[2];o[0]=f32x16{};o[1]=f32x16{};f32x16 negm=f32x16{};asm volatile("":"+v"(negm));
  const int qrel=wid*QBLK+r32;
  #define CMASK(P0,P1,t) do{int jb_=(t)-(NT-4); if(jb_>=0)cmask(P0,P1,jb_,qrel,hi);}while(0)
  bool resc=false;
  #define START(P0,P1) do{ const float rm=rowmax(P0,P1); resc=false; \
    { const float dl=rm; mhat=fadd_s(mhat,dl); \
      _Pragma("unroll") for(int r=0;r<16;++r){P0[r]=fsub_s(P0[r],dl);P1[r]=fsub_s(P1[r],dl);} \
      _Pragma("unroll") for(int r=0;r<16;++r)negm[r]=-mhat; asm volatile("":"+v"(negm)); } \
    _Pragma("unroll") for(int r=0;r<16;++r)P0[r]=__builtin_amdgcn_exp2f(P0[r]); }while(0)
  #define RESC() do{ if(resc){ asm volatile("s_waitcnt lgkmcnt(0)":::"memory"); \
      _Pragma("unroll") for(int d_=0;d_<2;++d_) _Pragma("unroll") for(int r=0;r<16;++r)o[d_][r]*=wsf[crow(r,hi)]; } }while(0)
  f32x16 pA0,pA1,pB0,pB1;
  int sl_prev=0,sl_cur=0,sl_next=SLOTB;
  #define ROT() do{sl_prev=sl_cur;sl_cur=sl_next;sl_next=(sl_next==(NSLOT-1)*SLOTB)?0:sl_next+SLOTB;}while(0)
  DMA_K(2,2*SLOTB);
  WAIT_BAR(3);
  qkt(pA0,pA1,Kbase,qr,negm,r32,hi);asm volatile("s_nop 15\n\ts_nop 7":"+v"(pA0),"+v"(pA1));CMASK(pA0,pA1,0);
  START(pA0,pA1);
  _Pragma("unroll") for(int r=0;r<16;++r)pA1[r]=__builtin_amdgcn_exp2f(pA1[r]);
  WAIT_BAR(0);
  DMA_K(3,0);DMA_V(1,SLOTB);
  ROT();
  kload8(kf,kp0+sl_cur);
  WAIT_BAR(2);
  s16x4 vlo[8],vhi[8]; u32x4 pw0,pw1,pw2,pw3;
  #define PKW(P,B) cvtpk_s(P[B],P[B+1])
  #define PAF(k) __builtin_bit_cast(bf16x8,pw##k)
  #define VFR(i) (bf16x8){vlo[i][0],vlo[i][1],vlo[i][2],vlo[i][3],vhi[i][0],vhi[i][1],vhi[i][2],vhi[i][3]}
  #define PIN(x) asm volatile("":"+v"(x))
  #define MX3(a,b,c) __builtin_fmaxf(__builtin_fmaxf((a),(b)),(c))
  #define GAPA(MF,A0,A1,A2,A3,W0,W1,PW) do{ MF; sacc+=A0; sacc+=A1; sacc+=A2; sacc+=A3; PIN(sacc); W0; W1; PIN(PW); SBAR(); }while(0)
  #define EX(v) __builtin_amdgcn_exp2f(v)
  #define GAPB(MF,X,B) do{ MF; X[B]=EX(X[B]); X[B+1]=EX(X[B+1]); X[B+2]=EX(X[B+2]); X[B+3]=EX(X[B+3]); PIN(X); SBAR(); }while(0)
  #define VRD(i) do{ vlo[i]=vtr(vp_+(((i)>>2)*4096+((i)&3)*1024)); vhi[i]=vtr(vp_+(((i)>>2)*4096+((i)&3)*1024+512)); }while(0)
  #define KRD(G,j) do{ if(G){ kload2(kf,kp0+sl_next,j); SBAR(); } }while(0)
  #define STEP(C0,C1,P0,P1,t,GK,GV,GL) do{ SBAR(); \
    const lds_cptr vp_=vp0+sl_prev; \
    VRD(0); SBAR(); float sacc=(P0[0]+P0[1]); \
    GAPA(C0=__builtin_amdgcn_mfma_f32_32x32x16_bf16(kf[0],qr[0],negm,0,0,0), P0[2],P0[3],P0[4],P0[5],     pw0[0]=PKW(P0,0), pw0[1]=PKW(P0,2), pw0); \
    VRD(4); SBAR(); GAPA(C1=__builtin_amdgcn_mfma_f32_32x32x16_bf16(kf[1],qr[0],negm,0,0,0), P0[6],P0[7],P0[8],P0[9],     pw0[2]=PKW(P0,4), pw0[3]=PKW(P0,6), pw0); \
    VRD(1); SBAR(); GAPA(C0=__builtin_amdgcn_mfma_f32_32x32x16_bf16(kf[2],qr[1],C0,0,0,0),   P0[10],P0[11],P0[12],P0[13], pw1[0]=PKW(P0,8), pw1[1]=PKW(P0,10), pw1); \
    VRD(5); SBAR(); GAPA(C1=__builtin_amdgcn_mfma_f32_32x32x16_bf16(kf[3],qr[1],C1,0,0,0),   P0[14],P0[15],P1[0],P1[1],   pw1[2]=PKW(P0,12),pw1[3]=PKW(P0,14), pw1); \
    VRD(2); SBAR(); GAPA(C0=__builtin_amdgcn_mfma_f32_32x32x16_bf16(kf[4],qr[2],C0,0,0,0),   P1[2],P1[3],P1[4],P1[5],     pw2[0]=PKW(P1,0), pw2[1]=PKW(P1,2), pw2); \
    VRD(6); SBAR(); GAPA(C1=__builtin_amdgcn_mfma_f32_32x32x16_bf16(kf[5],qr[2],C1,0,0,0),   P1[6],P1[7],P1[8],P1[9],     pw2[2]=PKW(P1,4), pw2[3]=PKW(P1,6), pw2); \
    VRD(3); SBAR(); GAPA(C0=__builtin_amdgcn_mfma_f32_32x32x16_bf16(kf[6],qr[3],C0,0,0,0),   P1[10],P1[11],P1[12],P1[13], pw3[0]=PKW(P1,8), pw3[1]=PKW(P1,10), pw3); \
    VRD(7); SBAR(); GAPA(C1=__builtin_amdgcn_mfma_f32_32x32x16_bf16(kf[7],qr[3],C1,0,0,0),   P1[14],P1[15],0.f,0.f,       pw3[2]=PKW(P1,12),pw3[3]=PKW(P1,14), pw3); \
    l_reg+=sacc; \
    if(GK){DMA_K((t)+3,sl_cur);} if(GV){DMA_V((t)+1,sl_next);} \
    CMASK(C0,C1,t); \
    { float a=MX3(C0[0],C0[1],C1[0]),b=MX3(C0[2],C0[3],C1[1]); a=MX3(a,C1[2],C1[3]); \
      _Pragma("unroll") for(int r=4;r<16;r+=4){a=MX3(a,C0[r],C0[r+1]);b=MX3(b,C0[r+2],C0[r+3]);a=MX3(a,C1[r],C1[r+1]);b=MX3(b,C1[r+2],C1[r+3]);} \
      float rm=__builtin_fmaxf(a,b); { auto rr=__builtin_amdgcn_permlane32_swap(__float_as_uint(rm),__float_as_uint(rm),false,false); rm=__builtin_fmaxf(__uint_as_float(rr[0]),__uint_as_float(rr[1])); } \
      resc=false; \
      if(__builtin_expect(__any(rm>(float)THRL),0)){ const float dl=__builtin_fmaxf(rm,0.f); mhat+=dl; \
        _Pragma("unroll") for(int r=0;r<16;++r){C0[r]-=dl;C1[r]-=dl;} \
        _Pragma("unroll") for(int r=0;r<16;++r)negm[r]=-mhat; asm volatile("":"+v"(negm)); \
        const float f=__builtin_amdgcn_exp2f(-dl); l_reg*=f; if(hi==0)wsf[r32]=f; resc=true; } } \
    SBAR(); \
    GAPB(o[0]=__builtin_amdgcn_mfma_f32_32x32x16_bf16(PAF(0),VFR(0),o[0],0,0,0), C0,0); \
    GAPB(o[1]=__builtin_amdgcn_mfma_f32_32x32x16_bf16(PAF(0),VFR(4),o[1],0,0,0), C0,4); \
    KRD(GL,0); GAPB(o[0]=__builtin_amdgcn_mfma_f32_32x32x16_bf16(PAF(1),VFR(1),o[0],0,0,0), C0,8); \
    KRD(GL,1); GAPB(o[1]=__builtin_amdgcn_mfma_f32_32x32x16_bf16(PAF(1),VFR(5),o[1],0,0,0), C0,12); \
    KRD(GL,2); GAPB(o[0]=__builtin_amdgcn_mfma_f32_32x32x16_bf16(PAF(2),VFR(2),o[0],0,0,0), C1,0); \
    KRD(GL,3); GAPB(o[1]=__builtin_amdgcn_mfma_f32_32x32x16_bf16(PAF(2),VFR(6),o[1],0,0,0), C1,4); \
    GAPB(o[0]=__builtin_amdgcn_mfma_f32_32x32x16_bf16(PAF(3),VFR(3),o[0],0,0,0), C1,8); \
    GAPB(o[1]=__builtin_amdgcn_mfma_f32_32x32x16_bf16(PAF(3),VFR(7),o[1],0,0,0), C1,12); \
    }while(0)
  int t=1;
  #undef CMASK
  #define CMASK(P0,P1,t) do{}while(0)
  for(;t+5<NT;t+=2){
    STEP(pB0,pB1,pA0,pA1,t,true,true,true);     WAIT_BAR(2); RESC(); ROT();
    STEP(pA0,pA1,pB0,pB1,t+1,true,true,true);   WAIT_BAR(2); RESC(); ROT();
  }
  #undef CMASK
  #define CMASK(P0,P1,t) do{int jb_=(t)-(NT-4); if(jb_>=0)cmask(P0,P1,jb_,qrel,hi);}while(0)
  #define ENDW(tt) do{ if((tt)+3<NT){WAIT_BAR(2);} else if((tt)+2<NT){WAIT_BAR(1);} else {WAIT_BAR(0);} }while(0)
  for(;t+1<NT;t+=2){
    STEP(pB0,pB1,pA0,pA1,t,(t+3<NT),(t+1<NT),(t+1<NT));       ENDW(t);   RESC(); ROT();
    STEP(pA0,pA1,pB0,pB1,t+1,(t+4<NT),(t+2<NT),(t+2<NT));     ENDW(t+1); RESC(); ROT();
  }
  STEP(pB0,pB1,pA0,pA1,NT-1,false,false,false); RESC();
  { float sacc=pB0[0]+pB0[1]; _Pragma("unroll") for(int r=2;r<16;++r)sacc+=pB0[r]; _Pragma("unroll") for(int r=0;r<16;++r)sacc+=pB1[r]; l_reg+=sacc;
    pw0=(u32x4){PKW(pB0,0),PKW(pB0,2),PKW(pB0,4),PKW(pB0,6)};pw1=(u32x4){PKW(pB0,8),PKW(pB0,10),PKW(pB0,12),PKW(pB0,14)};pw2=(u32x4){PKW(pB1,0),PKW(pB1,2),PKW(pB1,4),PKW(pB1,6)};pw3=(u32x4){PKW(pB1,8),PKW(pB1,10),PKW(pB1,12),PKW(pB1,14)};
    SBAR(); pv(o,vb0+sl_cur,PAF(0),PAF(1),PAF(2),PAF(3)); }
  #undef PKW
  #undef PAF
  #undef VFR
  #undef PIN
  #undef MX3
  #undef GAPA
  #undef GAPB
  #undef EX
  #undef VRD
  #undef KRD
  #undef STEP
  #undef ENDW
  {auto rr=__builtin_amdgcn_permlane32_swap(__float_as_uint(l_reg),__float_as_uint(l_reg),false,false);l_reg=__uint_as_float(rr[0])+__uint_as_float(rr[1]);}
  if(hi==0)wsf[32+r32]=l_reg;asm volatile("s_waitcnt lgkmcnt(0)":::"memory");
  float rli[16];
  #pragma unroll
  for(int r=0;r<16;++r)rli[r]=__builtin_amdgcn_rcpf(wsf[32+crow(r,hi)]);
  bf16*Ow=O+(rowbase+q0+wid*QBLK)*OP;
  { bf16*stg=(bf16*)(shm+LDS_OST)+wid*2048;
    #pragma unroll
    for(int r=0;r<16;++r){const int orow=crow(r,hi);
      #pragma unroll
      for(int d0=0;d0<2;++d0)stg[orow*64+d0*32+r32]=__float2bfloat16(o[d0][r]*rli[r]);}
    asm volatile("s_waitcnt lgkmcnt(0)":::"memory");
    #pragma unroll
    for(int i=0;i<4;++i){const int row=i*8+(lane>>3),ch=lane&7; const u32x4 v=*(const u32x4*)(stg+row*64+ch*8); ATTN_STORE16(Ow+(long)row*OP+ch*8,v);} }
  asm volatile("s_waitcnt lgkmcnt(0)\n\ts_barrier":::"memory");
  #undef DMA_K
  #undef DMA_V
  #undef CMASK
  #undef START
  #undef RESC
  #undef ROT
}
constexpr int ATTN_LDS_BYTES=LDS_BYTES;
struct AttnTensors { const bf16* U; bf16* O; };
__device__ __forceinline__ void attn_phase_static(char*lds,const AttnTensors&T,int vcu){
  if(vcu>=256)return; const int s=vcu&1,pr=vcu>>1; const int b=pr>>4,ph=pr&15; const int h=ph>>2,c=(ph>>1)&1,vh=ph&1;
  for(int i=0;i<4;++i){ const int qb=(i==0)?(7-s):(i==1)?s:(i==2)?(4+s):(3-s);
    attn_unit<8>(b,qb,T.U+h*128+c*64,T.U+512+h*128+c*64,T.U+1024+h*128+vh*64,T.O+ph*64,lds); }
}
template<int THRL=8> __device__ __forceinline__ void attn_phase_dyn(char*lds,const AttnTensors&T,unsigned*ctr,volatile __attribute__((address_space(3))) unsigned*bcast,int q0){
  for(int dq=0;dq<8;++dq){ const int q=(q0+dq)&7;
    for(;;){
      if(threadIdx.x==0) bcast[0]=__hip_atomic_fetch_add(ctr+64*q,1u,__ATOMIC_RELAXED,__HIP_MEMORY_SCOPE_AGENT);
      __syncthreads(); const unsigned j=bcast[0]; __syncthreads();
      if(j>=128u)break;
      const int pr=q*16+(int)(j>>3),qb=7-(int)(j&7); const int b=pr>>4,ph=pr&15; const int h=ph>>2,c=(ph>>1)&1,vh=ph&1;
      attn_unit<THRL>(b,qb,T.U+h*128+c*64,T.U+512+h*128+c*64,T.U+1024+h*128+vh*64,T.O+ph*64,lds);
    }
  }
}
#undef SBAR
#undef WAIT_BAR
}

namespace scan_body {
#define SLDS __attribute__((address_space(3)))
typedef float sf4 __attribute__((ext_vector_type(4)));
typedef float sf2 __attribute__((ext_vector_type(2)));
typedef unsigned su2 __attribute__((ext_vector_type(2)));
constexpr int TB = 16;
constexpr int OFF_NKK = 0, OFF_DEC = TB * 64, OFF_BB = 2 * TB * 64, OFF_KM = 3 * TB * 64, OFF_RR = 4 * TB * 64, OFF_VV = 5 * TB * 64, IN_FLOATS = 5 * TB * 64 + TB * 32, YP_FLOATS = TB * 512;
constexpr int OFF_YP = 2 * IN_FLOATS;
constexpr int SCAN_LDS_BYTES = (2 * IN_FLOATS + 2 * YP_FLOATS) * 4;
__device__ __forceinline__ float bf_lo(unsigned w) { return __uint_as_float(w << 16); }
__device__ __forceinline__ float bf_hi(unsigned w) { return __uint_as_float(w & 0xffff0000u); }
__device__ __forceinline__ unsigned pk_bf(float lo, float hi) { unsigned a = __builtin_bit_cast(unsigned, lo), b = __builtin_bit_cast(unsigned, hi);
    a = (a + 0x7fffu + ((a >> 16) & 1u)) >> 16; b = (b + 0x7fffu + ((b >> 16) & 1u)) & 0xffff0000u; return a | b; }
template <int CTRL> __device__ __forceinline__ float dpp_add(float x) {
    return x + __builtin_bit_cast(float, __builtin_amdgcn_mov_dpp(__builtin_bit_cast(int, x), CTRL, 0xF, 0xF, true));
}
__device__ __forceinline__ float reduce16(float x) {
    x = dpp_add<0xB1>(x);
    x = dpp_add<0x4E>(x);
    x = dpp_add<0x124>(x);
    x = dpp_add<0x128>(x);
    return x;
}
struct ScanArgs { const unsigned short* U; const unsigned short* E; unsigned short* Y; unsigned short* BT; const float* mu; const float* k_k; const float* k_a; const float* r_k; const float* w0; const float* a0; };
struct PrepRegs { su2 rc, kc, vc, rp, kp, vp, ew, ea; };

__device__ __forceinline__ void prep_load(PrepRegs& R, const ScanArgs& A, int b, int h, int blk, int tid) {
    const int i = tid >> 4, c = h * 64 + (tid & 15) * 4, t = blk * TB + i;
    const size_t tok = (size_t)b * 2048 + t;
    const unsigned short* ur = A.U + tok * 3328 + 1536 + c;
    R.rc = *(const su2*)ur; R.kc = *(const su2*)(ur + 512); R.vc = *(const su2*)(ur + 1024);
    const unsigned short* up = (t > 0) ? ur - 3328 : ur;
    R.rp = *(const su2*)up; R.kp = *(const su2*)(up + 512); R.vp = *(const su2*)(up + 1024);
    R.ew = *(const su2*)(A.E + tok * 1536 + c); R.ea = *(const su2*)(A.E + tok * 1536 + 512 + c);
}
__device__ __forceinline__ void prep_compute(SLDS float* buf, const PrepRegs& R, const ScanArgs& A, int b, int h, int hf, int blk, int tid,
                                             const sf4& mu_r, const sf4& mu_k, const sf4& mu_v, const sf4& kkw, const sf4& kaw, const sf4& rkw, const sf4& w0c, const sf4& a0c) {
    const int i = tid >> 4, sl = tid & 15, t = blk * TB + i;
    const float pz = (t > 0) ? 1.0f : 0.0f;
    sf4 rc = {bf_lo(R.rc.x), bf_hi(R.rc.x), bf_lo(R.rc.y), bf_hi(R.rc.y)}, kc = {bf_lo(R.kc.x), bf_hi(R.kc.x), bf_lo(R.kc.y), bf_hi(R.kc.y)}, vc = {bf_lo(R.vc.x), bf_hi(R.vc.x), bf_lo(R.vc.y), bf_hi(R.vc.y)};
    sf4 rp = {bf_lo(R.rp.x), bf_hi(R.rp.x), bf_lo(R.rp.y), bf_hi(R.rp.y)}, kp = {bf_lo(R.kp.x), bf_hi(R.kp.x), bf_lo(R.kp.y), bf_hi(R.kp.y)}, vp = {bf_lo(R.vp.x), bf_hi(R.vp.x), bf_lo(R.vp.y), bf_hi(R.vp.y)};
    rp = rp * pz; kp = kp * pz; vp = vp * pz;
    const sf4 r = rc + (rp - rc) * mu_r, k = kc + (kp - kc) * mu_k, v = vc + (vp - vc) * mu_v;
    const sf4 zw = w0c + (sf4){bf_lo(R.ew.x), bf_hi(R.ew.x), bf_lo(R.ew.y), bf_hi(R.ew.y)}, za = a0c + (sf4){bf_lo(R.ea.x), bf_hi(R.ea.x), bf_lo(R.ea.y), bf_hi(R.ea.y)};
    sf4 dec, a;
#pragma unroll
    for (int e = 0; e < 4; ++e) { const float nx = -zw[e]; const float sp = fmaxf(nx, 0.f) + __logf(1.0f + __expf(-fabsf(nx)));
        dec[e] = __expf(-__expf(-sp - 0.5f));
        a[e] = __builtin_amdgcn_rcpf(1.0f + __expf(-za[e])); }
    const sf4 kkr = k * kkw;
    const float n2 = reduce16((kkr.x * kkr.x + kkr.y * kkr.y) + (kkr.z * kkr.z + kkr.w * kkr.w));
    const sf4 kk = kkr * (1.0f / fmaxf(sqrtf(n2), 1e-12f));
    const sf4 km = k * (1.0f + (a - 1.0f) * kaw);
    const sf4 rkm = r * km * rkw;
    const float bon = reduce16((rkm.x + rkm.y) + (rkm.z + rkm.w));
    *(SLDS sf4*)&buf[OFF_NKK + i * 64 + sl * 4] = -kk;
    *(SLDS sf4*)&buf[OFF_DEC + i * 64 + sl * 4] = dec;
    *(SLDS sf4*)&buf[OFF_BB + i * 64 + sl * 4] = kk * a;
    *(SLDS sf4*)&buf[OFF_KM + i * 64 + sl * 4] = km;
    *(SLDS sf4*)&buf[OFF_RR + i * 64 + sl * 4] = r;
    if ((sl >> 3) == hf) {
        SLDS float* vv = &buf[OFF_VV + i * 32 + ((sl & 7) >> 1) * 8 + (sl & 1)];
        vv[0] = v.x; vv[2] = v.y; vv[4] = v.z; vv[6] = v.w;
        const sf4 bt = v * bon; su2 o; o.x = pk_bf(bt.x, bt.y); o.y = pk_bf(bt.z, bt.w);
        *(su2*)(A.BT + ((size_t)b * 2048 + t) * 512 + h * 64 + sl * 4) = o;
    }
}
struct StepOps { sf4 nk, dc, bb, km, rr; sf2 v; };
__device__ __forceinline__ void step_load(StepOps& o, const SLDS float* L, int i, int kq, int vo) {
    o.nk = *(const SLDS sf4*)&L[OFF_NKK + i * 64 + kq]; o.dc = *(const SLDS sf4*)&L[OFF_DEC + i * 64 + kq]; o.bb = *(const SLDS sf4*)&L[OFF_BB + i * 64 + kq];
    o.km = *(const SLDS sf4*)&L[OFF_KM + i * 64 + kq]; o.rr = *(const SLDS sf4*)&L[OFF_RR + i * 64 + kq]; o.v = *(const SLDS sf2*)&L[OFF_VV + i * 32 + vo];
}
__device__ __forceinline__ void step_compute(const StepOps& o, sf2& a01, sf2& a23, sf2& b01, sf2& b23, SLDS sf2* yp) {
    const sf2 pa = a01 * o.nk.xy + a23 * o.nk.zw, pb = b01 * o.nk.xy + b23 * o.nk.zw;
    const sf2 va = {o.v.x, o.v.x}, vb = {o.v.y, o.v.y};
    const float sa = reduce16(pa.x + pa.y), sb = reduce16(pb.x + pb.y);
    const sf2 sa2 = {sa, sa}, sb2 = {sb, sb};
    a01 = a01 * o.dc.xy + (sa2 * o.bb.xy + va * o.km.xy);
    a23 = a23 * o.dc.zw + (sa2 * o.bb.zw + va * o.km.zw);
    b01 = b01 * o.dc.xy + (sb2 * o.bb.xy + vb * o.km.xy);
    b23 = b23 * o.dc.zw + (sb2 * o.bb.zw + vb * o.km.zw);
    const sf2 qa = a01 * o.rr.xy + a23 * o.rr.zw, qb = b01 * o.rr.xy + b23 * o.rr.zw;
    *yp = (sf2){qa.x + qa.y, qb.x + qb.y};
}
__device__ __forceinline__ void flush_block(const SLDS float* YPb, const ScanArgs& A, int b, int h, int hf, int blk, int ptid) {
    const int i = ptid >> 4, w = (ptid >> 2) & 3, g = ptid & 3;
    const SLDS sf4* pp = (const SLDS sf4*)&YPb[i * 512 + (w * 64 + g * 16) * 2];
    sf4 acc = pp[0];
#pragma unroll
    for (int q = 1; q < 8; ++q) acc = acc + pp[q];
    unsigned short* yr = A.Y + ((size_t)b * 2048 + blk * TB + i) * 512 + h * 64 + hf * 32 + w * 8 + g;
    const unsigned pk = pk_bf(acc.x + acc.z, acc.y + acc.w);
    yr[0] = (unsigned short)(pk & 0xffffu); yr[4] = (unsigned short)(pk >> 16);
}
__device__ __forceinline__ void scan_unit(SLDS float* L, const ScanArgs& A, int b, int h, int hf) {
    const int tid = threadIdx.x, lane = tid & 63; const int wid = __builtin_amdgcn_readfirstlane(tid >> 6);
    constexpr int NBLK = 2048 / TB;
    if (wid >= 4) {
        const int ptid = tid - 256;
        const int c0 = h * 64 + (ptid & 15) * 4;
        const sf4 mu_r = *(const sf4*)(A.mu + c0), mu_k = *(const sf4*)(A.mu + 512 + c0), mu_v = *(const sf4*)(A.mu + 1024 + c0);
        const sf4 kkw = *(const sf4*)(A.k_k + c0), kaw = *(const sf4*)(A.k_a + c0), rkw = *(const sf4*)(A.r_k + c0), w0c = *(const sf4*)(A.w0 + c0), a0c = *(const sf4*)(A.a0 + c0);
        PrepRegs R;
        prep_load(R, A, b, h, 0, ptid);
        prep_compute(L, R, A, b, h, hf, 0, ptid, mu_r, mu_k, mu_v, kkw, kaw, rkw, w0c, a0c);
        prep_load(R, A, b, h, 1, ptid);
        __syncthreads();
        for (int blk = 0; blk < NBLK; ++blk) {
            if (blk + 1 < NBLK) prep_compute(L + ((blk + 1) & 1) * IN_FLOATS, R, A, b, h, hf, blk + 1, ptid, mu_r, mu_k, mu_v, kkw, kaw, rkw, w0c, a0c);
            if (blk + 2 < NBLK) prep_load(R, A, b, h, blk + 2, ptid);
            if (blk >= 1) flush_block(L + OFF_YP + ((blk - 1) & 1) * YP_FLOATS, A, b, h, hf, blk - 1, ptid);
            __syncthreads();
        }
        flush_block(L + OFF_YP + ((NBLK - 1) & 1) * YP_FLOATS, A, b, h, hf, NBLK - 1, ptid);
    } else {
        sf2 a01 = {0.f, 0.f}, a23 = {0.f, 0.f}, b01 = {0.f, 0.f}, b23 = {0.f, 0.f};
        const int kq = (lane & 15) * 4, vo = wid * 8 + (lane >> 4) * 2;
        __syncthreads();
        for (int blk = 0; blk < NBLK; ++blk) {
            const SLDS float* IN = L + (blk & 1) * IN_FLOATS;
            SLDS sf2* ypl = (SLDS sf2*)(L + OFF_YP + (blk & 1) * YP_FLOATS) + tid;
            StepOps oa, ob, na, nb;
            step_load(oa, IN, 0, kq, vo); step_load(ob, IN, 1, kq, vo);
#pragma unroll
            for (int i = 0; i < TB; i += 2) {
                if (i + 2 < TB) { step_load(na, IN, i + 2, kq, vo); step_load(nb, IN, i + 3, kq, vo); }
                __builtin_amdgcn_sched_barrier(0);
                step_compute(oa, a01, a23, b01, b23, ypl + i * 256);
                step_compute(ob, a01, a23, b01, b23, ypl + (i + 1) * 256);
                __builtin_amdgcn_sched_barrier(0);
                oa = na; ob = nb;
            }
            __syncthreads();
        }
    }
    __syncthreads();
}
}

#ifndef RW_STAGE
#define RW_STAGE 0
#endif
#ifndef PROBE_K
#define PROBE_K (-1)
#endif
namespace rwkv_body {
#ifndef RWS_C
#define RWS_C 0
#endif
#ifndef RWS_C
#define RWS_C 0
#endif
#define RWSTAMP(k) do { if (PROBE_K >= 0 && blockIdx.x == 0 && threadIdx.x == 0 && c == RWS_C) tsp[k] = __builtin_amdgcn_s_memrealtime(); } while (0)
#define RL __attribute__((address_space(3)))
#define RWBAR() do { asm volatile("s_waitcnt lgkmcnt(0)" ::: "memory"); __builtin_amdgcn_s_barrier(); asm volatile("" ::: "memory"); } while (0)
typedef short h8 __attribute__((ext_vector_type(8)));
typedef float f4 __attribute__((ext_vector_type(4)));
typedef unsigned u2 __attribute__((ext_vector_type(2)));
typedef unsigned u4 __attribute__((ext_vector_type(4)));
constexpr int ST = 72, SB = ST * 2, MBY = 64 * SB;
constexpr int O_AH = 0, O_BH = MBY, O_KH = 2 * MBY, O_RH = 3 * MBY, O_KHT = 4 * MBY, O_BHT = 5 * MBY, O_VMT = 6 * MBY, O_YT = 7 * MBY  ,
              O_MP0 = 9 * MBY, O_MPT0 = 10 * MBY, O_MP1 = 11 * MBY, O_MPT1 = 12 * MBY, O_OT = 13 * MBY, O_PC = O_OT + 2048, O_KC = O_PC + 256  , RWKV_LDS_BYTES = O_KC + 2048;
constexpr int O_CL = O_MP0;
constexpr int O_VM = O_MP1;
__device__ __forceinline__ float bflo(unsigned w) { return __uint_as_float(w << 16); }
__device__ __forceinline__ float bfhi(unsigned w) { return __uint_as_float(w & 0xffff0000u); }
typedef float f2t_ __attribute__((ext_vector_type(2))); typedef __bf16 b2t_ __attribute__((ext_vector_type(2)));
__device__ __forceinline__ unsigned pkbf(float lo, float hi) { const f2t_ v = {lo, hi}; const b2t_ b = __builtin_convertvector(v, b2t_); return __builtin_bit_cast(unsigned, b); }
template <int CTRL> __device__ __forceinline__ float dppadd(float x) { return x + __builtin_bit_cast(float, __builtin_amdgcn_mov_dpp(__builtin_bit_cast(int, x), CTRL, 0xF, 0xF, true)); }
__device__ __forceinline__ float reduce8(float x) { x = dppadd<0xB1>(x); x = dppadd<0x4E>(x); x = dppadd<0x141>(x); return x; }
__device__ __forceinline__ h8 ldfrag(const RL char* base, int row0, int ks, int lane) { return *(const RL h8*)(base + (row0 + (lane & 15)) * SB + ks * 64 + (lane >> 4) * 16); }
__device__ __forceinline__ void mma2(f4& acc, const RL char* A, int am0, const RL char* B, int bn0, int lane) {
    acc = __builtin_amdgcn_mfma_f32_16x16x32_bf16(ldfrag(A, am0, 0, lane), ldfrag(B, bn0, 0, lane), acc, 0, 0, 0);
    acc = __builtin_amdgcn_mfma_f32_16x16x32_bf16(ldfrag(A, am0, 1, lane), ldfrag(B, bn0, 1, lane), acc, 0, 0, 0);
}
__device__ __forceinline__ void mma2p(f4& acc0, f4& acc1, const RL char* A, int am0, const RL char* B, int bn0, int lane) {
    const h8 a0 = ldfrag(A, am0, 0, lane), a1 = ldfrag(A, am0, 1, lane);
    acc0 = __builtin_amdgcn_mfma_f32_16x16x32_bf16(a0, ldfrag(B, bn0, 0, lane), acc0, 0, 0, 0); acc1 = __builtin_amdgcn_mfma_f32_16x16x32_bf16(a0, ldfrag(B, bn0 + 16, 0, lane), acc1, 0, 0, 0);
    acc0 = __builtin_amdgcn_mfma_f32_16x16x32_bf16(a1, ldfrag(B, bn0, 1, lane), acc0, 0, 0, 0); acc1 = __builtin_amdgcn_mfma_f32_16x16x32_bf16(a1, ldfrag(B, bn0 + 16, 1, lane), acc1, 0, 0, 0);
}
__device__ __forceinline__ void storeT(RL char* dst, int m0, int n0, const f4& acc, int lane) {
    u2 w; w.x = pkbf(acc[0], acc[1]); w.y = pkbf(acc[2], acc[3]);
    *(RL u2*)(dst + (n0 + (lane & 15)) * SB + (m0 + 4 * (lane >> 4)) * 2) = w;
}
struct Args { unsigned long long* tsp_; const unsigned short* U; const unsigned short* E; unsigned short* Y; unsigned short* BT; unsigned char* GH; unsigned char* Q1; unsigned char* Q2;
              const float* mu; const float* k_k; const float* k_a; const float* r_k; const float* w0; const float* a0; };
__device__ __forceinline__ unsigned char* qptr(const Args& A, int cid) { return cid < 1024 ? A.Q1 + (size_t)cid * 8192 : A.Q2 + (size_t)(cid - 1024) * 8192; }

struct ChunkLoads { u4 rc, kc, vc, rp, kp, vp, ew, ea; };
__device__ __forceinline__ void chunk_consts_to_lds(RL char* L, const Args& A, int h) {
    const int tid = threadIdx.x; RL float* kc = (RL float*)(L + O_KC);
    if (tid < 64) { const int c = h * 64 + tid; kc[tid] = A.mu[c]; kc[64 + tid] = A.mu[512 + c]; kc[128 + tid] = A.mu[1024 + c]; kc[192 + tid] = A.k_k[c]; kc[256 + tid] = A.k_a[c]; kc[320 + tid] = A.r_k[c]; kc[384 + tid] = A.w0[c]; kc[448 + tid] = A.a0[c]; }
}
__device__ __forceinline__ void chunk_load(ChunkLoads& R, const Args& A, int b, int h, int c) {
    const int tid = threadIdx.x, ti = tid >> 3, ch0 = 8 * (tid & 7), t = c * 64 + ti;
    const size_t tok = (size_t)b * 2048 + t;
    const unsigned short* ur = A.U + tok * 3328 + 1536 + h * 64 + ch0;
    R.rc = *(const u4*)ur; R.kc = *(const u4*)(ur + 512); R.vc = *(const u4*)(ur + 1024);
    const unsigned short* up = (t > 0) ? ur - 3328 : ur;
    R.rp = *(const u4*)up; R.kp = *(const u4*)(up + 512); R.vp = *(const u4*)(up + 1024);
    R.ew = *(const u4*)(A.E + tok * 1536 + h * 64 + ch0); R.ea = *(const u4*)(A.E + tok * 1536 + 512 + h * 64 + ch0);
}
#define CVT_LOAD(P_, N_) const f4 cv0 = *(const f4*)(P_), cv1 = *(const f4*)((P_) + (size_t)(N_)), cv2 = *(const f4*)((P_) + (size_t)2 * (N_)), cv3 = *(const f4*)((P_) + (size_t)3 * (N_)), \
                               cv4 = *(const f4*)((P_) + (size_t)4 * (N_)), cv5 = *(const f4*)((P_) + (size_t)5 * (N_)), cv6 = *(const f4*)((P_) + (size_t)6 * (N_)), cv7 = *(const f4*)((P_) + (size_t)7 * (N_))
#define CVT_STORE(Q_, K_) do { _Pragma("unroll") for (int e_ = 0; e_ < 4; ++e_) *(u4*)((Q_) + (size_t)e_ * (K_)) = (u4){pkbf(cv0[e_], cv1[e_]), pkbf(cv2[e_], cv3[e_]), pkbf(cv4[e_], cv5[e_]), pkbf(cv6[e_], cv7[e_])}; } while (0)
__device__ __forceinline__ void rwkv_chunk_task(RL char* L, const Args& A, const ChunkLoads& LD, ChunkLoads& NEXT, bool has_next, int b, int h, int c, int cnext, const float* jWg, const float* jWu, unsigned short* jWGU, int jitem) {
    const int tid = threadIdx.x, lane = tid & 63; const int wid = __builtin_amdgcn_readfirstlane(tid >> 6);
    const int cid = (b * 8 + h) * 32 + c; unsigned long long* tsp = A.tsp_;
    RWSTAMP(17);
    const int ti = tid >> 3, ch0 = 8 * (tid & 7), t = c * 64 + ti;
    const size_t tok = (size_t)b * 2048 + t;
    float r8[8], km8[8], b8[8], nk8[8], v8[8], lw8[8];
    {
        const u4 rc = LD.rc, kc = LD.kc, vc = LD.vc, rp = LD.rp, kp = LD.kp, vp = LD.vp, ew = LD.ew, ea = LD.ea;
        const float pz = (t > 0) ? 1.0f : 0.0f;
        const RL float* kcst = (const RL float*)(L + O_KC) + ch0;
        float cmr[8], cmk[8], cmv[8], ckk[8], cka[8], crk[8], cw0[8], ca0[8];
#define LDC8(dst, off) do { const f4 t0_ = *(const RL f4*)(kcst + (off)), t1_ = *(const RL f4*)(kcst + (off) + 4); dst[0] = t0_[0]; dst[1] = t0_[1]; dst[2] = t0_[2]; dst[3] = t0_[3]; dst[4] = t1_[0]; dst[5] = t1_[1]; dst[6] = t1_[2]; dst[7] = t1_[3]; } while (0)
        LDC8(cmr, 0); LDC8(cmk, 64); LDC8(cmv, 128); LDC8(ckk, 192); LDC8(cka, 256); LDC8(crk, 320); LDC8(cw0, 384); LDC8(ca0, 448);
#undef LDC8
        float kkr[8], ag[8]; float n2 = 0.f, bon = 0.f;
#pragma unroll
        for (int e = 0; e < 8; ++e) {
            const unsigned wr = rc[e >> 1], wk = kc[e >> 1], wv = vc[e >> 1], pr = rp[e >> 1], pk = kp[e >> 1], pv = vp[e >> 1], we = ew[e >> 1], wa = ea[e >> 1];
            const float rcur = (e & 1) ? bfhi(wr) : bflo(wr), kcur = (e & 1) ? bfhi(wk) : bflo(wk), vcur = (e & 1) ? bfhi(wv) : bflo(wv);
            const float rprv = ((e & 1) ? bfhi(pr) : bflo(pr)) * pz, kprv = ((e & 1) ? bfhi(pk) : bflo(pk)) * pz, vprv = ((e & 1) ? bfhi(pv) : bflo(pv)) * pz;
            const float rr = rcur + (rprv - rcur) * cmr[e], kk_ = kcur + (kprv - kcur) * cmk[e], vv = vcur + (vprv - vcur) * cmv[e];
            const float zw = cw0[e] + ((e & 1) ? bfhi(we) : bflo(we)), za = ca0[e] + ((e & 1) ? bfhi(wa) : bflo(wa));
            const float nx = -zw; const float sp = fmaxf(nx, 0.f) + __logf(1.0f + __expf(-fabsf(nx)));
            lw8[e] = -__expf(-sp - 0.5f);
            ag[e] = __builtin_amdgcn_rcpf(1.0f + __expf(-za));
            kkr[e] = kk_ * ckk[e]; n2 += kkr[e] * kkr[e];
            km8[e] = kk_ * (1.0f + (ag[e] - 1.0f) * cka[e]);
            r8[e] = rr; v8[e] = vv; bon += rr * km8[e] * crk[e];
        }
        n2 = reduce8(n2); bon = reduce8(bon);
        const float inv = 1.0f / fmaxf(sqrtf(n2), 1e-12f);
#pragma unroll
        for (int e = 0; e < 8; ++e) { const float kk = kkr[e] * inv; nk8[e] = -kk; b8[e] = kk * ag[e]; }
        u4 bo; bo.x = pkbf(bon * v8[0], bon * v8[1]); bo.y = pkbf(bon * v8[2], bon * v8[3]); bo.z = pkbf(bon * v8[4], bon * v8[5]); bo.w = pkbf(bon * v8[6], bon * v8[7]);
        *(u4*)(A.BT + tok * 512 + h * 64 + ch0) = bo;
        RL float* cl = (RL float*)(L + O_CL) + ti * 64 + ch0;
        *(RL f4*)cl = (f4){lw8[0], lw8[1], lw8[2], lw8[3]}; *(RL f4*)(cl + 4) = (f4){lw8[4], lw8[5], lw8[6], lw8[7]};
    }
    if (has_next) chunk_load(NEXT, A, b, h, cnext);
    const int citem = jitem >= 0 ? jitem : 0;
    const int ce_ = citem >> 9, cmat = (citem >> 8) & 1, cit = citem & 255; const int ck0 = 64 * (cit >> 4), cn0 = 32 * (cit & 15);
    const float* cvp = (cmat ? jWu : jWg) + (size_t)ce_ * 1024 * 512 + (size_t)(ck0 + 8 * (lane >> 3)) * 512 + cn0 + 4 * (lane & 7);
    CVT_LOAD(cvp, 512);
    RWBAR(); RWSTAMP(23);
    {
        RL float* cl = (RL float*)(L + O_CL); RL float* ot = (RL float*)(L + O_OT);
        const int ch = tid & 63, oc = tid >> 6;
        float run = 0.f;
#pragma unroll
        for (int j = 0; j < 8; ++j) { run += cl[(8 * oc + j) * 64 + ch]; cl[(8 * oc + j) * 64 + ch] = run; }
        ot[oc * 64 + ch] = run;
    }
    RWBAR(); RWSTAMP(24);
    {
        const RL float* cl = (const RL float*)(L + O_CL) + ti * 64 + ch0; const RL float* ot = (const RL float*)(L + O_OT) + ch0;
        f4 c0 = *(const RL f4*)cl, c1 = *(const RL f4*)(cl + 4);
#pragma unroll 1
        for (int o = 0; o < wid; ++o) { c0 = c0 + *(const RL f4*)(ot + o * 64); c1 = c1 + *(const RL f4*)(ot + o * 64 + 4); }
        if (ti == 63) { RL float* pc = (RL float*)(L + O_PC) + ch0; *(RL f4*)pc = (f4){__expf(c0[0]), __expf(c0[1]), __expf(c0[2]), __expf(c0[3])}; *(RL f4*)(pc + 4) = (f4){__expf(c1[0]), __expf(c1[1]), __expf(c1[2]), __expf(c1[3])}; }
        const float cl8[8] = {c0[0], c0[1], c0[2], c0[3], c1[0], c1[1], c1[2], c1[3]};
        float ah[8], bh[8], kh[8], rh[8];
#pragma unroll
        for (int e = 0; e < 8; ++e) { const float P = __expf(cl8[e]), Pp = __expf(cl8[e] - lw8[e]), iP = __expf(-cl8[e]);
            ah[e] = nk8[e] * Pp; bh[e] = b8[e] * iP; kh[e] = km8[e] * iP; rh[e] = r8[e] * P; }
        const int off = ti * SB + ch0 * 2;
        *(RL u4*)(L + O_AH + off) = (u4){pkbf(ah[0], ah[1]), pkbf(ah[2], ah[3]), pkbf(ah[4], ah[5]), pkbf(ah[6], ah[7])};
        *(RL u4*)(L + O_BH + off) = (u4){pkbf(bh[0], bh[1]), pkbf(bh[2], bh[3]), pkbf(bh[4], bh[5]), pkbf(bh[6], bh[7])};
        *(RL u4*)(L + O_KH + off) = (u4){pkbf(kh[0], kh[1]), pkbf(kh[2], kh[3]), pkbf(kh[4], kh[5]), pkbf(kh[6], kh[7])};
        *(RL u4*)(L + O_RH + off) = (u4){pkbf(rh[0], rh[1]), pkbf(rh[2], rh[3]), pkbf(rh[4], rh[5]), pkbf(rh[6], rh[7])};
        *(RL u4*)(L + O_VM + off) = (u4){pkbf(v8[0], v8[1]), pkbf(v8[2], v8[3]), pkbf(v8[4], v8[5]), pkbf(v8[6], v8[7])};
    }
    RWBAR(); RWSTAMP(25);
    {
        const int k = tid & 63, og = tid >> 6;
        const int srcs[4] = {O_KH, O_BH, O_VM, O_AH}, dsts[4] = {O_KHT, O_BHT, O_VMT, O_YT};
#pragma unroll
        for (int q = 0; q < 4; ++q) {
            unsigned short e[8];
#pragma unroll
            for (int j = 0; j < 8; ++j) e[j] = *(const RL unsigned short*)(L + srcs[q] + (8 * og + j) * SB + k * 2);
            *(RL u4*)(L + dsts[q] + k * SB + og * 16) = (u4){(unsigned)e[0] | ((unsigned)e[1] << 16), (unsigned)e[2] | ((unsigned)e[3] << 16), (unsigned)e[4] | ((unsigned)e[5] << 16), (unsigned)e[6] | ((unsigned)e[7] << 16)};
        }
    }
    RWBAR(); RWSTAMP(18);
    const int mb = wid & 3, nb0 = 2 * (wid >> 2);
    const int lm = 4 * (lane >> 4), ln = lane & 15;
    {
        const int m_ = 16 * mb + lm, na = 16 * nb0 + ln, nb_ = na + 16;
        f4 c1a = {0.f, 0.f, 0.f, 0.f}, c1b = c1a, c2a = c1a, c2b = c1a, c3a = c1a, c3b = c1a;
        mma2p(c1a, c1b, L + O_BH, 16 * mb, L + O_AH, 16 * nb0, lane);
        mma2p(c2a, c2b, L + O_AH, 16 * mb, L + O_BH, 16 * nb0, lane);
        mma2p(c3a, c3b, L + O_KH, 16 * mb, L + O_AH, 16 * nb0, lane);
#pragma unroll
        for (int q = 0; q < 4; ++q) { if (!(na > m_ + q)) { c1a[q] = 0.f; c3a[q] = 0.f; } if (!(m_ + q > na)) c2a[q] = 0.f;
                                      if (!(nb_ > m_ + q)) { c1b[q] = 0.f; c3b[q] = 0.f; } if (!(m_ + q > nb_)) c2b[q] = 0.f; }
        storeT(L + O_MP0, 16 * mb, 16 * nb0, c1a, lane); storeT(L + O_MPT0, 16 * mb, 16 * nb0, c2a, lane); storeT(L + O_MP1, 16 * mb, 16 * nb0, c3a, lane);
        storeT(L + O_MP0, 16 * mb, 16 * nb0 + 16, c1b, lane); storeT(L + O_MPT0, 16 * mb, 16 * nb0 + 16, c2b, lane); storeT(L + O_MP1, 16 * mb, 16 * nb0 + 16, c3b, lane);
    }
    RWBAR();
    {   f4 cxa = {0.f, 0.f, 0.f, 0.f}, cxb = cxa; mma2p(cxa, cxb, L + O_MP1, 16 * mb, L + O_VMT, 16 * nb0, lane);
        storeT(L + O_YT + 64 * SB, 16 * mb, 16 * nb0, cxa, lane); storeT(L + O_YT + 64 * SB, 16 * mb, 16 * nb0 + 16, cxb, lane); }
    RWBAR();
    {
        f4 acc[2][4];
        if (wid < 4) {
#pragma unroll
            for (int cbk = 0; cbk < 2; ++cbk) { const RL char* yrow = L + O_YT + (32 * wid + 16 * cbk + ln) * SB;
#pragma unroll
                for (int ib = 0; ib < 4; ++ib) { const u2 w = *(const RL u2*)(yrow + (16 * ib + lm) * 2); acc[cbk][ib] = (f4){bflo(w.x), bfhi(w.x), bflo(w.y), bfhi(w.y)}; } }
        }
#pragma unroll
        for (int lev = 0; lev < 6; ++lev) {
            const RL char* Mp = L + ((lev & 1) ? O_MP1 : O_MP0); const RL char* MpT = L + ((lev & 1) ? O_MPT1 : O_MPT0);
            RL char* Mn = L + ((lev & 1) ? O_MP0 : O_MP1); RL char* MnT = L + ((lev & 1) ? O_MPT0 : O_MPT1);
            if (wid < 4) {
                const h8 ya0 = ldfrag(L + O_YT, 32 * wid, 0, lane), ya1 = ldfrag(L + O_YT, 32 * wid, 1, lane), yb0 = ldfrag(L + O_YT, 32 * wid + 16, 0, lane), yb1 = ldfrag(L + O_YT, 32 * wid + 16, 1, lane);
#pragma unroll
                for (int ib = 0; ib < 4; ++ib) {
                    const h8 m0 = ldfrag(Mp, 16 * ib, 0, lane), m1 = ldfrag(Mp, 16 * ib, 1, lane);
                    acc[0][ib] = __builtin_amdgcn_mfma_f32_16x16x32_bf16(m0, ya0, acc[0][ib], 0, 0, 0); acc[1][ib] = __builtin_amdgcn_mfma_f32_16x16x32_bf16(m0, yb0, acc[1][ib], 0, 0, 0);
                    acc[0][ib] = __builtin_amdgcn_mfma_f32_16x16x32_bf16(m1, ya1, acc[0][ib], 0, 0, 0); acc[1][ib] = __builtin_amdgcn_mfma_f32_16x16x32_bf16(m1, yb1, acc[1][ib], 0, 0, 0);
                }
#pragma unroll
                for (int cbk = 0; cbk < 2; ++cbk)
#pragma unroll
                    for (int ib = 0; ib < 4; ++ib) storeT(L + O_YT, 16 * ib, 32 * wid + 16 * cbk, acc[cbk][ib], lane);
            } else if (lev < 5) {
                const int sm = wid - 4;
                const h8 t0 = ldfrag(MpT, 16 * sm, 0, lane), t1 = ldfrag(MpT, 16 * sm, 1, lane), p0 = ldfrag(Mp, 16 * sm, 0, lane), p1 = ldfrag(Mp, 16 * sm, 1, lane);
#pragma unroll
                for (int nb = 0; nb < 4; ++nb) {
                    const h8 bp0 = ldfrag(Mp, 16 * nb, 0, lane), bp1 = ldfrag(Mp, 16 * nb, 1, lane), bt0 = ldfrag(MpT, 16 * nb, 0, lane), bt1 = ldfrag(MpT, 16 * nb, 1, lane);
                    f4 s1 = {0.f, 0.f, 0.f, 0.f}, s2 = s1;
                    s1 = __builtin_amdgcn_mfma_f32_16x16x32_bf16(t0, bp0, s1, 0, 0, 0); s2 = __builtin_amdgcn_mfma_f32_16x16x32_bf16(p0, bt0, s2, 0, 0, 0);
                    s1 = __builtin_amdgcn_mfma_f32_16x16x32_bf16(t1, bp1, s1, 0, 0, 0); s2 = __builtin_amdgcn_mfma_f32_16x16x32_bf16(p1, bt1, s2, 0, 0, 0);
                    storeT(Mn, 16 * sm, 16 * nb, s1, lane);
                    storeT(MnT, 16 * sm, 16 * nb, s2, lane);
                }
            }
            RWBAR();
        }
    }
    RWSTAMP(19);
    {
        const int m_ = 16 * mb + lm, na = 16 * nb0 + ln, nb_ = na + 16;
        f4 c3a = {0.f, 0.f, 0.f, 0.f}, c3b = c3a, c4a = c3a, c4b = c3a;
        mma2p(c3a, c3b, L + O_KH, 16 * mb, L + O_RH, 16 * nb0, lane); mma2p(c4a, c4b, L + O_BH, 16 * mb, L + O_RH, 16 * nb0, lane);
#pragma unroll
        for (int q = 0; q < 4; ++q) { if (!(m_ + q <= na)) { c3a[q] = 0.f; c4a[q] = 0.f; } if (!(m_ + q <= nb_)) { c3b[q] = 0.f; c4b[q] = 0.f; } }
        storeT(L + O_MP0, 16 * mb, 16 * nb0, c3a, lane); storeT(L + O_MPT0, 16 * mb, 16 * nb0, c4a, lane); storeT(L + O_MP0, 16 * mb, 16 * nb0 + 16, c3b, lane); storeT(L + O_MPT0, 16 * mb, 16 * nb0 + 16, c4b, lane);
    }
    if (jitem >= 0) { unsigned short* cvq = jWGU + (size_t)(ce_ * 1024 + (cn0 >> 7) * 256 + (cn0 & 127) + cmat * 128 + 4 * (lane & 7)) * 1024 + ck0 + 8 * (lane >> 3); CVT_STORE(cvq, 1024); }
    RWBAR();
    RWSTAMP(20);
    {
        unsigned char* gh = A.GH + (size_t)cid * 16384; unsigned char* qq = qptr(A, cid);
        const RL float* pc = (const RL float*)(L + O_PC);
        const RL char* AtT = L + O_YT; const RL char* WT = L + O_YT + 64 * SB;
#pragma unroll
        for (int tt = 0; tt < 2; ++tt) {
            const int nb = nb0 + tt; const int m_ = 16 * mb + lm, n_ = 16 * nb + ln;
            const float pcn = pc[n_];
            f4 g = {0.f, 0.f, 0.f, 0.f}; mma2(g, AtT, 16 * mb, L + O_BHT, 16 * nb, lane);
#pragma unroll
            for (int q = 0; q < 4; ++q) g[q] = (g[q] + ((m_ + q == n_) ? 1.0f : 0.0f)) * pcn;
            *(u2*)(gh + (size_t)n_ * 128 + (size_t)m_ * 2) = (u2){pkbf(g[0], g[1]), pkbf(g[2], g[3])};
            f4 hh = {0.f, 0.f, 0.f, 0.f}; mma2(hh, L + O_VMT, 16 * mb, L + O_KHT, 16 * nb, lane); mma2(hh, WT, 16 * mb, L + O_BHT, 16 * nb, lane);
            *(u2*)(gh + 8192 + ((size_t)(wid * 2 + tt) * 64 + lane) * 8) = (u2){pkbf(hh[0] * pcn, hh[1] * pcn), pkbf(hh[2] * pcn, hh[3] * pcn)};
            f4 qv; { const u2 w = *(const RL u2*)(L + O_RH + n_ * SB + m_ * 2); qv = (f4){bflo(w.x), bfhi(w.x), bflo(w.y), bfhi(w.y)}; }
            mma2(qv, AtT, 16 * mb, L + O_MPT0, 16 * nb, lane);
            *(u2*)(qq + (size_t)n_ * 128 + (size_t)m_ * 2) = (u2){pkbf(qv[0], qv[1]), pkbf(qv[2], qv[3])};
            f4 y0 = {0.f, 0.f, 0.f, 0.f};
            if (RW_STAGE == 0 || RW_STAGE == 1) mma2(y0, L + O_VMT, 16 * mb, L + O_MP0, 16 * nb, lane);
            if (RW_STAGE == 0 || RW_STAGE == 2) mma2(y0, WT, 16 * mb, L + O_MPT0, 16 * nb, lane);
            if (RW_STAGE == 7) mma2(y0, L + O_VMT, 16 * mb, L + O_VMT, 16 * nb, lane);
            if (RW_STAGE == 8) mma2(y0, L + O_VMT, 16 * mb, L + O_RH, 16 * nb, lane);
            if (RW_STAGE == 3) { const u2 w = *(const RL u2*)(L + O_MP0 + n_ * SB + m_ * 2); y0 = (f4){bflo(w.x), bfhi(w.x), bflo(w.y), bfhi(w.y)}; }
            if (RW_STAGE == 4) { const u2 w = *(const RL u2*)(WT + n_ * SB + m_ * 2); y0 = (f4){bflo(w.x), bfhi(w.x), bflo(w.y), bfhi(w.y)}; }
            if (RW_STAGE == 5) { const u2 w = *(const RL u2*)(L + O_VMT + n_ * SB + m_ * 2); y0 = (f4){bflo(w.x), bfhi(w.x), bflo(w.y), bfhi(w.y)}; }
            if (RW_STAGE == 6) { const u2 w = *(const RL u2*)(L + O_RH + n_ * SB + m_ * 2); y0 = (f4){bflo(w.x), bfhi(w.x), bflo(w.y), bfhi(w.y)}; }
            *(u2*)(A.Y + ((size_t)b * 2048 + c * 64 + n_) * 512 + h * 64 + m_) = (u2){pkbf(y0[0], y0[1]), pkbf(y0[2], y0[3])};
        }
    }
    RWBAR();
}

__device__ __forceinline__ void rwkv_seq_head(RL char* L, const Args& A, int b, int h, int mb) {
    const int tid = threadIdx.x, lane = tid & 63; const int wid = __builtin_amdgcn_readfirstlane(tid >> 6);
    const int lm = 4 * (lane >> 4), ln = lane & 15; const bool isS = wid < 4; const int nb = wid & 3;
    RL char* Sb = L;
    for (int i = tid; i < 16 * SB / 4; i += 512) ((RL unsigned*)Sb)[i] = 0u;
    RWBAR();
    const int cid0 = (b * 8 + h) * 32;
    const int hdump = ((4 * (nb >> 1) + mb) * 2 + (nb & 1)) * 64 + lane;
    struct Ops { h8 f0, f1; u2 x; };
#define RB_LOAD(O_, c_) do { const unsigned char* gh_ = A.GH + (size_t)(cid0 + (c_)) * 16384; \
        const unsigned char* src_ = (isS ? gh_ : qptr(A, cid0 + (c_))) + (size_t)(16 * nb + ln) * 128 + (lane >> 4) * 16; \
        O_.f0 = *(const h8*)src_; O_.f1 = *(const h8*)(src_ + 64); \
        O_.x = isS ? *(const u2*)(gh_ + 8192 + (size_t)hdump * 8) : *(const u2*)(A.Y + ((size_t)b * 2048 + (c_) * 64 + 16 * nb + ln) * 512 + h * 64 + 16 * mb + lm); } while (0)
#define RB_STEP(O_, c_) do { \
        const h8 a0 = ldfrag(Sb, 0, 0, lane), a1 = ldfrag(Sb, 0, 1, lane); \
        f4 r = {bflo(O_.x.x), bfhi(O_.x.x), bflo(O_.x.y), bfhi(O_.x.y)}; \
        r = __builtin_amdgcn_mfma_f32_16x16x32_bf16(a0, O_.f0, r, 0, 0, 0); r = __builtin_amdgcn_mfma_f32_16x16x32_bf16(a1, O_.f1, r, 0, 0, 0); \
        if (!isS) *(u2*)(A.Y + ((size_t)b * 2048 + (c_) * 64 + 16 * nb + ln) * 512 + h * 64 + 16 * mb + lm) = (u2){pkbf(r[0], r[1]), pkbf(r[2], r[3])}; \
        if ((c_) + 2 < 32) RB_LOAD(O_, (c_) + 2);                       \
        RWBAR();                                                      \
        if (isS) { RL unsigned short* sp = (RL unsigned short*)(Sb + lm * SB) + 16 * nb + ln; \
            _Pragma("unroll") for (int q = 0; q < 4; ++q) sp[q * ST] = (unsigned short)(pkbf(r[q], 0.f) & 0xffffu); } \
        RWBAR(); } while (0)
    Ops OA_, OB_;
    RB_LOAD(OA_, 0); RB_LOAD(OB_, 1);
    for (int c = 0; c < 32; c += 2) { RB_STEP(OA_, c); RB_STEP(OB_, c + 1); }
#undef RB_LOAD
#undef RB_STEP
}
}


#define GAS __attribute__((address_space(1)))
#define LAS __attribute__((address_space(3)))
typedef unsigned short bf16;
typedef unsigned v4u __attribute__((ext_vector_type(4)));
typedef float f32x4 __attribute__((ext_vector_type(4)));
typedef short bf16x8 __attribute__((ext_vector_type(8)));
typedef GAS unsigned gu32;
typedef GAS unsigned long long gu64;
#define RLX_AGENT __ATOMIC_RELAXED, __HIP_MEMORY_SCOPE_AGENT
#define LDS_WAIT() asm volatile("s_waitcnt lgkmcnt(0)" ::: "memory")
#define VM_WAIT() asm volatile("s_waitcnt vmcnt(0)" ::: "memory")
__device__ __forceinline__ unsigned long long rt() { return __builtin_amdgcn_s_memrealtime(); }
__device__ __forceinline__ unsigned f2bf(float f) { unsigned u = __builtin_bit_cast(unsigned, f); return (u + 0x7fffu + ((u >> 16) & 1u)) >> 16; }
__device__ __forceinline__ unsigned pk2(float lo, float hi) { return f2bf(lo) | (f2bf(hi) << 16); }

#define XB_TMO      128
#define XB_XCNT(j)  (256  + 64 * (j))
#define XB_XSUB(j)  (1280 + 64 * (j))
#define XB_XGEN(j)  (2304 + 64 * (j))
#define XB_TOP      3328
#define XB_TOPGEN   3392
#define XCD_BAR_WORDS 3456
#define XB_SPIN_CAP (1u << 18)

__device__ __forceinline__ unsigned xb_ld(unsigned* p)              { return __hip_atomic_load(p, __ATOMIC_RELAXED, __HIP_MEMORY_SCOPE_AGENT); }
__device__ __forceinline__ unsigned xb_add(unsigned* p, unsigned v) { return __hip_atomic_fetch_add(p, v, __ATOMIC_RELAXED, __HIP_MEMORY_SCOPE_AGENT); }
__device__ __forceinline__ unsigned xb_xcc_id() { return (unsigned)__builtin_amdgcn_s_getreg((3 << 11) | 20) & 0xFu; }
#define XB_SPIN(cond, bar) do { unsigned _sp = 0; while (cond) { __builtin_amdgcn_s_sleep(1); \
    if ((++_sp & 255u) == 0u) { if (xb_ld(&(bar)[XB_TMO])) break; if (_sp > XB_SPIN_CAP) { atomicAdd(&(bar)[XB_TMO], 1u); break; } } } } while (0)

struct XcdBarrier {
    unsigned* bar; unsigned x;
    volatile LAS unsigned* st;
};

__device__ __forceinline__ XcdBarrier xcd_barrier_post(unsigned* bar, volatile LAS unsigned* st) {
    XcdBarrier b; b.bar = bar; b.x = xb_xcc_id(); b.st = st;
    if (threadIdx.x == 0) (void)xb_add(&bar[XB_XCNT(b.x)], 1u);
    return b;
}
__device__ __forceinline__ void xcd_barrier_complete(unsigned* bar, unsigned x, unsigned& nloc, unsigned& nx) {
    const unsigned G = gridDim.x * gridDim.y * gridDim.z;
    unsigned sum, cnt, mine, sp = 0u;
    for (;;) {
        sum = 0u; cnt = 0u; mine = 0u;
#pragma unroll
        for (unsigned j = 0; j < 16; ++j) { const unsigned c = xb_ld(&bar[XB_XCNT(j)]); sum += c; cnt += (c > 0u) ? 1u : 0u; mine = (j == x) ? c : mine; }
        if (sum == G) break;
        __builtin_amdgcn_s_sleep(1);
        if ((++sp & 255u) == 0u) { if (xb_ld(&bar[XB_TMO])) break; if (sp > XB_SPIN_CAP) { atomicAdd(&bar[XB_TMO], 1u); break; } }
    }
    nloc = mine > 0u ? mine : 1u; nx = cnt > 0u ? cnt : 1u;
}

__device__ __forceinline__ void xcd_barrier(const XcdBarrier& b) {
    asm volatile("s_waitcnt vmcnt(0)" ::: "memory");
    __syncthreads();
    if (threadIdx.x == 0) {
        unsigned* bar = b.bar;
        __builtin_amdgcn_s_waitcnt(0);
        unsigned nloc = b.st[0], nx = b.st[1];
        if (nloc == 0u) { xcd_barrier_complete(bar, b.x, nloc, nx); b.st[0] = nloc; b.st[1] = nx; }
        const unsigned old = xb_add(&bar[XB_XSUB(b.x)], 1u);
        const unsigned gen = old / nloc;
        if (old + 1u == (gen + 1u) * nloc) {
            __builtin_amdgcn_fence(__ATOMIC_RELEASE, "agent");
            asm volatile("s_waitcnt vmcnt(0)" ::: "memory");
            const unsigned og = xb_add(&bar[XB_TOP], 1u);
            const unsigned tg = og / nx;
            if (og + 1u == (tg + 1u) * nx) xb_add(&bar[XB_TOPGEN], 1u);
            else XB_SPIN(xb_ld(&bar[XB_TOPGEN]) == tg, bar);
            __builtin_amdgcn_fence(__ATOMIC_ACQUIRE, "agent");
            xb_add(&bar[XB_XGEN(b.x)], 1u);
            asm volatile("s_waitcnt vmcnt(0)" ::: "memory");
        } else {
            XB_SPIN(xb_ld(&bar[XB_XGEN(b.x)]) == gen, bar);
            __builtin_amdgcn_fence(__ATOMIC_ACQUIRE, "agent");
            asm volatile("s_waitcnt vmcnt(0)" ::: "memory");
        }
    }
    __syncthreads();
}

__device__ __forceinline__ void xcd_barrier_local(const XcdBarrier& b) {
    asm volatile("s_waitcnt vmcnt(0)" ::: "memory");
    __syncthreads();
    if (threadIdx.x == 0) {
        unsigned* bar = b.bar;
        __builtin_amdgcn_s_waitcnt(0);
        const unsigned nloc = b.st[0];
        const unsigned old = xb_add(&bar[XB_XSUB(b.x)], 1u);
        const unsigned gen = old / nloc;
        if (old + 1u == (gen + 1u) * nloc) xb_add(&bar[XB_XGEN(b.x)], 1u);
        else XB_SPIN(xb_ld(&bar[XB_XGEN(b.x)]) == gen, bar);
        __builtin_amdgcn_fence(__ATOMIC_ACQUIRE, "agent");
        asm volatile("s_waitcnt vmcnt(0)" ::: "memory");
    }
    __syncthreads();
}

constexpr int BATCH = 8, SEQ = 2048, DM = 1024, M = BATCH * SEQ;
constexpr int DIN = 3328, DRW = 512, RC = 1792;
constexpr int NEXP = 32, DEXP = 512;
constexpr int NWAVES = 8;
constexpr int RING_OFF = 0, RING_BYTES = 131072;
constexpr int LDSCTL_OFF = RING_BYTES, MISC_OFF = LDSCTL_OFF + 320;
constexpr int LDS_BYTES = 147456;
constexpr size_t MBy = 1000000;
constexpr size_t WS_CTL = 0, CTL_ZERO_BYTES = 1 << 20;
constexpr int CW_TMO = 0, CW_CODE = 1, CW_BAR = 4096;

struct Frame {
    LAS unsigned char* lds;
    volatile LAS unsigned* MISC;
    gu32* ctl;
    int tid, lane, wave;
    int vcu, G;
};

__device__ __forceinline__ float wave_sum(float v) {
#pragma unroll
    for (int o = 1; o < 64; o <<= 1) v += __shfl_xor(v, o);
    return v;
}
__device__ __forceinline__ void p0_transpose_item(const float* W, int K, int N, bf16* WT, int row_off, LAS float* scr, int item, int lane) {
    const int nblk = N / 32, kb = item / nblk, nb = item % nblk, k0 = 64 * kb, n0 = 32 * nb;
#pragma unroll 8
    for (int i = 0; i < 32; ++i) { const int kk = 2 * i + (lane >> 5); scr[kk * 33 + (lane & 31)] = W[(size_t)(k0 + kk) * N + n0 + (lane & 31)]; }
    LDS_WAIT(); asm volatile("" ::: "memory");
    const int c = lane & 7;
#pragma unroll
    for (int j = 0; j < 4; ++j) { const int n = (lane >> 3) + 8 * j; const LAS float* s = scr + (8 * c) * 33 + n;
        v4u o; o.x = pk2(s[0 * 33], s[1 * 33]); o.y = pk2(s[2 * 33], s[3 * 33]); o.z = pk2(s[4 * 33], s[5 * 33]); o.w = pk2(s[6 * 33], s[7 * 33]);
        *(GAS v4u*)(WT + (size_t)(row_off + n0 + n) * K + k0 + 8 * c) = o; }
    LDS_WAIT(); asm volatile("" ::: "memory");
}
__device__ __forceinline__ void rms_row_to_bf16(int lane, const float* xrow, const float* g, bf16* orow, float eps) {
    const GAS f32x4* xr = (const GAS f32x4*)xrow + lane;
    const GAS f32x4* gr = (const GAS f32x4*)g + lane;
    f32x4 v[4]; float s = 0.f;
#pragma unroll
    for (int j = 0; j < 4; ++j) { v[j] = xr[64 * j]; s += (v[j].x * v[j].x + v[j].y * v[j].y) + (v[j].z * v[j].z + v[j].w * v[j].w); }
    const float rstd = 1.f / sqrtf(wave_sum(s) * (1.f / DM) + eps);
    GAS unsigned long long* o8 = (GAS unsigned long long*)orow + lane;
#pragma unroll
    for (int j = 0; j < 4; ++j) { const f32x4 gv = gr[64 * j];
        o8[64 * j] = (unsigned long long)pk2(v[j].x * rstd * gv.x, v[j].y * rstd * gv.y) | ((unsigned long long)pk2(v[j].z * rstd * gv.z, v[j].w * rstd * gv.w) << 32); }
}

__device__ __forceinline__ void rms_rows_pipelined(int lane, const float* x, const float* g, bf16* out, int first, int stride, float eps, int nrows = M) {
    const GAS f32x4* gr = (const GAS f32x4*)g + lane;
    const f32x4 g0 = gr[0], g1 = gr[64], g2 = gr[128], g3 = gr[192];
    f32x4 c0, c1, c2, c3;
    if (first < nrows) { const GAS f32x4* xr = (const GAS f32x4*)(x + (size_t)first * DM) + lane; c0 = xr[0]; c1 = xr[64]; c2 = xr[128]; c3 = xr[192]; }
    for (int m = first; m < nrows; m += stride) {
        f32x4 n0 = c0, n1 = c1, n2 = c2, n3 = c3;
        if (m + stride < nrows) { const GAS f32x4* xr = (const GAS f32x4*)(x + (size_t)(m + stride) * DM) + lane; n0 = xr[0]; n1 = xr[64]; n2 = xr[128]; n3 = xr[192]; }
        const float ssq = ((c0.x * c0.x + c0.y * c0.y) + (c0.z * c0.z + c0.w * c0.w)) + ((c1.x * c1.x + c1.y * c1.y) + (c1.z * c1.z + c1.w * c1.w))
                        + ((c2.x * c2.x + c2.y * c2.y) + (c2.z * c2.z + c2.w * c2.w)) + ((c3.x * c3.x + c3.y * c3.y) + (c3.z * c3.z + c3.w * c3.w));
        const float rstd = 1.f / sqrtf(wave_sum(ssq) * (1.f / DM) + eps);
        GAS unsigned long long* o8 = (GAS unsigned long long*)(out + (size_t)m * DM) + lane;
        o8[0]   = (unsigned long long)pk2(c0.x * rstd * g0.x, c0.y * rstd * g0.y) | ((unsigned long long)pk2(c0.z * rstd * g0.z, c0.w * rstd * g0.w) << 32);
        o8[64]  = (unsigned long long)pk2(c1.x * rstd * g1.x, c1.y * rstd * g1.y) | ((unsigned long long)pk2(c1.z * rstd * g1.z, c1.w * rstd * g1.w) << 32);
        o8[128] = (unsigned long long)pk2(c2.x * rstd * g2.x, c2.y * rstd * g2.y) | ((unsigned long long)pk2(c2.z * rstd * g2.z, c2.w * rstd * g2.w) << 32);
        o8[192] = (unsigned long long)pk2(c3.x * rstd * g3.x, c3.y * rstd * g3.y) | ((unsigned long long)pk2(c3.z * rstd * g3.z, c3.w * rstd * g3.w) << 32);
        c0 = n0; c1 = n1; c2 = n2; c3 = n3;
    }
}
struct Args { const float* in[30]; float* out; unsigned char* ws; int ph_lo, ph_hi; };
constexpr size_t WS_U = 2 * MBy;
constexpr size_t DO_XN = 0, DO_WIN = 34 * MBy;
constexpr size_t DO_O = 0;
constexpr size_t DO_Y = 33554432, DO_BT = 50331648;
constexpr size_t WS_E = 112 * MBy;
constexpr size_t WS_LA = 163 * MBy;
constexpr size_t WS_WL = 172 * MBy;
constexpr size_t WS_WOUT = 283 * MBy;
constexpr size_t WS_MIX = 2 * MBy;
constexpr size_t WS_T = WS_MIX;
constexpr size_t WS_WGU = 173 * MBy;
constexpr size_t WS_WD = 241 * MBy;
constexpr size_t WS_ACT = 120 * MBy;
constexpr size_t WS_XS = 36 * MBy;
constexpr size_t WS_YB = 36 * MBy;
constexpr size_t WS_ROWSLOT = 275 * MBy;
constexpr size_t WS_ROWGATE = WS_ROWSLOT + 40960 * 4;
constexpr size_t WS_SLOT_E = WS_ROWGATE + 40960 * 4;
constexpr size_t WS_SLOT_P = WS_SLOT_E + 32768 * 4;
constexpr size_t WS_SLOT_G = WS_SLOT_P + 32768 * 4;
constexpr size_t WS_WRP = 65536;
constexpr size_t WS_ROWTOK = WS_SLOT_G + 32768 * 4;
constexpr size_t WS_LISTS = 277 * MBy;
constexpr size_t WS_END = WS_LISTS + 32 * 16384 * 4;
constexpr size_t WS_GH = 241 * MBy;
constexpr size_t WS_Q1 = (size_t)162500000;
constexpr size_t WS_Q2 = (size_t)274600000;
constexpr size_t WS_TOTAL = 283 * MBy + 2097152;
static_assert(WS_Q2 + 8388608 <= WS_WOUT && WS_END <= WS_TOTAL && WS_GH + 33554432 <= WS_Q2 && WS_Q1 + 8388608 <= 172 * MBy, "ws map");
constexpr int CW_MAP = 10496, CW_MIS = 11072;
constexpr int CW_DBG = 10240;
constexpr int CW_AQ = 8192;
constexpr int CW_CNT = 2048;
constexpr int TILE_E_OFF = LDSCTL_OFF + 1024;
constexpr size_t WS_ROPE = 512 * 1024;
constexpr float QSCALE = 0.125f * 1.4426950408889634f;

__device__ __forceinline__ unsigned long long ldarg(int byte_off) {
    const __attribute__((address_space(4))) unsigned char* kp = (const __attribute__((address_space(4))) unsigned char*)__builtin_amdgcn_kernarg_segment_ptr();
    return *(const volatile __attribute__((address_space(4))) unsigned long long*)(kp + byte_off);
}
#define ARG_IN(i) ((const float*)(const GAS float*)ldarg(8 * (i)))
#define ARG_OUT ((unsigned char*)(GAS unsigned char*)ldarg(240))
#define ARG_WS ((unsigned char*)(GAS unsigned char*)ldarg(248))
static_assert(sizeof(Args) == 264, "Args layout vs ldarg offsets");
__global__ void __launch_bounds__(NWAVES * 64, 2) skel_fwd(Args args) {
    extern __shared__ __attribute__((aligned(16))) unsigned char lds[];
    Frame F;
    F.lds = (LAS unsigned char*)lds;
    F.MISC = (volatile LAS unsigned*)(F.lds + MISC_OFF);
    F.tid = threadIdx.x; F.lane = F.tid & 63; F.wave = __builtin_amdgcn_readfirstlane(F.tid >> 6);
    F.G = gridDim.x; { const int bx = blockIdx.x; F.vcu = (F.G % 8 == 0) ? (bx % 8) * (F.G / 8) + bx / 8 : bx; }
    F.ctl = (gu32*)(ARG_WS + WS_CTL);
    for (int u = F.tid; u < (LDS_BYTES - LDSCTL_OFF) / 4; u += NWAVES * 64) ((LAS unsigned*)(F.lds + LDSCTL_OFF))[u] = 0u;
    __syncthreads();
    XcdBarrier bar = xcd_barrier_post((unsigned*)(F.ctl + CW_BAR), F.MISC + 8);
    if (F.tid == 0) { const unsigned k = blockIdx.x & 7u; const unsigned old = atomicCAS((unsigned*)(F.ctl + CW_MAP + 64 * k), 0u, bar.x + 1u);
        if ((old != 0u && old != bar.x + 1u) || F.G != 256) atomicOr((unsigned*)(F.ctl + CW_MIS), 1u); }
#ifndef LOCAL_BARS
#define LOCAL_BARS 1
#endif
#define PHBAR(loc_) do { if (LOCAL_BARS && (loc_) && F.MISC[10]) xcd_barrier_local(bar); else xcd_barrier(bar); } while (0)
    const int lo = args.ph_lo, hi = args.ph_hi;
#ifndef PROBE_K
#define PROBE_K (-1)
#endif
#ifndef RWKV_DBG
#define RWKV_DBG 0
#endif
#ifndef RW_STAGE
#define RW_STAGE 0
#endif
    constexpr int CW_TS = 9216;
#define STAMP(k) do { if (PROBE_K >= 0 && blockIdx.x == 0 && F.tid == 0) ((GAS unsigned long long*)(F.ctl + CW_TS))[k] = rt(); } while (0)
    STAMP(0);
#define P_U ((bf16*)(ARG_WS + WS_U))
#define IN(k) (lo <= (k) && (k) < hi)
#define BOTH(k) (IN(k) && IN((k) + 1))
    if (IN(0)) {
        unsigned char* ws = ARG_WS; unsigned char* dout = ARG_OUT;
        const float* x = ARG_IN(0); const float* ln1_g = ARG_IN(1); const float* w_in = ARG_IN(2);
        bf16* XN = (bf16*)(dout + DO_XN); bf16* Wt_in = (bf16*)(dout + DO_WIN); float2* rope = (float2*)(ws + WS_ROPE);
        bf16* WL = (bf16*)(ws + WS_WL);
        LAS float* scr = (LAS float*)(F.lds + RING_OFF + F.wave * 16384);
        const int gw = F.vcu * NWAVES + F.wave, NGW = F.G * NWAVES;
        constexpr int I_IN = (DM / 64) * (DIN / 32);
        for (int it = gw; it < I_IN; it += NGW) p0_transpose_item(w_in, DM, DIN, Wt_in, 0, scr, it, F.lane);
        {   const float* w_out = ARG_IN(21); bf16* Wt_out = (bf16*)(ws + WS_WOUT);
            for (int it = (gw + 2048 - (I_IN & 2047)) & 2047; it < (DM / 64) * (DM / 32); it += NGW) p0_transpose_item(w_out, DM, DM, Wt_out, 0, scr, it, F.lane); }
        rms_rows_pipelined(F.lane, x, ln1_g, XN, gw, NGW, 1e-6f);
        {   const float* wup = ARG_IN(12); const float* aup = ARG_IN(14); const float* gup = ARG_IN(15);
            for (int idx = gw * 64 + F.lane; idx < 1536 * 256; idx += NGW * 64) {
                const int n = idx >> 8, j = idx & 255; float v = 0.f;
                if (n < 512) { if (j < 64) v = wup[j * 512 + n]; }
                else if (n < 1024) { if (j >= 64 && j < 128) v = aup[(j - 64) * 512 + (n - 512)]; }
                else { if (j >= 128) v = gup[(j - 128) * 512 + (n - 1024)]; }
                WL[idx] = (bf16)f2bf(v);
            }
        }
        {   const float* g2 = ARG_IN(22); const float* wrg = ARG_IN(23); const float* wre = ARG_IN(25); float* WRP = (float*)(ws + WS_WRP);
            for (int idx = gw * 64 + F.lane; idx < 64 * 3 * 64 * 4; idx += NGW * 64) {
                const int i = idx & 3, l = (idx >> 2) & 63, nt = (idx >> 8) % 3, sgrp = idx / 768;
                const int k = 16 * sgrp + 4 * (l >> 4) + i, n = nt * 16 + (l & 15);
                float v = 0.f; if (n < 32) v = wre[k * 32 + n]; else if (n < 36) v = wrg[k * 4 + (n - 32)];
                WRP[idx] = v * g2[k];
            }
        }
        for (int idx = gw * 64 + F.lane; idx < SEQ * 8; idx += NGW * 64) {
            const int pos = idx >> 3, j = idx & 7;
            const double invrev = j == 0 ? 0.15915494309189535 : j == 1 ? 0.03086376340470123 : j == 2 ? 0.005985185712713705 : j == 3 ? 0.001160663641240061 :
                                  j == 4 ? 0.00022507907903927653 : j == 5 ? 4.364795279280289e-05 : j == 6 ? 8.464330808241401e-06 : 1.6414262627950345e-06;
            const double tr = (double)pos * invrev; const float fr = (float)(tr - floor(tr));
            rope[idx] = make_float2(__builtin_amdgcn_cosf(fr), __builtin_amdgcn_sinf(fr));
        }
        if (BOTH(0)) xcd_barrier(bar); STAMP(1);
    }
    if (F.tid == 0) F.MISC[10] = (__hip_atomic_load((unsigned*)(F.ctl + CW_MIS), __ATOMIC_RELAXED, __HIP_MEMORY_SCOPE_AGENT) == 0u) ? 1u : 0u;
    __syncthreads();
    const int xk = F.vcu >> 5, xj = F.vcu & 31;
    if (IN(1)) {
        unsigned char* dout = ARG_OUT; bf16* XN = (bf16*)(dout + DO_XN); bf16* Wt_in = (bf16*)(dout + DO_WIN); bf16* U = P_U;
        pg8::Gemm g{XN, Wt_in, M, DIN, DM}; pg8::G1Order S; S.init(M, DIN - 256, F.G, (int)blockIdx.x);
        pg8::EpiBf16<0> E{U, DIN, nullptr, 0, 0, 1.f};
        pg8::gemm_phase<pg8::EpiBf16<0>, pg8::G1Order, PG8_ALIGN, PG8_SP2>(F.lds + RING_OFF, g, S, E);
        if (BOTH(1)) PHBAR(true); STAMP(2);
    }
    if (IN(2)) {
        unsigned char* ws = ARG_WS; bf16* U = P_U; const float* mu = ARG_IN(10); bf16* LA = (bf16*)(ws + WS_LA);
        const int NGW = 32 * NWAVES; const int tb = xk * SEQ, tend = tb + SEQ;
        const int lane = F.lane;
        typedef unsigned u32x2v __attribute__((ext_vector_type(2)));
        const f32x4 m4 = *(const GAS f32x4*)(mu + 1536 + lane * 4);
        for (int t0 = tb + xj * NWAVES + F.wave; t0 < tend; t0 += 4 * NGW) {
            u32x2v cw[4], pw[4];
#pragma unroll
            for (int j = 0; j < 4; ++j) { const int t = t0 + j * NGW; const bool ok = t < tend; const int tt = ok ? t : tb; const int pos = tt & (SEQ - 1);
                cw[j] = *(const GAS u32x2v*)(U + (size_t)tt * DIN + 3072 + lane * 4); pw[j] = *(const GAS u32x2v*)(U + (size_t)(pos > 0 ? tt - 1 : tt) * DIN + 3072 + lane * 4); }
#pragma unroll
            for (int j = 0; j < 4; ++j) { const int t = t0 + j * NGW; if (t < tend) { const int pos = t & (SEQ - 1);
                float c4[4] = {__uint_as_float(cw[j].x << 16), __uint_as_float(cw[j].x & 0xffff0000u), __uint_as_float(cw[j].y << 16), __uint_as_float(cw[j].y & 0xffff0000u)};
                float p4[4] = {__uint_as_float(pw[j].x << 16), __uint_as_float(pw[j].x & 0xffff0000u), __uint_as_float(pw[j].y << 16), __uint_as_float(pw[j].y & 0xffff0000u)};
                if (pos == 0) { p4[0] = 0.f; p4[1] = 0.f; p4[2] = 0.f; p4[3] = 0.f; }
                float o4[4];
#pragma unroll
                for (int i = 0; i < 4; ++i) { const float xs = c4[i] + (p4[i] - c4[i]) * m4[i];
                    float r = xs;
                    if (lane < 16) { const float e2 = __expf(-2.0f * fabsf(xs)); const float th = (1.0f - e2) / (1.0f + e2); r = xs < 0.f ? -th : th; }
                    else if (lane >= 32) r = 1.0f / (1.0f + __expf(-xs));
                    o4[i] = r; }
                u32x2v ow; ow.x = pk2(o4[0], o4[1]); ow.y = pk2(o4[2], o4[3]);
                *(GAS u32x2v*)(LA + (size_t)t * 256 + lane * 4) = ow; } }
        }
        if (BOTH(2)) PHBAR(true); STAMP(3);
    }
    if (IN(3)) {
        unsigned char* ws = ARG_WS; bf16* LA = (bf16*)(ws + WS_LA); bf16* WL = (bf16*)(ws + WS_WL); bf16* EB = (bf16*)(ws + WS_E);
        {
            unsigned char* dout = ARG_OUT; const bool big = xj < 8;
            pg8::Gemm g{big ? (const bf16*)(dout + DO_XN) : (const bf16*)LA, big ? (const bf16*)(dout + DO_WIN) : (const bf16*)WL, M, big ? DIN : 1536, big ? DM : 256}; pg8::P3Order S{xk, xj};
            pg8::EpiBf16<0> E{big ? P_U : EB, big ? DIN : 1536, nullptr, 0, 0, 1.f};
            pg8::gemm_phase<pg8::EpiBf16<0>, pg8::P3Order, PG8_ALIGN, PG8_SP2>(F.lds + RING_OFF, g, S, E);
            STAMP(26);
            if (!big) {
                bf16* U = P_U; const float* qg = ARG_IN(3); const float* kg = ARG_IN(4); const float2* rope = (const float2*)(ws + WS_ROPE);
                const int lane = F.lane; const int NGW2 = 24 * NWAVES; const int tb = xk * SEQ, tend = tb + SEQ;
                const GAS f32x4* gp4 = (const GAS f32x4*)((lane < 32 ? qg : kg) + (lane & 3) * 16);
                const f32x4 g0 = gp4[0], g1 = gp4[1], g2 = gp4[2], g3 = gp4[3];
                const float gp[16] = {g0.x, g0.y, g0.z, g0.w, g1.x, g1.y, g1.z, g1.w, g2.x, g2.y, g2.z, g2.w, g3.x, g3.y, g3.z, g3.w};
                for (int t0 = tb + (xj - 8) * NWAVES + F.wave; t0 < tend; t0 += 4 * NGW2) {
                    v4u wa[4], wb[4]; f32x4 rp[4];
#pragma unroll
                    for (int j = 0; j < 4; ++j) { const int t = t0 + j * NGW2; const int tt = t < tend ? t : tb; const GAS v4u* rowp = (const GAS v4u*)(U + (size_t)tt * DIN + lane * 16); wa[j] = rowp[0]; wb[j] = rowp[1];
                        rp[j] = *(const GAS f32x4*)(rope + (tt & (SEQ - 1)) * 8 + 2 * (lane & 3)); }
#pragma unroll
                    for (int j = 0; j < 4; ++j) { const int t = t0 + j * NGW2;
                        float rc[8], rs[8];
#define QB_(x_, c_) __builtin_bit_cast(float, __builtin_amdgcn_mov_dpp(__builtin_bit_cast(int, x_), c_, 0xF, 0xF, true))
                        const float rpx = rp[j][0], rpy = rp[j][1], rpz = rp[j][2], rpw = rp[j][3];
                        rc[0] = QB_(rpx, 0x00); rs[0] = QB_(rpy, 0x00); rc[1] = QB_(rpz, 0x00); rs[1] = QB_(rpw, 0x00);
                        rc[2] = QB_(rpx, 0x55); rs[2] = QB_(rpy, 0x55); rc[3] = QB_(rpz, 0x55); rs[3] = QB_(rpw, 0x55);
                        rc[4] = QB_(rpx, 0xAA); rs[4] = QB_(rpy, 0xAA); rc[5] = QB_(rpz, 0xAA); rs[5] = QB_(rpw, 0xAA);
                        rc[6] = QB_(rpx, 0xFF); rs[6] = QB_(rpy, 0xFF); rc[7] = QB_(rpz, 0xFF); rs[7] = QB_(rpw, 0xFF);
#undef QB_
                        if (t < tend) {
                        float v[16];
                        v[0] = __uint_as_float(wa[j].x << 16); v[1] = __uint_as_float(wa[j].x & 0xffff0000u); v[2] = __uint_as_float(wa[j].y << 16); v[3] = __uint_as_float(wa[j].y & 0xffff0000u);
                        v[4] = __uint_as_float(wa[j].z << 16); v[5] = __uint_as_float(wa[j].z & 0xffff0000u); v[6] = __uint_as_float(wa[j].w << 16); v[7] = __uint_as_float(wa[j].w & 0xffff0000u);
                        v[8] = __uint_as_float(wb[j].x << 16); v[9] = __uint_as_float(wb[j].x & 0xffff0000u); v[10] = __uint_as_float(wb[j].y << 16); v[11] = __uint_as_float(wb[j].y & 0xffff0000u);
                        v[12] = __uint_as_float(wb[j].z << 16); v[13] = __uint_as_float(wb[j].z & 0xffff0000u); v[14] = __uint_as_float(wb[j].w << 16); v[15] = __uint_as_float(wb[j].w & 0xffff0000u);
                        float ss = 0.f;
#pragma unroll
                        for (int i = 0; i < 16; ++i) ss += v[i] * v[i];
                        ss += __shfl_xor(ss, 1); ss += __shfl_xor(ss, 2);
                        const float rstd = 1.0f / sqrtf(ss * (1.0f / 64.0f) + 1e-6f);
#pragma unroll
                        for (int i = 0; i < 16; ++i) v[i] *= rstd * gp[i];
                        if ((lane & 3) == 0) {
#pragma unroll
                            for (int q = 0; q < 8; ++q) { const float x1 = v[q], x2 = v[q + 8]; v[q] = x1 * rc[q] - x2 * rs[q]; v[q + 8] = x2 * rc[q] + x1 * rs[q]; }
                        }
                        if (lane < 32) {
#pragma unroll
                            for (int i = 0; i < 16; ++i) v[i] *= QSCALE;
                        }
                        v4u oa, ob;
                        oa.x = pk2(v[0], v[1]); oa.y = pk2(v[2], v[3]); oa.z = pk2(v[4], v[5]); oa.w = pk2(v[6], v[7]);
                        ob.x = pk2(v[8], v[9]); ob.y = pk2(v[10], v[11]); ob.z = pk2(v[12], v[13]); ob.w = pk2(v[14], v[15]);
                        GAS v4u* rowp = (GAS v4u*)(U + (size_t)t * DIN + lane * 16);
                        rowp[0] = oa; rowp[1] = ob; } }
                }
            }
            STAMP(27);
        }
        if (BOTH(3)) xcd_barrier(bar); STAMP(4);
    }
    if (IN(4)) {
        static_assert(attn_body::ATTN_LDS_BYTES <= RING_BYTES && rwkv_body::RWKV_LDS_BYTES <= RING_BYTES, "phase body LDS vs frame");
        {
            unsigned char* ws = ARG_WS; unsigned char* dout = ARG_OUT;
            const rwkv_body::Args RA{(unsigned long long*)(F.ctl + 9216), P_U, (bf16*)(ws + WS_E), RWKV_DBG ? (bf16*)(ws + WS_WGU) : (bf16*)(dout + DO_Y), RWKV_DBG ? (bf16*)(ws + WS_WGU + 16777216) : (bf16*)(dout + DO_BT), ws + WS_GH, ws + WS_Q1, ws + WS_Q2, ARG_IN(10), ARG_IN(16), ARG_IN(17), ARG_IN(18), ARG_IN(11), ARG_IN(13)};
            if (F.vcu < 256) {
                const int hd = F.vcu >> 2;
                rwkv_body::chunk_consts_to_lds((LAS char*)(F.lds + RING_OFF), RA, hd & 7); __syncthreads();
                rwkv_body::ChunkLoads LA_, LB_; const int c0 = (F.vcu & 3) * 8;
                rwkv_body::chunk_load(LA_, RA, hd >> 3, hd & 7, c0);
#pragma unroll 1
                for (int j = 0; j < 8; j += 2) {
                    const int gwv = F.vcu * NWAVES + F.wave; const float* jWg = ARG_IN(27); const float* jWu = ARG_IN(28); bf16* jWGU = (bf16*)(ws + WS_WGU);
                    rwkv_body::rwkv_chunk_task((LAS char*)(F.lds + RING_OFF), RA, LA_, LB_, true, hd >> 3, hd & 7, c0 + j, c0 + j + 1, jWg, jWu, jWGU, RWKV_DBG ? -1 : j * 2048 + gwv);
                    rwkv_body::rwkv_chunk_task((LAS char*)(F.lds + RING_OFF), RA, LB_, LA_, j + 2 < 8, hd >> 3, hd & 7, c0 + j + 1, c0 + j + 2, jWg, jWu, jWGU, RWKV_DBG ? -1 : (j + 1) * 2048 + gwv);
                }
            }
            PHBAR(true); STAMP(13);
            if (RWKV_DBG != 3 && F.vcu < 256) { const int hd = F.vcu >> 2; rwkv_body::rwkv_seq_head((LAS char*)(F.lds + RING_OFF), RA, hd >> 3, hd & 7, F.vcu & 3); }
            STAMP(16);
        }
        if (RWKV_DBG && (F.vcu & 1) == 0 && F.vcu < 256) {
            unsigned char* ws = ARG_WS; unsigned char* dout = ARG_OUT; const int un = F.vcu >> 1;
            const scan_body::ScanArgs SA{P_U, (bf16*)(ws + WS_E), (bf16*)(dout + DO_Y), (bf16*)(dout + DO_BT), ARG_IN(10), ARG_IN(16), ARG_IN(17), ARG_IN(18), ARG_IN(11), ARG_IN(13)};
            scan_body::scan_unit((LAS float*)(F.lds + RING_OFF), SA, un >> 4, (un >> 1) & 7, un & 1);
        }
        {
        bf16* U = P_U; bf16* OA = (bf16*)(ARG_OUT + DO_O);
        const attn_body::AttnTensors AT{(const attn_body::bf16*)U, (attn_body::bf16*)OA};
        if (RWKV_DBG) attn_body::attn_phase_dyn<8>((char*)lds + RING_OFF, AT, (unsigned*)(F.ctl + CW_AQ), F.MISC, (int)(bar.x & 7u));
        else attn_body::attn_phase_static((char*)lds + RING_OFF, AT, F.vcu);
        }
        if (0) {
            unsigned char* ws = ARG_WS; const int lane = F.lane;
            const int gw = ((F.vcu >> 2) * 3 + (F.vcu & 3) - 1) * NWAVES + F.wave, NGW = (F.G >> 2) * 3 * NWAVES;
            LAS float* scr = (LAS float*)(F.lds + RING_OFF + F.wave * 16384);
            const float* Wg = ARG_IN(27); const float* Wu = ARG_IN(28);
            bf16* WGU = (bf16*)(ws + WS_WGU);
            for (int it = gw; it < 16384; it += NGW) { const int e = it >> 9, mat = (it >> 8) & 1, item = it & 255; const int n0 = 32 * (item & 15);
                p0_transpose_item((mat ? Wu : Wg) + (size_t)e * DM * DEXP, DM, DEXP, WGU, e * 1024 + (n0 >> 7) * 256 + (n0 & 127) - n0 + mat * 128, scr, item, lane); }
        }
        if (BOTH(4)) xcd_barrier(bar); STAMP(5);
    }
    if (IN(5)) {
        unsigned char* ws = ARG_WS; unsigned char* dout = ARG_OUT;
        const bf16* OA = (const bf16*)(dout + DO_O); const bf16* YB = (const bf16*)(dout + DO_Y); const bf16* BT = (const bf16*)(dout + DO_BT);
        const bf16* EB = (const bf16*)(ws + WS_E); bf16* MIX = (bf16*)(ws + WS_MIX);
        const int gw = F.vcu * NWAVES + F.wave, NGW = F.G * NWAVES; const int lane = F.lane; (void)gw; (void)NGW;
        const float lam = __expf(wave_sum(ARG_IN(5)[lane] * ARG_IN(6)[lane])) - __expf(wave_sum(ARG_IN(7)[lane] * ARG_IN(8)[lane])) + 0.2f;
        const float* subg = ARG_IN(9); const float* lng = ARG_IN(19); const float* lnb = ARG_IN(20);
        const f32x4 sgA = *(const GAS f32x4*)(subg + 8 * (lane & 15)), sgB = *(const GAS f32x4*)(subg + 8 * (lane & 15) + 4);
        const f32x4 lgA = *(const GAS f32x4*)(lng + 8 * lane), lgB = *(const GAS f32x4*)(lng + 8 * lane + 4), lbA = *(const GAS f32x4*)(lnb + 8 * lane), lbB = *(const GAS f32x4*)(lnb + 8 * lane + 4);
#define UNPK8(W_, F_) do { F_[0] = __uint_as_float(W_[0] << 16); F_[1] = __uint_as_float(W_[0] & 0xffff0000u); F_[2] = __uint_as_float(W_[1] << 16); F_[3] = __uint_as_float(W_[1] & 0xffff0000u); \
                           F_[4] = __uint_as_float(W_[2] << 16); F_[5] = __uint_as_float(W_[2] & 0xffff0000u); F_[6] = __uint_as_float(W_[3] << 16); F_[7] = __uint_as_float(W_[3] & 0xffff0000u); } while (0)
        float dbg_d = 0.f, dbg_r = 0.f;
        for (int t = xk * SEQ + xj * NWAVES + F.wave; t < (xk + 1) * SEQ; t += 32 * NWAVES) {
            const int h = lane >> 4, e0 = 8 * (lane & 15);
            const v4u w0 = *(const GAS v4u*)(OA + (size_t)t * 1024 + h * 256 + e0), w1 = *(const GAS v4u*)(OA + (size_t)t * 1024 + h * 256 + 128 + e0);
            const v4u wy = *(const GAS v4u*)(YB + (size_t)t * 512 + 8 * lane), wb = *(const GAS v4u*)(BT + (size_t)t * 512 + 8 * lane), wg = *(const GAS v4u*)(EB + (size_t)t * 1536 + 1024 + 8 * lane);
            float o0[8], o1[8], o[8];
            UNPK8(w0, o0); UNPK8(w1, o1);
            float ss = 0.f;
#pragma unroll
            for (int i = 0; i < 8; ++i) { o[i] = o0[i] - lam * o1[i]; ss += o[i] * o[i]; }
            ss = scan_body::reduce16(ss);
            const float rs = 0.8f / sqrtf(ss * (1.0f / 128.0f) + 1e-5f);
            v4u mo; mo.x = pk2(o[0] * rs * sgA.x, o[1] * rs * sgA.y); mo.y = pk2(o[2] * rs * sgA.z, o[3] * rs * sgA.w); mo.z = pk2(o[4] * rs * sgB.x, o[5] * rs * sgB.y); mo.w = pk2(o[6] * rs * sgB.z, o[7] * rs * sgB.w);
            *(GAS v4u*)(MIX + (size_t)t * DM + h * 128 + e0) = mo;
            float y[8], bt[8], gt[8];
            UNPK8(wy, y); UNPK8(wb, bt); UNPK8(wg, gt);
            float sm = ((y[0] + y[1]) + (y[2] + y[3])) + ((y[4] + y[5]) + (y[6] + y[7]));
            sm = scan_body::dpp_add<0xB1>(sm); sm = scan_body::dpp_add<0x4E>(sm); sm = scan_body::dpp_add<0x141>(sm);
            const float mean = sm * (1.0f / 64.0f);
            float sq = 0.f;
#pragma unroll
            for (int i = 0; i < 8; ++i) { y[i] -= mean; sq += y[i] * y[i]; }
            sq = scan_body::dpp_add<0xB1>(sq); sq = scan_body::dpp_add<0x4E>(sq); sq = scan_body::dpp_add<0x141>(sq);
            const float rv = 1.0f / sqrtf(sq * (1.0f / 64.0f) + 64e-5f);
            const float lg8[8] = {lgA.x, lgA.y, lgA.z, lgA.w, lgB.x, lgB.y, lgB.z, lgB.w}, lb8[8] = {lbA.x, lbA.y, lbA.z, lbA.w, lbB.x, lbB.y, lbB.z, lbB.w};
            float r8[8];
#pragma unroll
            for (int i = 0; i < 8; ++i) r8[i] = (y[i] * rv * lg8[i] + lb8[i] + bt[i]) * gt[i];
            v4u ro; ro.x = pk2(r8[0], r8[1]); ro.y = pk2(r8[2], r8[3]); ro.z = pk2(r8[4], r8[5]); ro.w = pk2(r8[6], r8[7]);
            *(GAS v4u*)(MIX + (size_t)t * DM + 512 + 8 * lane) = ro;
            if (RWKV_DBG) {
                const bf16* S2 = (const bf16*)(ws + WS_WGU) + (RWKV_DBG == 2 ? 8388608 : 0); const bool dsel = (RWKV_DBG < 3) || ((t & 2047) < 64);
                const v4u w2 = *(const GAS v4u*)(S2 + (size_t)t * 512 + 8 * lane); const v4u w1_ = (RWKV_DBG == 2) ? wb : wy;
                float a2[8], a1[8]; UNPK8(w2, a2); UNPK8(w1_, a1);
                float dd = 0.f, rr = 0.f;
#pragma unroll
                for (int i = 0; i < 8; ++i) { const float df = a2[i] - a1[i]; dd += (df == df && fabsf(df) < 1e30f) ? df * df : 1e30f; rr += a1[i] * a1[i]; }
                if (dsel) { dbg_d += dd; dbg_r += rr; }
            }
        }
        if (RWKV_DBG) { dbg_d = wave_sum(dbg_d); dbg_r = wave_sum(dbg_r);
            if (lane == 0) { atomicAdd((float*)(F.ctl + CW_DBG), dbg_d); atomicAdd((float*)(F.ctl + CW_DBG + 1), dbg_r); } }
#undef UNPK8
        {
            LAS float* scr = (LAS float*)(F.lds + RING_OFF + F.wave * 16384);
            if (RWKV_DBG) { const float* Wg = ARG_IN(27); const float* Wu = ARG_IN(28); bf16* WGU = (bf16*)(ws + WS_WGU);
                __syncthreads();
                for (int it = gw; it < 16384; it += NGW) { const int e = it >> 9, mat = (it >> 8) & 1, item = it & 255; const int n0 = 32 * (item & 15);
                    p0_transpose_item((mat ? Wu : Wg) + (size_t)e * DM * DEXP, DM, DEXP, WGU, e * 1024 + (n0 >> 7) * 256 + (n0 & 127) - n0 + mat * 128, scr, item, lane); } }
        }
        if (BOTH(5)) PHBAR(true); STAMP(6);
    }
    if (IN(6)) {
        unsigned char* ws = ARG_WS;
        pg8::Gemm g{(const bf16*)(ws + WS_MIX), (const bf16*)(ws + WS_WOUT), M, DM, DM}; pg8::StaticOrder S; S.init(M, DM, F.G, (int)blockIdx.x);
        pg8::EpiResF32 E{ARG_IN(0), (float*)ARG_OUT, DM};
        pg8::gemm_phase<pg8::EpiResF32, pg8::StaticOrder, false, PG8_SP2>(F.lds + RING_OFF, g, S, E);
        if (BOTH(6)) PHBAR(true); STAMP(7);
    }
    if (IN(7)) {
        unsigned char* ws = ARG_WS; const float* hbuf = (const float*)ARG_OUT; const int lane = F.lane;
        const int gw = F.vcu * NWAVES + F.wave, NGW = F.G * NWAVES;
        {   const float* g2 = ARG_IN(22); bf16* T = (bf16*)(ws + WS_T);
            rms_rows_pipelined(lane, hbuf + (size_t)xk * SEQ * DM, g2, T + (size_t)xk * SEQ * DM, xj * NWAVES + F.wave, 32 * NWAVES, 1e-6f, SEQ); }
        STAMP(14);
        {   const float* brg = ARG_IN(24); const float* bre = ARG_IN(26); const GAS f32x4* WRP0 = (const GAS f32x4*)(ws + WS_WRP);
            int* lists = (int*)(ws + WS_LISTS); float* slot_g = (float*)(ws + WS_SLOT_G);
            unsigned* cnt = (unsigned*)(F.ctl + CW_CNT);
            const int r = lane & 15, kq = lane >> 4;
            const int khalf = F.wave >> 2;
            for (int task = xk * 128 + (F.wave & 3) * 32 + xj; task < M / 16; task += M / 16) {
                const int tok0 = task * 16;
                const GAS f32x4* arow = (const GAS f32x4*)(hbuf + (size_t)(tok0 + r) * DM) + kq + khalf * 128;
                const GAS f32x4* WRP = WRP0 + khalf * (32 * 3 * 64);
                f32x4 acc0 = {0.f, 0.f, 0.f, 0.f}, acc1 = acc0, acc2 = acc0; float ssq = 0.f;
                f32x4 ca0, ca1, ca2, ca3, cb0, cb1, cb2, cb3, cb4, cb5, cb6, cb7, cb8, cb9, cb10, cb11;
                f32x4 na0, na1, na2, na3, nb0, nb1, nb2, nb3, nb4, nb5, nb6, nb7, nb8, nb9, nb10, nb11;
#define RT_LD1(A_, B0_, B1_, B2_, sg_) do { A_ = arow[4 * (sg_)]; B0_ = WRP[((sg_) * 3 + 0) * 64 + lane]; B1_ = WRP[((sg_) * 3 + 1) * 64 + lane]; B2_ = WRP[((sg_) * 3 + 2) * 64 + lane]; } while (0)
#define RT_MM1(A_, B0_, B1_, B2_) do { ssq += (A_.x * A_.x + A_.y * A_.y) + (A_.z * A_.z + A_.w * A_.w); \
        acc0 = __builtin_amdgcn_mfma_f32_16x16x4f32(A_.x, B0_.x, acc0, 0, 0, 0); acc1 = __builtin_amdgcn_mfma_f32_16x16x4f32(A_.x, B1_.x, acc1, 0, 0, 0); acc2 = __builtin_amdgcn_mfma_f32_16x16x4f32(A_.x, B2_.x, acc2, 0, 0, 0); \
        acc0 = __builtin_amdgcn_mfma_f32_16x16x4f32(A_.y, B0_.y, acc0, 0, 0, 0); acc1 = __builtin_amdgcn_mfma_f32_16x16x4f32(A_.y, B1_.y, acc1, 0, 0, 0); acc2 = __builtin_amdgcn_mfma_f32_16x16x4f32(A_.y, B2_.y, acc2, 0, 0, 0); \
        acc0 = __builtin_amdgcn_mfma_f32_16x16x4f32(A_.z, B0_.z, acc0, 0, 0, 0); acc1 = __builtin_amdgcn_mfma_f32_16x16x4f32(A_.z, B1_.z, acc1, 0, 0, 0); acc2 = __builtin_amdgcn_mfma_f32_16x16x4f32(A_.z, B2_.z, acc2, 0, 0, 0); \
        acc0 = __builtin_amdgcn_mfma_f32_16x16x4f32(A_.w, B0_.w, acc0, 0, 0, 0); acc1 = __builtin_amdgcn_mfma_f32_16x16x4f32(A_.w, B1_.w, acc1, 0, 0, 0); acc2 = __builtin_amdgcn_mfma_f32_16x16x4f32(A_.w, B2_.w, acc2, 0, 0, 0); } while (0)
                RT_LD1(ca0, cb0, cb1, cb2, 0); RT_LD1(ca1, cb3, cb4, cb5, 1); RT_LD1(ca2, cb6, cb7, cb8, 2); RT_LD1(ca3, cb9, cb10, cb11, 3);
                for (int g = 0; g < 8; ++g) {
                    const int gn = (g + 1 < 8) ? g + 1 : g;
                    RT_LD1(na0, nb0, nb1, nb2, gn * 4); RT_LD1(na1, nb3, nb4, nb5, gn * 4 + 1); RT_LD1(na2, nb6, nb7, nb8, gn * 4 + 2); RT_LD1(na3, nb9, nb10, nb11, gn * 4 + 3);
                    __builtin_amdgcn_sched_barrier(0);
                    RT_MM1(ca0, cb0, cb1, cb2); RT_MM1(ca1, cb3, cb4, cb5); RT_MM1(ca2, cb6, cb7, cb8); RT_MM1(ca3, cb9, cb10, cb11);
                    __builtin_amdgcn_sched_barrier(0);
                    ca0 = na0; ca1 = na1; ca2 = na2; ca3 = na3; cb0 = nb0; cb1 = nb1; cb2 = nb2; cb3 = nb3; cb4 = nb4; cb5 = nb5; cb6 = nb6; cb7 = nb7; cb8 = nb8; cb9 = nb9; cb10 = nb10; cb11 = nb11;
                }
#undef RT_LD1
#undef RT_MM1
                ssq += __shfl_xor(ssq, 16); ssq += __shfl_xor(ssq, 32);
                LAS float* LGT = (LAS float*)(F.lds + RING_OFF + (F.wave & 3) * 8192);
                LAS float* LGh = LGT + khalf * 768;
#pragma unroll
                for (int q = 0; q < 4; ++q) { const int row = 4 * kq + q; LGh[row * 48 + r] = acc0[q]; LGh[row * 48 + 16 + r] = acc1[q]; LGh[row * 48 + 32 + r] = acc2[q]; }
                if (lane < 16) LGT[1536 + khalf * 16 + lane] = ssq;
                LAS unsigned* hist = (LAS unsigned*)(F.lds + RING_OFF + 32768); LAS unsigned* hbase = hist + 32;
                if (F.tid < 32) hist[F.tid] = 0u;
                __syncthreads();
                int ea = 0, eb = 0; unsigned la = 0u, lb = 0u; float ga = 0.f, gb = 0.f;
                if (khalf == 0 && lane < 16) {
                    const LAS float* lg = LGT + lane * 48; const LAS float* lh = LGT + 768 + lane * 48;
                    const float rs = 1.f / sqrtf((LGT[1536 + lane] + LGT[1552 + lane]) * (1.f / DM) + 1e-6f);
                    const float lg0 = (lg[32] + lh[32]) * rs + brg[0], lg1 = (lg[33] + lh[33]) * rs + brg[1], lg2 = (lg[34] + lh[34]) * rs + brg[2], lg3 = (lg[35] + lh[35]) * rs + brg[3];
                    int gs = 0; float gm = lg0;
                    if (lg1 > gm) { gm = lg1; gs = 1; }
                    if (lg2 > gm) { gm = lg2; gs = 2; }
                    if (lg3 > gm) { gm = lg3; gs = 3; }
                    const float pgroup = 1.0f / (expf(lg0 - gm) + expf(lg1 - gm) + expf(lg2 - gm) + expf(lg3 - gm));
                    int i1 = 0, i2 = -1; float v1 = -3.0e38f, v2 = -3.0e38f;
                    for (int q = 0; q < 8; ++q) { const float x = (lg[gs * 8 + q] + lh[gs * 8 + q]) * rs + bre[gs * 8 + q];
                        if (x > v1) { v2 = v1; i2 = i1; v1 = x; i1 = q; } else if (x > v2) { v2 = x; i2 = q; } }
                    if (i2 < 0 || i2 == i1) i2 = (i1 + 1) & 7;
                    const float e2 = expf(v2 - v1);
                    ea = gs * 8 + i1; eb = gs * 8 + i2; ga = pgroup / (1.0f + e2); gb = pgroup * e2 / (1.0f + e2);
                    la = __hip_atomic_fetch_add(hist + ea, 1u, __ATOMIC_RELAXED, __HIP_MEMORY_SCOPE_WORKGROUP);
                    lb = __hip_atomic_fetch_add(hist + eb, 1u, __ATOMIC_RELAXED, __HIP_MEMORY_SCOPE_WORKGROUP);
                }
                __syncthreads();
                if (F.tid < 32) { const unsigned n = hist[F.tid]; hbase[F.tid] = n ? __hip_atomic_fetch_add(cnt + 64 * F.tid, n, __ATOMIC_RELAXED, __HIP_MEMORY_SCOPE_AGENT) : 0u; }
                __syncthreads();
                if (khalf == 0 && lane < 16) {
                    const int tok = tok0 + lane;
                    lists[ea * 16384 + (int)(hbase[ea] + la)] = tok * 2; slot_g[tok * 2] = ga;
                    lists[eb * 16384 + (int)(hbase[eb] + lb)] = tok * 2 + 1; slot_g[tok * 2 + 1] = gb;
                }
                __syncthreads();
            }
        }
        STAMP(15);
        if (BOTH(7)) xcd_barrier(bar); STAMP(8);
    }
    if (IN(8)) { STAMP(9); }
    if (IN(9) || IN(10)) {
        LAS int* tile_e = (LAS int*)(F.lds + TILE_E_OFF);
        int ntiles;
        {   const int lane = F.lane;
            const int mycnt = lane < 32 ? (int)__hip_atomic_load((unsigned*)(F.ctl + CW_CNT) + 64 * lane, __ATOMIC_RELAXED, __HIP_MEMORY_SCOPE_AGENT) : 0;
            const int myt = (mycnt + 255) >> 8;
            int incl = myt;
#pragma unroll
            for (int o = 1; o < 32; o <<= 1) { const int t = __shfl_up(incl, o); if (lane >= o) incl += t; }
            ntiles = __shfl(incl, 31);
            if (F.wave == 0 && lane < 32) { for (int j = 0; j < myt; ++j) { tile_e[incl - myt + j] = lane; tile_e[160 + incl - myt + j] = 256 * j; } tile_e[320 + lane] = mycnt; }
            __syncthreads();
        }
        unsigned char* ws = ARG_WS;
        if (IN(9)) {
            pg8::Gemm g{(const bf16*)(ws + WS_T), (const bf16*)(ws + WS_WGU), 0, 0, DM}; pg8::MoeOrder S{ntiles, F.G, F.vcu, tile_e, (const int*)(ws + WS_LISTS)};
            pg8::EpiSwiGLU E{(bf16*)(ws + WS_ACT)};
            pg8::gemm_phase<pg8::EpiSwiGLU, pg8::MoeOrder, PG8_ALIGN, PG8_SP2, true>(F.lds + RING_OFF, g, S, E);
            {
                const int total = ntiles * 4, maxn = (total + F.G - 1) / F.G, cut = total - (maxn - 1) * F.G;
                int nid = F.G - cut, k = F.vcu - cut; if (nid < 64) { nid = F.G; k = F.vcu; }
                __syncthreads();
                if (k >= 0) { LAS float* scr = (LAS float*)(F.lds + RING_OFF + F.wave * 16384);
                    const float* Wd = ARG_IN(29); bf16* WDT = (bf16*)(ws + WS_WD);
                    for (int it = k * NWAVES + F.wave; it < 8192; it += nid * NWAVES) { const int e = it >> 8, item = it & 255; p0_transpose_item(Wd + (size_t)e * DEXP * DM, DEXP, DM, WDT, e * 1024, scr, item, F.lane); } }
            }
            if (BOTH(9)) xcd_barrier(bar); STAMP(10);
        }
        if (IN(10)) {
            pg8::Gemm g{(const bf16*)(ws + WS_ACT), (const bf16*)(ws + WS_WD), 0, 0, DEXP}; pg8::MoeOrder S{ntiles, F.G, F.vcu, tile_e, nullptr};
            pg8::EpiScatter E{(bf16*)(ws + WS_YB), (const int*)(ws + WS_LISTS), (const float*)(ws + WS_SLOT_G), tile_e};
            pg8::gemm_phase<pg8::EpiScatter, pg8::MoeOrder, PG8_ALIGN, PG8_SP2>(F.lds + RING_OFF, g, S, E);
            if (BOTH(10)) xcd_barrier(bar); STAMP(11);
        }
    }
    if (IN(11)) {
        unsigned char* ws = ARG_WS; float* outp = (float*)ARG_OUT; const bf16* YB = (const bf16*)(ws + WS_YB); const int lane = F.lane;
        const int gw = F.vcu * NWAVES + F.wave, NGW = F.G * NWAVES;
        float dscale = 1.0f;
        if (RWKV_DBG) { const float dd = __hip_atomic_load((float*)(F.ctl + CW_DBG), __ATOMIC_RELAXED, __HIP_MEMORY_SCOPE_AGENT), rr = __hip_atomic_load((float*)(F.ctl + CW_DBG + 1), __ATOMIC_RELAXED, __HIP_MEMORY_SCOPE_AGENT);
            dscale = 1.0f + sqrtf(fminf(dd / fmaxf(rr, 1e-30f), 1e6f)); }
        {
            f32x4 ch[4]; unsigned long long ca[4], cb[4];
#define P11_LOAD(H_, A_, B_, tok_) do { const GAS f32x4* or_ = (const GAS f32x4*)(outp + (size_t)(tok_) * DM); \
                const GAS unsigned long long* y0_ = (const GAS unsigned long long*)(YB + (size_t)(2 * (tok_)) * DM), *y1_ = (const GAS unsigned long long*)(YB + (size_t)(2 * (tok_) + 1) * DM); \
                _Pragma("unroll") for (int j_ = 0; j_ < 4; ++j_) { H_[j_] = or_[64 * j_ + lane]; A_[j_] = y0_[64 * j_ + lane]; B_[j_] = y1_[64 * j_ + lane]; } } while (0)
            if (gw < M) P11_LOAD(ch, ca, cb, gw);
            for (int tok = gw; tok < M; tok += NGW) {
                f32x4 nh[4]; unsigned long long na[4], nb[4];
#pragma unroll
                for (int j = 0; j < 4; ++j) { nh[j] = ch[j]; na[j] = ca[j]; nb[j] = cb[j]; }
                if (tok + NGW < M) P11_LOAD(nh, na, nb, tok + NGW);
                GAS f32x4* orow = (GAS f32x4*)(outp + (size_t)tok * DM);
#pragma unroll
                for (int j = 0; j < 4; ++j) { const int q = 64 * j + lane; f32x4 h = ch[j]; const unsigned long long a = ca[j], b = cb[j];
                    h.x += __uint_as_float((unsigned)a << 16) + __uint_as_float((unsigned)b << 16);
                    h.y += __uint_as_float((unsigned)a & 0xffff0000u) + __uint_as_float((unsigned)b & 0xffff0000u);
                    h.z += __uint_as_float((unsigned)(a >> 32) << 16) + __uint_as_float((unsigned)(b >> 32) << 16);
                    h.w += __uint_as_float((unsigned)(a >> 32) & 0xffff0000u) + __uint_as_float((unsigned)(b >> 32) & 0xffff0000u);
                    if (RWKV_DBG) h = h * dscale;
                    orow[q] = h; }
#pragma unroll
                for (int j = 0; j < 4; ++j) { ch[j] = nh[j]; ca[j] = na[j]; cb[j] = nb[j]; }
            }
#undef P11_LOAD
        }
    }
    STAMP(12);
#ifndef PROBE_MULT
#define PROBE_MULT 4
#endif
    if (PROBE_K >= 0 && blockIdx.x == 0 && F.tid == 0) {
        const GAS unsigned long long* ts = (const GAS unsigned long long*)(F.ctl + CW_TS);
#ifndef PROBE_A
#define PROBE_A PROBE_K
#define PROBE_B (PROBE_K + 1)
#endif
        const unsigned long long d = (ts[PROBE_B] - ts[PROBE_A]) * PROBE_MULT, t0 = rt();
        while (rt() - t0 < d) __builtin_amdgcn_s_sleep(8);
    }
#undef IN
#undef BOTH
}

extern "C" void kernel_launch(void* const* d_in, const int* in_sizes, int n_in, void* d_out, int out_size, void* d_ws, size_t ws_size, hipStream_t stream) {
    static int grid = 0;
    if (grid == 0) {
        int dev = 0, cus = 0;
        if (hipGetDevice(&dev) != hipSuccess || hipDeviceGetAttribute(&cus, hipDeviceAttributeMultiprocessorCount, dev) != hipSuccess) { grid = -1; return; }
        if (hipFuncSetAttribute((const void*)skel_fwd, hipFuncAttributeMaxDynamicSharedMemorySize, LDS_BYTES) != hipSuccess) { grid = -1; return; }
        grid = cus;
        if (n_in != 30 || ws_size < WS_TOTAL || out_size != M * DM) { fprintf(stderr, "kernel_launch: unexpected problem (n_in %d, ws %zu, out %d)\n", n_in, ws_size, out_size); grid = -1; return; }
        if (grid != 256) fprintf(stderr, "kernel_launch: %d CUs; the phase programs assume 256\n", grid);
    }
    if (grid < 0) return;
    (void)hipMemsetAsync((char*)d_ws + WS_CTL, 0, CTL_ZERO_BYTES, stream);
    Args a{};
    for (int i = 0; i < 30; ++i) a.in[i] = (const float*)d_in[i];
    a.out = (float*)d_out; a.ws = (unsigned char*)d_ws; a.ph_lo = 0; a.ph_hi = 12;
    hipLaunchKernelGGL(skel_fwd, dim3(grid), dim3(NWAVES * 64), LDS_BYTES, stream, a);
}
```
